# Optimizing an MI355X kernel written in HIP

```python
import math
import jax, jax.numpy as jnp
from jax import lax
import numpy as np

D_MODEL = 1024
BATCH = 16
SEQ = 2048
DEPTH = 4

CTX_LEN = 256
GRID_W = 64

N_BRANCH = 4
BRANCH_WIDTH = D_MODEL // 4
RET_HEADS = 4
RET_DV = BRANCH_WIDTH // RET_HEADS
RET_DK = RET_DV // 2
RET_CHUNK = 128
S5_WIDTH = BRANCH_WIDTH
S5_GROUP = 16
S5_GROUPS = S5_WIDTH // S5_GROUP
S5_STATE = 64
DIFF_HEADS = 4
DIFF_DV = BRANCH_WIDTH // DIFF_HEADS
DIFF_DH = DIFF_DV // 2
Q_BLOCK = 128
ROPE_BASE = 10000.0
CONV_WIDTH = BRANCH_WIDTH
CONV_K = 31
FFN_DENSE = 2816
N_EXPERTS = 8
TOP_K = 2
FFN_EXPERT = 7 * D_MODEL // 2
EPS = 1e-6

RET_QK = RET_HEADS * RET_DK
RET_VW = RET_HEADS * RET_DV
DIFF_QK = DIFF_HEADS * 2 * DIFF_DH
DIFF_VW = DIFF_HEADS * DIFF_DV
KV_WIDTHS = (RET_QK, RET_VW, S5_WIDTH, DIFF_QK, DIFF_VW)
Q_WIDTHS = (RET_QK, RET_VW, DIFF_QK, 2 * CONV_WIDTH)
N_KV_COLS = sum(KV_WIDTHS)
N_IN_COLS = N_KV_COLS + sum(Q_WIDTHS)

kernel_name = 'hybrid_diffusion_gated_parallel_mixer_trunk'

F32 = jnp.float32


def rms_norm(x, g):
    xf = x.astype(F32)
    y = xf * lax.rsqrt(jnp.mean(xf * xf, axis=-1, keepdims=True) + EPS)
    return (y * g.astype(F32)).astype(x.dtype)


def layer_norm(x):
    xf = x.astype(F32)
    xc = xf - jnp.mean(xf, axis=-1, keepdims=True)
    return xc * lax.rsqrt(jnp.mean(xc * xc, axis=-1, keepdims=True) + EPS)


def modulate(x, g, shift, scale):
    return rms_norm(x, g) * (1 + scale) + shift


def split_cols(z, widths):
    cuts = [int(v) for v in np.cumsum(widths)[:-1]]
    return jnp.split(z, cuts, axis=-1)


def axial_rope(row, col):
    nf = DIFF_DH // 4
    inv = ROPE_BASE ** (-jnp.arange(nf, dtype=F32) / nf)
    ang = jnp.stack([row.astype(F32)[:, None] * inv, col.astype(F32)[:, None] * inv], axis=1)
    return jnp.cos(ang), jnp.sin(ang)


def apply_rope(x, cos, sin):
    nf = DIFF_DH // 4
    xs = x.reshape(x.shape[:-1] + (2, 2, nf))
    x1, x2 = xs[..., 0, :], xs[..., 1, :]
    cs = cos[:, None, None].astype(x.dtype)
    sn = sin[:, None, None].astype(x.dtype)
    out = jnp.stack([x1 * cs - x2 * sn, x2 * cs + x1 * sn], axis=-2)
    return out.reshape(x.shape)


def to_heads(x, n_heads):
    b, t, _ = x.shape
    return x.reshape(b, t, n_heads, -1).transpose(0, 2, 1, 3).astype(F32)


def retention_chunkwise(q, k, v, log_gamma, state0, strict):
    b, h, t, dk = q.shape
    dv = v.shape[-1]
    cs = RET_CHUNK
    n = t // cs
    qc = q.reshape(b, h, n, cs, dk)
    kc = k.reshape(b, h, n, cs, dk)
    vc = v.reshape(b, h, n, cs, dv)
    pos = jnp.arange(cs, dtype=F32)
    dist = pos[:, None] - pos[None, :]
    mask = dist > 0 if strict else dist >= 0
    lg = log_gamma[:, None, None]
    intra_decay = jnp.where(mask, jnp.exp(lg * jnp.where(mask, dist, 0.0)), 0.0)
    scores = jnp.einsum('bhnid,bhnjd->bhnij', qc, kc) * intra_decay[:, None]
    intra = jnp.einsum('bhnij,bhnje->bhnie', scores, vc)
    k_decay = jnp.exp(log_gamma[:, None] * (cs - 1 - pos))
    kv = jnp.einsum('bhnjd,hj,bhnje->nbhde', kc, k_decay, vc)
    chunk_decay = jnp.exp(log_gamma * cs)[None, :, None, None]

    def step(state, kv_n):
        return state * chunk_decay + kv_n, state

    _, states = lax.scan(step, state0, kv)
    q_decay = jnp.exp(log_gamma[:, None] * (pos + 1))
    cross = jnp.einsum('bhnid,hi,nbhde->bhnie', qc, q_decay, states)
    return (intra + cross).reshape(b, h, t, dv)


def retention_bidir(q, k, v, log_gamma, s_f, s_b):
    rev = lambda a: jnp.flip(a, axis=2)
    fwd = retention_chunkwise(q, k, v, log_gamma[0], s_f, False)
    bwd = retention_chunkwise(rev(q), rev(k), rev(v), log_gamma[1], s_b, True)
    return fwd + rev(bwd)


def retention_ctx_states(k, v, log_gamma):
    n = k.shape[2]
    pos = jnp.arange(n, dtype=F32)
    w_f = jnp.exp(log_gamma[0][:, None] * (n - 1 - pos))
    w_b = jnp.exp(log_gamma[1][:, None] * pos)
    s_f = jnp.einsum('bhld,hl,bhle->bhde', k, w_f, v)
    s_b = jnp.einsum('bhld,hl,bhle->bhde', k, w_b, v)
    return s_f, s_b


def retention_out(y, g, w_o):
    b, h, t, dv = y.shape
    y = layer_norm(y).transpose(0, 2, 1, 3).reshape(b, t, h * dv).astype(g.dtype)
    return (jax.nn.silu(g) * y) @ w_o


def cmul(ar, ai, br, bi):
    return ar * br - ai * bi, ar * bi + ai * br


def s5_discretize(a_re, a_im, log_dt):
    a_re = jnp.minimum(a_re.astype(F32), -1e-4)
    a_im = a_im.astype(F32)
    dt = jnp.exp(log_dt.astype(F32))[:, None]
    z_re, z_im = dt * a_re, dt * a_im
    mag = jnp.exp(z_re)
    ab_re, ab_im = mag * jnp.cos(z_im), mag * jnp.sin(z_im)
    den = a_re * a_re + a_im * a_im
    n_re = ab_re - 1.0
    cf_re = (n_re * a_re + ab_im * a_im) / den
    cf_im = (ab_im * a_re - n_re * a_im) / den
    return ab_re, ab_im, cf_re, cf_im, z_re, z_im


def s5_project(u, b_re, b_im):
    bsz, t, _ = u.shape
    uf = u.astype(F32).reshape(bsz, t, S5_GROUPS, S5_GROUP)
    return (jnp.einsum('btgc,gpc->btgp', uf, b_re.astype(F32)),
            jnp.einsum('btgc,gpc->btgp', uf, b_im.astype(F32)))


def s5_ctx_final_state(b_re, b_im, z_re, z_im, reverse):
    n = b_re.shape[1]
    pos = jnp.arange(n, dtype=F32)
    steps = pos if reverse else (n - 1 - pos)
    mag = jnp.exp(steps[:, None, None] * z_re)
    ph = steps[:, None, None] * z_im
    p_re, p_im = mag * jnp.cos(ph), mag * jnp.sin(ph)
    h_re = jnp.einsum('lgp,blgp->bgp', p_re, b_re) - jnp.einsum('lgp,blgp->bgp', p_im, b_im)
    h_im = jnp.einsum('lgp,blgp->bgp', p_re, b_im) + jnp.einsum('lgp,blgp->bgp', p_im, b_re)
    return h_re, h_im


def s5_combine(e1, e2):
    a1r, a1i, b1r, b1i = e1
    a2r, a2i, b2r, b2i = e2
    ar, ai = cmul(a2r, a2i, a1r, a1i)
    br, bi = cmul(a2r, a2i, b1r, b1i)
    return ar, ai, br + b2r, bi + b2i


def s5_scan(b_re, b_im, ab_re, ab_im, h0_re, h0_im, reverse):
    if reverse:
        b_re, b_im = jnp.flip(b_re, axis=1), jnp.flip(b_im, axis=1)
    i_re, i_im = cmul(ab_re, ab_im, h0_re, h0_im)
    b_re = b_re.at[:, 0].add(i_re)
    b_im = b_im.at[:, 0].add(i_im)
    t = b_re.shape[1]
    a_re = jnp.broadcast_to(ab_re, (1, t) + ab_re.shape)
    a_im = jnp.broadcast_to(ab_im, (1, t) + ab_im.shape)
    _, _, h_re, h_im = lax.associative_scan(s5_combine, (a_re, a_im, b_re, b_im), axis=1)
    if reverse:
        h_re, h_im = jnp.flip(h_re, axis=1), jnp.flip(h_im, axis=1)
    return h_re, h_im


def s5_readout(h_re, h_im, u, c_re, c_im, d_skip, w_glu):
    bsz, t, _ = u.shape
    uf = u.astype(F32).reshape(bsz, t, S5_GROUPS, S5_GROUP)
    y = (jnp.einsum('gcp,btgp->btgc', c_re.astype(F32), h_re)
         - jnp.einsum('gcp,btgp->btgc', c_im.astype(F32), h_im)
         + d_skip.astype(F32) * uf)
    y = jax.nn.gelu(y).reshape(bsz, t, S5_WIDTH).astype(u.dtype)
    a, g = jnp.split(y @ w_glu, 2, axis=-1)
    return a * jax.nn.sigmoid(g)


def s5_branch(u, uc, a_re, a_im, log_dt, b_re, b_im, c_re, c_im, d_skip, w_glu, need_ctx):
    bu_re, bu_im = s5_project(u, b_re, b_im)
    bc_re, bc_im = s5_project(uc, b_re, b_im)
    h_re = h_im = hc_re = hc_im = 0.0
    for d in range(2):
        rev = d == 1
        ab_re, ab_im, cf_re, cf_im, z_re, z_im = s5_discretize(a_re[d], a_im[d], log_dt[d])
        xc_re, xc_im = cmul(cf_re, cf_im, bc_re, bc_im)
        h0_re, h0_im = s5_ctx_final_state(xc_re, xc_im, z_re, z_im, rev)
        xl_re, xl_im = cmul(cf_re, cf_im, bu_re, bu_im)
        r_re, r_im = s5_scan(xl_re, xl_im, ab_re, ab_im, h0_re, h0_im, rev)
        h_re, h_im = h_re + r_re, h_im + r_im
        if need_ctx:
            zero = jnp.zeros_like(h0_re)
            r_re, r_im = s5_scan(xc_re, xc_im, ab_re, ab_im, zero, zero, rev)
            hc_re, hc_im = hc_re + r_re, hc_im + r_im
    y = s5_readout(h_re, h_im, u, c_re, c_im, d_skip, w_glu)
    yc = s5_readout(hc_re, hc_im, uc, c_re, c_im, d_skip, w_glu) if need_ctx else None
    return y, yc


def diff_attend(q, k, v, lam):
    s = jnp.einsum('bqhmd,bkhmd->bhmqk', q, k).astype(F32)
    p = jax.nn.softmax(s, axis=-1)
    a = (p[:, :, 0] - lam * p[:, :, 1]).astype(v.dtype)
    return jnp.einsum('bhqk,bkhe->bqhe', a, v)


def diff_out(o, subln_g, w_o, lambda_init):
    b, t, h, e = o.shape
    o = rms_norm(o, subln_g) * (1.0 - lambda_init)
    return o.reshape(b, t, h * e) @ w_o


def diff_branch(q, k, v, kc, vc, qc, cos, sin, lam_p, subln_g, w_o, lambda_init, need_ctx):
    def qk_heads(z):
        return z.reshape(z.shape[0], z.shape[1], DIFF_HEADS, 2, DIFF_DH)

    def v_heads(z):
        return z.reshape(z.shape[0], z.shape[1], DIFF_HEADS, DIFF_DV)

    scale = DIFF_DH ** -0.5
    lp = lam_p.astype(F32)
    lam = jnp.exp(jnp.dot(lp[0], lp[1])) - jnp.exp(jnp.dot(lp[2], lp[3])) + lambda_init
    q = apply_rope(qk_heads(q), cos, sin) * scale
    k = apply_rope(qk_heads(k), cos, sin)
    kc, vc = qk_heads(kc), v_heads(vc)
    k_all = jnp.concatenate([kc, k], axis=1)
    v_all = jnp.concatenate([vc, v_heads(v)], axis=1)
    bsz, t = q.shape[0], q.shape[1]
    n_blk = t // Q_BLOCK
    qb = q.reshape(bsz, n_blk, Q_BLOCK, DIFF_HEADS, 2, DIFF_DH).swapaxes(0, 1)
    o = lax.map(lambda qq: diff_attend(qq, k_all, v_all, lam), qb)
    o = o.swapaxes(0, 1).reshape(bsz, t, DIFF_HEADS, DIFF_DV)
    y = diff_out(o, subln_g, w_o, lambda_init)
    yc = diff_out(diff_attend(qk_heads(qc) * scale, kc, vc, lam), subln_g, w_o, lambda_init) if need_ctx else None
    return y, yc


def conformer_conv(z, dw, db, ln_g, ln_b, w_o):
    a, g = jnp.split(z, 2, axis=-1)
    u = a * jax.nn.sigmoid(g)
    y = lax.conv_general_dilated(
        u, dw[:, None, :].astype(u.dtype), window_strides=(1,),
        padding=((CONV_K // 2, CONV_K // 2),),
        dimension_numbers=('NWC', 'WIO', 'NWC'),
        feature_group_count=CONV_WIDTH) + db
    y = (layer_norm(y) * ln_g.astype(F32) + ln_b.astype(F32)).astype(z.dtype)
    return jax.nn.silu(y) @ w_o


def gated_merge(h, branches, w_gate, b_gate, w_out):
    m = 0.0
    for i, br in enumerate(branches):
        m = m + jax.nn.sigmoid(h @ w_gate[i] + b_gate[i]) * br
    return m @ w_out


def token_mixer(a, ac, cos, sin, need_ctx, lambda_init, w_in, w_gate, b_gate, ret_decay, ret_w_o,
                s5_a_re, s5_a_im, s5_log_dt, s5_b_re, s5_b_im, s5_c_re, s5_c_im, s5_d, s5_w_glu,
                diff_lambda, diff_subln_g, diff_w_o, conv_dw, conv_b, conv_ln_g, conv_ln_b, conv_w_o,
                w_out):
    widths = KV_WIDTHS + Q_WIDTHS
    r_k, r_v, s_u, d_k, d_v, r_q, r_g, d_q, cv_in = split_cols(a @ w_in, widths)
    if need_ctx:
        cr_k, cr_v, cs_u, cd_k, cd_v, cr_q, cr_g, cd_q, ccv_in = split_cols(ac @ w_in, widths)
    else:
        cr_k, cr_v, cs_u, cd_k, cd_v = split_cols(ac @ w_in[:, :N_KV_COLS], KV_WIDTHS)
        cr_q = cr_g = cd_q = ccv_in = None

    lg = jax.nn.log_sigmoid(ret_decay.astype(F32))
    ks = RET_DK ** -0.5
    kh_c, vh_c = to_heads(cr_k, RET_HEADS) * ks, to_heads(cr_v, RET_HEADS)
    s_f, s_b = retention_ctx_states(kh_c, vh_c, lg)
    y_a = retention_bidir(to_heads(r_q, RET_HEADS), to_heads(r_k, RET_HEADS) * ks,
                          to_heads(r_v, RET_HEADS), lg, s_f, s_b)
    br_a = retention_out(y_a, r_g, ret_w_o)
    br_b, brc_b = s5_branch(s_u, cs_u, s5_a_re, s5_a_im, s5_log_dt, s5_b_re, s5_b_im,
                            s5_c_re, s5_c_im, s5_d, s5_w_glu, need_ctx)
    br_c, brc_c = diff_branch(d_q, d_k, d_v, cd_k, cd_v, cd_q, cos, sin, diff_lambda,
                              diff_subln_g, diff_w_o, lambda_init, need_ctx)
    br_d = conformer_conv(cv_in, conv_dw, conv_b, conv_ln_g, conv_ln_b, conv_w_o)
    y = gated_merge(a, (br_a, br_b, br_c, br_d), w_gate, b_gate, w_out)
    if not need_ctx:
        return y, None
    zero = jnp.zeros_like(s_f)
    brc_a = retention_out(retention_bidir(to_heads(cr_q, RET_HEADS), kh_c, vh_c, lg, zero, zero),
                          cr_g, ret_w_o)
    brc_d = conformer_conv(ccv_in, conv_dw, conv_b, conv_ln_g, conv_ln_b, conv_w_o)
    yc = gated_merge(ac, (brc_a, brc_b, brc_c, brc_d), w_gate, b_gate, w_out)
    return y, yc


def swiglu(t, w_gu, w_d):
    a, b = jnp.split(t @ w_gu, 2, axis=-1)
    return (jax.nn.silu(a) * b) @ w_d


def moe_swiglu(t, router_w, router_b, w_gu, w_d):
    logits = (t @ router_w).astype(F32) + router_b.astype(F32)
    top_val, top_idx = lax.top_k(logits, TOP_K)
    top_w = jax.nn.softmax(top_val, axis=-1)
    combine = jnp.sum(jax.nn.one_hot(top_idx, N_EXPERTS, dtype=F32) * top_w[..., None], axis=-2)
    combine = combine.astype(t.dtype)
    out = jnp.zeros_like(t)
    for e in range(N_EXPERTS):
        out = out + combine[..., e:e + 1] * swiglu(t, w_gu[e], w_d[e])
    return out


def setup_inputs(seed: int = 0) -> dict:
    key = jax.random.key(seed)
    keys = iter(jax.random.split(key, 48))

    def nrm(shape, scale):
        return scale * jax.random.normal(next(keys), shape, dtype=jnp.float32)

    def gain(shape):
        return 1.0 + nrm(shape, 0.02)

    d, nl = D_MODEL, DEPTH
    n_dense, n_moe = (DEPTH + 1) // 2, DEPTH // 2
    ret_logit0 = jnp.asarray(np.log(2.0 ** (5 + np.arange(RET_HEADS)) - 1.0), dtype=jnp.float32)
    a_im0 = jnp.pi * jnp.arange(S5_STATE, dtype=jnp.float32)
    return {
        'x': nrm((BATCH, SEQ, d), 1.0),
        'c': nrm((BATCH, d), 1.0),
        'ctx': nrm((BATCH, CTX_LEN, d), 1.0),
        'c_ctx': nrm((d,), 1.0),
        'ada_w': nrm((nl, d, 6 * d), 0.5 * d ** -0.5),
        'ada_b': nrm((nl, 6 * d), 0.02),
        'mix_pre_g': gain((nl, d)),
        'mix_post_g': gain((nl, d)),
        'ffn_pre_g': gain((nl, d)),
        'ffn_post_g': gain((nl, d)),
        'w_in': nrm((nl, d, N_IN_COLS), d ** -0.5),
        'w_gate': nrm((nl, N_BRANCH, d, d), d ** -0.5),
        'b_gate': nrm((nl, N_BRANCH, d), 0.02),
        'ret_decay': ret_logit0 + nrm((nl, 2, RET_HEADS), 0.05),
        'ret_w_o': nrm((nl, RET_VW, d), RET_VW ** -0.5),
        's5_a_re': -0.5 + nrm((nl, 2, S5_GROUPS, S5_STATE), 0.01),
        's5_a_im': a_im0 + nrm((nl, 2, S5_GROUPS, S5_STATE), 0.01),
        's5_log_dt': jax.random.uniform(next(keys), (nl, 2, S5_GROUPS), jnp.float32,
                                        math.log(1e-3), math.log(1e-1)),
        's5_b_re': nrm((nl, S5_GROUPS, S5_STATE, S5_GROUP), (2 * S5_GROUP) ** -0.5),
        's5_b_im': nrm((nl, S5_GROUPS, S5_STATE, S5_GROUP), (2 * S5_GROUP) ** -0.5),
        's5_c_re': nrm((nl, S5_GROUPS, S5_GROUP, S5_STATE), (2 * S5_STATE) ** -0.5),
        's5_c_im': nrm((nl, S5_GROUPS, S5_GROUP, S5_STATE), (2 * S5_STATE) ** -0.5),
        's5_d': nrm((nl, S5_GROUPS, S5_GROUP), 1.0),
        's5_w_glu': nrm((nl, S5_WIDTH, 2 * d), S5_WIDTH ** -0.5),
        'diff_lambda': nrm((nl, 4, DIFF_DH), 0.1),
        'diff_subln_g': gain((nl, DIFF_DV)),
        'diff_w_o': nrm((nl, DIFF_VW, d), DIFF_VW ** -0.5),
        'conv_dw': nrm((nl, CONV_K, CONV_WIDTH), CONV_K ** -0.5),
        'conv_b': nrm((nl, CONV_WIDTH), 0.02),
        'conv_ln_g': gain((nl, CONV_WIDTH)),
        'conv_ln_b': nrm((nl, CONV_WIDTH), 0.02),
        'conv_w_o': nrm((nl, CONV_WIDTH, d), CONV_WIDTH ** -0.5),
        'w_out': nrm((nl, d, d), d ** -0.5),
        'ffn_w_gu': nrm((n_dense, d, 2 * FFN_DENSE), d ** -0.5),
        'ffn_w_d': nrm((n_dense, FFN_DENSE, d), FFN_DENSE ** -0.5),
        'router_w': nrm((n_moe, d, N_EXPERTS), d ** -0.5),
        'router_b': nrm((n_moe, N_EXPERTS), 0.01),
        'moe_w_gu': nrm((n_moe, N_EXPERTS, d, 2 * FFN_EXPERT), d ** -0.5),
        'moe_w_d': nrm((n_moe, N_EXPERTS, FFN_EXPERT, d), FFN_EXPERT ** -0.5),
    }


def reference(x, c, ctx, c_ctx, ada_w, ada_b, mix_pre_g, mix_post_g, ffn_pre_g, ffn_post_g,
              w_in, w_gate, b_gate, ret_decay, ret_w_o, s5_a_re, s5_a_im, s5_log_dt, s5_b_re,
              s5_b_im, s5_c_re, s5_c_im, s5_d, s5_w_glu, diff_lambda, diff_subln_g, diff_w_o,
              conv_dw, conv_b, conv_ln_g, conv_ln_b, conv_w_o, w_out, ffn_w_gu, ffn_w_d,
              router_w, router_b, moe_w_gu, moe_w_d):
    bsz, n_lat, d = x.shape
    n_ctx = ctx.shape[1]
    rows = n_lat // GRID_W
    row = jnp.repeat(jnp.arange(rows), GRID_W)
    col = jnp.tile(jnp.arange(GRID_W), rows)
    cos, sin = axial_rope(row, col)
    sc, scc = jax.nn.silu(c), jax.nn.silu(c_ctx)
    h, hc = x, ctx
    for l in range(DEPTH):
        need_ctx = l < DEPTH - 1
        m = (sc @ ada_w[l] + ada_b[l]).reshape(bsz, 6, 1, d)
        mc = (scc @ ada_w[l] + ada_b[l]).reshape(6, d)
        sh1, sc1, g1, sh2, sc2, g2 = [m[:, i] for i in range(6)]
        csh1, csc1, cg1, csh2, csc2, cg2 = [mc[i] for i in range(6)]
        lambda_init = 0.8 - 0.6 * math.exp(-0.3 * l)

        a = modulate(h, mix_pre_g[l], sh1, sc1)
        ac = modulate(hc, mix_pre_g[l], csh1, csc1)
        y, yc = token_mixer(a, ac, cos, sin, need_ctx, lambda_init, w_in[l], w_gate[l], b_gate[l],
                            ret_decay[l], ret_w_o[l], s5_a_re[l], s5_a_im[l], s5_log_dt[l],
                            s5_b_re[l], s5_b_im[l], s5_c_re[l], s5_c_im[l], s5_d[l], s5_w_glu[l],
                            diff_lambda[l], diff_subln_g[l], diff_w_o[l], conv_dw[l], conv_b[l],
                            conv_ln_g[l], conv_ln_b[l], conv_w_o[l], w_out[l])
        h = h + g1 * rms_norm(y, mix_post_g[l])
        if need_ctx:
            hc = hc + cg1 * rms_norm(yc, mix_post_g[l])

        f = modulate(h, ffn_pre_g[l], sh2, sc2)
        if need_ctx:
            f = jnp.concatenate([modulate(hc, ffn_pre_g[l], csh2, csc2), f], axis=1)
        if l % 2 == 0:
            o = swiglu(f, ffn_w_gu[l // 2], ffn_w_d[l // 2])
        else:
            o = moe_swiglu(f, router_w[l // 2], router_b[l // 2], moe_w_gu[l // 2], moe_w_d[l // 2])
        if need_ctx:
            oc, o = o[:, :n_ctx], o[:, n_ctx:]
            hc = hc + cg2 * rms_norm(oc, ffn_post_g[l])
        h = h + g2 * rms_norm(o, ffn_post_g[l])
    return h
```

```cpp
#include <hip/hip_runtime.h>
#include <cstdio>
#include <cstdint>

#define LAS __attribute__((address_space(3)))
#define GAS __attribute__((address_space(1)))
typedef unsigned short bf16;
typedef short bf16x8 __attribute__((ext_vector_type(8)));
typedef short s16x4 __attribute__((ext_vector_type(4)));
typedef float f32x4 __attribute__((ext_vector_type(4)));
typedef float f32x2 __attribute__((ext_vector_type(2)));
typedef float f32x16 __attribute__((ext_vector_type(16)));
typedef unsigned u32x4 __attribute__((ext_vector_type(4)));
typedef unsigned u32x2 __attribute__((ext_vector_type(2)));

constexpr int D = 1024, NB = 16, SEQ = 2048, NCTX = 256, DEPTH = 4;
constexpr int RL = NB * SEQ;
constexpr int RC = NB * NCTX;
constexpr int RT = RL + RC;
constexpr int NIN = 2304;
constexpr int ZW = 2048;
constexpr int ZQ_RQ = 0, ZQ_RK = 128, ZQ_RV = 256, ZQ_RG = 512, ZQ_SU = 768, ZQ_DQ = 1024, ZQ_DK = 1280, ZQ_DV = 1536, ZQ_CV = 1792;
constexpr int FFD = 2816, FFE = 3584, NE = 8;
constexpr int MOE_ROWS = 2 * RT + NE * 256;
constexpr int NCH = 18;
constexpr float EPS = 1e-6f;

__device__ __forceinline__ unsigned f2bf(float f) { unsigned u = __builtin_bit_cast(unsigned, f); return (u + 0x7fffu + ((u >> 16) & 1u)) >> 16; }
__device__ __forceinline__ unsigned pk2(float lo, float hi) { return f2bf(lo) | (f2bf(hi) << 16); }
__device__ __forceinline__ float bf2f(unsigned short b) { return __builtin_bit_cast(float, ((unsigned)b) << 16); }
__device__ __forceinline__ float bflo(unsigned w) { return __builtin_bit_cast(float, w << 16); }
__device__ __forceinline__ float bfhi(unsigned w) { return __builtin_bit_cast(float, w & 0xffff0000u); }
__device__ __forceinline__ unsigned cvt_pk_bf16(float lo, float hi) { unsigned r; asm volatile("v_cvt_pk_bf16_f32 %0, %1, %2" : "=v"(r) : "v"(lo), "v"(hi)); return r; }
__device__ __forceinline__ float sigmoidf_(float x) { return __builtin_amdgcn_rcpf(1.0f + __builtin_amdgcn_exp2f(-1.44269504f * x)); }
__device__ __forceinline__ float siluf_(float x) { return x * sigmoidf_(x); }
__device__ __forceinline__ float wave_sum(float v) {
#pragma unroll
    for (int o = 1; o < 64; o <<= 1) v += __shfl_xor(v, o);
    return v;
}
__device__ __forceinline__ int opaque_v(int x) { asm volatile("" : "+v"(x)); return x; }
__device__ __forceinline__ int opaque_s(int x) { asm volatile("" : "+s"(x)); return x; }
#define LDS_WAIT() asm volatile("s_waitcnt lgkmcnt(0)" ::: "memory")
#define VM_WAIT() asm volatile("s_waitcnt vmcnt(0)" ::: "memory")
namespace pg8 {
constexpr int BM = 256, BK = 64, HALF = 128, HTB = HALF * BK * 2  , STAGE_BYTES = 8 * HTB, NXCD = 8, WGM = 8;

__host__ __device__ __forceinline__ int lds_byte(int r, int c) { const int st = (r >> 4) * 2 + (c >> 5), rr = r & 15, cc = c & 31, ob = rr * 64 + cc * 2; return st * 1024 + (ob ^ (((ob >> 9) & 1) << 5)); }
__host__ __device__ __forceinline__ void stage_rc(int b, int& R, int& C) { const int st = b / 1024, sb = b % 1024, swz = sb ^ (((sb >> 9) & 1) << 5); R = (st >> 1) * 16 + swz / 64; C = (st & 1) * 32 + (swz % 64) / 2; }
__host__ __device__ __forceinline__ int perm32(int rho) { const int n = rho >> 4, i = rho & 15; return 8 * (i >> 2) + 4 * n + (i & 3); }

struct Unit { int pm, pn, am, bn, z; };
struct Gemm { const bf16* A; const bf16* Bt; int K; };

__device__ __forceinline__ void decode_tile(int wgid, int nM, int nN, int& pm, int& pn) {
    const int nwg = nM * nN;
    { const int q = nwg / NXCD, r = nwg % NXCD, xcd = wgid % NXCD, off = wgid / NXCD; wgid = (xcd < r ? xcd * (q + 1) : r * (q + 1) + (xcd - r) * q) + off; }
    const int nig = WGM * nN, gid = wgid / nig, fm = gid * WGM, gsz = (nM - fm) < WGM ? (nM - fm) : WGM;
    pm = fm + ((wgid % nig) % gsz); pn = (wgid % nig) / gsz;
}
struct SchedStd {
    int nM, nN, G, c;
    __device__ __forceinline__ void init(int nM_, int nN_, int G_, int c_) { nM = nM_; nN = nN_; G = G_; c = c_; }
    __device__ __forceinline__ bool next(int i, Unit& u) const {
        const long L = (long)i * G + c; if (L >= (long)nM * nN) return false;
        decode_tile((int)L, nM, nN, u.pm, u.pn); u.am = u.pm; u.bn = u.pn; u.z = 0; return true;
    }
};
struct SchedBr {
    int nM, G, c;
    __device__ __forceinline__ void init(int nM_, int G_, int c_) { nM = nM_; G = G_; c = c_; }
    __device__ __forceinline__ bool next(int i, Unit& u) const {
        const long L = (long)i * G + c; if (L >= (long)nM * 20) return false;
        int pm, pa; decode_tile((int)L, nM, 20, pm, pa);
        const int z = pa < 4 ? 0 : (pa < 12 ? 1 : (pa < 16 ? 2 : 3)), st = z == 0 ? 0 : (z == 1 ? 4 : (z == 2 ? 12 : 16));
        u.pm = pm; u.pn = pa - st; u.am = z * (RT / 256) + pm; u.bn = pa; u.z = z; return true;
    }
};
struct SchedGate {
    int nM, G, c;
    __device__ __forceinline__ void init(int nM_, int G_, int c_) { nM = nM_; G = G_; c = c_; }
    __device__ __forceinline__ bool next(int i, Unit& u) const {
        const long L = (long)(i >> 2) * G + c; if (L >= (long)nM * 4) return false;
        decode_tile((int)L, nM, 4, u.pm, u.pn); u.z = i & 3; u.am = u.pm; u.bn = u.z * 4 + u.pn; return true;
    }
};
struct SchedMoe {
    int nM, nN, G, c; const int* tile_e;
    __device__ __forceinline__ void init(int nM_, int nN_, int G_, int c_, const int* te) { nM = nM_; nN = nN_; G = G_; c = c_; tile_e = te; }
    __device__ __forceinline__ bool next(int i, Unit& u) const {
        const long L = (long)i * G + c; if (L >= (long)nM * nN) return false;
        decode_tile((int)L, nM, nN, u.pm, u.pn); u.am = u.pm; u.z = 0;
        const int e = __builtin_amdgcn_readfirstlane(__hip_atomic_load(tile_e + u.pm, __ATOMIC_RELAXED, __HIP_MEMORY_SCOPE_AGENT));
        u.bn = e * nN + u.pn; return true;
    }
};

#define EPI_ROWS(...) _Pragma("unroll") for (int ai = 0; ai < 2; ++ai) _Pragma("unroll") for (int m = 0; m < 4; ++m) { const int row = u.pm * BM + wr * 64 + fr + ai * HALF + m * 16; _Pragma("unroll") for (int bj = 0; bj < 2; ++bj) { const f32x4 v0 = acc[ai][bj][m][0], v1 = acc[ai][bj][m][1]; const int cb = 128 * bj + 32 * wc + 8 * fq; __VA_ARGS__ } }

struct EpiF32 {
    static constexpr bool PERM = false;
    float* C; int ldc;
    __device__ __forceinline__ void operator()(const f32x4 (&acc)[2][2][4][2], const Unit& u, int wr, int wc, int fr, int fq) const {
        const int row0 = u.pm * BM + wr * 64 + fr, col0 = u.pn * BM + wc * 32 + 4 * fq;
#pragma unroll
        for (int ai = 0; ai < 2; ++ai)
#pragma unroll
            for (int m = 0; m < 4; ++m) { float* rowp = C + (size_t)(row0 + ai * HALF + m * 16) * ldc + col0;
#pragma unroll
                for (int bj = 0; bj < 2; ++bj)
#pragma unroll
                    for (int n = 0; n < 2; ++n) *(f32x4*)(rowp + bj * HALF + n * 16) = acc[ai][bj][m][n]; }
    }
};
struct EpiBf16 {
    static constexpr bool PERM = true;
    bf16* O; int ldc;
    __device__ __forceinline__ void operator()(const f32x4 (&acc)[2][2][4][2], const Unit& u, int wr, int wc, int fr, int fq) const {
        EPI_ROWS({ u32x4 w; w.x = cvt_pk_bf16(v0[0], v0[1]); w.y = cvt_pk_bf16(v0[2], v0[3]); w.z = cvt_pk_bf16(v1[0], v1[1]); w.w = cvt_pk_bf16(v1[2], v1[3]);
                   *(u32x4*)(O + (size_t)row * ldc + u.pn * BM + cb) = w; })
    }
};
struct EpiSwiGLU {
    static constexpr bool PERM = true;
    bf16* O; int ldc;
    __device__ __forceinline__ void operator()(const f32x4 (&acc)[2][2][4][2], const Unit& u, int wr, int wc, int fr, int fq) const {
        EPI_ROWS({ u32x2 w; w.x = cvt_pk_bf16(siluf_(v0[0]) * v0[1], siluf_(v0[2]) * v0[3]); w.y = cvt_pk_bf16(siluf_(v1[0]) * v1[1], siluf_(v1[2]) * v1[3]);
                   *(u32x2*)(O + (size_t)row * ldc + ((u.pn * BM + cb) >> 1)) = w; })
    }
};
struct EpiWin {
    static constexpr bool PERM = true;
    bf16* Z; const float* rope;
    __device__ __forceinline__ void operator()(const f32x4 (&acc)[2][2][4][2], const Unit& u, int wr, int wc, int fr, int fq) const {
        if (u.pn >= 7) {
            EPI_ROWS({ u32x2 w; w.x = cvt_pk_bf16(v0[0] * sigmoidf_(v0[1]), v0[2] * sigmoidf_(v0[3])); w.y = cvt_pk_bf16(v1[0] * sigmoidf_(v1[1]), v1[2] * sigmoidf_(v1[3]));
                       *(u32x2*)(Z + (size_t)row * ZW + ZQ_CV + (u.pn - 7) * 128 + (cb >> 1)) = w; })
        } else if ((u.pn == 4 || u.pn == 5) && u.pm < RL / 256) {
            EPI_ROWS({ const f32x4* rp = (const f32x4*)(rope + (size_t)(row & (SEQ - 1)) * 32 + fq * 8); const f32x4 c0 = rp[0], c1 = rp[1];
                       u32x4 w; w.x = cvt_pk_bf16(v0[0] * c0[0] - v0[1] * c0[1], v0[1] * c0[0] + v0[0] * c0[1]); w.y = cvt_pk_bf16(v0[2] * c0[2] - v0[3] * c0[3], v0[3] * c0[2] + v0[2] * c0[3]);
                       w.z = cvt_pk_bf16(v1[0] * c1[0] - v1[1] * c1[1], v1[1] * c1[0] + v1[0] * c1[1]); w.w = cvt_pk_bf16(v1[2] * c1[2] - v1[3] * c1[3], v1[3] * c1[2] + v1[2] * c1[3]);
                       *(u32x4*)(Z + (size_t)row * ZW + u.pn * BM + cb) = w; })
        } else {
            EPI_ROWS({ u32x4 w; w.x = cvt_pk_bf16(v0[0], v0[1]); w.y = cvt_pk_bf16(v0[2], v0[3]); w.z = cvt_pk_bf16(v1[0], v1[1]); w.w = cvt_pk_bf16(v1[2], v1[3]);
                       *(u32x4*)(Z + (size_t)row * ZW + u.pn * BM + cb) = w; })
        }
    }
};
struct EpiBr {
    static constexpr bool PERM = true;
    bf16* BO;
    __device__ __forceinline__ void operator()(const f32x4 (&acc)[2][2][4][2], const Unit& u, int wr, int wc, int fr, int fq) const {
        bf16* base = BO + (size_t)u.z * RT * D;
        if (u.z == 1) {
            EPI_ROWS({ u32x2 w; w.x = cvt_pk_bf16(v0[0] * sigmoidf_(v0[1]), v0[2] * sigmoidf_(v0[3])); w.y = cvt_pk_bf16(v1[0] * sigmoidf_(v1[1]), v1[2] * sigmoidf_(v1[3]));
                       *(u32x2*)(base + (size_t)row * D + ((u.pn * BM + cb) >> 1)) = w; })
        } else {
            EPI_ROWS({ u32x4 w; w.x = cvt_pk_bf16(v0[0], v0[1]); w.y = cvt_pk_bf16(v0[2], v0[3]); w.z = cvt_pk_bf16(v1[0], v1[1]); w.w = cvt_pk_bf16(v1[2], v1[3]);
                       *(u32x4*)(base + (size_t)row * D + u.pn * BM + cb) = w; })
        }
    }
};
struct EpiGate {
    static constexpr bool PERM = true;
    const bf16* BO; bf16* MM; const float* bgate;
    __device__ __forceinline__ void operator()(const f32x4 (&acc)[2][2][4][2], const Unit& u, int wr, int wc, int fr, int fq) const {
        const bf16* bo = BO + (size_t)u.z * RT * D; const float* bg = bgate + u.z * D + u.pn * BM;
        EPI_ROWS({ const int col = u.pn * BM + cb; const f32x4 b0 = *(const f32x4*)(bg + cb), b1 = *(const f32x4*)(bg + cb + 4);
                   const u32x4 bw = *(const u32x4*)(bo + (size_t)row * D + col);
                   float r0 = sigmoidf_(v0[0] + b0[0]) * bflo(bw.x), r1 = sigmoidf_(v0[1] + b0[1]) * bfhi(bw.x), r2 = sigmoidf_(v0[2] + b0[2]) * bflo(bw.y), r3 = sigmoidf_(v0[3] + b0[3]) * bfhi(bw.y);
                   float r4 = sigmoidf_(v1[0] + b1[0]) * bflo(bw.z), r5 = sigmoidf_(v1[1] + b1[1]) * bfhi(bw.z), r6 = sigmoidf_(v1[2] + b1[2]) * bflo(bw.w), r7 = sigmoidf_(v1[3] + b1[3]) * bfhi(bw.w);
                   if (u.z) { const u32x4 ow = *(const u32x4*)(MM + (size_t)row * D + col);
                       r0 += bflo(ow.x); r1 += bfhi(ow.x); r2 += bflo(ow.y); r3 += bfhi(ow.y); r4 += bflo(ow.z); r5 += bfhi(ow.z); r6 += bflo(ow.w); r7 += bfhi(ow.w); }
                   u32x4 w; w.x = cvt_pk_bf16(r0, r1); w.y = cvt_pk_bf16(r2, r3); w.z = cvt_pk_bf16(r4, r5); w.w = cvt_pk_bf16(r6, r7);
                   *(u32x4*)(MM + (size_t)row * D + col) = w; })
    }
};

template <class Epi, class Sched>
__device__ __forceinline__ void gemm_phase(LAS unsigned char* lds, const Gemm g, const Sched& S, const Epi& E) {
    const int tid = opaque_v(threadIdx.x), wid = __builtin_amdgcn_readfirstlane(tid >> 6), lane = tid & 63, wr = wid >> 2, wc = wid & 3, fr = lane & 15, fq = lane >> 4;
    const int K = opaque_s(g.K), nt = K / BK;
    unsigned voffA[2], voffB[2];
#pragma unroll
    for (int i = 0; i < 2; ++i) { int R, C; stage_rc(tid * 16 + i * 8192, R, C); const int Rb = Epi::PERM ? ((R & ~31) + perm32(R & 31)) : R;
        voffA[i] = (unsigned)(R * K + C) * 2u; voffB[i] = (unsigned)(Rb * K + C) * 2u; }
    const size_t kstep = (size_t)(BK * 2);
    const size_t hstep = (size_t)HALF * K * 2;
    const size_t tstep = 2 * hstep;
    const unsigned ldsw = (unsigned)wid * 1024u;
    const int aoff = lds_byte(wr * 64 + fr, fq * 8), boff = lds_byte(wc * 32 + fr, fq * 8);
#define PG8_SA(b, h) (((b) * 2 + (h)) * HTB)
#define PG8_SB(b, h) ((4 + (b) * 2 + (h)) * HTB)
#define PG8_STAGE(bufoff, gbase, voff) do { _Pragma("unroll") for (int _i = 0; _i < 2; ++_i) \
        __builtin_amdgcn_global_load_lds((const unsigned*)((const char*)(gbase) + (voff)[_i]), (LAS unsigned*)(lds + (bufoff) + ldsw + _i * 8192), 16, 0, 0); } while (0)
#define PG8_LDA(dst, b, h) do { _Pragma("unroll") for (int m = 0; m < 4; ++m) _Pragma("unroll") for (int k = 0; k < 2; ++k) dst[m][k] = *(const LAS bf16x8*)(lds + PG8_SA(b, h) + aoff + m * 2048 + k * 1024); } while (0)
#define PG8_LDB(dst, b, h) do { _Pragma("unroll") for (int n = 0; n < 2; ++n) _Pragma("unroll") for (int k = 0; k < 2; ++k) dst[n][k] = *(const LAS bf16x8*)(lds + PG8_SB(b, h) + boff + n * 2048 + k * 1024); } while (0)
#define PG8_MMA(ai, bj, At, Bt) do { __builtin_amdgcn_s_setprio(1); _Pragma("unroll") for (int m = 0; m < 4; ++m) _Pragma("unroll") for (int n = 0; n < 2; ++n) _Pragma("unroll") for (int k = 0; k < 2; ++k) \
        acc[ai][bj][m][n] = __builtin_amdgcn_mfma_f32_16x16x32_bf16(Bt[n][k], At[m][k], acc[ai][bj][m][n], 0, 0, 0); __builtin_amdgcn_s_setprio(0); } while (0)
#define PG8_WAIT_V(n) asm volatile("s_waitcnt vmcnt(" #n ")" ::: "memory")
#define PG8_WAIT_L(n) asm volatile("s_waitcnt lgkmcnt(" #n ")" ::: "memory")
#define PG8_BAR __builtin_amdgcn_s_barrier()
#define PG8_SCHED __builtin_amdgcn_sched_barrier(0)
    Unit cur, nxt; int ui = 0;
    if (!S.next(0, cur)) return;
    f32x4 acc[2][2][4][2];
#pragma unroll
    for (int a = 0; a < 2; ++a)
#pragma unroll
        for (int b = 0; b < 2; ++b)
#pragma unroll
            for (int m = 0; m < 4; ++m)
#pragma unroll
                for (int n = 0; n < 2; ++n) acc[a][b][m][n] = (f32x4){0.f, 0.f, 0.f, 0.f};
    bf16x8 At[4][2], B0[2][2], B1[2][2];
    const char* cA = (const char*)g.A + (size_t)cur.am * tstep; const char* cB = (const char*)g.Bt + (size_t)cur.bn * tstep;
    PG8_STAGE(PG8_SB(0, 0), cB, voffB); PG8_STAGE(PG8_SB(0, 1), cB + hstep, voffB); PG8_STAGE(PG8_SA(0, 0), cA, voffA); PG8_STAGE(PG8_SA(0, 1), cA + hstep, voffA);
    if (wr == 1) PG8_BAR;
    PG8_WAIT_V(2); PG8_BAR;
    PG8_STAGE(PG8_SB(1, 0), cB + kstep, voffB); PG8_STAGE(PG8_SA(1, 0), cA + kstep, voffA); PG8_STAGE(PG8_SB(1, 1), cB + hstep + kstep, voffB);
    PG8_WAIT_V(6); PG8_BAR;
    for (;;) {
        const bool has_next = S.next(ui + 1, nxt);
        const char* nA = has_next ? (const char*)g.A + (size_t)nxt.am * tstep : cA; const char* nB = has_next ? (const char*)g.Bt + (size_t)nxt.bn * tstep : cB;
        for (int t = 0; t < nt; t += 2) {
            const bool last = (t == nt - 2);
            const char* a1 = cA + (size_t)(t + 1) * kstep;
            const char* a2 = last ? nA : cA + (size_t)(t + 2) * kstep; const char* b2 = last ? nB : cB + (size_t)(t + 2) * kstep;
            const char* a3 = a2 + kstep; const char* b3 = b2 + kstep;
            PG8_LDB(B0, 0, 0); PG8_LDB(B1, 0, 1); PG8_SCHED; PG8_LDA(At, 0, 0); PG8_STAGE(PG8_SA(1, 1), a1 + hstep, voffA);
            PG8_WAIT_V(8); PG8_WAIT_L(0); PG8_BAR; PG8_MMA(0, 0, At, B0); PG8_MMA(0, 1, At, B1); PG8_BAR; PG8_SCHED;
            PG8_LDA(At, 0, 1); PG8_STAGE(PG8_SB(0, 0), b2, voffB); PG8_STAGE(PG8_SB(0, 1), b2 + hstep, voffB); PG8_STAGE(PG8_SA(0, 0), a2, voffA);
            PG8_WAIT_V(8); PG8_WAIT_L(0); PG8_BAR; PG8_MMA(1, 0, At, B0); PG8_MMA(1, 1, At, B1); PG8_BAR; PG8_SCHED;
            PG8_LDB(B0, 1, 0); PG8_LDB(B1, 1, 1); PG8_SCHED; PG8_LDA(At, 1, 0); PG8_STAGE(PG8_SA(0, 1), a2 + hstep, voffA);
            PG8_WAIT_V(8); PG8_WAIT_L(0); PG8_BAR; PG8_MMA(0, 0, At, B0); PG8_MMA(0, 1, At, B1); PG8_BAR; PG8_SCHED;
            PG8_LDA(At, 1, 1); PG8_STAGE(PG8_SB(1, 0), b3, voffB); PG8_STAGE(PG8_SB(1, 1), b3 + hstep, voffB); PG8_STAGE(PG8_SA(1, 0), a3, voffA);
            PG8_WAIT_V(8); PG8_WAIT_L(0); PG8_BAR; PG8_MMA(1, 0, At, B0); PG8_MMA(1, 1, At, B1); PG8_BAR; PG8_SCHED;
        }
        if (wr == 0) PG8_BAR;
        E(acc, cur, wr, wc, fr, fq);
        if (!has_next) break;
#pragma unroll
        for (int a = 0; a < 2; ++a)
#pragma unroll
            for (int b = 0; b < 2; ++b)
#pragma unroll
                for (int m = 0; m < 4; ++m)
#pragma unroll
                    for (int n = 0; n < 2; ++n) acc[a][b][m][n] = (f32x4){0.f, 0.f, 0.f, 0.f};
        cur = nxt; cA = nA; cB = nB; ++ui;
        if (wr == 1) PG8_BAR;
    }
    PG8_WAIT_V(0);
    PG8_BAR;
#undef PG8_SA
#undef PG8_SB
#undef PG8_STAGE
#undef PG8_LDA
#undef PG8_LDB
#undef PG8_MMA
#undef PG8_WAIT_V
#undef PG8_WAIT_L
#undef PG8_BAR
#undef PG8_SCHED
}
}
constexpr size_t al256(size_t x) { return (x + 255) & ~(size_t)255; }
constexpr size_t WS_CTL = 0, CTL_ZERO_BYTES = 1u << 20;
constexpr size_t E_WIN = (size_t)NIN * D, E_WG = (size_t)4 * D * D, E_WBR = (size_t)5120 * 256, E_WOUT = (size_t)D * D;
constexpr size_t E_WGU = (size_t)2 * FFD * D, E_WD = (size_t)D * FFD, E_MGU = (size_t)2 * FFE * D, E_MWD = (size_t)D * FFE;
constexpr size_t WS_WIN = CTL_ZERO_BYTES;
constexpr size_t WS_WG = WS_WIN + 2 * DEPTH * E_WIN;
constexpr size_t WS_WBR = WS_WG + 2 * DEPTH * E_WG;
constexpr size_t WS_WOUT = WS_WBR + 2 * DEPTH * E_WBR;
constexpr size_t WS_WGU = WS_WOUT + 2 * DEPTH * E_WOUT;
constexpr size_t WS_WD = WS_WGU + 2 * 2 * E_WGU;
constexpr size_t WS_MGU = WS_WD + 2 * 2 * E_WD;
constexpr size_t WS_MWD = WS_MGU + 2 * 2 * NE * E_MGU;
constexpr size_t WS_WEND = WS_MWD + 2 * 2 * NE * E_MWD;
constexpr size_t WS_MODS = al256(WS_WEND);
constexpr size_t WS_ROPE = WS_MODS + al256((size_t)DEPTH * 17 * 6 * D * 4);
constexpr size_t S5P_ABAR = 0, S5P_A128 = 16384, S5P_BP = 32768, S5P_CH = S5P_BP + 2 * 16 * 128 * 16 * 2, S5P_BYTES = S5P_CH + 16 * 16 * 128 * 2;
constexpr size_t WS_S5P = WS_ROPE + (size_t)SEQ * 32 * 4;
constexpr size_t WS_LAYP = WS_S5P + DEPTH * S5P_BYTES;
constexpr size_t WS_RETSUM = al256(WS_LAYP + DEPTH * 64 * 4);
constexpr size_t WS_RETST = WS_RETSUM + (size_t)NB * NCH * 2 * 4 * 2048 * 4;
constexpr size_t WS_S5E = WS_RETST + (size_t)NB * NCH * 2 * 4 * 2048 * 2;
constexpr size_t WS_S5C = WS_S5E + (size_t)NB * NCH * 16 * 2 * 64 * 8;
constexpr size_t WS_REC = WS_S5C + (size_t)NB * NCH * 16 * 2 * 64 * 8;
constexpr size_t WS_HIST = WS_REC + (size_t)RT * 32;
constexpr size_t WS_TILEE = WS_HIST + 256 * 8 * 4;
constexpr size_t WS_H = al256(WS_TILEE + 512 * 4);
constexpr size_t WS_AF = WS_H + (size_t)RT * D * 4;
constexpr size_t WS_RA = WS_AF + (size_t)RT * D * 2;
constexpr size_t WS_Z = WS_RA;
constexpr size_t WS_XB = WS_Z + (size_t)RT * ZW * 2;
constexpr size_t WS_BO = WS_XB + (size_t)4 * RT * 256 * 2;
constexpr size_t WS_MM = WS_BO + (size_t)4 * RT * D * 2;
constexpr size_t WS_Y = WS_MM + (size_t)RT * D * 2;
constexpr size_t WS_RA_END = WS_Y + (size_t)RT * D * 4;
constexpr size_t WS_G = WS_RA;
constexpr size_t WS_FS = WS_RA;
constexpr size_t WS_GS = WS_FS + (size_t)MOE_ROWS * D * 2;
constexpr size_t WS_YS = WS_GS + (size_t)MOE_ROWS * FFE * 2;
constexpr size_t WS_RB_END = WS_YS + (size_t)MOE_ROWS * D * 2;
constexpr size_t WS_END = WS_RA_END > WS_RB_END ? WS_RA_END : WS_RB_END;
static_assert(WS_G + (size_t)RT * FFD * 2 <= WS_Y, "dense hidden must not reach Y");
constexpr int CW_BAR = 4096;

constexpr int SCRATCH_BYTES = 153600;
constexpr int LDSCTL_OFF = SCRATCH_BYTES, MISC_OFF = LDSCTL_OFF + 320;
constexpr int LDS_BYTES = 155648;
constexpr int NWAVES = 8;

typedef GAS unsigned gu32;
#define RLX_AGENT __ATOMIC_RELAXED, __HIP_MEMORY_SCOPE_AGENT

#define XB_TMO      128
#define XB_XCNT(j)  (256  + 64 * (j))
#define XB_XSUB(j)  (1280 + 64 * (j))
#define XB_XGEN(j)  (2304 + 64 * (j))
#define XB_TOP      3328
#define XB_TOPGEN   3392
#define XCD_BAR_WORDS 3456
#define XB_SPIN_CAP (1u << 20)

__device__ __forceinline__ unsigned xb_ld(unsigned* p)              { return __hip_atomic_load(p, __ATOMIC_RELAXED, __HIP_MEMORY_SCOPE_AGENT); }
__device__ __forceinline__ unsigned xb_add(unsigned* p, unsigned v) { return __hip_atomic_fetch_add(p, v, __ATOMIC_RELAXED, __HIP_MEMORY_SCOPE_AGENT); }
__device__ __forceinline__ unsigned xb_xcc_id() { return (unsigned)__builtin_amdgcn_s_getreg((3 << 11) | 20) & 0xFu; }
#define XB_SPIN(cond, bar) do { unsigned _sp = 0; while (cond) { __builtin_amdgcn_s_sleep(1); \
    if ((++_sp & 255u) == 0u) { if (xb_ld(&(bar)[XB_TMO])) break; if (_sp > XB_SPIN_CAP) { atomicAdd(&(bar)[XB_TMO], 1u); break; } } } } while (0)

struct XcdBarrier {
    unsigned* bar; unsigned x;
    volatile LAS unsigned* st;
};
__device__ __forceinline__ XcdBarrier xcd_barrier_post(unsigned* bar, volatile LAS unsigned* st) {
    XcdBarrier b; b.bar = bar; b.x = xb_xcc_id(); b.st = st;
    if (threadIdx.x == 0) (void)xb_add(&bar[XB_XCNT(b.x)], 1u);
    return b;
}
__device__ __forceinline__ void xcd_barrier_complete(unsigned* bar, unsigned x, unsigned& nloc, unsigned& nx) {
    const unsigned G = gridDim.x * gridDim.y * gridDim.z;
    unsigned sum, cnt, mine, sp = 0u;
    for (;;) {
        sum = 0u; cnt = 0u; mine = 0u;
#pragma unroll
        for (unsigned j = 0; j < 16; ++j) { const unsigned c = xb_ld(&bar[XB_XCNT(j)]); sum += c; cnt += (c > 0u) ? 1u : 0u; mine = (j == x) ? c : mine; }
        if (sum == G) break;
        __builtin_amdgcn_s_sleep(1);
        if ((++sp & 255u) == 0u) { if (xb_ld(&bar[XB_TMO])) break; if (sp > XB_SPIN_CAP) { atomicAdd(&bar[XB_TMO], 1u); break; } }
    }
    nloc = mine > 0u ? mine : 1u; nx = cnt > 0u ? cnt : 1u;
}
__device__ __forceinline__ void xcd_barrier(const XcdBarrier& b) {
    asm volatile("s_waitcnt vmcnt(0)" ::: "memory");
    __syncthreads();
    if (threadIdx.x == 0) {
        unsigned* bar = b.bar;
        __builtin_amdgcn_s_waitcnt(0);
        unsigned nloc = b.st[0], nx = b.st[1];
        if (nloc == 0u) { xcd_barrier_complete(bar, b.x, nloc, nx); b.st[0] = nloc; b.st[1] = nx; }
        const unsigned old = xb_add(&bar[XB_XSUB(b.x)], 1u);
        const unsigned gen = old / nloc;
        if (old + 1u == (gen + 1u) * nloc) {
            __builtin_amdgcn_fence(__ATOMIC_RELEASE, "agent");
            asm volatile("s_waitcnt vmcnt(0)" ::: "memory");
            const unsigned og = xb_add(&bar[XB_TOP], 1u);
            const unsigned tg = og / nx;
            if (og + 1u == (tg + 1u) * nx) xb_add(&bar[XB_TOPGEN], 1u);
            else XB_SPIN(xb_ld(&bar[XB_TOPGEN]) == tg, bar);
            __builtin_amdgcn_fence(__ATOMIC_ACQUIRE, "agent");
            xb_add(&bar[XB_XGEN(b.x)], 1u);
            asm volatile("s_waitcnt vmcnt(0)" ::: "memory");
        } else {
            XB_SPIN(xb_ld(&bar[XB_XGEN(b.x)]) == gen, bar);
            __builtin_amdgcn_fence(__ATOMIC_ACQUIRE, "agent");
            asm volatile("s_waitcnt vmcnt(0)" ::: "memory");
        }
    }
    __syncthreads();
}

struct Frame {
    LAS unsigned char* lds;
    volatile LAS unsigned* MISC;
    int tid, lane, wave;
    int vcu, G;
    unsigned char* ws;
};
__device__ __forceinline__ int permqk(int c) { const int hm = c >> 5, d = c & 31, axis = d >> 4, half = (d >> 3) & 1, f = d & 7; return hm * 32 + axis * 16 + f * 2 + half; }
__device__ __forceinline__ int win_dest(int n, float& sc) {
    sc = 1.0f;
    if (n < 128) { sc = 0.17677669529663687f; return 128 + n; }
    if (n < 384) return 256 + (n - 128);
    if (n < 640) return 768 + (n - 384);
    if (n < 896) return 1280 + permqk(n - 640);
    if (n < 1152) return 1536 + (n - 896);
    if (n < 1280) return n - 1152;
    if (n < 1536) return 512 + (n - 1280);
    if (n < 1792) { sc = 0.17677669529663687f; return 1024 + permqk(n - 1536); }
    const int j = (n - 1792) & 255, half = (n - 1792) >> 8; return 1792 + 2 * j + half;
}
template <int MODE>
__device__ __forceinline__ void transpose_item(const float* __restrict__ W, int K, int N, bf16* WT, int row_off, LAS float* scr, int item, int lane) {
    const int nblk = N / 32, kb = item / nblk, nb = item % nblk, k0 = 64 * kb, n0 = 32 * nb;
#pragma unroll 8
    for (int i = 0; i < 32; ++i) { const int kk = 2 * i + (lane >> 5); scr[kk * 33 + (lane & 31)] = W[(size_t)(k0 + kk) * N + n0 + (lane & 31)]; }
    LDS_WAIT(); asm volatile("" ::: "memory");
    const int c = lane & 7;
#pragma unroll
    for (int j = 0; j < 4; ++j) { const int n = (lane >> 3) + 8 * j; const LAS float* s = scr + (8 * c) * 33 + n;
        int dr; float sc = 1.0f; const int ng = n0 + n;
        if (MODE == 0) dr = row_off + ng; else if (MODE == 1) { const int Hh = N >> 1; dr = row_off + 2 * (ng % Hh) + ng / Hh; } else dr = win_dest(ng, sc);
        u32x4 o; o.x = pk2(s[0 * 33] * sc, s[1 * 33] * sc); o.y = pk2(s[2 * 33] * sc, s[3 * 33] * sc); o.z = pk2(s[4 * 33] * sc, s[5 * 33] * sc); o.w = pk2(s[6 * 33] * sc, s[7 * 33] * sc);
        *(u32x4*)(WT + (size_t)dr * K + k0 + 8 * c) = o; }
    LDS_WAIT(); asm volatile("" ::: "memory");
}
__device__ __forceinline__ void sincos_d(double x, double& s, double& c) {
    const double tp = 6.283185307179586476925287; x -= tp * rint(x / tp);
    const double x2 = x * x; double cs = 1.0, sn = 1.0;
    double tc = 1.0, ts = 1.0; cs = 1.0; sn = 1.0;
#pragma unroll
    for (int k = 1; k <= 17; ++k) { tc *= -x2 / (double)((2 * k - 1) * (2 * k)); ts *= -x2 / (double)((2 * k) * (2 * k + 1)); cs += tc; sn += ts; }
    s = sn * x; c = cs;
}

struct P0Args {
    const float *c, *c_ctx, *ada_w, *ada_b, *w_in, *w_gate, *ret_w_o, *s5_w_glu, *diff_w_o, *conv_w_o, *w_out, *ffn_w_gu, *ffn_w_d, *moe_w_gu, *moe_w_d;
    const float *ret_decay, *s5_a_re, *s5_a_im, *s5_log_dt, *s5_b_re, *s5_b_im, *s5_c_re, *s5_c_im, *diff_lambda;
};
__device__ __forceinline__ void p0_prologue(Frame& F, const P0Args& P) {
    unsigned char* ws = F.ws;
    {
        LAS float* scr = (LAS float*)(F.lds + F.wave * 8448);
        const int gw = F.vcu * NWAVES + F.wave, NGW = F.G * NWAVES;
        constexpr int I_WIN = 16 * (NIN / 32), I_WG = 16 * 32, I_BR1 = 4 * 32, I_BR2 = 4 * 64, I_WOUT = 16 * 32;
        constexpr int I_LAYER = I_WIN + 4 * I_WG + I_BR1 + I_BR2 + I_BR1 + I_BR1 + I_WOUT;
        constexpr int I_GU = 16 * (2 * FFD / 32), I_DD = (FFD / 64) * 32, I_DENSE = I_GU + I_DD;
        constexpr int I_MGU = 16 * (2 * FFE / 32), I_MD = (FFE / 64) * 32, I_EXP = I_MGU + I_MD;
        constexpr int NITEMS = DEPTH * I_LAYER + 2 * I_DENSE + 2 * NE * I_EXP;
        for (int it = gw; it < NITEMS; it += NGW) {
            int r = it;
            if (r < DEPTH * I_LAYER) {
                const int l = r / I_LAYER; r -= l * I_LAYER;
                if (r < I_WIN) { transpose_item<2>(P.w_in + (size_t)l * D * NIN, D, NIN, (bf16*)(ws + WS_WIN) + (size_t)l * E_WIN, 0, scr, r, F.lane); continue; } r -= I_WIN;
                if (r < 4 * I_WG) { const int z = r / I_WG; transpose_item<0>(P.w_gate + ((size_t)l * 4 + z) * D * D, D, D, (bf16*)(ws + WS_WG) + (size_t)l * E_WG, z * D, scr, r % I_WG, F.lane); continue; } r -= 4 * I_WG;
                bf16* wbr = (bf16*)(ws + WS_WBR) + (size_t)l * E_WBR;
                if (r < I_BR1) { transpose_item<0>(P.ret_w_o + (size_t)l * 256 * D, 256, D, wbr, 0, scr, r, F.lane); continue; } r -= I_BR1;
                if (r < I_BR2) { transpose_item<1>(P.s5_w_glu + (size_t)l * 256 * 2 * D, 256, 2 * D, wbr, 1024, scr, r, F.lane); continue; } r -= I_BR2;
                if (r < I_BR1) { transpose_item<0>(P.diff_w_o + (size_t)l * 256 * D, 256, D, wbr, 3072, scr, r, F.lane); continue; } r -= I_BR1;
                if (r < I_BR1) { transpose_item<0>(P.conv_w_o + (size_t)l * 256 * D, 256, D, wbr, 4096, scr, r, F.lane); continue; } r -= I_BR1;
                transpose_item<0>(P.w_out + (size_t)l * D * D, D, D, (bf16*)(ws + WS_WOUT) + (size_t)l * E_WOUT, 0, scr, r, F.lane); continue;
            }
            r -= DEPTH * I_LAYER;
            if (r < 2 * I_DENSE) {
                const int j = r / I_DENSE; r -= j * I_DENSE;
                if (r < I_GU) { transpose_item<1>(P.ffn_w_gu + (size_t)j * D * 2 * FFD, D, 2 * FFD, (bf16*)(ws + WS_WGU) + (size_t)j * E_WGU, 0, scr, r, F.lane); continue; } r -= I_GU;
                transpose_item<0>(P.ffn_w_d + (size_t)j * FFD * D, FFD, D, (bf16*)(ws + WS_WD) + (size_t)j * E_WD, 0, scr, r, F.lane); continue;
            }
            r -= 2 * I_DENSE;
            { const int je = r / I_EXP; r -= je * I_EXP;
              if (r < I_MGU) { transpose_item<1>(P.moe_w_gu + (size_t)je * D * 2 * FFE, D, 2 * FFE, (bf16*)(ws + WS_MGU) + (size_t)je * E_MGU, 0, scr, r, F.lane); continue; } r -= I_MGU;
              transpose_item<0>(P.moe_w_d + (size_t)je * FFE * D, FFE, D, (bf16*)(ws + WS_MWD) + (size_t)je * E_MWD, 0, scr, r, F.lane); }
        }
    }
    __syncthreads();
    {
        LAS float* sc = (LAS float*)F.lds;
        LAS float* part = (LAS float*)(F.lds + 17 * 1024 * 4);
        for (int i = F.tid; i < 17 * D; i += 512) { const int r = i >> 10, k = i & 1023; const float v = r < 16 ? P.c[r * D + k] : P.c_ctx[k]; sc[i] = v / (1.0f + __expf(-v)); }
        __syncthreads();
        float* mods = (float*)(ws + WS_MODS);
        for (int u = F.vcu; u < DEPTH * 96; u += F.G) {
            const int l = u / 96, n0 = (u % 96) * 64;
            const float* w = P.ada_w + (size_t)l * D * 6 * D + n0 + F.lane;
            float acc[17];
#pragma unroll
            for (int r = 0; r < 17; ++r) acc[r] = 0.f;
            const int kb = F.wave * 128;
#pragma unroll 2
            for (int k4 = 0; k4 < 128; k4 += 4) {
                float wv[4];
#pragma unroll
                for (int j = 0; j < 4; ++j) wv[j] = w[(size_t)(kb + k4 + j) * 6 * D];
#pragma unroll
                for (int r = 0; r < 17; ++r) { const f32x4 s = *(const LAS f32x4*)(sc + r * 1024 + kb + k4); acc[r] += wv[0] * s[0] + wv[1] * s[1] + wv[2] * s[2] + wv[3] * s[3]; }
            }
#pragma unroll
            for (int r = 0; r < 17; ++r) part[(F.wave * 17 + r) * 64 + F.lane] = acc[r];
            __syncthreads();
            for (int i = F.tid; i < 17 * 64; i += 512) { float s = 0.f;
#pragma unroll
                for (int w8 = 0; w8 < 8; ++w8) s += part[w8 * 17 * 64 + i];
                const int r = i >> 6, n = n0 + (i & 63); mods[((size_t)l * 17 + r) * 6 * D + n] = s + P.ada_b[(size_t)l * 6 * D + n]; }
            __syncthreads();
        }
    }
    {
        const int gt = F.vcu * 512 + F.tid, NGT = F.G * 512;
        float* rope = (float*)(ws + WS_ROPE);
        for (int i = gt; i < SEQ * 16; i += NGT) { const int t = i >> 4, pi = i & 15, axis = pi >> 3, f = pi & 7;
            const float inv = exp2f(-(float)f * (13.287712379549449f / 8.0f));
            const float ang = (float)(axis ? (t & 63) : (t >> 6)) * inv; float s, c; sincosf(ang, &s, &c); rope[2 * i] = c; rope[2 * i + 1] = s; }
        for (int i = gt; i < DEPTH * 2048; i += NGT) {
            const int l = i >> 11, d = (i >> 10) & 1, g = (i >> 6) & 15, p = i & 63;
            unsigned char* sp = ws + WS_S5P + (size_t)l * S5P_BYTES;
            const float are = fminf(P.s5_a_re[i], -1e-4f), aim = P.s5_a_im[i];
            const float dt = expf(P.s5_log_dt[(l * 2 + d) * 16 + g]);
            const float zre = dt * are; const double zim = (double)dt * (double)aim;
            double sn, cs; sincos_d(zim, sn, cs);
            const float mag = expf(zre), abre = mag * (float)cs, abim = mag * (float)sn;
            double sn2, cs2; sincos_d(128.0 * zim, sn2, cs2); const float mag2 = expf(128.0f * zre);
            ((f32x2*)(sp + S5P_ABAR))[i & 2047] = (f32x2){abre, abim};
            ((f32x2*)(sp + S5P_A128))[i & 2047] = (f32x2){mag2 * (float)cs2, mag2 * (float)sn2};
            const float den = are * are + aim * aim, nre = abre - 1.0f;
            const float cfre = (nre * are + abim * aim) / den, cfim = (abim * are - nre * aim) / den;
            const float* bre = P.s5_b_re + (((size_t)l * 16 + g) * 64 + p) * 16; const float* bim = P.s5_b_im + (((size_t)l * 16 + g) * 64 + p) * 16;
            bf16* bp = (bf16*)(sp + S5P_BP) + (((size_t)d * 16 + g) * 128 + 2 * p) * 16;
#pragma unroll
            for (int c = 0; c < 16; ++c) { const float br = bre[c], bi = bim[c]; bp[c] = (bf16)f2bf(cfre * br - cfim * bi); bp[16 + c] = (bf16)f2bf(cfre * bi + cfim * br); }
            if (d == 0) { bf16* ch = (bf16*)(sp + S5P_CH) + (size_t)g * 16 * 128;
#pragma unroll
                for (int c = 0; c < 16; ++c) { const size_t ci = (((size_t)l * 16 + g) * 16 + c) * 64 + p; ch[c * 128 + 2 * p] = (bf16)f2bf(P.s5_c_re[ci]); ch[c * 128 + 2 * p + 1] = (bf16)f2bf(-P.s5_c_im[ci]); } }
        }
        if (gt < DEPTH) { const int l = gt; float* lp = (float*)(ws + WS_LAYP) + l * 64;
            for (int j = 0; j < 8; ++j) { const float x = P.ret_decay[l * 8 + j]; lp[j] = -log2f(1.0f + expf(-x)); }
            const float* dl = P.diff_lambda + l * 128; float d01 = 0.f, d23 = 0.f;
            for (int j = 0; j < 32; ++j) { d01 += dl[j] * dl[32 + j]; d23 += dl[64 + j] * dl[96 + j]; }
            const float li = 0.8f - 0.6f * expf(-0.3f * (float)l);
            lp[8] = expf(d01) - expf(d23) + li; lp[9] = 1.0f - li; }
    }
}
struct RowArgs {
    const float *x, *ctx;
    const float *post_g;
    const float *pre_g;
    const float *router_w, *router_b;
    float* out;
    int l, nrows, moe, last;
};
template <int MODE>
__device__ __forceinline__ void row_pass(Frame& F, const RowArgs& A) {
    unsigned char* ws = F.ws;
    float* H = (float*)(ws + WS_H); bf16* AF = (bf16*)(ws + WS_AF); const float* Y = (const float*)(ws + WS_Y);
    const float* mods = (const float*)(ws + WS_MODS);
    const int gw = F.vcu * NWAVES + F.wave, NGW = F.G * NWAVES, lane = opaque_v(F.lane);
    volatile LAS unsigned* cnt = F.MISC + 16;
    if (MODE == 1 && A.moe) { if (F.tid < 8) cnt[F.tid] = 0u; __syncthreads(); }
    const int lg = A.l, lm = (MODE == 2) ? A.l + 1 : A.l;
    const int goff = (MODE == 1) ? 2 * D : 5 * D, shoff = (MODE == 1) ? 3 * D : 0, scoff = (MODE == 1) ? 4 * D : D;
    for (int row = gw; row < A.nrows; row += NGW) {
        const int br = row < RL ? (row >> 11) : 16;
        f32x4 h[4];
        if (MODE == 0) {
            const float* src = row < RL ? A.x + (size_t)row * D : A.ctx + (size_t)(row - RL) * D;
#pragma unroll
            for (int j = 0; j < 4; ++j) h[j] = *(const f32x4*)(src + 4 * lane + 256 * j);
        } else {
            f32x4 y[4]; float ss = 0.f;
            if (MODE == 2 && A.moe) {
                const int* rec = (const int*)(ws + WS_REC) + (size_t)row * 8;
                const int p0 = rec[6], p1 = rec[7]; const float w0 = __builtin_bit_cast(float, rec[2]), w1 = __builtin_bit_cast(float, rec[3]);
                const bf16* ys = (const bf16*)(ws + WS_YS);
#pragma unroll
                for (int j = 0; j < 4; ++j) { const u32x2 a = *(const u32x2*)(ys + (size_t)p0 * D + 4 * lane + 256 * j), b = *(const u32x2*)(ys + (size_t)p1 * D + 4 * lane + 256 * j);
                    y[j] = (f32x4){w0 * bflo(a.x) + w1 * bflo(b.x), w0 * bfhi(a.x) + w1 * bfhi(b.x), w0 * bflo(a.y) + w1 * bflo(b.y), w0 * bfhi(a.y) + w1 * bfhi(b.y)}; }
            } else {
#pragma unroll
                for (int j = 0; j < 4; ++j) y[j] = *(const f32x4*)(Y + (size_t)row * D + 4 * lane + 256 * j);
            }
#pragma unroll
            for (int j = 0; j < 4; ++j) ss += (y[j][0] * y[j][0] + y[j][1] * y[j][1]) + (y[j][2] * y[j][2] + y[j][3] * y[j][3]);
            const float rstd = 1.0f / sqrtf(wave_sum(ss) * (1.0f / D) + EPS);
            const float* gate = mods + ((size_t)lg * 17 + br) * 6 * D + goff;
#pragma unroll
            for (int j = 0; j < 4; ++j) { const int c = 4 * lane + 256 * j; const f32x4 hv = *(const f32x4*)(H + (size_t)row * D + c), gv = *(const f32x4*)(gate + c), pg = *(const f32x4*)(A.post_g + c);
                h[j] = hv + gv * (y[j] * rstd * pg); }
        }
        if (MODE == 2 && A.last) {
#pragma unroll
            for (int j = 0; j < 4; ++j) *(f32x4*)(A.out + (size_t)row * D + 4 * lane + 256 * j) = h[j];
            continue;
        }
#pragma unroll
        for (int j = 0; j < 4; ++j) *(f32x4*)(H + (size_t)row * D + 4 * lane + 256 * j) = h[j];
        float s2 = 0.f;
#pragma unroll
        for (int j = 0; j < 4; ++j) s2 += (h[j][0] * h[j][0] + h[j][1] * h[j][1]) + (h[j][2] * h[j][2] + h[j][3] * h[j][3]);
        const float rs2 = 1.0f / sqrtf(wave_sum(s2) * (1.0f / D) + EPS);
        const float* mrow = mods + ((size_t)lm * 17 + br) * 6 * D;
        f32x4 f[4];
#pragma unroll
        for (int j = 0; j < 4; ++j) { const int c = 4 * lane + 256 * j; const f32x4 pg = *(const f32x4*)(A.pre_g + c), sh = *(const f32x4*)(mrow + shoff + c), sc = *(const f32x4*)(mrow + scoff + c);
            f[j] = (h[j] * rs2 * pg) * (1.0f + sc) + sh;
            u32x2 w; w.x = pk2(f[j][0], f[j][1]); w.y = pk2(f[j][2], f[j][3]); *(u32x2*)(AF + (size_t)row * D + c) = w; }
        if (MODE == 1 && A.moe) {
            float lg8[8];
#pragma unroll
            for (int e = 0; e < 8; ++e) lg8[e] = 0.f;
#pragma unroll
            for (int j = 0; j < 4; ++j)
#pragma unroll
                for (int q = 0; q < 4; ++q) { const float* rw = A.router_w + (size_t)(4 * lane + 256 * j + q) * 8; const f32x4 r0 = *(const f32x4*)rw, r1 = *(const f32x4*)(rw + 4); const float fv = f[j][q];
                    lg8[0] += fv * r0[0]; lg8[1] += fv * r0[1]; lg8[2] += fv * r0[2]; lg8[3] += fv * r0[3]; lg8[4] += fv * r1[0]; lg8[5] += fv * r1[1]; lg8[6] += fv * r1[2]; lg8[7] += fv * r1[3]; }
#pragma unroll
            for (int e = 0; e < 8; ++e) lg8[e] = wave_sum(lg8[e]) + A.router_b[e];
            int e0 = 0; float v0 = lg8[0];
#pragma unroll
            for (int e = 1; e < 8; ++e) if (lg8[e] > v0) { v0 = lg8[e]; e0 = e; }
            int e1 = -1; float v1 = -3.0e38f;
#pragma unroll
            for (int e = 0; e < 8; ++e) if (e != e0 && lg8[e] > v1) { v1 = lg8[e]; e1 = e; }
            const float w0 = 1.0f / (1.0f + __expf(v1 - v0)), w1 = 1.0f - w0;
            if (lane == 0) {
                const unsigned r0 = __hip_atomic_fetch_add((LAS unsigned*)(cnt + e0), 1u, __ATOMIC_RELAXED, __HIP_MEMORY_SCOPE_WORKGROUP);
                const unsigned r1 = __hip_atomic_fetch_add((LAS unsigned*)(cnt + e1), 1u, __ATOMIC_RELAXED, __HIP_MEMORY_SCOPE_WORKGROUP);
                int* rec = (int*)(ws + WS_REC) + (size_t)row * 8;
                rec[0] = e0; rec[1] = e1; rec[2] = __builtin_bit_cast(int, w0); rec[3] = __builtin_bit_cast(int, w1); rec[4] = (int)r0; rec[5] = (int)r1;
            }
        }
    }
    if (MODE == 1 && A.moe) { __syncthreads(); if (F.tid < 8) ((int*)(ws + WS_HIST))[blockIdx.x * 8 + F.tid] = (int)cnt[F.tid]; }
}

__device__ __forceinline__ void moe_dispatch(Frame& F, int nrows) {
    unsigned char* ws = F.ws;
    volatile LAS int* sh = (volatile LAS int*)F.lds;
    const int* hist = (const int*)(ws + WS_HIST);
    if (F.tid < 8) { int tot = 0, pre = 0; for (int b = 0; b < (int)gridDim.x; ++b) { const int v = hist[b * 8 + F.tid]; tot += v; if (b < (int)blockIdx.x) pre += v; } sh[F.tid] = tot; sh[8 + F.tid] = pre; }
    __syncthreads();
    if (F.tid == 0) { int base = 0; for (int e = 0; e < 8; ++e) { sh[24 + e] = base; sh[16 + e] = base + sh[8 + e]; base += (sh[e] + 255) & ~255; } sh[32] = base;
        if (blockIdx.x == 0) { int* te = (int*)(ws + WS_TILEE); int idx = 0; for (int e = 0; e < 8; ++e) { const int nt = (sh[e] + 255) >> 8; for (int t = 0; t < nt; ++t) te[idx++] = e; } te[400] = idx; } }
    __syncthreads();
    const int gw = F.vcu * NWAVES + F.wave, NGW = F.G * NWAVES, lane = F.lane;
    const bf16* AF = (const bf16*)(ws + WS_AF); bf16* FS = (bf16*)(ws + WS_FS);
    for (int row = gw; row < nrows; row += NGW) {
        int* rec = (int*)(ws + WS_REC) + (size_t)row * 8;
        const int e0 = rec[0], e1 = rec[1], r0 = rec[4], r1 = rec[5];
        const int p0 = sh[16 + e0] + r0, p1 = sh[16 + e1] + r1;
        const u32x4 a = *(const u32x4*)(AF + (size_t)row * D + 8 * lane), b = *(const u32x4*)(AF + (size_t)row * D + 512 + 8 * lane);
        *(u32x4*)(FS + (size_t)p0 * D + 8 * lane) = a; *(u32x4*)(FS + (size_t)p0 * D + 512 + 8 * lane) = b;
        *(u32x4*)(FS + (size_t)p1 * D + 8 * lane) = a; *(u32x4*)(FS + (size_t)p1 * D + 512 + 8 * lane) = b;
        if (lane == 0) { rec[6] = p0; rec[7] = p1; }
    }
}
__device__ __forceinline__ int chunk_row0(int b, int c) { return c < 2 ? RL + b * NCTX + c * 128 : b * SEQ + (c - 2) * 128; }
__device__ __forceinline__ bf16x8 tr_read2(unsigned a0, unsigned a1) {
    s16x4 lo, hi; asm volatile("ds_read_b64_tr_b16 %0, %2\n\tds_read_b64_tr_b16 %1, %3\n\ts_waitcnt lgkmcnt(0)" : "=&v"(lo), "=&v"(hi) : "v"(a0), "v"(a1) : "memory");
    return __builtin_shufflevector(lo, hi, 0, 1, 2, 3, 4, 5, 6, 7);
}
__device__ __forceinline__ unsigned scale_pk(unsigned w, float s) { return pk2(bflo(w) * s, bfhi(w) * s); }

constexpr int RS_KSTR = 288, RS_VSTR = 544, RS_KF = 0, RS_KB = 128 * RS_KSTR, RS_V = 2 * 128 * RS_KSTR;

__device__ __forceinline__ void ret_summary_unit(Frame& F, int b, int c, const float* lp) {
    const bf16* Z = (const bf16*)(F.ws + WS_Z); const int row0 = chunk_row0(b, c);
    LAS unsigned char* L = F.lds;
    for (int i = F.tid; i < 2048; i += 512) { const int a = i >> 4, ch = i & 15, hd = ch >> 2;
        const u32x4 kv = *(const u32x4*)(Z + (size_t)(row0 + a) * ZW + ZQ_RK + ch * 8);
        const float wf = exp2f((float)(127 - a) * lp[hd]), wb = exp2f((float)a * lp[4 + hd]);
        u32x4 f, g; f.x = scale_pk(kv.x, wf); f.y = scale_pk(kv.y, wf); f.z = scale_pk(kv.z, wf); f.w = scale_pk(kv.w, wf);
        g.x = scale_pk(kv.x, wb); g.y = scale_pk(kv.y, wb); g.z = scale_pk(kv.z, wb); g.w = scale_pk(kv.w, wb);
        *(LAS u32x4*)(L + RS_KF + a * RS_KSTR + ch * 16) = f; *(LAS u32x4*)(L + RS_KB + a * RS_KSTR + ch * 16) = g; }
    for (int i = F.tid; i < 4096; i += 512) { const int a = i >> 5, ch = i & 31;
        *(LAS u32x4*)(L + RS_V + a * RS_VSTR + ch * 16) = *(const u32x4*)(Z + (size_t)(row0 + a) * ZW + ZQ_RV + ch * 8); }
    __syncthreads();
    const int h = F.wave & 3, dir = F.wave >> 2, l = opaque_v(F.lane), hh = l >> 5, blk = (l >> 4) & 1, q = (l & 15) >> 2, p = l & 3;
    const unsigned lb = (unsigned)(size_t)L;
    f32x16 acc0, acc1;
#pragma unroll
    for (int r = 0; r < 16; ++r) { acc0[r] = 0.f; acc1[r] = 0.f; }
    const unsigned kbase = lb + (dir ? RS_KB : RS_KF) + (h * 32 + 16 * blk) * 2 + 8 * p;
    const unsigned vbase = lb + RS_V + (h * 64 + 16 * blk) * 2 + 8 * p;
#pragma unroll 2
    for (int ks = 0; ks < 8; ++ks) {
        const int r0 = 16 * ks + 8 * hh + q, r1 = r0 + 4;
        const bf16x8 bk = tr_read2(kbase + r0 * RS_KSTR, kbase + r1 * RS_KSTR);
        const bf16x8 a0 = tr_read2(vbase + r0 * RS_VSTR, vbase + r1 * RS_VSTR);
        const bf16x8 a1 = tr_read2(vbase + 64 + r0 * RS_VSTR, vbase + 64 + r1 * RS_VSTR);
        acc0 = __builtin_amdgcn_mfma_f32_32x32x16_bf16(a0, bk, acc0, 0, 0, 0);
        acc1 = __builtin_amdgcn_mfma_f32_32x32x16_bf16(a1, bk, acc1, 0, 0, 0);
    }
    float* out = (float*)(F.ws + WS_RETSUM) + ((((size_t)b * NCH + c) * 2 + dir) * 4 + h) * 2048;
#pragma unroll
    for (int r = 0; r < 16; ++r) { const int e = (r & 3) + 8 * (r >> 2) + 4 * hh; out[e * 32 + (l & 31)] = acc0[r]; out[(32 + e) * 32 + (l & 31)] = acc1[r]; }
    __syncthreads();
}

__device__ __forceinline__ void ret_prefix_unit(Frame& F, int b, int h, int dir, const float* lp) {
    const float g128 = exp2f(128.0f * lp[dir * 4 + h]);
    f32x4 S[8];
#pragma unroll
    for (int j = 0; j < 8; ++j) S[j] = (f32x4){0.f, 0.f, 0.f, 0.f};
    for (int i = 0; i < NCH; ++i) {
        const int c = dir == 0 ? i : (i == 0 ? 1 : (i == 1 ? 0 : 19 - i));
        const size_t idx = ((((size_t)b * NCH + c) * 2 + dir) * 4 + h) * 2048;
        const float* kv = (const float*)(F.ws + WS_RETSUM) + idx; bf16* st = (bf16*)(F.ws + WS_RETST) + idx;
#pragma unroll
        for (int j = 0; j < 8; ++j) { const int o = 4 * F.lane + 256 * j;
            u32x2 w; w.x = pk2(S[j][0], S[j][1]); w.y = pk2(S[j][2], S[j][3]); *(u32x2*)(st + o) = w;
            S[j] = S[j] * g128 + *(const f32x4*)(kv + o); }
    }
}
__device__ __forceinline__ void s5_prefix_unit(Frame& F, int b, int g, int d, int l) {
    const f32x2 a = ((const f32x2*)(F.ws + WS_S5P + (size_t)l * S5P_BYTES + S5P_A128))[(d * 16 + g) * 64 + F.lane];
    float cr = 0.f, ci = 0.f;
    for (int i = 0; i < NCH; ++i) {
        const int c = d == 0 ? i : (i == 0 ? 1 : (i == 1 ? 0 : 19 - i));
        const size_t idx = ((((size_t)b * NCH + c) * 16 + g) * 2 + d) * 64 + F.lane;
        ((f32x2*)(F.ws + WS_S5C))[idx] = (f32x2){cr, ci};
        const f32x2 e = ((const f32x2*)(F.ws + WS_S5E))[idx];
        const float nr = a.x * cr - a.y * ci + e.x, ni = a.x * ci + a.y * cr + e.y; cr = nr; ci = ni;
    }
}

constexpr int S5_XSTR = 132  , S5_HSTR = 272  , S5_WAVE_LDS = 16 * S5_XSTR * 4 + 16 * S5_HSTR;
template <bool OUT>
__device__ __forceinline__ void s5_wave_unit(Frame& F, int b, int c, int g, int l, const float* s5_d) {
    const unsigned char* sp = F.ws + WS_S5P + (size_t)l * S5P_BYTES;
    const bf16* Z = (const bf16*)(F.ws + WS_Z); const int row0 = chunk_row0(b, c);
    LAS float* X = (LAS float*)(F.lds + F.wave * S5_WAVE_LDS);
    LAS unsigned char* Hb = (LAS unsigned char*)X + 16 * S5_XSTR * 4;
    const int lane = opaque_v(F.lane), tk = lane & 15, kg = lane >> 4;
    const bf16x8 zero8 = (bf16x8){0, 0, 0, 0, 0, 0, 0, 0};
    f32x4 yacc[8]; bf16x8 chf[4];
    if (OUT) {
#pragma unroll
        for (int s = 0; s < 8; ++s) yacc[s] = (f32x4){0.f, 0.f, 0.f, 0.f};
#pragma unroll
        for (int ks = 0; ks < 4; ++ks) chf[ks] = *(const bf16x8*)((const bf16*)(sp + S5P_CH) + ((size_t)g * 16 + tk) * 128 + 32 * ks + 8 * kg);
    }
#pragma unroll 1
    for (int d = 0; d < 2; ++d) {
        const f32x2 ab = ((const f32x2*)(sp + S5P_ABAR))[(d * 16 + g) * 64 + lane];
        bf16x8 af[8];
#pragma unroll
        for (int rb = 0; rb < 8; ++rb) af[rb] = kg < 2 ? *(const bf16x8*)((const bf16*)(sp + S5P_BP) + (((size_t)d * 16 + g) * 128 + 16 * rb + tk) * 16 + 8 * kg) : zero8;
        float hr = 0.f, hi = 0.f;
        const size_t sidx = ((((size_t)b * NCH + c) * 16 + g) * 2 + d) * 64 + lane;
        if (OUT) { const f32x2 cin = ((const f32x2*)(F.ws + WS_S5C))[sidx]; hr = cin.x; hi = cin.y; }
#pragma unroll 1
        for (int si = 0; si < 8; ++si) {
            const int sub = d ? 7 - si : si;
            const bf16x8 uf = kg < 2 ? *(const bf16x8*)(Z + (size_t)(row0 + 16 * sub + tk) * ZW + ZQ_SU + g * 16 + 8 * kg) : zero8;
#pragma unroll
            for (int rb = 0; rb < 8; ++rb) { const f32x4 xa = __builtin_amdgcn_mfma_f32_16x16x32_bf16(af[rb], uf, (f32x4){0.f, 0.f, 0.f, 0.f}, 0, 0, 0);
                *(LAS f32x4*)(X + tk * S5_XSTR + 16 * rb + 4 * kg) = xa; }
#pragma unroll
            for (int ti = 0; ti < 16; ++ti) {
                const int tok = d ? 15 - ti : ti;
                const f32x2 x = *(const LAS f32x2*)(X + tok * S5_XSTR + 2 * lane);
                const float nr = ab.x * hr - ab.y * hi + x.x, ni = ab.x * hi + ab.y * hr + x.y; hr = nr; hi = ni;
                if (OUT) *(LAS unsigned*)(Hb + tok * S5_HSTR + 4 * lane) = cvt_pk_bf16(hr, hi);
            }
            if (OUT) {
                f32x4 ya = (f32x4){0.f, 0.f, 0.f, 0.f};
#pragma unroll
                for (int ks = 0; ks < 4; ++ks) { const bf16x8 hf = *(const LAS bf16x8*)(Hb + tk * S5_HSTR + (32 * ks + 8 * kg) * 2); ya = __builtin_amdgcn_mfma_f32_16x16x32_bf16(hf, chf[ks], ya, 0, 0, 0); }
#pragma unroll
                for (int s = 0; s < 8; ++s) if (s == sub) yacc[s] += ya;
            }
        }
        if (!OUT) ((f32x2*)(F.ws + WS_S5E))[sidx] = (f32x2){hr, hi};
    }
    if (OUT) {
        bf16* xb = (bf16*)(F.ws + WS_XB) + (size_t)1 * RT * 256;
        const float dsk = s5_d[((size_t)l * 16 + g) * 16 + tk];
#pragma unroll
        for (int s = 0; s < 8; ++s)
#pragma unroll
            for (int r = 0; r < 4; ++r) { const int row = row0 + 16 * s + 4 * kg + r;
                const float u = bf2f(Z[(size_t)row * ZW + ZQ_SU + g * 16 + tk]);
                const float y = yacc[s][r] + dsk * u;
                const float o = y * sigmoidf_(1.5957691216f * (y + 0.044715f * y * y * y));
                xb[(size_t)row * 256 + g * 16 + tk] = (bf16)f2bf(o); }
    }
}
__device__ __forceinline__ bf16x8 pack8(const f32x16& x, int s) {
    u32x4 p;
    if (s == 0) { p.x = cvt_pk_bf16(x[0], x[1]); p.y = cvt_pk_bf16(x[2], x[3]); p.z = cvt_pk_bf16(x[4], x[5]); p.w = cvt_pk_bf16(x[6], x[7]); }
    else { p.x = cvt_pk_bf16(x[8], x[9]); p.y = cvt_pk_bf16(x[10], x[11]); p.z = cvt_pk_bf16(x[12], x[13]); p.w = cvt_pk_bf16(x[14], x[15]); }
    return __builtin_bit_cast(bf16x8, p);
}
#define MFMA32(a, b, c) __builtin_amdgcn_mfma_f32_32x32x16_bf16((a), (b), (c), 0, 0, 0)

__device__ __forceinline__ void ret_out_unit(Frame& F, int b, int c, const float* lp) {
    const bf16* Z = (const bf16*)(F.ws + WS_Z); const int row0 = chunk_row0(b, c);
    LAS unsigned char* L = F.lds;
    for (int i = F.tid; i < 4096; i += 512) { const int a = i >> 5, ch = i & 31;
        *(LAS u32x4*)(L + a * RS_VSTR + ch * 16) = *(const u32x4*)(Z + (size_t)(row0 + a) * ZW + ZQ_RV + ch * 8); }
    __syncthreads();
    const int h = F.wave >> 1, ih = F.wave & 1, l = opaque_v(F.lane), li = l & 31, hh = l >> 5, blk = (l >> 4) & 1, q = (l & 15) >> 2, p = l & 3;
    const float lgf = lp[h], lgb = lp[4 + h];
    bf16x8 qf[2][2];
#pragma unroll
    for (int ib = 0; ib < 2; ++ib)
#pragma unroll
        for (int ks = 0; ks < 2; ++ks) qf[ib][ks] = *(const bf16x8*)(Z + (size_t)(row0 + 64 * ih + 32 * ib + li) * ZW + ZQ_RQ + 32 * h + 16 * ks + 8 * hh);
    f32x16 o[2][2];
#pragma unroll
    for (int eb = 0; eb < 2; ++eb)
#pragma unroll
        for (int ib = 0; ib < 2; ++ib)
#pragma unroll
            for (int r = 0; r < 16; ++r) o[eb][ib][r] = 0.f;
    const unsigned vbase = (unsigned)(size_t)L + (h * 64 + 16 * blk) * 2 + 8 * p;
#pragma unroll 1
    for (int jb = 0; jb < 4; ++jb) {
        bf16x8 kf[2];
#pragma unroll
        for (int ks = 0; ks < 2; ++ks) kf[ks] = *(const bf16x8*)(Z + (size_t)(row0 + 32 * jb + li) * ZW + ZQ_RK + 32 * h + 16 * ks + 8 * hh);
        bf16x8 vf[2][2];
#pragma unroll
        for (int s2 = 0; s2 < 2; ++s2) { const int r0 = 32 * jb + 16 * s2 + 4 * hh + q, r1 = r0 + 8;
            vf[0][s2] = tr_read2(vbase + r0 * RS_VSTR, vbase + r1 * RS_VSTR); vf[1][s2] = tr_read2(vbase + 64 + r0 * RS_VSTR, vbase + 64 + r1 * RS_VSTR); }
#pragma unroll
        for (int ib = 0; ib < 2; ++ib) {
            f32x16 s;
#pragma unroll
            for (int r = 0; r < 16; ++r) s[r] = 0.f;
            s = MFMA32(kf[0], qf[ib][0], s); s = MFMA32(kf[1], qf[ib][1], s);
            const int iq = 64 * ih + 32 * ib + li;
#pragma unroll
            for (int r = 0; r < 16; ++r) { const int j = 32 * jb + (r & 3) + 8 * (r >> 2) + 4 * hh; const int dl = iq - j;
                s[r] *= dl >= 0 ? exp2f((float)dl * lgf) : exp2f((float)(-dl) * lgb); }
            const bf16x8 p0 = pack8(s, 0), p1 = pack8(s, 1);
            o[0][ib] = MFMA32(vf[0][0], p0, o[0][ib]); o[0][ib] = MFMA32(vf[0][1], p1, o[0][ib]);
            o[1][ib] = MFMA32(vf[1][0], p0, o[1][ib]); o[1][ib] = MFMA32(vf[1][1], p1, o[1][ib]);
        }
    }
#pragma unroll
    for (int dir = 0; dir < 2; ++dir) {
        const bf16* st = (const bf16*)(F.ws + WS_RETST) + ((((size_t)b * NCH + c) * 2 + dir) * 4 + h) * 2048;
#pragma unroll
        for (int eb = 0; eb < 2; ++eb) {
            const bf16x8 s0 = *(const bf16x8*)(st + (32 * eb + li) * 32 + 8 * hh), s1 = *(const bf16x8*)(st + (32 * eb + li) * 32 + 16 + 8 * hh);
#pragma unroll
            for (int ib = 0; ib < 2; ++ib) {
                f32x16 x;
#pragma unroll
                for (int r = 0; r < 16; ++r) x[r] = 0.f;
                x = MFMA32(s0, qf[ib][0], x); x = MFMA32(s1, qf[ib][1], x);
                const int a = 64 * ih + 32 * ib + li;
                const float wq = dir == 0 ? exp2f((float)(a + 1) * lgf) : exp2f((float)(128 - a) * lgb);
#pragma unroll
                for (int r = 0; r < 16; ++r) o[eb][ib][r] += wq * x[r];
            }
        }
    }
    bf16* xb = (bf16*)(F.ws + WS_XB);
#pragma unroll
    for (int ib = 0; ib < 2; ++ib) {
        float sm = 0.f;
#pragma unroll
        for (int r = 0; r < 16; ++r) sm += o[0][ib][r] + o[1][ib][r];
        sm += __shfl_xor(sm, 32); const float mean = sm * (1.0f / 64.0f);
        float sq = 0.f;
#pragma unroll
        for (int r = 0; r < 16; ++r) { const float d0 = o[0][ib][r] - mean, d1 = o[1][ib][r] - mean; sq += d0 * d0 + d1 * d1; }
        sq += __shfl_xor(sq, 32); const float rstd = 1.0f / sqrtf(sq * (1.0f / 64.0f) + EPS);
        const size_t row = (size_t)(row0 + 64 * ih + 32 * ib + li);
#pragma unroll
        for (int eb = 0; eb < 2; ++eb)
#pragma unroll
            for (int g4 = 0; g4 < 4; ++g4) { const int e = 32 * eb + 8 * g4 + 4 * hh;
                const u32x2 gw = *(const u32x2*)(Z + row * ZW + ZQ_RG + h * 64 + e);
                const float y0 = (o[eb][ib][4 * g4 + 0] - mean) * rstd * siluf_(bflo(gw.x)), y1 = (o[eb][ib][4 * g4 + 1] - mean) * rstd * siluf_(bfhi(gw.x));
                const float y2 = (o[eb][ib][4 * g4 + 2] - mean) * rstd * siluf_(bflo(gw.y)), y3 = (o[eb][ib][4 * g4 + 3] - mean) * rstd * siluf_(bfhi(gw.y));
                u32x2 w; w.x = cvt_pk_bf16(y0, y1); w.y = cvt_pk_bf16(y2, y3); *(u32x2*)(xb + row * 256 + h * 64 + e) = w; }
    }
    __syncthreads();
}

constexpr int AT_STR = 144, AT_TILE = 64 * AT_STR;
__device__ __forceinline__ void attn_unit(Frame& F, int b, int h, int qrow0, int nkt, bool ctx_only, float lam, float omli, const float* subln_g) {
    const bf16* Z = (const bf16*)(F.ws + WS_Z);
    LAS unsigned char* L = F.lds; const unsigned lb = (unsigned)(size_t)L;
    const int l = opaque_v(F.lane), li = l & 31, hh = l >> 5, blk = (l >> 4) & 1, q4 = (l & 15) >> 2, p = l & 3;
    const int qrow = qrow0 + 32 * F.wave + li;
    bf16x8 qf[2][2];
#pragma unroll
    for (int mp = 0; mp < 2; ++mp)
#pragma unroll
        for (int ks = 0; ks < 2; ++ks) qf[mp][ks] = *(const bf16x8*)(Z + (size_t)qrow * ZW + ZQ_DQ + h * 64 + mp * 32 + 16 * ks + 8 * hh);
    f32x16 o[2][2];
#pragma unroll
    for (int mp = 0; mp < 2; ++mp)
#pragma unroll
        for (int eb = 0; eb < 2; ++eb)
#pragma unroll
            for (int r = 0; r < 16; ++r) o[mp][eb][r] = 0.f;
    float mx[2] = {-3.0e38f, -3.0e38f}, ls[2] = {0.f, 0.f};
    const int stid = opaque_v(F.tid), skey = stid >> 3, sch = stid & 7;
    auto key_row = [&](int kt) -> int { const int k0 = kt * 64; return (ctx_only || k0 < NCTX) ? RL + b * NCTX + k0 : b * SEQ + (k0 - NCTX); };
    u32x4 kreg, vreg;
    { const size_t r = (size_t)(key_row(0) + skey); kreg = *(const u32x4*)(Z + r * ZW + ZQ_DK + h * 64 + sch * 8); vreg = *(const u32x4*)(Z + r * ZW + ZQ_DV + h * 64 + sch * 8); }
#pragma unroll 1
    for (int kt = 0; kt < nkt; ++kt) {
        const int buf = kt & 1;
        *(LAS u32x4*)(L + buf * 2 * AT_TILE + skey * AT_STR + sch * 16) = kreg;
        *(LAS u32x4*)(L + buf * 2 * AT_TILE + AT_TILE + skey * AT_STR + sch * 16) = vreg;
        __syncthreads();
        if (kt + 1 < nkt) { const size_t r = (size_t)(key_row(kt + 1) + skey); kreg = *(const u32x4*)(Z + r * ZW + ZQ_DK + h * 64 + sch * 8); vreg = *(const u32x4*)(Z + r * ZW + ZQ_DV + h * 64 + sch * 8); }
        const LAS unsigned char* Kt = L + buf * 2 * AT_TILE; const unsigned vb = lb + buf * 2 * AT_TILE + AT_TILE + 16 * blk * 2 + 8 * p;
        bf16x8 vf[2][4];
#pragma unroll
        for (int k4 = 0; k4 < 4; ++k4) { const int r0 = 16 * k4 + 4 * hh + q4, r1 = r0 + 8;
            vf[0][k4] = tr_read2(vb + r0 * AT_STR, vb + r1 * AT_STR); vf[1][k4] = tr_read2(vb + 64 + r0 * AT_STR, vb + 64 + r1 * AT_STR); }
#pragma unroll
        for (int mp = 0; mp < 2; ++mp) {
            f32x16 s[2];
#pragma unroll
            for (int kb = 0; kb < 2; ++kb) {
#pragma unroll
                for (int r = 0; r < 16; ++r) s[kb][r] = 0.f;
#pragma unroll
                for (int ks = 0; ks < 2; ++ks) { const bf16x8 ka = *(const LAS bf16x8*)(Kt + (32 * kb + li) * AT_STR + (mp * 32 + 16 * ks + 8 * hh) * 2); s[kb] = MFMA32(ka, qf[mp][ks], s[kb]); }
            }
            float tm = s[0][0];
#pragma unroll
            for (int r = 1; r < 16; ++r) tm = fmaxf(tm, s[0][r]);
#pragma unroll
            for (int r = 0; r < 16; ++r) tm = fmaxf(tm, s[1][r]);
            tm = fmaxf(tm, __shfl_xor(tm, 32));
            if (__any(tm > mx[mp])) {
                const float mn = fmaxf(mx[mp], tm), al = exp2f((mx[mp] - mn) * 1.44269504f);
                mx[mp] = mn; ls[mp] *= al;
#pragma unroll
                for (int eb = 0; eb < 2; ++eb)
#pragma unroll
                    for (int r = 0; r < 16; ++r) o[mp][eb][r] *= al;
            }
            const float mb = mx[mp] * 1.44269504f; float rs = 0.f;
#pragma unroll
            for (int kb = 0; kb < 2; ++kb)
#pragma unroll
                for (int r = 0; r < 16; ++r) { const float pv = exp2f(s[kb][r] * 1.44269504f - mb); s[kb][r] = pv; rs += pv; }
            ls[mp] += rs;
#pragma unroll
            for (int kb = 0; kb < 2; ++kb)
#pragma unroll
                for (int s2 = 0; s2 < 2; ++s2) { const bf16x8 pb = pack8(s[kb], s2);
                    o[mp][0] = MFMA32(vf[0][2 * kb + s2], pb, o[mp][0]); o[mp][1] = MFMA32(vf[1][2 * kb + s2], pb, o[mp][1]); }
        }
    }
    const float l0 = ls[0] + __shfl_xor(ls[0], 32), l1 = ls[1] + __shfl_xor(ls[1], 32);
    const float i0 = 1.0f / l0, i1 = lam / l1;
    float sq = 0.f;
#pragma unroll
    for (int eb = 0; eb < 2; ++eb)
#pragma unroll
        for (int r = 0; r < 16; ++r) { const float v = o[0][eb][r] * i0 - o[1][eb][r] * i1; o[0][eb][r] = v; sq += v * v; }
    sq += __shfl_xor(sq, 32);
    const float rstd = omli / sqrtf(sq * (1.0f / 64.0f) + EPS);
    bf16* xb = (bf16*)(F.ws + WS_XB) + (size_t)2 * RT * 256;
#pragma unroll
    for (int eb = 0; eb < 2; ++eb)
#pragma unroll
        for (int g4 = 0; g4 < 4; ++g4) { const int e = 32 * eb + 8 * g4 + 4 * hh; const f32x4 sg = *(const f32x4*)(subln_g + e);
            u32x2 w; w.x = cvt_pk_bf16(o[0][eb][4 * g4] * rstd * sg[0], o[0][eb][4 * g4 + 1] * rstd * sg[1]); w.y = cvt_pk_bf16(o[0][eb][4 * g4 + 2] * rstd * sg[2], o[0][eb][4 * g4 + 3] * rstd * sg[3]);
            *(u32x2*)(xb + (size_t)qrow * 256 + h * 64 + e) = w; }
    __syncthreads();
}

__device__ __forceinline__ void conv_unit(Frame& F, int seq_row0, int seq_len, int tok0, const float* dw, const float* db, const float* lng, const float* lnb) {
    const bf16* Z = (const bf16*)(F.ws + WS_Z);
    LAS unsigned short* U = (LAS unsigned short*)F.lds;
    LAS float* Yt = (LAS float*)(F.lds + 94 * 512);
    for (int i = F.tid; i < 94 * 32; i += 512) { const int tt = i >> 5, ch = i & 31; const int t = tok0 - 15 + tt;
        u32x4 v = (u32x4){0u, 0u, 0u, 0u}; if (t >= 0 && t < seq_len) v = *(const u32x4*)(Z + (size_t)(seq_row0 + t) * ZW + ZQ_CV + ch * 8);
        *(LAS u32x4*)(U + tt * 256 + ch * 8) = v; }
    __syncthreads();
    const int ctid = opaque_v(F.tid), ch = ctid & 255, half = ctid >> 8;
    float w[31];
#pragma unroll
    for (int k = 0; k < 31; ++k) w[k] = dw[k * 256 + ch];
    const float bias = db[ch];
#pragma unroll 1
    for (int g = 0; g < 2; ++g) {
        const int t0 = half * 32 + g * 16;
        float x[46];
#pragma unroll
        for (int i = 0; i < 46; ++i) x[i] = bf2f(U[(t0 + i) * 256 + ch]);
#pragma unroll
        for (int j = 0; j < 16; ++j) { float a = bias;
#pragma unroll
            for (int k = 0; k < 31; ++k) a += w[k] * x[j + k];
            Yt[(t0 + j) * 256 + ch] = a; }
    }
    __syncthreads();
    bf16* xb = (bf16*)(F.ws + WS_XB) + (size_t)3 * RT * 256;
    for (int t = F.wave; t < 64; t += 8) {
        const f32x4 y = *(const LAS f32x4*)(Yt + t * 256 + 4 * F.lane);
        const float mean = wave_sum((y[0] + y[1]) + (y[2] + y[3])) * (1.0f / 256.0f);
        const f32x4 dv = y - mean; const float var = wave_sum((dv[0] * dv[0] + dv[1] * dv[1]) + (dv[2] * dv[2] + dv[3] * dv[3])) * (1.0f / 256.0f);
        const float rstd = 1.0f / sqrtf(var + EPS);
        const f32x4 g4 = *(const f32x4*)(lng + 4 * F.lane), b4 = *(const f32x4*)(lnb + 4 * F.lane);
        const f32x4 z = dv * rstd * g4 + b4;
        u32x2 wv; wv.x = cvt_pk_bf16(siluf_(z[0]), siluf_(z[1])); wv.y = cvt_pk_bf16(siluf_(z[2]), siluf_(z[3]));
        *(u32x2*)(xb + (size_t)(seq_row0 + tok0 + t) * 256 + 4 * F.lane) = wv;
    }
    __syncthreads();
}
constexpr int NSTEP_L = 12, NSTEPS = 2 + DEPTH * NSTEP_L;
struct Args { const float* in[39]; float* out; unsigned char* ws; int s_lo, s_hi; };
static_assert(sizeof(Args) == 39 * 8 + 8 + 8 + 8, "Args has no padding");

template <int OFF> __device__ __forceinline__ unsigned long long ka64() { unsigned long long v; asm volatile("s_load_dwordx2 %0, %1, %2\n\ts_waitcnt lgkmcnt(0)" : "=s"(v) : "s"(__builtin_amdgcn_kernarg_segment_ptr()), "n"(OFF)); return v; }
template <int OFF> __device__ __forceinline__ int ka32() { int v; asm volatile("s_load_dword %0, %1, %2\n\ts_waitcnt lgkmcnt(0)" : "=s"(v) : "s"(__builtin_amdgcn_kernarg_segment_ptr()), "n"(OFF)); return v; }
#define KIN(k) ((const float*)ka64<8 * (k)>())
#define KOUT ((float*)ka64<312>())
#define KWS ((unsigned char*)ka64<320>())
__global__ void __launch_bounds__(NWAVES * 64, 2) fwd_kernel(Args) {
    extern __shared__ __attribute__((aligned(16))) unsigned char lds[];
    Frame F;
    F.lds = (LAS unsigned char*)lds;
    F.MISC = (volatile LAS unsigned*)(F.lds + MISC_OFF);
    F.tid = threadIdx.x; F.lane = F.tid & 63; F.wave = __builtin_amdgcn_readfirstlane(F.tid >> 6);
    F.G = gridDim.x; { const int bx = blockIdx.x; F.vcu = (F.G % 8 == 0) ? (bx % 8) * (F.G / 8) + bx / 8 : bx; }
    F.ws = KWS;
    unsigned char* ws = F.ws;
    for (int u = F.tid; u < (LDS_BYTES - LDSCTL_OFF) / 4; u += NWAVES * 64) ((LAS unsigned*)(F.lds + LDSCTL_OFF))[u] = 0u;
    __syncthreads();
    unsigned* barw = (unsigned*)(ws + WS_CTL) + CW_BAR; asm volatile("" : "+s"(barw));
    const int lo = ka32<328>(), hi = ka32<332>();
    XcdBarrier bar; bar.bar = barw; bar.x = 0; bar.st = nullptr;
    if (hi - lo > 1) bar = xcd_barrier_post(barw, F.MISC + 8);
#ifndef PH_MASK
#define PH_MASK 0xFFFFF
#endif
#define EN(j) (((PH_MASK) >> (j)) & 1)
#define IN(k) (lo <= (k) && (k) < hi)
#define FRESH() do { F.tid = opaque_v(F.tid); F.lane = F.tid & 63; F.wave = __builtin_amdgcn_readfirstlane(F.tid >> 6); F.vcu = opaque_s(F.vcu); F.G = opaque_s(F.G); asm volatile("" : "+s"(F.ws)); ws = F.ws; } while (0)
#define GW (F.vcu * NWAVES + F.wave)
#define NGW_ (F.G * NWAVES)
#define SEAM(k) do { if (IN(k) && IN((k) + 1)) xcd_barrier(bar); } while (0)

    if (EN(12) && IN(0)) { FRESH();
        P0Args P; P.c = KIN(1); P.c_ctx = KIN(3); P.ada_w = KIN(4); P.ada_b = KIN(5); P.w_in = KIN(10); P.w_gate = KIN(11); P.ret_w_o = KIN(14); P.s5_w_glu = KIN(23);
        P.diff_w_o = KIN(26); P.conv_w_o = KIN(31); P.w_out = KIN(32); P.ffn_w_gu = KIN(33); P.ffn_w_d = KIN(34); P.moe_w_gu = KIN(37); P.moe_w_d = KIN(38);
        P.ret_decay = KIN(13); P.s5_a_re = KIN(15); P.s5_a_im = KIN(16); P.s5_log_dt = KIN(17); P.s5_b_re = KIN(18); P.s5_b_im = KIN(19); P.s5_c_re = KIN(20); P.s5_c_im = KIN(21); P.diff_lambda = KIN(24);
        p0_prologue(F, P);
    }
    SEAM(0);
    if (EN(13) && IN(1)) { FRESH(); RowArgs A{}; A.x = KIN(0); A.ctx = KIN(2); A.pre_g = KIN(6); A.l = 0; A.nrows = RT; row_pass<0>(F, A); }
    SEAM(1);

#pragma unroll 1
    for (int l = 0; l < DEPTH; ++l) {
        const int s0 = 2 + l * NSTEP_L;
        if (hi <= s0 || lo >= s0 + NSTEP_L) continue;
        const bool need_ctx = l < DEPTH - 1, moe = (l & 1) != 0;
        const int nrows = need_ctx ? RT : RL, nM = nrows / 256, j2 = l >> 1;
#define lp ((const float*)(ws + WS_LAYP) + l * 64)
#define AF ((bf16*)(ws + WS_AF))
#define Z ((bf16*)(ws + WS_Z))

        if (EN(0) && IN(s0 + 0)) { FRESH();
            pg8::Gemm g{AF, (const bf16*)(ws + WS_WIN) + (size_t)l * E_WIN, D}; pg8::SchedStd S; S.init(RT / 256, NIN / 256, F.G, opaque_s((int)blockIdx.x));
            pg8::EpiWin E{Z, (const float*)(ws + WS_ROPE)};
            pg8::gemm_phase(F.lds, g, S, E);
        }
        SEAM(s0 + 0);
        if (EN(1) && IN(s0 + 1)) { FRESH();
            for (int u = F.vcu; u < NB * NCH; u += F.G) ret_summary_unit(F, u / NCH, u % NCH, lp);
            for (int wu = GW; wu < NB * NCH * 16; wu += NGW_) { const int g = wu & 15, bc = wu >> 4; s5_wave_unit<false>(F, bc / NCH, bc % NCH, g, l, nullptr); }
        }
        SEAM(s0 + 1);
        if (EN(2) && IN(s0 + 2)) { FRESH();
            for (int wu = GW; wu < 128 + 512; wu += NGW_) {
                if (wu < 128) ret_prefix_unit(F, wu >> 3, (wu >> 1) & 3, wu & 1, lp);
                else { const int v = wu - 128; s5_prefix_unit(F, v >> 5, (v >> 1) & 15, v & 1, l); }
            }
        }
        SEAM(s0 + 2);
        if (EN(3) && IN(s0 + 3)) { FRESH();
            const int c_lo = need_ctx ? 0 : 2, nch = NCH - c_lo;
            if (EN(16)) { FRESH(); const int natt = need_ctx ? 576 : 512; const float lam = lp[8], omli = lp[9]; const float* sg = KIN(25) + l * 64;
              for (int u = F.vcu; u < natt; u += F.G) {
                  if (u < 512) attn_unit(F, u >> 5, (u >> 3) & 3, (u >> 5) * SEQ + (u & 7) * 256, 36, false, lam, omli, sg);
                  else { const int v = u - 512; attn_unit(F, v >> 2, v & 3, RL + (v >> 2) * NCTX, 4, true, lam, omli, sg); } } }
            if (EN(17)) { FRESH(); const int vb = (F.vcu + F.G - 64 % F.G) % F.G;
              for (int u = vb; u < NB * nch; u += F.G) ret_out_unit(F, u / nch, c_lo + u % nch, lp); }
            if (EN(18)) { FRESH(); const int vw = ((F.vcu + F.G - 96 % F.G) % F.G) * NWAVES + F.wave;
              for (int wu = vw; wu < NB * nch * 16; wu += NGW_) { const int g = wu & 15, bc = wu >> 4; s5_wave_unit<true>(F, bc / nch, c_lo + bc % nch, g, l, KIN(22)); } }
            __syncthreads();
            if (EN(19)) { FRESH(); const int ncv = need_ctx ? 576 : 512; const int vb = (F.vcu + F.G - 160 % F.G) % F.G;
              const float* dw = KIN(27) + (size_t)l * 31 * 256; const float* db = KIN(28) + l * 256; const float* lng = KIN(29) + l * 256; const float* lnb = KIN(30) + l * 256;
              for (int u = vb; u < ncv; u += F.G) {
                  if (u < 512) conv_unit(F, (u >> 5) * SEQ, SEQ, (u & 31) * 64, dw, db, lng, lnb);
                  else { const int v = u - 512; conv_unit(F, RL + (v >> 2) * NCTX, NCTX, (v & 3) * 64, dw, db, lng, lnb); } } }
        }
        SEAM(s0 + 3);
        if (EN(4) && IN(s0 + 4)) { FRESH();
            pg8::Gemm g{(const bf16*)(ws + WS_XB), (const bf16*)(ws + WS_WBR) + (size_t)l * E_WBR, 256}; pg8::SchedBr S; S.init(nM, F.G, opaque_s((int)blockIdx.x));
            pg8::EpiBr E{(bf16*)(ws + WS_BO)};
            pg8::gemm_phase(F.lds, g, S, E);
        }
        SEAM(s0 + 4);
        if (EN(5) && IN(s0 + 5)) { FRESH();
            pg8::Gemm g{AF, (const bf16*)(ws + WS_WG) + (size_t)l * E_WG, D}; pg8::SchedGate S; S.init(nM, F.G, opaque_s((int)blockIdx.x));
            pg8::EpiGate E{(const bf16*)(ws + WS_BO), (bf16*)(ws + WS_MM), KIN(12) + (size_t)l * 4 * D};
            pg8::gemm_phase(F.lds, g, S, E);
        }
        SEAM(s0 + 5);
        if (EN(6) && IN(s0 + 6)) { FRESH();
            pg8::Gemm g{(const bf16*)(ws + WS_MM), (const bf16*)(ws + WS_WOUT) + (size_t)l * E_WOUT, D}; pg8::SchedStd S; S.init(nM, 4, F.G, opaque_s((int)blockIdx.x));
            pg8::EpiF32 E{(float*)(ws + WS_Y), D};
            pg8::gemm_phase(F.lds, g, S, E);
        }
        SEAM(s0 + 6);
        if (EN(7) && IN(s0 + 7)) { FRESH(); RowArgs A{}; A.post_g = KIN(7) + l * D; A.pre_g = KIN(8) + l * D; A.l = l; A.nrows = nrows; A.moe = moe ? 1 : 0;
            A.router_w = KIN(35) + (size_t)j2 * D * NE; A.router_b = KIN(36) + j2 * NE; row_pass<1>(F, A); }
        SEAM(s0 + 7);
        if (moe) {
            if (EN(8) && IN(s0 + 8)) { FRESH(); moe_dispatch(F, nrows); }
            SEAM(s0 + 8);
            if (EN(9) && IN(s0 + 9)) { FRESH();
                const int* te = (const int*)(ws + WS_TILEE); const int nt = __builtin_amdgcn_readfirstlane(__hip_atomic_load(te + 400, RLX_AGENT));
                pg8::Gemm g{(const bf16*)(ws + WS_FS), (const bf16*)(ws + WS_MGU) + (size_t)j2 * NE * E_MGU, D}; pg8::SchedMoe S; S.init(nt, 2 * FFE / 256, F.G, opaque_s((int)blockIdx.x), te);
                pg8::EpiSwiGLU E{(bf16*)(ws + WS_GS), FFE};
                pg8::gemm_phase(F.lds, g, S, E);
            }
            SEAM(s0 + 9);
            if (EN(10) && IN(s0 + 10)) { FRESH();
                const int* te = (const int*)(ws + WS_TILEE); const int nt = __builtin_amdgcn_readfirstlane(__hip_atomic_load(te + 400, RLX_AGENT));
                pg8::Gemm g{(const bf16*)(ws + WS_GS), (const bf16*)(ws + WS_MWD) + (size_t)j2 * NE * E_MWD, FFE}; pg8::SchedMoe S; S.init(nt, 4, F.G, opaque_s((int)blockIdx.x), te);
                pg8::EpiBf16 E{(bf16*)(ws + WS_YS), D};
                pg8::gemm_phase(F.lds, g, S, E);
            }
            SEAM(s0 + 10);
        } else {
            if (IN(s0 + 8) && IN(s0 + 9)) {}
            if (EN(9) && IN(s0 + 9)) { FRESH();
                pg8::Gemm g{AF, (const bf16*)(ws + WS_WGU) + (size_t)j2 * E_WGU, D}; pg8::SchedStd S; S.init(nM, 2 * FFD / 256, F.G, opaque_s((int)blockIdx.x));
                pg8::EpiSwiGLU E{(bf16*)(ws + WS_G), FFD};
                pg8::gemm_phase(F.lds, g, S, E);
            }
            SEAM(s0 + 9);
            if (EN(10) && IN(s0 + 10)) { FRESH();
                pg8::Gemm g{(const bf16*)(ws + WS_G), (const bf16*)(ws + WS_WD) + (size_t)j2 * E_WD, FFD}; pg8::SchedStd S; S.init(nM, 4, F.G, opaque_s((int)blockIdx.x));
                pg8::EpiF32 E{(float*)(ws + WS_Y), D};
                pg8::gemm_phase(F.lds, g, S, E);
            }
            SEAM(s0 + 10);
        }
        if (EN(11) && IN(s0 + 11)) { FRESH(); RowArgs A{}; A.post_g = KIN(9) + l * D; A.pre_g = KIN(6) + (l + 1 < DEPTH ? l + 1 : l) * D; A.l = l; A.nrows = nrows; A.moe = moe ? 1 : 0; A.last = need_ctx ? 0 : 1; A.out = KOUT;
            row_pass<2>(F, A); }
        if (l + 1 < DEPTH) SEAM(s0 + 11);
    }
#undef lp
#undef AF
#undef Z
#undef IN
#undef SEAM
}

#ifndef MK_LAUNCH_PER_STEP
#define MK_LAUNCH_PER_STEP 0
#endif
extern "C" void kernel_launch(void* const* d_in, const int* in_sizes, int n_in, void* d_out, int out_size, void* d_ws, size_t ws_size, hipStream_t stream) {
    static int grid = 0;
    if (grid == 0) {
        if (n_in != 39 || out_size != RL * D || ws_size < WS_END) { fprintf(stderr, "kernel_launch: unexpected shapes: n_in %d out %d ws %zu (need %zu)\n", n_in, out_size, ws_size, (size_t)WS_END); grid = -1; return; }
        int dev = 0, cus = 0, per_cu = 0;
        if (hipGetDevice(&dev) != hipSuccess || hipDeviceGetAttribute(&cus, hipDeviceAttributeMultiprocessorCount, dev) != hipSuccess) { grid = -1; return; }
        if (hipFuncSetAttribute((const void*)fwd_kernel, hipFuncAttributeMaxDynamicSharedMemorySize, LDS_BYTES) != hipSuccess) { fprintf(stderr, "kernel_launch: hipFuncSetAttribute failed\n"); grid = -1; return; }
        if (hipOccupancyMaxActiveBlocksPerMultiprocessor(&per_cu, (const void*)fwd_kernel, NWAVES * 64, LDS_BYTES) != hipSuccess || per_cu < 1) { fprintf(stderr, "kernel_launch: occupancy query says %d\n", per_cu); }
        (void)hipGetLastError();
        grid = cus;
    }
    if (grid < 0) return;
    if (hipMemsetAsync((char*)d_ws + WS_CTL, 0, CTL_ZERO_BYTES, stream) != hipSuccess) return;
    Args a{};
    for (int i = 0; i < 39; ++i) a.in[i] = (const float*)d_in[i];
    a.out = (float*)d_out; a.ws = (unsigned char*)d_ws;
#if MK_LAUNCH_PER_STEP
    for (int s = 0; s < NSTEPS; ++s) { a.s_lo = s; a.s_hi = s + 1; hipLaunchKernelGGL(fwd_kernel, dim3(grid), dim3(NWAVES * 64), LDS_BYTES, stream, a); }
#else
    a.s_lo = 0; a.s_hi = NSTEPS;
    hipLaunchKernelGGL(fwd_kernel, dim3(grid), dim3(NWAVES * 64), LDS_BYTES, stream, a);
#endif
    const hipError_t le = hipPeekAtLastError();
    if (le != hipSuccess) fprintf(stderr, "kernel_launch: launch failed: %s\n", hipGetErrorName(le));
}
```

```cpp
#include <hip/hip_runtime.h>
#include <cstdio>
#include <cstdint>

#define LAS __attribute__((address_space(3)))
#define GAS __attribute__((address_space(1)))
typedef unsigned short bf16;
typedef short bf16x8 __attribute__((ext_vector_type(8)));
typedef short s16x4 __attribute__((ext_vector_type(4)));
typedef float f32x4 __attribute__((ext_vector_type(4)));
typedef float f32x2 __attribute__((ext_vector_type(2)));
typedef float f32x16 __attribute__((ext_vector_type(16)));
typedef unsigned u32x4 __attribute__((ext_vector_type(4)));
typedef unsigned u32x2 __attribute__((ext_vector_type(2)));

constexpr int D = 1024, NB = 16, SEQ = 2048, NCTX = 256, DEPTH = 4;
constexpr int RL = NB * SEQ;
constexpr int RC = NB * NCTX;
constexpr int RT = RL + RC;
constexpr int NIN = 2304;
constexpr int ZW = 2048;
constexpr int ZQ_RQ = 0, ZQ_RK = 128, ZQ_RV = 256, ZQ_RG = 512, ZQ_SU = 768, ZQ_DQ = 1024, ZQ_DK = 1280, ZQ_DV = 1536, ZQ_CV = 1792;
constexpr int FFD = 2816, FFE = 3584, NE = 8;
constexpr int MOE_ROWS = 2 * RT + NE * 256;
constexpr int NCH = 18;
constexpr float EPS = 1e-6f;

__device__ __forceinline__ unsigned f2bf(float f) { unsigned u = __builtin_bit_cast(unsigned, f); return (u + 0x7fffu + ((u >> 16) & 1u)) >> 16; }
__device__ __forceinline__ unsigned pk2(float lo, float hi) { return f2bf(lo) | (f2bf(hi) << 16); }
__device__ __forceinline__ float bf2f(unsigned short b) { return __builtin_bit_cast(float, ((unsigned)b) << 16); }
__device__ __forceinline__ float bflo(unsigned w) { return __builtin_bit_cast(float, w << 16); }
__device__ __forceinline__ float bfhi(unsigned w) { return __builtin_bit_cast(float, w & 0xffff0000u); }
__device__ __forceinline__ unsigned cvt_pk_bf16(float lo, float hi) { unsigned r; asm volatile("v_cvt_pk_bf16_f32 %0, %1, %2" : "=v"(r) : "v"(lo), "v"(hi)); return r; }
__device__ __forceinline__ float sigmoidf_(float x) { return __builtin_amdgcn_rcpf(1.0f + __builtin_amdgcn_exp2f(-1.44269504f * x)); }
__device__ __forceinline__ float siluf_(float x) { return x * sigmoidf_(x); }
__device__ __forceinline__ float wave_sum(float v) {
#pragma unroll
    for (int o = 1; o < 64; o <<= 1) v += __shfl_xor(v, o);
    return v;
}
__device__ __forceinline__ float opaque_f(float x) { asm volatile("" : "+v"(x)); return x; }
__device__ __forceinline__ float sigk(float x, float k) { return __builtin_amdgcn_rcpf(1.0f + __builtin_amdgcn_exp2f(k * x)); }
__device__ __forceinline__ float silk(float x, float k) { return x * sigk(x, k); }
__device__ __forceinline__ int opaque_v(int x) { asm volatile("" : "+v"(x)); return x; }
__device__ __forceinline__ int opaque_s(int x) { asm volatile("" : "+s"(x)); return x; }
#define LDS_WAIT() asm volatile("s_waitcnt lgkmcnt(0)" ::: "memory")
#define VM_WAIT() asm volatile("s_waitcnt vmcnt(0)" ::: "memory")
namespace pg8 {
constexpr int BM = 256, BK = 64, HALF = 128, HTB = HALF * BK * 2  , STAGE_BYTES = 8 * HTB, NXCD = 8, WGM = 8;

__host__ __device__ __forceinline__ int lds_byte(int r, int c) { const int st = (r >> 4) * 2 + (c >> 5), rr = r & 15, cc = c & 31, ob = rr * 64 + cc * 2; return st * 1024 + (ob ^ (((ob >> 9) & 1) << 5)); }
__host__ __device__ __forceinline__ void stage_rc(int b, int& R, int& C) { const int st = b / 1024, sb = b % 1024, swz = sb ^ (((sb >> 9) & 1) << 5); R = (st >> 1) * 16 + swz / 64; C = (st & 1) * 32 + (swz % 64) / 2; }
__host__ __device__ __forceinline__ int perm32(int rho) { const int n = rho >> 4, i = rho & 15; return 8 * (i >> 2) + 4 * n + (i & 3); }

struct Unit { int pm, pn, am, bn, z; };
struct Gemm { const void* A; const void* Bt; int K; int sa, sb; };
typedef int v8i_t __attribute__((ext_vector_type(8))); typedef int v4i_t __attribute__((ext_vector_type(4)));

__device__ __forceinline__ void decode_tile(int wgid, int nM, int nN, int& pm, int& pn) {
    const int nwg = nM * nN;
    { const int q = nwg / NXCD, r = nwg % NXCD, xcd = wgid % NXCD, off = wgid / NXCD; wgid = (xcd < r ? xcd * (q + 1) : r * (q + 1) + (xcd - r) * q) + off; }
    const int nig = WGM * nN, gid = wgid / nig, fm = gid * WGM, gsz = (nM - fm) < WGM ? (nM - fm) : WGM;
    pm = fm + ((wgid % nig) % gsz); pn = (wgid % nig) / gsz;
}
struct SchedStd {
    int nM, nN, G, c;
    __device__ __forceinline__ void init(int nM_, int nN_, int G_, int c_) { nM = nM_; nN = nN_; G = G_; c = c_; }
    __device__ __forceinline__ bool next(int i, Unit& u) const {
        const long L = (long)i * G + c; if (L >= (long)nM * nN) return false;
        decode_tile((int)L, nM, nN, u.pm, u.pn); u.am = u.pm; u.bn = u.pn; u.z = 0; return true;
    }
};
struct SchedWin {
    int G, c, mode;
    __device__ __forceinline__ void init(int G_, int c_, int mode_) { G = G_; c = c_; mode = mode_; }
    __device__ __forceinline__ bool next(int i, Unit& u) const {
        const int L = i * G + c; u.z = 0;
        if (mode == 1) { if (L >= 16) return false; u.pm = 128 + L; u.pn = 8; }
        else if (L < 1152) decode_tile(L, 128, 9, u.pm, u.pn);
        else if (mode == 0) { if (L >= 1280) return false; decode_tile(L - 1152, 16, 8, u.pm, u.pn); u.pm += 128; }
        else { if (L >= 1232) return false; int q; decode_tile(L - 1152, 16, 5, u.pm, q); u.pm += 128; u.pn = q < 2 ? q : (q == 2 ? 3 : q + 2); }
        u.am = u.pm; u.bn = u.pn; return true;
    }
};
struct SchedBr {
    int nM, G, c;
    __device__ __forceinline__ void init(int nM_, int G_, int c_) { nM = nM_; G = G_; c = c_; }
    __device__ __forceinline__ bool next(int i, Unit& u) const {
        const long L = (long)i * G + c; if (L >= (long)nM * 20) return false;
        int pm, pa; decode_tile((int)L, nM, 20, pm, pa);
        const int z = pa < 4 ? 0 : (pa < 12 ? 1 : (pa < 16 ? 2 : 3)), st = z == 0 ? 0 : (z == 1 ? 4 : (z == 2 ? 12 : 16));
        u.pm = pm; u.pn = pa - st; u.am = z * (RT / 256) + pm; u.bn = pa; u.z = z; return true;
    }
};
struct SchedGate {
    int nM, G, c;
    __device__ __forceinline__ void init(int nM_, int G_, int c_) { nM = nM_; G = G_; c = c_; }
    __device__ __forceinline__ bool next(int i, Unit& u) const {
        const long L = (long)(i >> 2) * G + c; if (L >= (long)nM * 4) return false;
        decode_tile((int)L, nM, 4, u.pm, u.pn); u.z = i & 3; u.am = u.pm; u.bn = u.z * 4 + u.pn; return true;
    }
};
struct SchedMoe {
    int nM, nN, G, c; const int* tile_e;
    __device__ __forceinline__ void init(int nM_, int nN_, int G_, int c_, const int* te) { nM = nM_; nN = nN_; G = G_; c = c_; tile_e = te; }
    __device__ __forceinline__ bool next(int i, Unit& u) const {
        const long L = (long)i * G + c; if (L >= (long)nM * nN) return false;
        decode_tile((int)L, nM, nN, u.pm, u.pn); u.am = u.pm; u.z = 0;
        const int e = __builtin_amdgcn_readfirstlane(__hip_atomic_load(tile_e + u.pm, __ATOMIC_RELAXED, __HIP_MEMORY_SCOPE_AGENT));
        u.bn = e * nN + u.pn; return true;
    }
};

#define EPI_ROWS(...) _Pragma("unroll") for (int ai = 0; ai < 2; ++ai) _Pragma("unroll") for (int m = 0; m < 4; ++m) { const int row = u.pm * BM + wr * 64 + fr + ai * HALF + m * 16; _Pragma("unroll") for (int bj = 0; bj < 2; ++bj) { const f32x4 v0 = acc[ai][bj][m][0], v1 = acc[ai][bj][m][1]; const int cb = 128 * bj + 32 * wc + 8 * fq; __VA_ARGS__ } }
typedef GAS u32x4* gq4; typedef GAS u32x2* gq2; typedef const GAS u32x4* cgq4; typedef const GAS f32x4* cgf4;

struct EpiF32 {
    static constexpr bool PERM = false;
    float* C; int ldc;
    __device__ __forceinline__ void operator()(const f32x4 (&acc)[2][2][4][2], const Unit& u, int wr, int wc, int fr, int fq) const {
        const int row0 = u.pm * BM + wr * 64 + fr, col0 = u.pn * BM + wc * 32 + 4 * fq;
#pragma unroll
        for (int ai = 0; ai < 2; ++ai)
#pragma unroll
            for (int m = 0; m < 4; ++m) { GAS float* rowp = (GAS float*)C + (size_t)(row0 + ai * HALF + m * 16) * ldc + col0;
#pragma unroll
                for (int bj = 0; bj < 2; ++bj)
#pragma unroll
                    for (int n = 0; n < 2; ++n) *(GAS f32x4*)(rowp + bj * HALF + n * 16) = acc[ai][bj][m][n]; }
    }
};
struct EpiBf16 {
    static constexpr bool PERM = true;
    bf16* O; int ldc;
    __device__ __forceinline__ void operator()(const f32x4 (&acc)[2][2][4][2], const Unit& u, int wr, int wc, int fr, int fq) const {
        EPI_ROWS({ u32x4 w; w.x = cvt_pk_bf16(v0[0], v0[1]); w.y = cvt_pk_bf16(v0[2], v0[3]); w.z = cvt_pk_bf16(v1[0], v1[1]); w.w = cvt_pk_bf16(v1[2], v1[3]);
                   *(gq4)((GAS bf16*)O + (size_t)row * ldc + u.pn * BM + cb) = w; })
    }
};
struct EpiSwiGLU {
    static constexpr bool PERM = true;
    bf16* O; int ldc;
    __device__ __forceinline__ void operator()(const f32x4 (&acc)[2][2][4][2], const Unit& u, int wr, int wc, int fr, int fq) const {
        const float kq = opaque_f(-1.44269504f);
        EPI_ROWS({ u32x2 w; w.x = cvt_pk_bf16(silk(v0[0], kq) * v0[1], silk(v0[2], kq) * v0[3]); w.y = cvt_pk_bf16(silk(v1[0], kq) * v1[1], silk(v1[2], kq) * v1[3]);
                   *(gq2)((GAS bf16*)O + (size_t)row * ldc + ((u.pn * BM + cb) >> 1)) = w; })
    }
};
struct EpiSwiGLU8 {
    static constexpr bool PERM = true;
    unsigned char* O; int ldc;
    __device__ __forceinline__ void operator()(const f32x4 (&acc)[2][2][4][2], const Unit& u, int wr, int wc, int fr, int fq) const {
        const float kq = opaque_f(-1.44269504f), k8 = opaque_f(8.0f);
        EPI_ROWS({ unsigned w = 0; w = __builtin_amdgcn_cvt_pk_fp8_f32(k8 * silk(v0[0], kq) * v0[1], k8 * silk(v0[2], kq) * v0[3], w, false); w = __builtin_amdgcn_cvt_pk_fp8_f32(k8 * silk(v1[0], kq) * v1[1], k8 * silk(v1[2], kq) * v1[3], w, true);
                   *(GAS unsigned*)((GAS unsigned char*)O + (size_t)row * ldc + ((u.pn * BM + cb) >> 1)) = w; })
    }
};
struct EpiWin {
    static constexpr bool PERM = true;
    bf16* Z; const float* rope;
    __device__ __forceinline__ void operator()(const f32x4 (&acc)[2][2][4][2], const Unit& u, int wr, int wc, int fr, int fq) const {
        const float kq = opaque_f(-1.44269504f);
        GAS bf16* Zg = (GAS bf16*)Z;
        if (u.pn >= 7) {
            EPI_ROWS({ u32x2 w; w.x = cvt_pk_bf16(v0[0] * sigk(v0[1], kq), v0[2] * sigk(v0[3], kq)); w.y = cvt_pk_bf16(v1[0] * sigk(v1[1], kq), v1[2] * sigk(v1[3], kq));
                       *(gq2)(Zg + (size_t)row * ZW + ZQ_CV + (u.pn - 7) * 128 + (cb >> 1)) = w; })
        } else if ((u.pn == 4 || u.pn == 5) && u.pm < RL / 256) {
#pragma unroll
            for (int ai = 0; ai < 2; ++ai) {
                f32x4 c0[4], c1[4];
#pragma unroll
                for (int m = 0; m < 4; ++m) { const int row = u.pm * BM + wr * 64 + fr + ai * HALF + m * 16; cgf4 rp = (cgf4)((const GAS float*)rope + (size_t)(row & (SEQ - 1)) * 32 + fq * 8); c0[m] = rp[0]; c1[m] = rp[1]; }
#pragma unroll
                for (int m = 0; m < 4; ++m) { const int row = u.pm * BM + wr * 64 + fr + ai * HALF + m * 16;
#pragma unroll
                    for (int bj = 0; bj < 2; ++bj) { const f32x4 v0 = acc[ai][bj][m][0], v1 = acc[ai][bj][m][1]; const int cb = 128 * bj + 32 * wc + 8 * fq; const f32x4 a = c0[m], b = c1[m];
                        u32x4 w; w.x = cvt_pk_bf16(v0[0] * a[0] - v0[1] * a[1], v0[1] * a[0] + v0[0] * a[1]); w.y = cvt_pk_bf16(v0[2] * a[2] - v0[3] * a[3], v0[3] * a[2] + v0[2] * a[3]);
                        w.z = cvt_pk_bf16(v1[0] * b[0] - v1[1] * b[1], v1[1] * b[0] + v1[0] * b[1]); w.w = cvt_pk_bf16(v1[2] * b[2] - v1[3] * b[3], v1[3] * b[2] + v1[2] * b[3]);
                        *(gq4)(Zg + (size_t)row * ZW + u.pn * BM + cb) = w; } }
            }
        } else {
            EPI_ROWS({ u32x4 w; w.x = cvt_pk_bf16(v0[0], v0[1]); w.y = cvt_pk_bf16(v0[2], v0[3]); w.z = cvt_pk_bf16(v1[0], v1[1]); w.w = cvt_pk_bf16(v1[2], v1[3]);
                       *(gq4)(Zg + (size_t)row * ZW + u.pn * BM + cb) = w; })
        }
    }
};
struct EpiBr {
    static constexpr bool PERM = true;
    bf16* BO;
    __device__ __forceinline__ void operator()(const f32x4 (&acc)[2][2][4][2], const Unit& u, int wr, int wc, int fr, int fq) const {
        const float kq = opaque_f(-1.44269504f);
        GAS unsigned char* base = (GAS unsigned char*)((GAS bf16*)BO + (size_t)u.z * RT * D) + (size_t)u.pm * (128 * 256 * 16) + (size_t)((wr * 64 + fr) * 16);
        if (u.z == 1) {
            GAS unsigned char* lp = base + (size_t)(16 * u.pn + 2 * wc + (fq >> 1)) * 4096 + (fq & 1) * 8;
#pragma unroll
            for (int ai = 0; ai < 2; ++ai)
#pragma unroll
                for (int m = 0; m < 4; ++m)
#pragma unroll
                    for (int bj = 0; bj < 2; ++bj) { const f32x4 v0 = acc[ai][bj][m][0], v1 = acc[ai][bj][m][1];
                        u32x2 w; w.x = cvt_pk_bf16(v0[0] * sigk(v0[1], kq), v0[2] * sigk(v0[3], kq)); w.y = cvt_pk_bf16(v1[0] * sigk(v1[1], kq), v1[2] * sigk(v1[3], kq));
                        *(gq2)(lp + bj * (8 * 4096) + (ai * 128 + m * 16) * 16) = w; }
        } else {
            GAS unsigned char* lp = base + (size_t)(32 * u.pn + 4 * wc + fq) * 4096;
#pragma unroll
            for (int ai = 0; ai < 2; ++ai)
#pragma unroll
                for (int m = 0; m < 4; ++m)
#pragma unroll
                    for (int bj = 0; bj < 2; ++bj) { const f32x4 v0 = acc[ai][bj][m][0], v1 = acc[ai][bj][m][1];
                        u32x4 w; w.x = cvt_pk_bf16(v0[0], v0[1]); w.y = cvt_pk_bf16(v0[2], v0[3]); w.z = cvt_pk_bf16(v1[0], v1[1]); w.w = cvt_pk_bf16(v1[2], v1[3]);
                        *(gq4)(lp + bj * (16 * 4096) + (ai * 128 + m * 16) * 16) = w; }
        }
    }
};
struct EpiGate {
    static constexpr bool PERM = true;
    const bf16* BO; bf16* MM; const float* bgate; LAS unsigned char* xl;
    __device__ __forceinline__ void operator()(const f32x4 (&acc)[2][2][4][2], const Unit& u, int wr, int wc, int fr, int fq) const {
        const float kq = opaque_f(-1.44269504f); fr = opaque_v(fr); fq = opaque_v(fq);
        const int oc = u.pn * 64 + 32 * (wc & 1) + 8 * fq, zlo = wc >> 1, lane = fr + 16 * fq;
        const GAS unsigned char* bo0 = (const GAS unsigned char*)((const GAS bf16*)BO + (size_t)zlo * RT * D) + ((size_t)u.pm * 128 + (oc >> 3)) * (256 * 16); const GAS unsigned char* bo1 = bo0 + (size_t)2 * RT * D * 2; GAS bf16* mm = (GAS bf16*)MM + oc;
        f32x4 bs[2][2];
#pragma unroll
        for (int bj = 0; bj < 2; ++bj) { const GAS float* bg = (const GAS float*)bgate + (2 * bj + zlo) * D + oc; bs[bj][0] = *(cgf4)bg; bs[bj][1] = *(cgf4)(bg + 4); }
        LAS u32x4* xs = (LAS u32x4*)xl + ((wr * 2 + (wc & 1)) * 4) * 64 + lane;
#pragma unroll
        for (int ai = 0; ai < 2; ++ai) {
            u32x4 bw[4][2];
#pragma unroll
            for (int m = 0; m < 4; ++m) { const size_t ro = (size_t)(wr * 64 + fr + ai * HALF + m * 16) * 16; bw[m][0] = *(cgq4)(bo0 + ro); bw[m][1] = *(cgq4)(bo1 + ro); }
            float r[4][8];
#pragma unroll
            for (int m = 0; m < 4; ++m) {
#pragma unroll
                for (int j = 0; j < 8; ++j) r[m][j] = 0.f;
#pragma unroll
                for (int bj = 0; bj < 2; ++bj) { const f32x4 v0 = acc[ai][bj][m][0] + bs[bj][0], v1 = acc[ai][bj][m][1] + bs[bj][1]; const u32x4 b = bw[m][bj];
                    r[m][0] += sigk(v0[0], kq) * bflo(b.x); r[m][1] += sigk(v0[1], kq) * bfhi(b.x); r[m][2] += sigk(v0[2], kq) * bflo(b.y); r[m][3] += sigk(v0[3], kq) * bfhi(b.y);
                    r[m][4] += sigk(v1[0], kq) * bflo(b.z); r[m][5] += sigk(v1[1], kq) * bfhi(b.z); r[m][6] += sigk(v1[2], kq) * bflo(b.w); r[m][7] += sigk(v1[3], kq) * bfhi(b.w); }
            }
            if (wc >= 2) {
#pragma unroll
                for (int m = 0; m < 4; ++m) { u32x4 w; w.x = cvt_pk_bf16(r[m][0], r[m][1]); w.y = cvt_pk_bf16(r[m][2], r[m][3]); w.z = cvt_pk_bf16(r[m][4], r[m][5]); w.w = cvt_pk_bf16(r[m][6], r[m][7]); xs[m * 64] = w; }
            }
            asm volatile("s_waitcnt lgkmcnt(0)" ::: "memory"); __builtin_amdgcn_s_barrier(); asm volatile("" ::: "memory");
            if (wc < 2) {
#pragma unroll
                for (int m = 0; m < 4; ++m) { const u32x4 q = xs[m * 64]; const size_t ro = (size_t)(u.pm * BM + wr * 64 + fr + ai * HALF + m * 16) * D;
                    u32x4 w; w.x = cvt_pk_bf16(r[m][0] + bflo(q.x), r[m][1] + bfhi(q.x)); w.y = cvt_pk_bf16(r[m][2] + bflo(q.y), r[m][3] + bfhi(q.y));
                    w.z = cvt_pk_bf16(r[m][4] + bflo(q.z), r[m][5] + bfhi(q.z)); w.w = cvt_pk_bf16(r[m][6] + bflo(q.w), r[m][7] + bfhi(q.w));
                    *(gq4)(mm + ro) = w; }
            }
            if (ai == 0) { asm volatile("s_waitcnt lgkmcnt(0)" ::: "memory"); __builtin_amdgcn_s_barrier(); asm volatile("" ::: "memory"); }
        }
    }
};

template <class Epi, class Sched, bool F8 = false>
__device__ __forceinline__ void gemm_phase(LAS unsigned char* lds, const Gemm g, const Sched& S, const Epi& E, int tid_in) {
    const int tid = opaque_v(tid_in), wid = __builtin_amdgcn_readfirstlane(tid >> 6), lane = tid & 63, wr = wid >> 2, wc = wid & 3, fr = lane & 15, fq = lane >> 4;
    const int K = opaque_s(g.K), rowb = F8 ? K : 2 * K, nt = rowb / 128;
    unsigned voffA[2], voffB[2];
#pragma unroll
    for (int i = 0; i < 2; ++i) { int R, C; stage_rc(tid * 16 + i * 8192, R, C); const int Rb = Epi::PERM ? ((R & ~31) + perm32(R & 31)) : R;
        voffA[i] = (unsigned)(R * rowb + C * 2); voffB[i] = (unsigned)(Rb * rowb + C * 2); }
    const size_t kstep = (size_t)(BK * 2);
    const size_t hstep = (size_t)HALF * rowb;
    const size_t tstep = 2 * hstep;
    const unsigned ldsw = (unsigned)wid * 1024u;
    const int aoff = lds_byte(wr * 64 + fr, fq * 8), boff = lds_byte(wc * 32 + fr, fq * 8);
#define PG8_SA(b, h) (((b) * 2 + (h)) * HTB)
#define PG8_SB(b, h) ((4 + (b) * 2 + (h)) * HTB)
#define PG8_STAGE(bufoff, gbase, voff) do { _Pragma("unroll") for (int _i = 0; _i < 2; ++_i) \
        __builtin_amdgcn_global_load_lds((const unsigned*)((const char*)(gbase) + (voff)[_i]), (LAS unsigned*)(lds + (bufoff) + ldsw + _i * 8192), 16, 0, 0); } while (0)
#define PG8_LD1(off) (*(const LAS v4i_t*)(lds + (off)))
#define PG8_LDA(dst, b, h) do { if constexpr (F8) { _Pragma("unroll") for (int m = 0; m < 4; ++m) dst##8[m] = __builtin_shufflevector(PG8_LD1(PG8_SA(b, h) + aoff + m * 2048), PG8_LD1(PG8_SA(b, h) + aoff + m * 2048 + 1024), 0, 1, 2, 3, 4, 5, 6, 7); } \
        else { _Pragma("unroll") for (int m = 0; m < 4; ++m) _Pragma("unroll") for (int k = 0; k < 2; ++k) dst[m][k] = *(const LAS bf16x8*)(lds + PG8_SA(b, h) + aoff + m * 2048 + k * 1024); } } while (0)
#define PG8_LDB(dst, b, h) do { if constexpr (F8) { _Pragma("unroll") for (int n = 0; n < 2; ++n) dst##8[n] = __builtin_shufflevector(PG8_LD1(PG8_SB(b, h) + boff + n * 2048), PG8_LD1(PG8_SB(b, h) + boff + n * 2048 + 1024), 0, 1, 2, 3, 4, 5, 6, 7); } \
        else { _Pragma("unroll") for (int n = 0; n < 2; ++n) _Pragma("unroll") for (int k = 0; k < 2; ++k) dst[n][k] = *(const LAS bf16x8*)(lds + PG8_SB(b, h) + boff + n * 2048 + k * 1024); } } while (0)
#define PG8_MMA(ai, bj, At, Bt) do { __builtin_amdgcn_s_setprio(1); _Pragma("unroll") for (int m = 0; m < 4; ++m) _Pragma("unroll") for (int n = 0; n < 2; ++n) { \
        if constexpr (F8) { asm volatile("v_mfma_scale_f32_16x16x128_f8f6f4 %0, %1, %2, %0, %3, %4 op_sel_hi:[0,0,0]" : "+v"(acc[ai][bj][m][n]) : "v"(Bt##8[n]), "v"(At##8[m]), "v"(sclB), "v"(sclA)); } \
        else { _Pragma("unroll") for (int k = 0; k < 2; ++k) acc[ai][bj][m][n] = __builtin_amdgcn_mfma_f32_16x16x32_bf16(Bt[n][k], At[m][k], acc[ai][bj][m][n], 0, 0, 0); } } \
        __builtin_amdgcn_s_setprio(0); } while (0)
#define PG8_WAIT_V(n) asm volatile("s_waitcnt vmcnt(" #n ")" ::: "memory")
#define PG8_WAIT_L(n) asm volatile("s_waitcnt lgkmcnt(" #n ")" ::: "memory")
#define PG8_BAR __builtin_amdgcn_s_barrier()
#define PG8_SCHED __builtin_amdgcn_sched_barrier(0)
    const int sclB = g.sa * 0x01010101, sclA = g.sb * 0x01010101;
    Unit cur, nxt; int ui = 0;
    if (!S.next(0, cur)) return;
#ifndef GEMM_STAGGER
#define GEMM_STAGGER 0
#endif
    if (GEMM_STAGGER) {
        const unsigned long long t0 = __builtin_amdgcn_s_memrealtime(); const unsigned long long dl = (unsigned long long)(((blockIdx.x >> 3) & 3) * ((K >> 6) * 29 + 350));
        while (__builtin_amdgcn_s_memrealtime() - t0 < dl) __builtin_amdgcn_s_sleep(16);
    }
    f32x4 acc[2][2][4][2];
#pragma unroll
    for (int a = 0; a < 2; ++a)
#pragma unroll
        for (int b = 0; b < 2; ++b)
#pragma unroll
            for (int m = 0; m < 4; ++m)
#pragma unroll
                for (int n = 0; n < 2; ++n) acc[a][b][m][n] = (f32x4){0.f, 0.f, 0.f, 0.f};
    bf16x8 At[4][2], B0[2][2], B1[2][2]; v8i_t At8[4], B08[2], B18[2];
    const char* cA = (const char*)g.A + (size_t)cur.am * tstep; const char* cB = (const char*)g.Bt + (size_t)cur.bn * tstep;
    PG8_STAGE(PG8_SB(0, 0), cB, voffB); PG8_STAGE(PG8_SB(0, 1), cB + hstep, voffB); PG8_STAGE(PG8_SA(0, 0), cA, voffA); PG8_STAGE(PG8_SA(0, 1), cA + hstep, voffA);
    if (wr == 1) PG8_BAR;
    PG8_WAIT_V(2); PG8_BAR;
    PG8_STAGE(PG8_SB(1, 0), cB + kstep, voffB); PG8_STAGE(PG8_SA(1, 0), cA + kstep, voffA); PG8_STAGE(PG8_SB(1, 1), cB + hstep + kstep, voffB);
    PG8_WAIT_V(6); PG8_BAR;
    for (;;) {
        const bool has_next = S.next(ui + 1, nxt);
        const char* nA = has_next ? (const char*)g.A + (size_t)nxt.am * tstep : cA; const char* nB = has_next ? (const char*)g.Bt + (size_t)nxt.bn * tstep : cB;
        for (int t = 0; t < nt; t += 2) {
            const bool last = (t == nt - 2);
            const char* a1 = cA + (size_t)(t + 1) * kstep;
            const char* a2 = last ? nA : cA + (size_t)(t + 2) * kstep; const char* b2 = last ? nB : cB + (size_t)(t + 2) * kstep;
            const char* a3 = a2 + kstep; const char* b3 = b2 + kstep;
            PG8_LDB(B0, 0, 0); PG8_LDB(B1, 0, 1); PG8_SCHED; PG8_LDA(At, 0, 0); PG8_STAGE(PG8_SA(1, 1), a1 + hstep, voffA);
            PG8_WAIT_V(8); PG8_WAIT_L(0); PG8_BAR; PG8_MMA(0, 0, At, B0); PG8_MMA(0, 1, At, B1); PG8_BAR; PG8_SCHED;
            PG8_LDA(At, 0, 1); PG8_STAGE(PG8_SB(0, 0), b2, voffB); PG8_STAGE(PG8_SB(0, 1), b2 + hstep, voffB); PG8_STAGE(PG8_SA(0, 0), a2, voffA);
            PG8_WAIT_V(8); PG8_WAIT_L(0); PG8_BAR; PG8_MMA(1, 0, At, B0); PG8_MMA(1, 1, At, B1); PG8_BAR; PG8_SCHED;
            PG8_LDB(B0, 1, 0); PG8_LDB(B1, 1, 1); PG8_SCHED; PG8_LDA(At, 1, 0); PG8_STAGE(PG8_SA(0, 1), a2 + hstep, voffA);
            PG8_WAIT_V(8); PG8_WAIT_L(0); PG8_BAR; PG8_MMA(0, 0, At, B0); PG8_MMA(0, 1, At, B1); PG8_BAR; PG8_SCHED;
            PG8_LDA(At, 1, 1); PG8_STAGE(PG8_SB(1, 0), b3, voffB); PG8_STAGE(PG8_SB(1, 1), b3 + hstep, voffB); PG8_STAGE(PG8_SA(1, 0), a3, voffA);
            PG8_WAIT_V(8); PG8_WAIT_L(0); PG8_BAR; PG8_MMA(1, 0, At, B0); PG8_MMA(1, 1, At, B1); PG8_BAR; PG8_SCHED;
        }
        if (wr == 0) PG8_BAR;
        if constexpr (F8) asm volatile("s_nop 15\n\ts_nop 15" ::: "memory");
        E(acc, cur, wr, wc, fr, fq);
        if (!has_next) break;
#pragma unroll
        for (int a = 0; a < 2; ++a)
#pragma unroll
            for (int b = 0; b < 2; ++b)
#pragma unroll
                for (int m = 0; m < 4; ++m)
#pragma unroll
                    for (int n = 0; n < 2; ++n) acc[a][b][m][n] = (f32x4){0.f, 0.f, 0.f, 0.f};
        cur = nxt; cA = nA; cB = nB; ++ui;
        if (wr == 1) PG8_BAR;
    }
    PG8_WAIT_V(0);
    PG8_BAR;
#undef PG8_SA
#undef PG8_SB
#undef PG8_STAGE
#undef PG8_LD1
#undef PG8_LDA
#undef PG8_LDB
#undef PG8_MMA
#undef PG8_WAIT_V
#undef PG8_WAIT_L
#undef PG8_BAR
#undef PG8_SCHED
}
}
constexpr size_t al256(size_t x) { return (x + 255) & ~(size_t)255; }
constexpr size_t WS_CTL = 0, CTL_ZERO_BYTES = 1u << 20;
constexpr size_t E_WIN = (size_t)NIN * D, E_WG = (size_t)4 * D * D, E_WBR = (size_t)5120 * 256, E_WOUT = (size_t)D * D;
constexpr size_t E_WGU = (size_t)2 * FFD * D, E_WD = (size_t)D * FFD, E_MGU = (size_t)2 * FFE * D, E_MWD = (size_t)D * FFE;
constexpr size_t WS_WIN = CTL_ZERO_BYTES;
constexpr size_t WS_WG = WS_WIN + 2 * DEPTH * E_WIN;
constexpr size_t WS_WBR = WS_WG + 2 * DEPTH * E_WG;
constexpr size_t WS_WOUT = WS_WBR + 2 * DEPTH * E_WBR;
constexpr size_t WS_WGU = WS_WOUT + 2 * DEPTH * E_WOUT;
constexpr size_t WS_WD = WS_WGU + 2 * 2 * E_WGU;
constexpr size_t WS_MGU = WS_WD + 2 * 2 * E_WD;
constexpr size_t WS_MWD = WS_MGU + 2 * 2 * NE * E_MGU;
constexpr size_t WS_WEND = WS_MWD + 2 * 2 * NE * E_MWD;
constexpr size_t WS_MODS = al256(WS_WEND);
constexpr size_t WS_ROPE = WS_MODS + al256((size_t)DEPTH * 17 * 6 * D * 4);
constexpr size_t S5P_ABAR = 0, S5P_A128 = 16384, S5P_BP = 32768, S5P_CH = S5P_BP + 2 * 16 * 128 * 16 * 2, S5P_BYTES = S5P_CH + 16 * 16 * 128 * 2;
constexpr size_t WS_S5P = WS_ROPE + (size_t)SEQ * 32 * 4;
constexpr size_t WS_LAYP = WS_S5P + DEPTH * S5P_BYTES;
constexpr size_t WS_RETSUM = al256(WS_LAYP + DEPTH * 64 * 4);
constexpr size_t WS_RETST = WS_RETSUM + (size_t)NB * NCH * 2 * 4 * 2048 * 4;
constexpr size_t WS_S5E = WS_RETST + (size_t)NB * NCH * 2 * 4 * 2048 * 2;
constexpr size_t WS_S5C = WS_S5E + (size_t)NB * NCH * 16 * 2 * 64 * 8;
constexpr size_t WS_REC = WS_S5C + (size_t)NB * NCH * 16 * 2 * 64 * 8;
constexpr size_t WS_HIST = WS_REC + (size_t)RT * 32;
constexpr size_t WS_TILEE = WS_HIST + 256 * 8 * 4;
constexpr size_t WS_H = al256(WS_TILEE + 512 * 4);
constexpr size_t WS_AF = WS_H + (size_t)RT * D * 4;
constexpr size_t WS_AF8 = WS_AF + (size_t)RT * D * 2;
constexpr size_t WS_RA = WS_AF8 + (size_t)RT * D;
constexpr size_t WS_Z = WS_RA;
constexpr size_t WS_XB = WS_Z + (size_t)RT * ZW * 2;
constexpr size_t WS_BO = WS_XB + (size_t)4 * RT * 256 * 2;
constexpr size_t WS_MM = WS_BO + (size_t)4 * RT * D * 2;
constexpr size_t WS_Y = WS_MM + (size_t)RT * D * 2;
constexpr size_t WS_RA_END = WS_Y + (size_t)RT * D * 4;
constexpr size_t WS_G = WS_RA;
constexpr size_t WS_FS = WS_RA;
constexpr size_t WS_GS = WS_FS + (size_t)MOE_ROWS * D * 2;
constexpr size_t WS_YS = WS_GS + (size_t)MOE_ROWS * FFE * 2;
constexpr size_t WS_RB_END = WS_YS + (size_t)MOE_ROWS * D * 2;
constexpr size_t WS_END = WS_RA_END > WS_RB_END ? WS_RA_END : WS_RB_END;
static_assert(WS_G + (size_t)RT * FFD * 2 <= WS_Y, "dense hidden must not reach Y");
constexpr int CW_DEP = 12288;
constexpr int CW_BAR = 4096;

constexpr int SCRATCH_BYTES = 153600;
constexpr int LDSCTL_OFF = SCRATCH_BYTES, MISC_OFF = LDSCTL_OFF + 320;
constexpr int LDS_BYTES = 155648;
constexpr int NWAVES = 8;

typedef GAS unsigned gu32;
#define RLX_AGENT __ATOMIC_RELAXED, __HIP_MEMORY_SCOPE_AGENT

#define XB_TMO      128
#define XB_XCNT(j)  (256  + 64 * (j))
#define XB_XSUB(j)  (1280 + 64 * (j))
#define XB_XGEN(j)  (2304 + 64 * (j))
#define XB_TOP      3328
#define XB_TOPGEN   3392
#define XCD_BAR_WORDS 3456
#define XB_SPIN_CAP (1u << 20)

__device__ __forceinline__ unsigned xb_ld(unsigned* p)              { return __hip_atomic_load(p, __ATOMIC_RELAXED, __HIP_MEMORY_SCOPE_AGENT); }
__device__ __forceinline__ unsigned xb_add(unsigned* p, unsigned v) { return __hip_atomic_fetch_add(p, v, __ATOMIC_RELAXED, __HIP_MEMORY_SCOPE_AGENT); }
__device__ __forceinline__ unsigned xb_xcc_id() { return (unsigned)__builtin_amdgcn_s_getreg((3 << 11) | 20) & 0xFu; }
#define XB_SPIN(cond, bar) do { unsigned _sp = 0; while (cond) { __builtin_amdgcn_s_sleep(1); \
    if ((++_sp & 255u) == 0u) { if (xb_ld(&(bar)[XB_TMO])) break; if (_sp > XB_SPIN_CAP) { atomicAdd(&(bar)[XB_TMO], 1u); break; } } } } while (0)

struct XcdBarrier {
    unsigned* bar; unsigned x;
    volatile LAS unsigned* st;
};
__device__ __forceinline__ XcdBarrier xcd_barrier_post(unsigned* bar, volatile LAS unsigned* st, int tid) {
    XcdBarrier b; b.bar = bar; b.x = xb_xcc_id(); b.st = st;
    if (tid == 0) (void)xb_add(&bar[XB_XCNT(b.x)], 1u);
    return b;
}
__device__ __forceinline__ void xcd_barrier_complete(unsigned* bar, unsigned x, unsigned& nloc, unsigned& nx) {
    const unsigned G = gridDim.x * gridDim.y * gridDim.z;
    unsigned sum, cnt, mine, sp = 0u;
    for (;;) {
        sum = 0u; cnt = 0u; mine = 0u;
#pragma unroll
        for (unsigned j = 0; j < 16; ++j) { const unsigned c = xb_ld(&bar[XB_XCNT(j)]); sum += c; cnt += (c > 0u) ? 1u : 0u; mine = (j == x) ? c : mine; }
        if (sum == G) break;
        __builtin_amdgcn_s_sleep(1);
        if ((++sp & 255u) == 0u) { if (xb_ld(&bar[XB_TMO])) break; if (sp > XB_SPIN_CAP) { atomicAdd(&bar[XB_TMO], 1u); break; } }
    }
    nloc = mine > 0u ? mine : 1u; nx = cnt > 0u ? cnt : 1u;
}
__device__ __forceinline__ void xcd_barrier(const XcdBarrier& b, int tid) {
    asm volatile("s_waitcnt vmcnt(0)" ::: "memory");
    __syncthreads();
    if (tid == 0) {
        unsigned* bar = b.bar;
        __builtin_amdgcn_s_waitcnt(0);
        unsigned nloc = b.st[0], nx = b.st[1];
        if (nloc == 0u) { xcd_barrier_complete(bar, b.x, nloc, nx); b.st[0] = nloc; b.st[1] = nx; }
        const unsigned old = xb_add(&bar[XB_XSUB(b.x)], 1u);
        const unsigned gen = old / nloc;
        if (old + 1u == (gen + 1u) * nloc) {
            __builtin_amdgcn_fence(__ATOMIC_RELEASE, "agent");
            asm volatile("s_waitcnt vmcnt(0)" ::: "memory");
            const unsigned og = xb_add(&bar[XB_TOP], 1u);
            const unsigned tg = og / nx;
            if (og + 1u == (tg + 1u) * nx) xb_add(&bar[XB_TOPGEN], 1u);
            else XB_SPIN(xb_ld(&bar[XB_TOPGEN]) == tg, bar);
            __builtin_amdgcn_fence(__ATOMIC_ACQUIRE, "agent");
            xb_add(&bar[XB_XGEN(b.x)], 1u);
            asm volatile("s_waitcnt vmcnt(0)" ::: "memory");
        } else {
            XB_SPIN(xb_ld(&bar[XB_XGEN(b.x)]) == gen, bar);
            __builtin_amdgcn_fence(__ATOMIC_ACQUIRE, "agent");
            asm volatile("s_waitcnt vmcnt(0)" ::: "memory");
        }
    }
    __syncthreads();
}

struct Frame {
    LAS unsigned char* lds;
    volatile LAS unsigned* MISC;
    int tid, lane, wave;
    int vcu, G;
    unsigned char* ws;
};

__device__ __forceinline__ void dep_signal(Frame& F, unsigned* ctr, unsigned n) {
    asm volatile("s_waitcnt vmcnt(0)" ::: "memory");
    __syncthreads();
    if (F.tid == 0) { __builtin_amdgcn_fence(__ATOMIC_RELEASE, "agent"); asm volatile("s_waitcnt vmcnt(0)" ::: "memory"); (void)xb_add(ctr, n); }
}
__device__ __forceinline__ void dep_wait(Frame& F, unsigned* ctr, unsigned target) {
    if (F.tid == 0) { unsigned sp = 0u; while (xb_ld(ctr) < target) { __builtin_amdgcn_s_sleep(2); if (++sp > (1u << 22)) break; }
        __builtin_amdgcn_fence(__ATOMIC_ACQUIRE, "agent"); asm volatile("s_waitcnt vmcnt(0)" ::: "memory"); }
    __syncthreads();
}
__device__ __forceinline__ int permqk(int c) { const int hm = c >> 5, d = c & 31, axis = d >> 4, half = (d >> 3) & 1, f = d & 7; return hm * 32 + axis * 16 + f * 2 + half; }
__device__ __forceinline__ int win_dest(int n, float& sc) {
    sc = 1.0f;
    if (n < 128) { sc = 0.17677669529663687f; return 128 + n; }
    if (n < 384) return 256 + (n - 128);
    if (n < 640) return 768 + (n - 384);
    if (n < 896) return 1280 + permqk(n - 640);
    if (n < 1152) return 1536 + (n - 896);
    if (n < 1280) return n - 1152;
    if (n < 1536) return 512 + (n - 1280);
    if (n < 1792) { sc = 0.17677669529663687f; return 1024 + permqk(n - 1536); }
    const int j = (n - 1792) & 255, half = (n - 1792) >> 8; return 1792 + 2 * j + half;
}
template <int MODE, bool OUT8 = false>
__device__ __forceinline__ void transpose_item(const float* __restrict__ W, int K, int N, bf16* WT, int row_off, LAS float* scr, int item, int lane) {
    const int nblk = N / 32, kb = item / nblk, nb = item % nblk, k0 = 64 * kb, n0 = 32 * nb;
    float wreg[32];
#pragma unroll
    for (int i = 0; i < 32; ++i) { const int kk = 2 * i + (lane >> 5); wreg[i] = __builtin_nontemporal_load(W + (size_t)(k0 + kk) * N + n0 + (lane & 31)); }
#pragma unroll
    for (int i = 0; i < 32; ++i) { const int kk = 2 * i + (lane >> 5); scr[kk * 33 + (lane & 31)] = wreg[i]; }
    LDS_WAIT(); asm volatile("" ::: "memory");
    const int c = lane & 7;
#pragma unroll
    for (int j = 0; j < 4; ++j) { const int n = (lane >> 3) + 8 * j; const LAS float* s = scr + (8 * c) * 33 + n;
        int dr; float sc = 1.0f; const int ng = n0 + n;
        if (MODE == 0) dr = row_off + ng; else if (MODE == 3) dr = ((ng >> 6) << 8) + row_off + (ng & 63); else if (MODE == 1) { const int Hh = N >> 1; dr = row_off + 2 * (ng % Hh) + ng / Hh; } else dr = win_dest(ng, sc);
        if (OUT8) { unsigned w0 = 0, w1 = 0;
            w0 = __builtin_amdgcn_cvt_pk_fp8_f32(64.f * s[0 * 33], 64.f * s[1 * 33], w0, false); w0 = __builtin_amdgcn_cvt_pk_fp8_f32(64.f * s[2 * 33], 64.f * s[3 * 33], w0, true);
            w1 = __builtin_amdgcn_cvt_pk_fp8_f32(64.f * s[4 * 33], 64.f * s[5 * 33], w1, false); w1 = __builtin_amdgcn_cvt_pk_fp8_f32(64.f * s[6 * 33], 64.f * s[7 * 33], w1, true);
            *(u32x2*)((unsigned char*)WT + (size_t)dr * K + k0 + 8 * c) = (u32x2){w0, w1}; }
        else { u32x4 o; o.x = pk2(s[0 * 33] * sc, s[1 * 33] * sc); o.y = pk2(s[2 * 33] * sc, s[3 * 33] * sc); o.z = pk2(s[4 * 33] * sc, s[5 * 33] * sc); o.w = pk2(s[6 * 33] * sc, s[7 * 33] * sc);
        *(u32x4*)(WT + (size_t)dr * K + k0 + 8 * c) = o; } }
    LDS_WAIT(); asm volatile("" ::: "memory");
}
__device__ __forceinline__ void sincos_d(double x, double& s, double& c) {
    const double tp = 6.283185307179586476925287; x -= tp * rint(x / tp);
    const double x2 = x * x; double cs = 1.0, sn = 1.0;
    double tc = 1.0, ts = 1.0; cs = 1.0; sn = 1.0;
#pragma unroll
    for (int k = 1; k <= 17; ++k) { tc *= -x2 / (double)((2 * k - 1) * (2 * k)); ts *= -x2 / (double)((2 * k) * (2 * k + 1)); cs += tc; sn += ts; }
    s = sn * x; c = cs;
}

struct P0Args {
    const float *c, *c_ctx, *ada_w, *ada_b, *w_in, *w_gate, *ret_w_o, *s5_w_glu, *diff_w_o, *conv_w_o, *w_out, *ffn_w_gu, *ffn_w_d, *moe_w_gu, *moe_w_d;
    int f8mask;
    const float *ret_decay, *s5_a_re, *s5_a_im, *s5_log_dt, *s5_b_re, *s5_b_im, *s5_c_re, *s5_c_im, *diff_lambda;
};
__device__ __forceinline__ void p0_prologue(Frame& F, const P0Args& P) {
    unsigned char* ws = F.ws;
    {
        LAS float* scr = (LAS float*)(F.lds + F.wave * 8448);
        const int gw = F.vcu * NWAVES + F.wave, NGW = F.G * NWAVES;
        constexpr int I_WIN = 16 * (NIN / 32), I_WG = 16 * 32, I_BR1 = 4 * 32, I_BR2 = 4 * 64, I_WOUT = 16 * 32;
        constexpr int I_LAYER = I_WIN + 4 * I_WG + I_BR1 + I_BR2 + I_BR1 + I_BR1 + I_WOUT;
        constexpr int I_GU = 16 * (2 * FFD / 32), I_DD = (FFD / 64) * 32, I_DENSE = I_GU + I_DD;
        constexpr int I_MGU = 16 * (2 * FFE / 32), I_MD = (FFE / 64) * 32, I_EXP = I_MGU + I_MD;
        constexpr int NITEMS = DEPTH * I_LAYER + 2 * I_DENSE + 2 * NE * I_EXP;
        for (int it = gw; it < NITEMS; it += NGW) {
            int r = it;
            if (r < DEPTH * I_LAYER) {
                const int l = r / I_LAYER; r -= l * I_LAYER;
                if (r < I_WIN) { transpose_item<2>(P.w_in + (size_t)l * D * NIN, D, NIN, (bf16*)(ws + WS_WIN) + (size_t)l * E_WIN, 0, scr, r, F.lane); continue; } r -= I_WIN;
                if (r < 4 * I_WG) { const int z = r / I_WG; transpose_item<3, true>(P.w_gate + ((size_t)l * 4 + z) * D * D, D, D, (bf16*)(ws + WS_WG) + (size_t)l * E_WG, z * 64, scr, r % I_WG, F.lane); continue; } r -= 4 * I_WG;
                bf16* wbr = (bf16*)(ws + WS_WBR) + (size_t)l * E_WBR;
                if (r < I_BR1) { transpose_item<0>(P.ret_w_o + (size_t)l * 256 * D, 256, D, wbr, 0, scr, r, F.lane); continue; } r -= I_BR1;
                if (r < I_BR2) { transpose_item<1>(P.s5_w_glu + (size_t)l * 256 * 2 * D, 256, 2 * D, wbr, 1024, scr, r, F.lane); continue; } r -= I_BR2;
                if (r < I_BR1) { transpose_item<0>(P.diff_w_o + (size_t)l * 256 * D, 256, D, wbr, 3072, scr, r, F.lane); continue; } r -= I_BR1;
                if (r < I_BR1) { transpose_item<0>(P.conv_w_o + (size_t)l * 256 * D, 256, D, wbr, 4096, scr, r, F.lane); continue; } r -= I_BR1;
                transpose_item<0>(P.w_out + (size_t)l * D * D, D, D, (bf16*)(ws + WS_WOUT) + (size_t)l * E_WOUT, 0, scr, r, F.lane); continue;
            }
            r -= DEPTH * I_LAYER;
            if (r < 2 * I_DENSE) {
                const int j = r / I_DENSE; r -= j * I_DENSE;
                const bool f8 = (P.f8mask >> (2 * j)) & 1; bf16* wgu = (bf16*)(ws + WS_WGU + (size_t)j * E_WGU * 2); bf16* wd = (bf16*)(ws + WS_WD + (size_t)j * E_WD * 2);
                if (r < I_GU) { if (f8) transpose_item<1, true>(P.ffn_w_gu + (size_t)j * D * 2 * FFD, D, 2 * FFD, wgu, 0, scr, r, F.lane); else transpose_item<1, false>(P.ffn_w_gu + (size_t)j * D * 2 * FFD, D, 2 * FFD, wgu, 0, scr, r, F.lane); continue; } r -= I_GU;
                if (f8) transpose_item<0, true>(P.ffn_w_d + (size_t)j * FFD * D, FFD, D, wd, 0, scr, r, F.lane); else transpose_item<0, false>(P.ffn_w_d + (size_t)j * FFD * D, FFD, D, wd, 0, scr, r, F.lane); continue;
            }
            r -= 2 * I_DENSE;
            { const int je = r / I_EXP; r -= je * I_EXP;
              const int jj = je >> 3, ee = je & 7; const bool f8 = (P.f8mask >> (2 * jj + 1)) & 1; const size_t esz = f8 ? 1 : 2;
              bf16* wgu = (bf16*)(ws + WS_MGU + (size_t)jj * NE * E_MGU * 2 + (size_t)ee * E_MGU * esz); bf16* wd = (bf16*)(ws + WS_MWD + (size_t)jj * NE * E_MWD * 2 + (size_t)ee * E_MWD * esz);
              if (r < I_MGU) { if (f8) transpose_item<1, true>(P.moe_w_gu + (size_t)je * D * 2 * FFE, D, 2 * FFE, wgu, 0, scr, r, F.lane); else transpose_item<1, false>(P.moe_w_gu + (size_t)je * D * 2 * FFE, D, 2 * FFE, wgu, 0, scr, r, F.lane); continue; } r -= I_MGU;
              if (f8) transpose_item<0, true>(P.moe_w_d + (size_t)je * FFE * D, FFE, D, wd, 0, scr, r, F.lane); else transpose_item<0, false>(P.moe_w_d + (size_t)je * FFE * D, FFE, D, wd, 0, scr, r, F.lane); }
        }
    }
    __syncthreads();
    {
        LAS float* sc = (LAS float*)F.lds;
        LAS float* part = (LAS float*)(F.lds + 17 * 1024 * 4);
        for (int i = F.tid; i < 17 * D; i += 512) { const int r = i >> 10, k = i & 1023; const float v = r < 16 ? P.c[r * D + k] : P.c_ctx[k]; sc[i] = v / (1.0f + __expf(-v)); }
        __syncthreads();
        float* mods = (float*)(ws + WS_MODS);
        for (int u = F.vcu; u < DEPTH * 96; u += F.G) {
            const int l = u / 96, n0 = (u % 96) * 64;
            const float* w = P.ada_w + (size_t)l * D * 6 * D + n0 + F.lane;
            float acc[17];
#pragma unroll
            for (int r = 0; r < 17; ++r) acc[r] = 0.f;
            const int kb = F.wave * 128;
#pragma unroll 2
            for (int k4 = 0; k4 < 128; k4 += 4) {
                float wv[4];
#pragma unroll
                for (int j = 0; j < 4; ++j) wv[j] = w[(size_t)(kb + k4 + j) * 6 * D];
#pragma unroll
                for (int r = 0; r < 17; ++r) { const f32x4 s = *(const LAS f32x4*)(sc + r * 1024 + kb + k4); acc[r] += wv[0] * s[0] + wv[1] * s[1] + wv[2] * s[2] + wv[3] * s[3]; }
            }
#pragma unroll
            for (int r = 0; r < 17; ++r) part[(F.wave * 17 + r) * 64 + F.lane] = acc[r];
            __syncthreads();
            for (int i = F.tid; i < 17 * 64; i += 512) { float s = 0.f;
#pragma unroll
                for (int w8 = 0; w8 < 8; ++w8) s += part[w8 * 17 * 64 + i];
                const int r = i >> 6, n = n0 + (i & 63); mods[((size_t)l * 17 + r) * 6 * D + n] = s + P.ada_b[(size_t)l * 6 * D + n]; }
            __syncthreads();
        }
    }
    {
        const int gt = F.vcu * 512 + F.tid, NGT = F.G * 512;
        float* rope = (float*)(ws + WS_ROPE);
        for (int i = gt; i < SEQ * 16; i += NGT) { const int t = i >> 4, pi = i & 15, axis = pi >> 3, f = pi & 7;
            const float inv = exp2f(-(float)f * (13.287712379549449f / 8.0f));
            const float ang = (float)(axis ? (t & 63) : (t >> 6)) * inv; float s, c; sincosf(ang, &s, &c); rope[2 * i] = c; rope[2 * i + 1] = s; }
        for (int i = gt; i < DEPTH * 2048; i += NGT) {
            const int l = i >> 11, d = (i >> 10) & 1, g = (i >> 6) & 15, p = i & 63;
            unsigned char* sp = ws + WS_S5P + (size_t)l * S5P_BYTES;
            const float are = fminf(P.s5_a_re[i], -1e-4f), aim = P.s5_a_im[i];
            const float dt = expf(P.s5_log_dt[(l * 2 + d) * 16 + g]);
            const float zre = dt * are; const double zim = (double)dt * (double)aim;
            double sn, cs; sincos_d(zim, sn, cs);
            const float mag = expf(zre), abre = mag * (float)cs, abim = mag * (float)sn;
            double sn2, cs2; sincos_d(128.0 * zim, sn2, cs2); const float mag2 = expf(128.0f * zre);
            ((f32x2*)(sp + S5P_ABAR))[i & 2047] = (f32x2){abre, abim};
            ((f32x2*)(sp + S5P_A128))[i & 2047] = (f32x2){mag2 * (float)cs2, mag2 * (float)sn2};
            const float den = are * are + aim * aim, nre = abre - 1.0f;
            const float cfre = (nre * are + abim * aim) / den, cfim = (abim * are - nre * aim) / den;
            const float* bre = P.s5_b_re + (((size_t)l * 16 + g) * 64 + p) * 16; const float* bim = P.s5_b_im + (((size_t)l * 16 + g) * 64 + p) * 16;
            bf16* bp = (bf16*)(sp + S5P_BP) + (((size_t)d * 16 + g) * 128 + 2 * p) * 16;
#pragma unroll
            for (int c = 0; c < 16; ++c) { const float br = bre[c], bi = bim[c]; bp[c] = (bf16)f2bf(cfre * br - cfim * bi); bp[16 + c] = (bf16)f2bf(cfre * bi + cfim * br); }
            if (d == 0) { bf16* ch = (bf16*)(sp + S5P_CH) + (size_t)g * 16 * 128;
#pragma unroll
                for (int c = 0; c < 16; ++c) { const size_t ci = (((size_t)l * 16 + g) * 16 + c) * 64 + p; ch[c * 128 + 2 * p] = (bf16)f2bf(P.s5_c_re[ci]); ch[c * 128 + 2 * p + 1] = (bf16)f2bf(-P.s5_c_im[ci]); } }
        }
        if (gt < DEPTH) { const int l = gt; float* lp = (float*)(ws + WS_LAYP) + l * 64;
            for (int j = 0; j < 8; ++j) { const float x = P.ret_decay[l * 8 + j]; lp[j] = -log2f(1.0f + expf(-x)); }
            const float* dl = P.diff_lambda + l * 128; float d01 = 0.f, d23 = 0.f;
            for (int j = 0; j < 32; ++j) { d01 += dl[j] * dl[32 + j]; d23 += dl[64 + j] * dl[96 + j]; }
            const float li = 0.8f - 0.6f * expf(-0.3f * (float)l);
            lp[8] = expf(d01) - expf(d23) + li; lp[9] = 1.0f - li; }
    }
}
struct RowArgs {
    const float *x, *ctx;
    const float *post_g;
    const float *pre_g;
    const float *router_w, *router_b;
    float* out;
    int l, nrows, moe, last, f8, dry;
};
template <int MODE>
__device__ __forceinline__ void row_pass(Frame& F, const RowArgs& A) {
    unsigned char* ws = F.ws;
    float* H = (float*)(ws + WS_H); bf16* AF = (bf16*)(ws + WS_AF); const float* Y = (const float*)(ws + WS_Y);
    float* Hst = A.dry ? (float*)(ws + WS_END) : H; if (A.dry) AF = (bf16*)(ws + WS_END + (size_t)RT * D * 2);
    const float* mods = (const float*)(ws + WS_MODS);
    const int gw = F.vcu * NWAVES + F.wave, NGW = F.G * NWAVES, lane = opaque_v(F.lane);
    volatile LAS unsigned* cnt = F.MISC + 16;
    if (MODE == 1 && A.moe) { if (F.tid < 8) cnt[F.tid] = 0u; __syncthreads(); }
    const int lg = A.l, lm = (MODE == 2) ? A.l + 1 : A.l;
    const int goff = (MODE == 1) ? 2 * D : 5 * D, shoff = (MODE == 1) ? 3 * D : 0, scoff = (MODE == 1) ? 4 * D : D;
    LAS float* rwL = (LAS float*)F.lds;
    if (MODE == 1 && A.moe) {
        for (int i = F.tid; i < D * NE; i += 512) rwL[(i & 7) * D + (i >> 3)] = A.router_w[i];
        __syncthreads();
    }
    const bool wr_af = !(MODE == 2 && A.last);
    f32x4 pg[4], pg2[4];
#pragma unroll
    for (int j = 0; j < 4; ++j) { const int c = 4 * lane + 256 * j; pg[j] = (MODE != 0) ? *(const GAS f32x4*)((const GAS float*)A.post_g + c) : (f32x4){0.f, 0.f, 0.f, 0.f}; pg2[j] = wr_af ? *(const GAS f32x4*)((const GAS float*)A.pre_g + c) : (f32x4){0.f, 0.f, 0.f, 0.f}; }
    struct Raw { u32x2 ya[4], yb[4], hw[4]; f32x4 gv[4], sh[4], sc[4], x[4]; };
    Raw cur, nx;
    u32x4 recn = (u32x4){0u, 0u, 0u, 0u}; u32x2 posn = (u32x2){0u, 0u};
    u32x4 recc = recn, recx = recn; u32x2 posc = posn, posx = posn;
#define ROW_REC(R4, P2, rw) do { if (false) { const GAS int* rec_ = (const GAS int*)(ws + WS_REC) + (size_t)(rw) * 8; R4 = (u32x4){0u, 0u, (unsigned)rec_[2], (unsigned)rec_[3]}; P2 = (u32x2){(unsigned)rec_[6], (unsigned)rec_[7]}; } } while (0)
#define ROW_LOAD(R, rw, R4, P2) do { const int br_ = (rw) < RL ? ((rw) >> 11) : 16; \
        if (wr_af) { const GAS float* mrow_ = (const GAS float*)mods + ((size_t)lm * 17 + br_) * 6 * D; _Pragma("unroll") for (int j = 0; j < 4; ++j) { const int c = 4 * lane + 256 * j; R.sh[j] = *(const GAS f32x4*)(mrow_ + shoff + c); R.sc[j] = *(const GAS f32x4*)(mrow_ + scoff + c); } } \
        if (MODE == 0) { const GAS float* src_ = (rw) < RL ? (const GAS float*)A.x + (size_t)(rw) * D : (const GAS float*)A.ctx + (size_t)((rw) - RL) * D; _Pragma("unroll") for (int j = 0; j < 4; ++j) R.x[j] = *(const GAS f32x4*)(src_ + 4 * lane + 256 * j); } \
        else { const GAS float* gate_ = (const GAS float*)mods + ((size_t)lg * 17 + br_) * 6 * D + goff; \
            _Pragma("unroll") for (int j = 0; j < 4; ++j) { const int c = 4 * lane + 256 * j; R.hw[j] = *(const GAS u32x2*)((const GAS bf16*)H + (size_t)(rw) * D + c); R.gv[j] = *(const GAS f32x4*)(gate_ + c); } \
            if (MODE == 2 && A.moe) { } else if (false) { const GAS bf16* ys_ = (const GAS bf16*)(ws + WS_YS); const size_t p0_ = (size_t)P2.x, p1_ = (size_t)P2.y; \
                _Pragma("unroll") for (int j = 0; j < 4; ++j) { R.ya[j] = *(const GAS u32x2*)(ys_ + p0_ * D + 4 * lane + 256 * j); R.yb[j] = *(const GAS u32x2*)(ys_ + p1_ * D + 4 * lane + 256 * j); } } \
            else { _Pragma("unroll") for (int j = 0; j < 4; ++j) R.ya[j] = *(const GAS u32x2*)((const GAS bf16*)Y + (size_t)(rw) * D + 4 * lane + 256 * j); } } } while (0)
    if (gw < A.nrows) { ROW_REC(recc, posc, gw); if (gw + NGW < A.nrows) ROW_REC(recx, posx, gw + NGW); ROW_LOAD(cur, gw, recc, posc); }
    for (int row = gw; row < A.nrows; row += NGW) {
        const int nrow = row + NGW;
        if (nrow + NGW < A.nrows) ROW_REC(recn, posn, nrow + NGW);
        if (nrow < A.nrows) ROW_LOAD(nx, nrow, recx, posx);
        f32x4 h[4]; f32x4 sh[4], sc[4];
#pragma unroll
        for (int j = 0; j < 4; ++j) { sh[j] = cur.sh[j]; sc[j] = cur.sc[j]; }
        if (MODE == 0) {
#pragma unroll
            for (int j = 0; j < 4; ++j) h[j] = cur.x[j];
        } else {
            f32x4 y[4]; float ss = 0.f;
            if (MODE == 2 && A.moe) { const GAS int* rec = (const GAS int*)(ws + WS_REC) + (size_t)row * 8;
                const int p0 = rec[6], p1 = rec[7]; const float w0 = __builtin_bit_cast(float, rec[2]), w1 = __builtin_bit_cast(float, rec[3]);
                const GAS bf16* ys = (const GAS bf16*)(ws + WS_YS);
#pragma unroll
                for (int j = 0; j < 4; ++j) { const u32x2 a = *(const GAS u32x2*)(ys + (size_t)p0 * D + 4 * lane + 256 * j), b = *(const GAS u32x2*)(ys + (size_t)p1 * D + 4 * lane + 256 * j);
                    y[j] = (f32x4){w0 * bflo(a.x) + w1 * bflo(b.x), w0 * bfhi(a.x) + w1 * bfhi(b.x), w0 * bflo(a.y) + w1 * bflo(b.y), w0 * bfhi(a.y) + w1 * bfhi(b.y)}; }
            } else {
#pragma unroll
                for (int j = 0; j < 4; ++j) { const u32x2 a = cur.ya[j]; y[j] = (f32x4){bflo(a.x), bfhi(a.x), bflo(a.y), bfhi(a.y)}; }
            }
#pragma unroll
            for (int j = 0; j < 4; ++j) ss += (y[j][0] * y[j][0] + y[j][1] * y[j][1]) + (y[j][2] * y[j][2] + y[j][3] * y[j][3]);
            const float rstd = 1.0f / sqrtf(wave_sum(ss) * (1.0f / D) + EPS);
#pragma unroll
            for (int j = 0; j < 4; ++j) { const u32x2 hw = cur.hw[j]; const f32x4 hv = (f32x4){bflo(hw.x), bfhi(hw.x), bflo(hw.y), bfhi(hw.y)}; h[j] = hv + cur.gv[j] * (y[j] * rstd * pg[j]); }
        }
        cur = nx; recc = recx; posc = posx; recx = recn; posx = posn;
        if (!wr_af) {
#pragma unroll
            for (int j = 0; j < 4; ++j) if (!A.dry) *(GAS f32x4*)((GAS float*)A.out + (size_t)row * D + 4 * lane + 256 * j) = h[j];
            continue;
        }
#pragma unroll
        for (int j = 0; j < 4; ++j) { u32x2 hw; hw.x = pk2(h[j][0], h[j][1]); hw.y = pk2(h[j][2], h[j][3]); *(GAS u32x2*)((GAS bf16*)Hst + (size_t)row * D + 4 * lane + 256 * j) = hw; }
        float s2 = 0.f;
#pragma unroll
        for (int j = 0; j < 4; ++j) s2 += (h[j][0] * h[j][0] + h[j][1] * h[j][1]) + (h[j][2] * h[j][2] + h[j][3] * h[j][3]);
        const float rs2 = 1.0f / sqrtf(wave_sum(s2) * (1.0f / D) + EPS);
        f32x4 f[4];
#pragma unroll
        for (int j = 0; j < 4; ++j) { const int c = 4 * lane + 256 * j;
            f[j] = (h[j] * rs2 * pg2[j]) * (1.0f + sc[j]) + sh[j];
            if (MODE == 1 && A.f8) { unsigned w = 0; w = __builtin_amdgcn_cvt_pk_fp8_f32(4.f * f[j][0], 4.f * f[j][1], w, false); w = __builtin_amdgcn_cvt_pk_fp8_f32(4.f * f[j][2], 4.f * f[j][3], w, true);
                *(GAS unsigned*)((GAS unsigned char*)AF + (size_t)row * D + c) = w; }
            else { u32x2 w; w.x = pk2(f[j][0], f[j][1]); w.y = pk2(f[j][2], f[j][3]); *(GAS u32x2*)((GAS bf16*)AF + (size_t)row * D + c) = w;
                if (MODE != 1) { unsigned w8 = 0; w8 = __builtin_amdgcn_cvt_pk_fp8_f32(4.f * f[j][0], 4.f * f[j][1], w8, false); w8 = __builtin_amdgcn_cvt_pk_fp8_f32(4.f * f[j][2], 4.f * f[j][3], w8, true);
                    *(GAS unsigned*)((GAS unsigned char*)(ws + (A.dry ? WS_END + (size_t)RT * D * 4 : WS_AF8)) + (size_t)row * D + c) = w8; } } }
        if (MODE == 1 && A.moe) {
            float pl[8];
#pragma unroll
            for (int e = 0; e < 8; ++e) pl[e] = 0.f;
#pragma unroll
            for (int j = 0; j < 4; ++j)
#pragma unroll
                for (int e = 0; e < 8; ++e) { const f32x4 w4 = *(const LAS f32x4*)(rwL + e * D + 4 * lane + 256 * j); pl[e] += (f[j][0] * w4[0] + f[j][1] * w4[1]) + (f[j][2] * w4[2] + f[j][3] * w4[3]); }
            float a4[4], a2[2], a1;
            { const bool hi = (lane & 32) != 0;
#pragma unroll
              for (int k = 0; k < 4; ++k) { const float mine = hi ? pl[4 + k] : pl[k], theirs = hi ? pl[k] : pl[4 + k]; a4[k] = mine + __shfl_xor(theirs, 32); } }
            { const bool hi = (lane & 16) != 0;
#pragma unroll
              for (int k = 0; k < 2; ++k) { const float mine = hi ? a4[2 + k] : a4[k], theirs = hi ? a4[k] : a4[2 + k]; a2[k] = mine + __shfl_xor(theirs, 16); } }
            { const bool hi = (lane & 8) != 0; const float mine = hi ? a2[1] : a2[0], theirs = hi ? a2[0] : a2[1]; a1 = mine + __shfl_xor(theirs, 8); }
            a1 += __shfl_xor(a1, 4); a1 += __shfl_xor(a1, 2); a1 += __shfl_xor(a1, 1);
            float lg8[8];
#pragma unroll
            for (int e = 0; e < 8; ++e) lg8[e] = __builtin_bit_cast(float, __builtin_amdgcn_readlane(__builtin_bit_cast(int, a1), 8 * e)) + A.router_b[e];
            int e0 = 0; float v0 = lg8[0];
#pragma unroll
            for (int e = 1; e < 8; ++e) if (lg8[e] > v0) { v0 = lg8[e]; e0 = e; }
            int e1 = -1; float v1 = -3.0e38f;
#pragma unroll
            for (int e = 0; e < 8; ++e) if (e != e0 && lg8[e] > v1) { v1 = lg8[e]; e1 = e; }
            const float w0 = 1.0f / (1.0f + __expf(v1 - v0)), w1 = 1.0f - w0;
            if (lane == 0) {
                const unsigned r0 = __hip_atomic_fetch_add((LAS unsigned*)(cnt + e0), 1u, __ATOMIC_RELAXED, __HIP_MEMORY_SCOPE_WORKGROUP);
                const unsigned r1 = __hip_atomic_fetch_add((LAS unsigned*)(cnt + e1), 1u, __ATOMIC_RELAXED, __HIP_MEMORY_SCOPE_WORKGROUP);
                int* rec = (int*)(ws + (A.dry ? WS_END + (size_t)RT * D * 5 : WS_REC)) + (size_t)row * 8;
                rec[0] = e0; rec[1] = e1; rec[2] = __builtin_bit_cast(int, w0); rec[3] = __builtin_bit_cast(int, w1); rec[4] = (int)r0; rec[5] = (int)r1;
            }
        }
    }
#undef ROW_REC
#undef ROW_LOAD
    if (MODE == 1 && A.moe) { __syncthreads(); if (F.tid < 8 && !A.dry) ((int*)(ws + WS_HIST))[blockIdx.x * 8 + F.tid] = (int)cnt[F.tid]; }
}

__device__ __forceinline__ void moe_dispatch(Frame& F, int nrows, int f8) {
    unsigned char* ws = F.ws;
    volatile LAS int* sh = (volatile LAS int*)F.lds;
    const int* hist = (const int*)(ws + WS_HIST);
    if (F.tid < 16) sh[F.tid] = 0;
    __syncthreads();
    { const int e = F.tid & 7; int tot = 0, pre = 0;
      int v[4];
#pragma unroll
      for (int q = 0; q < 4; ++q) { const int b = (F.tid >> 3) + 64 * q; v[q] = b < (int)gridDim.x ? __hip_atomic_load(hist + b * 8 + e, __ATOMIC_RELAXED, __HIP_MEMORY_SCOPE_AGENT) : 0; }
#pragma unroll
      for (int q = 0; q < 4; ++q) { const int b = (F.tid >> 3) + 64 * q; tot += v[q]; if (b < (int)blockIdx.x) pre += v[q]; }
      __hip_atomic_fetch_add((LAS int*)(sh + e), tot, __ATOMIC_RELAXED, __HIP_MEMORY_SCOPE_WORKGROUP); __hip_atomic_fetch_add((LAS int*)(sh + 8 + e), pre, __ATOMIC_RELAXED, __HIP_MEMORY_SCOPE_WORKGROUP); }
    __syncthreads();
    if (F.tid == 0) { int base = 0; for (int e = 0; e < 8; ++e) { sh[24 + e] = base; sh[16 + e] = base + sh[8 + e]; base += (sh[e] + 255) & ~255; } sh[32] = base;
        if (blockIdx.x == 0) { int* te = (int*)(ws + WS_TILEE); const int ntile = base >> 8;
#pragma clang loop vectorize(disable) unroll(disable)
            for (int t = 0; t < ntile; ++t) { int e = 0;
#pragma clang loop vectorize(disable) unroll(disable)
                for (int q = 1; q < 8; ++q) e += (t * 256 >= sh[24 + q]) ? 1 : 0;
                te[t] = e; }
            te[400] = ntile; } }
    __syncthreads();
    const int gw = F.vcu * NWAVES + F.wave, NGW = F.G * NWAVES, lane = F.lane;
    const GAS unsigned char* AFb = (const GAS unsigned char*)(ws + WS_AF); GAS unsigned char* FSb = (GAS unsigned char*)(ws + WS_FS);
    const int nmine = (nrows - gw + NGW - 1) / NGW;
    for (int k0 = 0; k0 < nmine; k0 += 64) {
        int p0v = 0, p1v = 0;
        if (k0 + lane < nmine) { GAS int* rec = (GAS int*)(ws + WS_REC) + (size_t)(gw + (k0 + lane) * NGW) * 8;
            const u32x4 ra = *(const GAS u32x4*)rec; const u32x2 rb = *(const GAS u32x2*)(rec + 4);
            p0v = sh[16 + (int)ra.x] + (int)rb.x; p1v = sh[16 + (int)ra.y] + (int)rb.y; *(GAS u32x2*)(rec + 6) = (u32x2){(unsigned)p0v, (unsigned)p1v}; }
        const int nk = (nmine - k0) < 64 ? (nmine - k0) : 64;
        for (int kb = 0; kb < nk; kb += 6) {
            u32x4 a[6], b[6];
#pragma unroll
            for (int q = 0; q < 6; ++q) if (kb + q < nk) { const size_t row = (size_t)(gw + (k0 + kb + q) * NGW);
                if (f8) a[q] = *(const GAS u32x4*)(AFb + row * D + 16 * lane);
                else { a[q] = *(const GAS u32x4*)(AFb + row * 2 * D + 16 * lane); b[q] = *(const GAS u32x4*)(AFb + row * 2 * D + 1024 + 16 * lane); } }
#pragma unroll
            for (int q = 0; q < 6; ++q) if (kb + q < nk) { const size_t p0 = (size_t)__builtin_amdgcn_readlane(p0v, kb + q), p1 = (size_t)__builtin_amdgcn_readlane(p1v, kb + q);
                if (f8) { *(GAS u32x4*)(FSb + p0 * D + 16 * lane) = a[q]; *(GAS u32x4*)(FSb + p1 * D + 16 * lane) = a[q]; }
                else { *(GAS u32x4*)(FSb + p0 * 2 * D + 16 * lane) = a[q]; *(GAS u32x4*)(FSb + p0 * 2 * D + 1024 + 16 * lane) = b[q];
                       *(GAS u32x4*)(FSb + p1 * 2 * D + 16 * lane) = a[q]; *(GAS u32x4*)(FSb + p1 * 2 * D + 1024 + 16 * lane) = b[q]; } }
        }
    }
}
__device__ __forceinline__ int chunk_row0(int b, int c) { return c < 2 ? RL + b * NCTX + c * 128 : b * SEQ + (c - 2) * 128; }
__device__ __forceinline__ bf16x8 tr_read2(unsigned a0, unsigned a1) {
    s16x4 lo, hi; asm volatile("ds_read_b64_tr_b16 %0, %2\n\tds_read_b64_tr_b16 %1, %3\n\ts_waitcnt lgkmcnt(0)" : "=&v"(lo), "=&v"(hi) : "v"(a0), "v"(a1) : "memory");
    return __builtin_shufflevector(lo, hi, 0, 1, 2, 3, 4, 5, 6, 7);
}
__device__ __forceinline__ unsigned scale_pk(unsigned w, float s) { return pk2(bflo(w) * s, bfhi(w) * s); }

constexpr int RS_KSTR = 288, RS_VSTR = 544, RS_KF = 0, RS_KB = 128 * RS_KSTR, RS_V = 2 * 128 * RS_KSTR;

__device__ __forceinline__ void ret_summary_unit(Frame& F, int b, int c, const float* lp) {
    const bf16* Z = (const bf16*)(F.ws + WS_Z); const int row0 = chunk_row0(b, c);
    LAS unsigned char* L = F.lds;
    for (int i = F.tid; i < 2048; i += 512) { const int a = i >> 4, ch = i & 15, hd = ch >> 2;
        const u32x4 kv = *(const u32x4*)(Z + (size_t)(row0 + a) * ZW + ZQ_RK + ch * 8);
        const float wf = __builtin_amdgcn_exp2f((float)(127 - a) * lp[hd]), wb = __builtin_amdgcn_exp2f((float)a * lp[4 + hd]);
        u32x4 f, g; f.x = scale_pk(kv.x, wf); f.y = scale_pk(kv.y, wf); f.z = scale_pk(kv.z, wf); f.w = scale_pk(kv.w, wf);
        g.x = scale_pk(kv.x, wb); g.y = scale_pk(kv.y, wb); g.z = scale_pk(kv.z, wb); g.w = scale_pk(kv.w, wb);
        *(LAS u32x4*)(L + RS_KF + a * RS_KSTR + ch * 16) = f; *(LAS u32x4*)(L + RS_KB + a * RS_KSTR + ch * 16) = g; }
    for (int i = F.tid; i < 4096; i += 512) { const int a = i >> 5, ch = i & 31;
        *(LAS u32x4*)(L + RS_V + a * RS_VSTR + ch * 16) = *(const u32x4*)(Z + (size_t)(row0 + a) * ZW + ZQ_RV + ch * 8); }
    __syncthreads();
    const int h = F.wave & 3, dir = F.wave >> 2, l = opaque_v(F.lane), hh = l >> 5, blk = (l >> 4) & 1, q = (l & 15) >> 2, p = l & 3;
    const unsigned lb = (unsigned)(size_t)L;
    f32x16 acc0, acc1;
#pragma unroll
    for (int r = 0; r < 16; ++r) { acc0[r] = 0.f; acc1[r] = 0.f; }
    const unsigned kbase = lb + (dir ? RS_KB : RS_KF) + (h * 32 + 16 * blk) * 2 + 8 * p;
    const unsigned vbase = lb + RS_V + (h * 64 + 16 * blk) * 2 + 8 * p;
#pragma unroll 2
    for (int ks = 0; ks < 8; ++ks) {
        const int r0 = 16 * ks + 8 * hh + q, r1 = r0 + 4;
        const bf16x8 bk = tr_read2(kbase + r0 * RS_KSTR, kbase + r1 * RS_KSTR);
        const bf16x8 a0 = tr_read2(vbase + r0 * RS_VSTR, vbase + r1 * RS_VSTR);
        const bf16x8 a1 = tr_read2(vbase + 64 + r0 * RS_VSTR, vbase + 64 + r1 * RS_VSTR);
        acc0 = __builtin_amdgcn_mfma_f32_32x32x16_bf16(a0, bk, acc0, 0, 0, 0);
        acc1 = __builtin_amdgcn_mfma_f32_32x32x16_bf16(a1, bk, acc1, 0, 0, 0);
    }
    float* out = (float*)(F.ws + WS_RETSUM) + ((((size_t)b * NCH + c) * 2 + dir) * 4 + h) * 2048;
#pragma unroll
    for (int r = 0; r < 16; ++r) { const int e = (r & 3) + 8 * (r >> 2) + 4 * hh; out[e * 32 + (l & 31)] = acc0[r]; out[(32 + e) * 32 + (l & 31)] = acc1[r]; }
    __syncthreads();
}

__device__ __forceinline__ int prefix_chunk(int dir, int i) { return dir == 0 ? i : (i == 0 ? 1 : (i == 1 ? 0 : 19 - i)); }
__device__ __forceinline__ void ret_prefix_unit(Frame& F, int b, int h, int dir, const float* lp) {
    const int lane_ = opaque_v(F.lane);
    const float g128 = __builtin_amdgcn_exp2f(128.0f * lp[dir * 4 + h]);
    f32x4 S[8], nx[8]; const float z0 = opaque_f(0.f);
#pragma unroll
    for (int j = 0; j < 8; ++j) S[j] = (f32x4){z0, z0, z0, z0};
    { const size_t idx = ((((size_t)b * NCH + prefix_chunk(dir, 0)) * 2 + dir) * 4 + h) * 2048; const GAS float* kv = (const GAS float*)(F.ws + WS_RETSUM) + idx;
#pragma unroll
      for (int j = 0; j < 8; ++j) nx[j] = *(const GAS f32x4*)(kv + 4 * lane_ + 256 * j); }
#pragma unroll 1
    for (int i = 0; i < NCH; ++i) {
        const size_t idx = ((((size_t)b * NCH + prefix_chunk(dir, i)) * 2 + dir) * 4 + h) * 2048;
        GAS bf16* st = (GAS bf16*)(F.ws + WS_RETST) + idx;
        f32x4 cur[8];
#pragma unroll
        for (int j = 0; j < 8; ++j) cur[j] = nx[j];
        if (i + 1 < NCH) { const size_t idn = ((((size_t)b * NCH + prefix_chunk(dir, i + 1)) * 2 + dir) * 4 + h) * 2048; const GAS float* kv = (const GAS float*)(F.ws + WS_RETSUM) + idn;
#pragma unroll
            for (int j = 0; j < 8; ++j) nx[j] = *(const GAS f32x4*)(kv + 4 * lane_ + 256 * j); }
#pragma unroll
        for (int j = 0; j < 8; ++j) { const int o = 4 * lane_ + 256 * j;
            u32x2 w; w.x = pk2(S[j][0], S[j][1]); w.y = pk2(S[j][2], S[j][3]); *(GAS u32x2*)(st + o) = w;
            S[j] = S[j] * g128 + cur[j]; }
    }
}
__device__ __forceinline__ void s5_prefix_unit(Frame& F, int b, int g, int d, int l) {
    const int lane_ = opaque_v(F.lane);
    const f32x2 a = ((const GAS f32x2*)(F.ws + WS_S5P + (size_t)l * S5P_BYTES + S5P_A128))[(d * 16 + g) * 64 + lane_];
    f32x2 e[NCH];
#pragma unroll
    for (int i = 0; i < NCH; ++i) e[i] = ((const GAS f32x2*)(F.ws + WS_S5E))[((((size_t)b * NCH + prefix_chunk(d, i)) * 16 + g) * 2 + d) * 64 + lane_];
    float cr = opaque_f(0.f), ci = cr;
#pragma unroll
    for (int i = 0; i < NCH; ++i) {
        ((GAS f32x2*)(F.ws + WS_S5C))[((((size_t)b * NCH + prefix_chunk(d, i)) * 16 + g) * 2 + d) * 64 + lane_] = (f32x2){cr, ci};
        const float nr = a.x * cr - a.y * ci + e[i].x, ni = a.x * ci + a.y * cr + e[i].y; cr = nr; ci = ni;
    }
}

constexpr int S5_XSTR = 132  , S5_HSTR = 272  , S5_WAVE_LDS = 16 * S5_XSTR * 4 + 16 * S5_HSTR;
template <bool OUT, int DIR>
__device__ __forceinline__ void s5_scan_dir(const unsigned char* sp, unsigned char* wsb, LAS float* X, LAS unsigned char* Hb, int lane, int tk, int kg, int g, size_t sidx, const bf16x8 (&ufr)[8], const bf16x8 (&chf)[4], f32x4 (&yacc)[8]) {
    const bf16x8 zero8 = (bf16x8){0, 0, 0, 0, 0, 0, 0, 0};
    const f32x2 ab = ((const GAS f32x2*)(sp + S5P_ABAR))[(DIR * 16 + g) * 64 + lane];
    bf16x8 af[8];
#pragma unroll
    for (int rb = 0; rb < 8; ++rb) af[rb] = kg < 2 ? *(const GAS bf16x8*)((const GAS bf16*)(sp + S5P_BP) + (((size_t)DIR * 16 + g) * 128 + 16 * rb + tk) * 16 + 8 * kg) : zero8;
    float hr = 0.f, hi = 0.f;
    if (OUT) { const f32x2 cin = ((const GAS f32x2*)(wsb + WS_S5C))[sidx + DIR * 64]; hr = cin.x; hi = cin.y; }
#pragma unroll
    for (int si = 0; si < 8; ++si) {
        const int sub = DIR ? 7 - si : si;
#pragma unroll
        for (int rb = 0; rb < 8; ++rb) { const f32x4 xa = __builtin_amdgcn_mfma_f32_16x16x32_bf16(af[rb], ufr[sub], (f32x4){0.f, 0.f, 0.f, 0.f}, 0, 0, 0);
            *(LAS f32x4*)(X + tk * S5_XSTR + 16 * rb + 4 * kg) = xa; }
        asm volatile("" ::: "memory");
#pragma unroll
        for (int ti = 0; ti < 16; ++ti) {
            const int tok = DIR ? 15 - ti : ti;
            const f32x2 x = *(const LAS f32x2*)(X + tok * S5_XSTR + 2 * lane);
            const float nr = ab.x * hr - ab.y * hi + x.x, ni = ab.x * hi + ab.y * hr + x.y; hr = nr; hi = ni;
            if (OUT) *(LAS unsigned*)(Hb + tok * S5_HSTR + 4 * lane) = cvt_pk_bf16(hr, hi);
        }
        asm volatile("" ::: "memory");
        if (OUT) {
#pragma unroll
            for (int ks = 0; ks < 4; ++ks) { const bf16x8 hf = *(const LAS bf16x8*)(Hb + tk * S5_HSTR + (32 * ks + 8 * kg) * 2); yacc[sub] = __builtin_amdgcn_mfma_f32_16x16x32_bf16(hf, chf[ks], yacc[sub], 0, 0, 0); }
        }
        asm volatile("" ::: "memory");
    }
    if (!OUT) ((GAS f32x2*)(wsb + WS_S5E))[sidx + DIR * 64] = (f32x2){hr, hi};
}
template <bool OUT>
__device__ __forceinline__ void s5_wave_unit(Frame& F, int b, int c, int g, int l, const float* s5_d) {
    const unsigned char* sp = F.ws + WS_S5P + (size_t)l * S5P_BYTES;
    const bf16* Z = (const bf16*)(F.ws + WS_Z); const int row0 = chunk_row0(b, c);
    LAS float* X = (LAS float*)(F.lds + F.wave * S5_WAVE_LDS);
    LAS unsigned char* Hb = (LAS unsigned char*)X + 16 * S5_XSTR * 4;
    const int lane = opaque_v(F.lane), tk = lane & 15, kg = lane >> 4;
    const bf16x8 zero8 = (bf16x8){0, 0, 0, 0, 0, 0, 0, 0};
    f32x4 yacc[8]; bf16x8 chf[4];
#pragma unroll
    for (int s8 = 0; s8 < 8; ++s8) yacc[s8] = (f32x4){0.f, 0.f, 0.f, 0.f};
#pragma unroll
    for (int ks = 0; ks < 4; ++ks) chf[ks] = OUT ? *(const GAS bf16x8*)((const GAS bf16*)(sp + S5P_CH) + ((size_t)g * 16 + tk) * 128 + 32 * ks + 8 * kg) : zero8;
    bf16x8 ufr[8];
#pragma unroll
    for (int sb = 0; sb < 8; ++sb) ufr[sb] = kg < 2 ? *(const GAS bf16x8*)((const GAS bf16*)Z + (size_t)(row0 + 16 * sb + tk) * ZW + ZQ_SU + g * 16 + 8 * kg) : zero8;
    const size_t sidx = ((((size_t)b * NCH + c) * 16 + g) * 2) * 64 + lane;
    s5_scan_dir<OUT, 0>(sp, F.ws, X, Hb, lane, tk, kg, g, sidx, ufr, chf, yacc);
    s5_scan_dir<OUT, 1>(sp, F.ws, X, Hb, lane, tk, kg, g, sidx, ufr, chf, yacc);
    if (OUT) {
        GAS bf16* xb = (GAS bf16*)(F.ws + WS_XB) + (size_t)1 * RT * 256;
        const float dsk = s5_d[((size_t)l * 16 + g) * 16 + tk];
#pragma unroll
        for (int s8 = 0; s8 < 8; ++s8)
#pragma unroll
            for (int r = 0; r < 4; ++r) { const int row = row0 + 16 * s8 + 4 * kg + r;
                const float u = bf2f(((const GAS bf16*)Z)[(size_t)row * ZW + ZQ_SU + g * 16 + tk]);
                const float y = yacc[s8][r] + dsk * u;
                const float o = y * sigmoidf_(1.5957691216f * (y + 0.044715f * y * y * y));
                xb[(size_t)row * 256 + g * 16 + tk] = (bf16)f2bf(o); }
    }
}
__device__ __forceinline__ bf16x8 pack8(const f32x16& x, int s) {
    u32x4 p;
    if (s == 0) { p.x = cvt_pk_bf16(x[0], x[1]); p.y = cvt_pk_bf16(x[2], x[3]); p.z = cvt_pk_bf16(x[4], x[5]); p.w = cvt_pk_bf16(x[6], x[7]); }
    else { p.x = cvt_pk_bf16(x[8], x[9]); p.y = cvt_pk_bf16(x[10], x[11]); p.z = cvt_pk_bf16(x[12], x[13]); p.w = cvt_pk_bf16(x[14], x[15]); }
    return __builtin_bit_cast(bf16x8, p);
}
#define MFMA32(a, b, c) __builtin_amdgcn_mfma_f32_32x32x16_bf16((a), (b), (c), 0, 0, 0)

__device__ __forceinline__ void ret_out_unit(Frame& F, int b, int c, const float* lp) {
    const bf16* Z = (const bf16*)(F.ws + WS_Z); const int row0 = chunk_row0(b, c);
    LAS unsigned char* L = F.lds;
    for (int i = F.tid; i < 4096; i += 512) { const int a = i >> 5, ch = i & 31;
        *(LAS u32x4*)(L + a * RS_VSTR + ch * 16) = *(const u32x4*)(Z + (size_t)(row0 + a) * ZW + ZQ_RV + ch * 8); }
    __syncthreads();
    const int h = F.wave >> 1, ih = F.wave & 1, l = opaque_v(F.lane), li = l & 31, hh = l >> 5, blk = (l >> 4) & 1, q = (l & 15) >> 2, p = l & 3;
    const float lgf = lp[h], lgb = lp[4 + h];
    bf16x8 qf[2][2];
#pragma unroll
    for (int ib = 0; ib < 2; ++ib)
#pragma unroll
        for (int ks = 0; ks < 2; ++ks) qf[ib][ks] = *(const bf16x8*)(Z + (size_t)(row0 + 64 * ih + 32 * ib + li) * ZW + ZQ_RQ + 32 * h + 16 * ks + 8 * hh);
    f32x16 o[2][2];
#pragma unroll
    for (int eb = 0; eb < 2; ++eb)
#pragma unroll
        for (int ib = 0; ib < 2; ++ib)
#pragma unroll
            for (int r = 0; r < 16; ++r) o[eb][ib][r] = 0.f;
    const unsigned vbase = (unsigned)(size_t)L + (h * 64 + 16 * blk) * 2 + 8 * p;
    bf16x8 kfa[4][2];
#pragma unroll
    for (int jb = 0; jb < 4; ++jb)
#pragma unroll
        for (int ks = 0; ks < 2; ++ks) kfa[jb][ks] = *(const GAS bf16x8*)((const GAS bf16*)Z + (size_t)(row0 + 32 * jb + li) * ZW + ZQ_RK + 32 * h + 16 * ks + 8 * hh);
#pragma unroll
    for (int jb = 0; jb < 4; ++jb) {
        bf16x8 kf[2]; kf[0] = kfa[jb][0]; kf[1] = kfa[jb][1];
        bf16x8 vf[2][2];
#pragma unroll
        for (int s2 = 0; s2 < 2; ++s2) { const int r0 = 32 * jb + 16 * s2 + 4 * hh + q, r1 = r0 + 8;
            vf[0][s2] = tr_read2(vbase + r0 * RS_VSTR, vbase + r1 * RS_VSTR); vf[1][s2] = tr_read2(vbase + 64 + r0 * RS_VSTR, vbase + 64 + r1 * RS_VSTR); }
#pragma unroll
        for (int ib = 0; ib < 2; ++ib) {
            f32x16 s;
#pragma unroll
            for (int r = 0; r < 16; ++r) s[r] = 0.f;
            s = MFMA32(kf[0], qf[ib][0], s); s = MFMA32(kf[1], qf[ib][1], s);
            const int iq = 64 * ih + 32 * ib + li;
#pragma unroll
            for (int r = 0; r < 16; ++r) { const int j = 32 * jb + (r & 3) + 8 * (r >> 2) + 4 * hh; const int dl = iq - j;
                s[r] *= dl >= 0 ? __builtin_amdgcn_exp2f((float)dl * lgf) : __builtin_amdgcn_exp2f((float)(-dl) * lgb); }
            const bf16x8 p0 = pack8(s, 0), p1 = pack8(s, 1);
            o[0][ib] = MFMA32(vf[0][0], p0, o[0][ib]); o[0][ib] = MFMA32(vf[0][1], p1, o[0][ib]);
            o[1][ib] = MFMA32(vf[1][0], p0, o[1][ib]); o[1][ib] = MFMA32(vf[1][1], p1, o[1][ib]);
        }
    }
#pragma unroll
    for (int dir = 0; dir < 2; ++dir) {
        const bf16* st = (const bf16*)(F.ws + WS_RETST) + ((((size_t)b * NCH + c) * 2 + dir) * 4 + h) * 2048;
#pragma unroll
        for (int eb = 0; eb < 2; ++eb) {
            const bf16x8 s0 = *(const bf16x8*)(st + (32 * eb + li) * 32 + 8 * hh), s1 = *(const bf16x8*)(st + (32 * eb + li) * 32 + 16 + 8 * hh);
#pragma unroll
            for (int ib = 0; ib < 2; ++ib) {
                f32x16 x;
#pragma unroll
                for (int r = 0; r < 16; ++r) x[r] = 0.f;
                x = MFMA32(s0, qf[ib][0], x); x = MFMA32(s1, qf[ib][1], x);
                const int a = 64 * ih + 32 * ib + li;
                const float wq = dir == 0 ? __builtin_amdgcn_exp2f((float)(a + 1) * lgf) : __builtin_amdgcn_exp2f((float)(128 - a) * lgb);
#pragma unroll
                for (int r = 0; r < 16; ++r) o[eb][ib][r] += wq * x[r];
            }
        }
    }
    bf16* xb = (bf16*)(F.ws + WS_XB);
#pragma unroll
    for (int ib = 0; ib < 2; ++ib) {
        float sm = 0.f;
#pragma unroll
        for (int r = 0; r < 16; ++r) sm += o[0][ib][r] + o[1][ib][r];
        sm += __shfl_xor(sm, 32); const float mean = sm * (1.0f / 64.0f);
        float sq = 0.f;
#pragma unroll
        for (int r = 0; r < 16; ++r) { const float d0 = o[0][ib][r] - mean, d1 = o[1][ib][r] - mean; sq += d0 * d0 + d1 * d1; }
        sq += __shfl_xor(sq, 32); const float rstd = 1.0f / sqrtf(sq * (1.0f / 64.0f) + EPS);
        const size_t row = (size_t)(row0 + 64 * ih + 32 * ib + li);
#pragma unroll
        for (int eb = 0; eb < 2; ++eb)
#pragma unroll
            for (int g4 = 0; g4 < 4; ++g4) { const int e = 32 * eb + 8 * g4 + 4 * hh;
                const u32x2 gw = *(const u32x2*)(Z + row * ZW + ZQ_RG + h * 64 + e);
                const float y0 = (o[eb][ib][4 * g4 + 0] - mean) * rstd * siluf_(bflo(gw.x)), y1 = (o[eb][ib][4 * g4 + 1] - mean) * rstd * siluf_(bfhi(gw.x));
                const float y2 = (o[eb][ib][4 * g4 + 2] - mean) * rstd * siluf_(bflo(gw.y)), y3 = (o[eb][ib][4 * g4 + 3] - mean) * rstd * siluf_(bfhi(gw.y));
                u32x2 w; w.x = cvt_pk_bf16(y0, y1); w.y = cvt_pk_bf16(y2, y3); *(u32x2*)(xb + row * 256 + h * 64 + e) = w; }
    }
    __syncthreads();
}

__device__ __forceinline__ void tr_read_vtile(unsigned base, bf16x8 (&vf)[2][4]) {
    s16x4 r[16];
    asm volatile("ds_read_b64_tr_b16 %0, %16 offset:0\n\t" "ds_read_b64_tr_b16 %1, %16 offset:1152\n\t" "ds_read_b64_tr_b16 %2, %16 offset:2304\n\t" "ds_read_b64_tr_b16 %3, %16 offset:3456\n\t" "ds_read_b64_tr_b16 %4, %16 offset:4608\n\t" "ds_read_b64_tr_b16 %5, %16 offset:5760\n\t" "ds_read_b64_tr_b16 %6, %16 offset:6912\n\t" "ds_read_b64_tr_b16 %7, %16 offset:8064\n\t" "ds_read_b64_tr_b16 %8, %16 offset:64\n\t" "ds_read_b64_tr_b16 %9, %16 offset:1216\n\t" "ds_read_b64_tr_b16 %10, %16 offset:2368\n\t" "ds_read_b64_tr_b16 %11, %16 offset:3520\n\t" "ds_read_b64_tr_b16 %12, %16 offset:4672\n\t" "ds_read_b64_tr_b16 %13, %16 offset:5824\n\t" "ds_read_b64_tr_b16 %14, %16 offset:6976\n\t" "ds_read_b64_tr_b16 %15, %16 offset:8128\n\t" "s_waitcnt lgkmcnt(0)" : "=&v"(r[0]), "=&v"(r[1]), "=&v"(r[2]), "=&v"(r[3]), "=&v"(r[4]), "=&v"(r[5]), "=&v"(r[6]), "=&v"(r[7]), "=&v"(r[8]), "=&v"(r[9]), "=&v"(r[10]), "=&v"(r[11]), "=&v"(r[12]), "=&v"(r[13]), "=&v"(r[14]), "=&v"(r[15]) : "v"(base) : "memory");
#pragma unroll
    for (int eb = 0; eb < 2; ++eb)
#pragma unroll
        for (int k4 = 0; k4 < 4; ++k4) vf[eb][k4] = __builtin_shufflevector(r[(eb * 4 + k4) * 2], r[(eb * 4 + k4) * 2 + 1], 0, 1, 2, 3, 4, 5, 6, 7);
}
constexpr int AT_STR = 144, AT_TILE = 64 * AT_STR, AT_BUF = 2 * AT_TILE;
__device__ __forceinline__ unsigned cvt_pk_bf16_nv(float lo, float hi) { unsigned r; asm("v_cvt_pk_bf16_f32 %0, %1, %2" : "=v"(r) : "v"(lo), "v"(hi)); return r; }
typedef LAS s16x4* lp4;
__device__ __forceinline__ void at_load_k(const LAS unsigned char* Kt, int li, int hh, int mp, bf16x8 (&kf)[2][2]) {
#pragma unroll
    for (int kb = 0; kb < 2; ++kb)
#pragma unroll
        for (int ks = 0; ks < 2; ++ks) kf[kb][ks] = *(const LAS bf16x8*)(Kt + (32 * kb + li) * AT_STR + (mp * 32 + 16 * ks + 8 * hh) * 2);
}
__device__ __forceinline__ void at_load_v(LAS unsigned char* vb, bf16x8 (&vf)[2][4]) {
#pragma unroll
    for (int eb = 0; eb < 2; ++eb)
#pragma unroll
        for (int k4 = 0; k4 < 4; ++k4) { const s16x4 a = __builtin_amdgcn_ds_read_tr16_b64_v4i16((lp4)(vb + 64 * eb + 1152 * (2 * k4))), c = __builtin_amdgcn_ds_read_tr16_b64_v4i16((lp4)(vb + 64 * eb + 1152 * (2 * k4 + 1)));
            vf[eb][k4] = __builtin_shufflevector(a, c, 0, 1, 2, 3, 4, 5, 6, 7); }
}
__device__ __forceinline__ void at_refresh(const f32x16 (&sv)[2], float& mx, float& lsum, f32x16 (&ov)[2]) {
    float tm = sv[0][0];
#pragma unroll
    for (int r = 1; r < 16; ++r) tm = fmaxf(tm, sv[0][r]);
#pragma unroll
    for (int r = 0; r < 16; ++r) tm = fmaxf(tm, sv[1][r]);
    tm = fmaxf(tm, __shfl_xor(tm, 32));
    if (__any(tm > mx)) {
        const float mn = fmaxf(mx, tm), al = __builtin_amdgcn_exp2f((mx - mn) * 1.44269504f);
        mx = mn; lsum *= al;
#pragma unroll
        for (int eb = 0; eb < 2; ++eb)
#pragma unroll
            for (int r = 0; r < 16; ++r) ov[eb][r] *= al;
    }
}
__device__ __forceinline__ void at_stage(f32x16 (&sc)[2], f32x16 (&sn)[2], const bf16x8 (&kf)[2][2], const bf16x8 (&qn)[2], f32x16 (&ov)[2], const bf16x8 (&vf)[2][4], const bf16x8 (&pp)[4],
                                         bf16x8 (&pc)[4], float mb, float& lsum) {
    const f32x2 k2 = (f32x2){1.44269504f, 1.44269504f}, nm2 = (f32x2){-mb, -mb};
    f32x2 rs[2] = {(f32x2){0.f, 0.f}, (f32x2){0.f, 0.f}};
    u32x2 w[8];
#define AT_FMA(g) do { const int kb_ = (g) >> 2, r_ = 4 * ((g) & 3); const f32x2 t_ = __builtin_elementwise_fma((f32x2){sc[kb_][r_], sc[kb_][r_ + 1]}, k2, nm2), u_ = __builtin_elementwise_fma((f32x2){sc[kb_][r_ + 2], sc[kb_][r_ + 3]}, k2, nm2); \
        sc[kb_][r_] = t_.x; sc[kb_][r_ + 1] = t_.y; sc[kb_][r_ + 2] = u_.x; sc[kb_][r_ + 3] = u_.y; } while (0)
#define AT_EXP(g) do { const int kb_ = (g) >> 2, r_ = 4 * ((g) & 3); _Pragma("unroll") for (int i_ = 0; i_ < 4; ++i_) sc[kb_][r_ + i_] = __builtin_amdgcn_exp2f(sc[kb_][r_ + i_]); } while (0)
#define AT_SUM(g) do { const int kb_ = (g) >> 2, r_ = 4 * ((g) & 3); rs[0] += (f32x2){sc[kb_][r_], sc[kb_][r_ + 1]}; rs[1] += (f32x2){sc[kb_][r_ + 2], sc[kb_][r_ + 3]}; \
        w[g].x = cvt_pk_bf16_nv(sc[kb_][r_], sc[kb_][r_ + 1]); w[g].y = cvt_pk_bf16_nv(sc[kb_][r_ + 2], sc[kb_][r_ + 3]); } while (0)
#define AT_MMA(c) do { if ((c) < 4) { const int kb_ = (c) & 1, ks_ = (c) >> 1; if (ks_ == 0) { _Pragma("unroll") for (int r_ = 0; r_ < 16; ++r_) sn[kb_][r_] = 0.f; } sn[kb_] = MFMA32(kf[kb_][ks_], qn[ks_], sn[kb_]); } \
        else { const int k4_ = ((c) - 4) >> 1, eb_ = ((c) - 4) & 1; ov[eb_] = MFMA32(vf[eb_][k4_], pp[k4_], ov[eb_]); } } while (0)
    __builtin_amdgcn_sched_barrier(0);
    AT_FMA(0);
#pragma unroll
    for (int c = 0; c < 12; ++c) {
        __builtin_amdgcn_sched_barrier(0);
        AT_MMA(c);
        if (c < 8) AT_EXP(c);
        if (c + 1 < 8) AT_FMA(c + 1);
        if (c >= 1 && c <= 8) { AT_SUM(c - 1); asm volatile("" : "+v"(rs[0]), "+v"(rs[1])); }
    }
    __builtin_amdgcn_sched_barrier(0);
    rs[0] += rs[1]; lsum += rs[0].x + rs[0].y;
#pragma unroll
    for (int f = 0; f < 4; ++f) pc[f] = __builtin_bit_cast(bf16x8, (u32x4){w[2 * f].x, w[2 * f].y, w[2 * f + 1].x, w[2 * f + 1].y});
#undef AT_FMA
#undef AT_EXP
#undef AT_SUM
#undef AT_MMA
}
__device__ __forceinline__ void attn_unit(Frame& F, int b, int h, int qrow0, int nkt, bool ctx_only, float lam, float omli, const float* subln_g) {
    const bf16* Z = (const bf16*)(F.ws + WS_Z);
    LAS unsigned char* L = F.lds;
    const int l = opaque_v(F.lane), li = l & 31, hh = l >> 5, blk = (l >> 4) & 1, q4 = (l & 15) >> 2, p = l & 3;
    const int qrow = qrow0 + 32 * F.wave + li;
    bf16x8 qf[2][2];
#pragma unroll
    for (int mp = 0; mp < 2; ++mp)
#pragma unroll
        for (int ks = 0; ks < 2; ++ks) qf[mp][ks] = *(const bf16x8*)(Z + (size_t)qrow * ZW + ZQ_DQ + h * 64 + mp * 32 + 16 * ks + 8 * hh);
    f32x16 o[2][2];
#pragma unroll
    for (int mp = 0; mp < 2; ++mp)
#pragma unroll
        for (int eb = 0; eb < 2; ++eb)
#pragma unroll
            for (int r = 0; r < 16; ++r) o[mp][eb][r] = 0.f;
    float mx[2] = {-3.0e38f, -3.0e38f}, ls[2] = {0.f, 0.f};
    const int stid = opaque_v(F.tid), skey = stid >> 3, sch = stid & 7;
    auto key_row = [&](int kt) -> int { const int k0 = kt * 64; return (ctx_only || k0 < NCTX) ? RL + b * NCTX + k0 : b * SEQ + (k0 - NCTX); };
    const int soff = skey * AT_STR + sch * 16, voff = AT_TILE + (4 * hh + q4) * AT_STR + 16 * blk * 2 + 8 * p;
    u32x4 kreg, vreg;
    { const size_t r = (size_t)(key_row(0) + skey); kreg = *(const u32x4*)(Z + r * ZW + ZQ_DK + h * 64 + sch * 8); vreg = *(const u32x4*)(Z + r * ZW + ZQ_DV + h * 64 + sch * 8); }
    *(LAS u32x4*)(L + soff) = kreg; *(LAS u32x4*)(L + AT_TILE + soff) = vreg;
    if (nkt > 1) { const size_t r = (size_t)(key_row(1) + skey); kreg = *(const u32x4*)(Z + r * ZW + ZQ_DK + h * 64 + sch * 8); vreg = *(const u32x4*)(Z + r * ZW + ZQ_DV + h * 64 + sch * 8); }
    __syncthreads();
    f32x16 s0[2], s1[2]; bf16x8 kf[2][2], vf[2][4], pa[4], pb[4];
    at_load_k(L, li, hh, 0, kf);
#pragma unroll
    for (int kb = 0; kb < 2; ++kb) {
#pragma unroll
        for (int r = 0; r < 16; ++r) s0[kb][r] = 0.f;
#pragma unroll
        for (int ks = 0; ks < 2; ++ks) s0[kb] = MFMA32(kf[kb][ks], qf[0][ks], s0[kb]);
    }
    at_load_k(L, li, hh, 1, kf);
    { const bf16x8 z8 = (bf16x8){0, 0, 0, 0, 0, 0, 0, 0};
#pragma unroll
      for (int k4 = 0; k4 < 4; ++k4) { pb[k4] = z8; vf[0][k4] = z8; vf[1][k4] = z8; } }
    int cb = 0;
#pragma unroll 1
    for (int kt = 0; kt < nkt; ++kt) {
        const int nb = cb == 2 * AT_BUF ? 0 : cb + AT_BUF;
        if (kt + 1 < nkt) { *(LAS u32x4*)(L + nb + soff) = kreg; *(LAS u32x4*)(L + nb + AT_TILE + soff) = vreg; }
        __syncthreads();
        if (kt + 2 < nkt) { const size_t r = (size_t)(key_row(kt + 2) + skey); kreg = *(const u32x4*)(Z + r * ZW + ZQ_DK + h * 64 + sch * 8); vreg = *(const u32x4*)(Z + r * ZW + ZQ_DV + h * 64 + sch * 8); }
        const bool refresh = kt < 4 || (kt & 3) == 0;
        if (refresh) at_refresh(s0, mx[0], ls[0], o[0]);
        at_stage(s0, s1, kf, qf[1], o[1], vf, pb, pa, mx[0] * 1.44269504f, ls[0]);
        at_load_v(L + cb + voff, vf);
        at_load_k(L + nb, li, hh, 0, kf);
        if (refresh) at_refresh(s1, mx[1], ls[1], o[1]);
        at_stage(s1, s0, kf, qf[0], o[0], vf, pa, pb, mx[1] * 1.44269504f, ls[1]);
        at_load_k(L + nb, li, hh, 1, kf);
        cb = nb;
    }
#pragma unroll
    for (int k4 = 0; k4 < 4; ++k4) { o[1][0] = MFMA32(vf[0][k4], pb[k4], o[1][0]); o[1][1] = MFMA32(vf[1][k4], pb[k4], o[1][1]); }
    const float l0 = ls[0] + __shfl_xor(ls[0], 32), l1 = ls[1] + __shfl_xor(ls[1], 32);
    const float i0 = 1.0f / l0, i1 = lam / l1;
    float sq = 0.f;
#pragma unroll
    for (int eb = 0; eb < 2; ++eb)
#pragma unroll
        for (int r = 0; r < 16; ++r) { const float v = o[0][eb][r] * i0 - o[1][eb][r] * i1; o[0][eb][r] = v; sq += v * v; }
    sq += __shfl_xor(sq, 32);
    const float rstd = omli / sqrtf(sq * (1.0f / 64.0f) + EPS);
    bf16* xb = (bf16*)(F.ws + WS_XB) + (size_t)2 * RT * 256;
#pragma unroll
    for (int eb = 0; eb < 2; ++eb)
#pragma unroll
        for (int g4 = 0; g4 < 4; ++g4) { const int e = 32 * eb + 8 * g4 + 4 * hh; const f32x4 sg = *(const f32x4*)(subln_g + e);
            u32x2 w; w.x = cvt_pk_bf16(o[0][eb][4 * g4] * rstd * sg[0], o[0][eb][4 * g4 + 1] * rstd * sg[1]); w.y = cvt_pk_bf16(o[0][eb][4 * g4 + 2] * rstd * sg[2], o[0][eb][4 * g4 + 3] * rstd * sg[3]);
            *(u32x2*)(xb + (size_t)qrow * 256 + h * 64 + e) = w; }
    __syncthreads();
}

__device__ __forceinline__ void conv_unit(Frame& F, int seq_row0, int seq_len, int tok0, const float* dw, const float* db, const float* lng, const float* lnb) {
    const bf16* Z = (const bf16*)(F.ws + WS_Z);
    LAS unsigned short* U = (LAS unsigned short*)F.lds;
    LAS float* Yt = (LAS float*)(F.lds + 94 * 512);
    for (int i = F.tid; i < 94 * 32; i += 512) { const int tt = i >> 5, ch = i & 31; const int t = tok0 - 15 + tt;
        u32x4 v = (u32x4){0u, 0u, 0u, 0u}; if (t >= 0 && t < seq_len) v = *(const u32x4*)(Z + (size_t)(seq_row0 + t) * ZW + ZQ_CV + ch * 8);
        *(LAS u32x4*)(U + tt * 256 + ch * 8) = v; }
    __syncthreads();
    const int ctid = opaque_v(F.tid), ch = ctid & 255, half = ctid >> 8;
    float w[31];
#pragma unroll
    for (int k = 0; k < 31; ++k) w[k] = dw[k * 256 + ch];
    const float bias = db[ch];
#pragma unroll 1
    for (int g = 0; g < 2; ++g) {
        const int t0 = half * 32 + g * 16;
        float x[46];
#pragma unroll
        for (int i = 0; i < 46; ++i) x[i] = bf2f(U[(t0 + i) * 256 + ch]);
#pragma unroll
        for (int j = 0; j < 16; ++j) { float a = bias;
#pragma unroll
            for (int k = 0; k < 31; ++k) a += w[k] * x[j + k];
            Yt[(t0 + j) * 256 + ch] = a; }
    }
    __syncthreads();
    bf16* xb = (bf16*)(F.ws + WS_XB) + (size_t)3 * RT * 256;
    for (int t = F.wave; t < 64; t += 8) {
        const f32x4 y = *(const LAS f32x4*)(Yt + t * 256 + 4 * F.lane);
        const float mean = wave_sum((y[0] + y[1]) + (y[2] + y[3])) * (1.0f / 256.0f);
        const f32x4 dv = y - mean; const float var = wave_sum((dv[0] * dv[0] + dv[1] * dv[1]) + (dv[2] * dv[2] + dv[3] * dv[3])) * (1.0f / 256.0f);
        const float rstd = 1.0f / sqrtf(var + EPS);
        const f32x4 g4 = *(const f32x4*)(lng + 4 * F.lane), b4 = *(const f32x4*)(lnb + 4 * F.lane);
        const f32x4 z = dv * rstd * g4 + b4;
        u32x2 wv; wv.x = cvt_pk_bf16(siluf_(z[0]), siluf_(z[1])); wv.y = cvt_pk_bf16(siluf_(z[2]), siluf_(z[3]));
        *(u32x2*)(xb + (size_t)(seq_row0 + tok0 + t) * 256 + 4 * F.lane) = wv;
    }
    __syncthreads();
}
#ifndef F8_LAYER_MASK
#define F8_LAYER_MASK 0xF
#endif
constexpr int F8MASK = F8_LAYER_MASK;
constexpr int NSTEP_L = 12, NSTEPS = 2 + DEPTH * NSTEP_L;
struct Args { const float* in[39]; float* out; unsigned char* ws; int s_lo, s_hi; };
static_assert(sizeof(Args) == 39 * 8 + 8 + 8 + 8, "Args has no padding");

template <int OFF> __device__ __forceinline__ unsigned long long ka64() { unsigned long long v; asm volatile("s_load_dwordx2 %0, %1, %2\n\ts_waitcnt lgkmcnt(0)" : "=s"(v) : "s"(__builtin_amdgcn_kernarg_segment_ptr()), "n"(OFF)); return v; }
template <int OFF> __device__ __forceinline__ int ka32() { int v; asm volatile("s_load_dword %0, %1, %2\n\ts_waitcnt lgkmcnt(0)" : "=s"(v) : "s"(__builtin_amdgcn_kernarg_segment_ptr()), "n"(OFF)); return v; }
#define KIN(k) ((const float*)ka64<8 * (k)>())
#define KOUT ((float*)ka64<312>())
#define KWS ((unsigned char*)ka64<320>())
__global__ void __launch_bounds__(NWAVES * 64, 2) fwd_kernel(Args) {
    extern __shared__ __attribute__((aligned(16))) unsigned char lds[];
    Frame F;
    F.lds = (LAS unsigned char*)lds;
    F.MISC = (volatile LAS unsigned*)(F.lds + MISC_OFF);
    F.tid = threadIdx.x; F.lane = F.tid & 63; F.wave = __builtin_amdgcn_readfirstlane(F.tid >> 6);
    F.G = gridDim.x; { const int bx = blockIdx.x; F.vcu = (F.G % 8 == 0) ? (bx % 8) * (F.G / 8) + bx / 8 : bx; }
    F.ws = KWS;
    unsigned char* ws = F.ws;
    for (int u = F.tid; u < (LDS_BYTES - LDSCTL_OFF) / 4; u += NWAVES * 64) ((LAS unsigned*)(F.lds + LDSCTL_OFF))[u] = 0u;
    __syncthreads();
    unsigned* barw = (unsigned*)(ws + WS_CTL) + CW_BAR; asm volatile("" : "+s"(barw));
    const int lo = ka32<328>(), hi = ka32<332>();
    XcdBarrier bar; bar.bar = barw; bar.x = 0; bar.st = nullptr;
    if (hi - lo > 1) bar = xcd_barrier_post(barw, F.MISC + 8, F.tid);
#ifndef BR_REP
#define BR_REP 0
#endif
#ifndef PH_MASK
#define PH_MASK 0xFFFFF
#endif
#define EN(j) (((PH_MASK) >> (j)) & 1)
#define IN(k) (lo <= (k) && (k) < hi)
#define FRESH() do { int ln_; asm volatile("v_mbcnt_lo_u32_b32 %0, -1, 0\n\tv_mbcnt_hi_u32_b32 %0, -1, %0" : "=v"(ln_)); F.wave = opaque_s(F.wave); F.lane = ln_; F.tid = F.wave * 64 + ln_; \
    F.vcu = opaque_s(F.vcu); F.G = opaque_s(F.G); asm volatile("" : "+s"(F.ws)); ws = F.ws; } while (0)
#define GW (F.vcu * NWAVES + F.wave)
#define NGW_ (F.G * NWAVES)
#define SEAM(k) do { if (IN(k) && IN((k) + 1)) { FRESH(); xcd_barrier(bar, F.tid); } } while (0)

    if (EN(12) && IN(0)) { FRESH();
        P0Args P; P.c = KIN(1); P.c_ctx = KIN(3); P.ada_w = KIN(4); P.ada_b = KIN(5); P.w_in = KIN(10); P.w_gate = KIN(11); P.ret_w_o = KIN(14); P.s5_w_glu = KIN(23);
        P.diff_w_o = KIN(26); P.conv_w_o = KIN(31); P.w_out = KIN(32); P.ffn_w_gu = KIN(33); P.ffn_w_d = KIN(34); P.moe_w_gu = KIN(37); P.moe_w_d = KIN(38);
        P.ret_decay = KIN(13); P.s5_a_re = KIN(15); P.s5_a_im = KIN(16); P.s5_log_dt = KIN(17); P.s5_b_re = KIN(18); P.s5_b_im = KIN(19); P.s5_c_re = KIN(20); P.s5_c_im = KIN(21); P.diff_lambda = KIN(24);
        P.f8mask = F8MASK;
        p0_prologue(F, P);
    }
    SEAM(0);
    if (EN(13) && IN(1)) { FRESH(); RowArgs A{}; A.x = KIN(0); A.ctx = KIN(2); A.pre_g = KIN(6); A.l = 0; A.nrows = RT; row_pass<0>(F, A); }
    SEAM(1);

#pragma unroll 1
    for (int l = 0; l < DEPTH; ++l) {
        const int s0 = 2 + l * NSTEP_L;
        if (hi <= s0 || lo >= s0 + NSTEP_L) continue;
        const bool need_ctx = l < DEPTH - 1, moe = (l & 1) != 0;
        const int nrows = need_ctx ? RT : RL, nM = nrows / 256, j2 = l >> 1;
#define lp ((const float*)(ws + WS_LAYP) + l * 64)
#define AF ((bf16*)(ws + WS_AF))
#define Z ((bf16*)(ws + WS_Z))

        if (EN(0) && IN(s0 + 0)) { FRESH();
            pg8::Gemm g{AF, (const bf16*)(ws + WS_WIN) + (size_t)l * E_WIN, D, 0, 0}; pg8::SchedWin S; S.init(F.G, opaque_s((int)blockIdx.x), need_ctx ? 0 : 2);
            pg8::EpiWin E{Z, (const float*)(ws + WS_ROPE)};
            pg8::gemm_phase(F.lds, g, S, E, F.tid);
        }
        SEAM(s0 + 0);
        if (EN(1) && IN(s0 + 1)) { FRESH();
            unsigned* dep = (unsigned*)(ws + WS_CTL) + CW_DEP + 1024 * l;
            if (need_ctx) {
                pg8::Gemm g{AF, (const bf16*)(ws + WS_WIN) + (size_t)l * E_WIN, D, 0, 0}; pg8::SchedWin S; S.init(F.G, opaque_s((int)blockIdx.x), 1);
                pg8::EpiWin E{Z, (const float*)(ws + WS_ROPE)};
                pg8::gemm_phase(F.lds, g, S, E, F.tid);
                __syncthreads(); FRESH();
                const int bx = opaque_s((int)blockIdx.x), nmine = bx < 16 ? (16 - bx + F.G - 1) / F.G : 0;
                if (nmine > 0) dep_signal(F, dep + 128, (unsigned)nmine);
            }
            unsigned* ctr = (unsigned*)(ws + WS_CTL) + 8192 + 64 * (l * 2 + 0);
            const int n_rs = NB * NCH, nS = n_rs + NB * NCH * 2, nP = 80, e0 = nS + nP;
            const int c_lo = need_ctx ? 0 : 2, nch = NCH - c_lo;
            const int n_at = 512, n_ret = NB * nch, n_s5 = NB * nch * 2, n_cv = need_ctx ? 576 : 512, n_ac = need_ctx ? 64 : 0;
            const int e1 = e0 + n_at, e2 = e1 + n_ret, e3 = e2 + n_s5, e4 = e3 + n_cv, total = e4 + n_ac;
            int u = F.vcu, nsum = 0;
            while (u < total) {
                int nx = 0; if (F.tid == 0) nx = F.G + (int)__hip_atomic_fetch_add(ctr, 1u, RLX_AGENT);
                FRESH();
                if (u < n_rs) { for (int rp_ = 0; rp_ < 1 + ((BR_REP >> 4) & 1); ++rp_) ret_summary_unit(F, u / NCH, u % NCH, lp); }
                else if (u < nS) { const int wu = (u - n_rs) * 8 + F.wave; const int g = wu & 15, bc = wu >> 4; for (int rp_ = 0; rp_ < 1 + ((BR_REP >> 5) & 1); ++rp_) s5_wave_unit<false>(F, bc / NCH, bc % NCH, g, l, nullptr); }
                else if (u < e0) { dep_wait(F, dep, (unsigned)nS); FRESH();
                    const int wu = (u - nS) * 8 + F.wave;
                    if (wu < 128) ret_prefix_unit(F, wu >> 3, (wu >> 1) & 3, wu & 1, lp);
                    else { const int v = wu - 128; s5_prefix_unit(F, v >> 5, (v >> 1) & 15, v & 1, l); } }
                else if (u < e1) { const int v = u - e0; for (int rp_ = 0; rp_ < 1 + ((BR_REP >> 0) & 1); ++rp_) attn_unit(F, v >> 5, (v >> 3) & 3, (v >> 5) * SEQ + (v & 7) * 256, 36, false, lp[8], lp[9], KIN(25) + l * 64); }
                else if (u < e2) { dep_wait(F, dep + 64, (unsigned)nP); FRESH(); const int v = u - e1; for (int rp_ = 0; rp_ < 1 + ((BR_REP >> 1) & 1); ++rp_) ret_out_unit(F, v / nch, c_lo + v % nch, lp); }
                else if (u < e3) { dep_wait(F, dep + 64, (unsigned)nP); FRESH(); const int wu = (u - e2) * 8 + F.wave; const int g = wu & 15, bc = wu >> 4; for (int rp_ = 0; rp_ < 1 + ((BR_REP >> 2) & 1); ++rp_) s5_wave_unit<true>(F, bc / nch, c_lo + bc % nch, g, l, KIN(22)); }
                else if (u < e4) { const int v = u - e3; const float* dw = KIN(27) + (size_t)l * 31 * 256; const float* db = KIN(28) + l * 256; const float* lng = KIN(29) + l * 256; const float* lnb = KIN(30) + l * 256;
                    if (v >= 512) { dep_wait(F, dep + 128, 16u); FRESH(); }
                    for (int rp_ = 0; rp_ < 1 + ((BR_REP >> 3) & 1); ++rp_)
                    if (v < 512) conv_unit(F, (v >> 5) * SEQ, SEQ, (v & 31) * 64, dw, db, lng, lnb);
                    else { const int v2 = v - 512; conv_unit(F, RL + (v2 >> 2) * NCTX, NCTX, (v2 & 3) * 64, dw, db, lng, lnb); } }
                else { const int v = u - e4; attn_unit(F, v >> 2, v & 3, RL + (v >> 2) * NCTX, 4, true, lp[8], lp[9], KIN(25) + l * 64); }
                if (F.tid == 0) F.MISC[24] = (unsigned)nx;
                __syncthreads(); const int un = (int)F.MISC[24]; __syncthreads();
                if (u < nS) { ++nsum; if (un >= nS) dep_signal(F, dep, (unsigned)nsum); }
                else if (u < e0) dep_signal(F, dep + 64, 1u);
                u = un;
            }
        }
        SEAM(s0 + 3);
        if (EN(4) && IN(s0 + 4)) { FRESH();
            pg8::Gemm g{(const bf16*)(ws + WS_XB), (const bf16*)(ws + WS_WBR) + (size_t)l * E_WBR, 256}; pg8::SchedBr S; S.init(nM, F.G, opaque_s((int)blockIdx.x));
            pg8::EpiBr E{(bf16*)(ws + WS_BO)};
            pg8::gemm_phase(F.lds, g, S, E, F.tid);
        }
        SEAM(s0 + 4);
        if (EN(5) && IN(s0 + 5)) { FRESH();
            pg8::Gemm g{ws + WS_AF8, ws + WS_WG + (size_t)l * E_WG * 2, D, 121, 125}; pg8::SchedStd S; S.init(nM, 16, F.G, opaque_s((int)blockIdx.x));
            pg8::EpiGate E{(const bf16*)(ws + WS_BO), (bf16*)(ws + WS_MM), KIN(12) + (size_t)l * 4 * D, F.lds + 131072};
            pg8::gemm_phase<pg8::EpiGate, pg8::SchedStd, true>(F.lds, g, S, E, F.tid);
        }
        SEAM(s0 + 5);
        if (EN(6) && IN(s0 + 6)) { FRESH();
            pg8::Gemm g{(const bf16*)(ws + WS_MM), (const bf16*)(ws + WS_WOUT) + (size_t)l * E_WOUT, D}; pg8::SchedStd S; S.init(nM, 4, F.G, opaque_s((int)blockIdx.x));
            pg8::EpiBf16 E{(bf16*)(ws + WS_Y), D};
            pg8::gemm_phase(F.lds, g, S, E, F.tid);
        }
        SEAM(s0 + 6);
        if (EN(7) && IN(s0 + 7)) { FRESH(); RowArgs A{}; A.post_g = KIN(7) + l * D; A.pre_g = KIN(8) + l * D; A.l = l; A.nrows = nrows; A.moe = moe ? 1 : 0;
            A.f8 = (F8MASK >> l) & 1; A.router_w = KIN(35) + (size_t)j2 * D * NE; A.router_b = KIN(36) + j2 * NE;
#if defined(PROBE_DRY) && (PROBE_DRY & 1)
            if ((PROBE_DRY_L >> l) & 1) { for (int rp_ = 0; rp_ < PROBE_DRY_N; ++rp_) { A.dry = 1; row_pass<1>(F, A); A.dry = 0; __syncthreads(); FRESH(); } }
#endif
            row_pass<1>(F, A); }
        SEAM(s0 + 7);
        if (moe) {
            if (EN(8) && IN(s0 + 8)) { FRESH(); moe_dispatch(F, nrows, (F8MASK >> l) & 1); }
            SEAM(s0 + 8);
            if (EN(9) && IN(s0 + 9)) { FRESH();
                const int* te = (const int*)(ws + WS_TILEE); const int nt = __builtin_amdgcn_readfirstlane(__hip_atomic_load(te + 400, RLX_AGENT));
                pg8::SchedMoe S; S.init(nt, 2 * FFE / 256, F.G, opaque_s((int)blockIdx.x), te);
                if ((F8MASK & 0xA) && ((F8MASK >> l) & 1)) {
                    pg8::Gemm g{ws + WS_FS, ws + WS_MGU + (size_t)j2 * NE * E_MGU * 2, D, 121, 125}; pg8::EpiSwiGLU8 E{ws + WS_GS, FFE};
                    pg8::gemm_phase<pg8::EpiSwiGLU8, pg8::SchedMoe, true>(F.lds, g, S, E, F.tid);
                } else if ((~F8MASK) & 0xA) {
                    pg8::Gemm g{ws + WS_FS, ws + WS_MGU + (size_t)j2 * NE * E_MGU * 2, D, 0, 0}; pg8::EpiSwiGLU E{(bf16*)(ws + WS_GS), FFE};
                    pg8::gemm_phase(F.lds, g, S, E, F.tid);
                }
            }
            SEAM(s0 + 9);
            if (EN(10) && IN(s0 + 10)) { FRESH();
                const int* te = (const int*)(ws + WS_TILEE); const int nt = __builtin_amdgcn_readfirstlane(__hip_atomic_load(te + 400, RLX_AGENT));
                pg8::SchedMoe S; S.init(nt, 4, F.G, opaque_s((int)blockIdx.x), te); pg8::EpiBf16 E{(bf16*)(ws + WS_YS), D};
                if ((F8MASK & 0xA) && ((F8MASK >> l) & 1)) {
                    pg8::Gemm g{ws + WS_GS, ws + WS_MWD + (size_t)j2 * NE * E_MWD * 2, FFE, 121, 124};
                    pg8::gemm_phase<pg8::EpiBf16, pg8::SchedMoe, true>(F.lds, g, S, E, F.tid);
                } else if ((~F8MASK) & 0xA) {
                    pg8::Gemm g{ws + WS_GS, ws + WS_MWD + (size_t)j2 * NE * E_MWD * 2, FFE, 0, 0};
                    pg8::gemm_phase(F.lds, g, S, E, F.tid);
                }
            }
            SEAM(s0 + 10);
        } else {
            if (EN(9) && IN(s0 + 9)) { FRESH();
                pg8::SchedStd S; S.init(nM, 2 * FFD / 256, F.G, opaque_s((int)blockIdx.x));
                if ((F8MASK & 0x5) && ((F8MASK >> l) & 1)) {
                    pg8::Gemm g{AF, ws + WS_WGU + (size_t)j2 * E_WGU * 2, D, 121, 125}; pg8::EpiSwiGLU8 E{ws + WS_G, FFD};
                    pg8::gemm_phase<pg8::EpiSwiGLU8, pg8::SchedStd, true>(F.lds, g, S, E, F.tid);
                } else if ((~F8MASK) & 0x5) {
                    pg8::Gemm g{AF, ws + WS_WGU + (size_t)j2 * E_WGU * 2, D, 0, 0}; pg8::EpiSwiGLU E{(bf16*)(ws + WS_G), FFD};
                    pg8::gemm_phase(F.lds, g, S, E, F.tid);
                }
            }
            SEAM(s0 + 9);
            if (EN(10) && IN(s0 + 10)) { FRESH();
                pg8::SchedStd S; S.init(nM, 4, F.G, opaque_s((int)blockIdx.x)); pg8::EpiBf16 E{(bf16*)(ws + WS_Y), D};
                if ((F8MASK & 0x5) && ((F8MASK >> l) & 1)) {
                    pg8::Gemm g{ws + WS_G, ws + WS_WD + (size_t)j2 * E_WD * 2, FFD, 121, 124};
                    pg8::gemm_phase<pg8::EpiBf16, pg8::SchedStd, true>(F.lds, g, S, E, F.tid);
                } else if ((~F8MASK) & 0x5) {
                    pg8::Gemm g{ws + WS_G, ws + WS_WD + (size_t)j2 * E_WD * 2, FFD, 0, 0};
                    pg8::gemm_phase(F.lds, g, S, E, F.tid);
                }
            }
            SEAM(s0 + 10);
        }
        if (EN(11) && IN(s0 + 11)) { FRESH(); RowArgs A{}; A.post_g = KIN(9) + l * D; A.pre_g = KIN(6) + (l + 1 < DEPTH ? l + 1 : l) * D; A.l = l; A.nrows = nrows; A.moe = moe ? 1 : 0; A.last = need_ctx ? 0 : 1; A.out = KOUT;
#if defined(PROBE_DRY) && (PROBE_DRY & 2)
            if ((PROBE_DRY_L >> l) & 1) { for (int rp_ = 0; rp_ < PROBE_DRY_N; ++rp_) { A.dry = 1; row_pass<2>(F, A); A.dry = 0; __syncthreads(); FRESH(); } }
#endif
            row_pass<2>(F, A); }
        if (l + 1 < DEPTH) SEAM(s0 + 11);
    }
#undef lp
#undef AF
#undef Z
#undef IN
#undef SEAM
}

#ifndef MK_LAUNCH_PER_STEP
#define MK_LAUNCH_PER_STEP 0
#endif
extern "C" void kernel_launch(void* const* d_in, const int* in_sizes, int n_in, void* d_out, int out_size, void* d_ws, size_t ws_size, hipStream_t stream) {
    static int grid = 0;
    if (grid == 0) {
        if (n_in != 39 || out_size != RL * D || ws_size < WS_END) { fprintf(stderr, "kernel_launch: unexpected shapes: n_in %d out %d ws %zu (need %zu)\n", n_in, out_size, ws_size, (size_t)WS_END); grid = -1; return; }
        int dev = 0, cus = 0, per_cu = 0;
        if (hipGetDevice(&dev) != hipSuccess || hipDeviceGetAttribute(&cus, hipDeviceAttributeMultiprocessorCount, dev) != hipSuccess) { grid = -1; return; }
        if (hipFuncSetAttribute((const void*)fwd_kernel, hipFuncAttributeMaxDynamicSharedMemorySize, LDS_BYTES) != hipSuccess) { fprintf(stderr, "kernel_launch: hipFuncSetAttribute failed\n"); grid = -1; return; }
        if (hipOccupancyMaxActiveBlocksPerMultiprocessor(&per_cu, (const void*)fwd_kernel, NWAVES * 64, LDS_BYTES) != hipSuccess || per_cu < 1) { fprintf(stderr, "kernel_launch: occupancy query says %d\n", per_cu); }
        (void)hipGetLastError();
        grid = cus;
    }
    if (grid < 0) return;
    if (hipMemsetAsync((char*)d_ws + WS_CTL, 0, CTL_ZERO_BYTES, stream) != hipSuccess) return;
    Args a{};
    for (int i = 0; i < 39; ++i) a.in[i] = (const float*)d_in[i];
    a.out = (float*)d_out; a.ws = (unsigned char*)d_ws;
#if MK_LAUNCH_PER_STEP
    for (int s = 0; s < NSTEPS; ++s) { a.s_lo = s; a.s_hi = s + 1;
        int rep = 1;
#ifdef PROBE_REP_MASK
        if (s >= 2) { const int j = (s - 2) % NSTEP_L, l = (s - 2) / NSTEP_L; if (((PROBE_REP_MASK) >> j) & 1 && ((PROBE_LAYER_MASK) >> l) & 1) rep = 2; } else if (((PROBE_REP_MASK) >> (12 + s)) & 1) rep = 2;
#endif
        for (int r = 0; r < rep; ++r) hipLaunchKernelGGL(fwd_kernel, dim3(grid), dim3(NWAVES * 64), LDS_BYTES, stream, a); }
#else
    a.s_lo = 0; a.s_hi = NSTEPS;
    hipLaunchKernelGGL(fwd_kernel, dim3(grid), dim3(NWAVES * 64), LDS_BYTES, stream, a);
#endif
    const hipError_t le = hipPeekAtLastError();
    if (le != hipSuccess) fprintf(stderr, "kernel_launch: launch failed: %s\n", hipGetErrorName(le));
}
```

```cpp
#include <hip/hip_runtime.h>
#include <cstdio>
#include <cstdint>

#define LAS __attribute__((address_space(3)))
#define GAS __attribute__((address_space(1)))
typedef unsigned short bf16;
typedef short bf16x8 __attribute__((ext_vector_type(8)));
typedef short s16x4 __attribute__((ext_vector_type(4)));
typedef float f32x4 __attribute__((ext_vector_type(4)));
typedef float f32x2 __attribute__((ext_vector_type(2)));
typedef float f32x16 __attribute__((ext_vector_type(16)));
typedef unsigned u32x4 __attribute__((ext_vector_type(4)));
typedef unsigned u32x2 __attribute__((ext_vector_type(2)));

constexpr int D = 1024, NB = 16, SEQ = 2048, NCTX = 256, DEPTH = 4;
constexpr int RL = NB * SEQ;
constexpr int RC = NB * NCTX;
constexpr int RT = RL + RC;
constexpr int NIN = 2304;
constexpr int ZW = 2048;
constexpr int ZQ_RQ = 0, ZQ_RK = 128, ZQ_RV = 256, ZQ_RG = 512, ZQ_SU = 768, ZQ_DQ = 1024, ZQ_DK = 1280, ZQ_DV = 1536, ZQ_CV = 1792;
constexpr int FFD = 2816, FFE = 3584, NE = 8;
constexpr int MOE_ROWS = 2 * RT + NE * 256;
constexpr int NCH = 18;
constexpr float EPS = 1e-6f;

__device__ __forceinline__ unsigned f2bf(float f) { unsigned u = __builtin_bit_cast(unsigned, f); return (u + 0x7fffu + ((u >> 16) & 1u)) >> 16; }
__device__ __forceinline__ unsigned pk2(float lo, float hi) { return f2bf(lo) | (f2bf(hi) << 16); }
__device__ __forceinline__ float bf2f(unsigned short b) { return __builtin_bit_cast(float, ((unsigned)b) << 16); }
__device__ __forceinline__ float bflo(unsigned w) { return __builtin_bit_cast(float, w << 16); }
__device__ __forceinline__ float bfhi(unsigned w) { return __builtin_bit_cast(float, w & 0xffff0000u); }
__device__ __forceinline__ unsigned cvt_pk_bf16(float lo, float hi) { unsigned r; asm volatile("v_cvt_pk_bf16_f32 %0, %1, %2" : "=v"(r) : "v"(lo), "v"(hi)); return r; }
__device__ __forceinline__ float sigmoidf_(float x) { return __builtin_amdgcn_rcpf(1.0f + __builtin_amdgcn_exp2f(-1.44269504f * x)); }
__device__ __forceinline__ float siluf_(float x) { return x * sigmoidf_(x); }
__device__ __forceinline__ float wave_sum(float v) {
#pragma unroll
    for (int o = 1; o < 64; o <<= 1) v += __shfl_xor(v, o);
    return v;
}
__device__ __forceinline__ float opaque_f(float x) { asm volatile("" : "+v"(x)); return x; }
__device__ __forceinline__ float sigk(float x, float k) { return __builtin_amdgcn_rcpf(1.0f + __builtin_amdgcn_exp2f(k * x)); }
__device__ __forceinline__ float silk(float x, float k) { return x * sigk(x, k); }
__device__ __forceinline__ int opaque_v(int x) { asm volatile("" : "+v"(x)); return x; }
__device__ __forceinline__ int opaque_s(int x) { asm volatile("" : "+s"(x)); return x; }
#define LDS_WAIT() asm volatile("s_waitcnt lgkmcnt(0)" ::: "memory")
#define VM_WAIT() asm volatile("s_waitcnt vmcnt(0)" ::: "memory")
namespace pg8 {
constexpr int BM = 256, BK = 64, HALF = 128, HTB = HALF * BK * 2  , STAGE_BYTES = 8 * HTB, NXCD = 8, WGM = 8;

__host__ __device__ __forceinline__ int lds_byte(int r, int c) { const int st = (r >> 4) * 2 + (c >> 5), rr = r & 15, cc = c & 31, ob = rr * 64 + cc * 2; return st * 1024 + (ob ^ (((ob >> 9) & 1) << 5)); }
__host__ __device__ __forceinline__ void stage_rc(int b, int& R, int& C) { const int st = b / 1024, sb = b % 1024, swz = sb ^ (((sb >> 9) & 1) << 5); R = (st >> 1) * 16 + swz / 64; C = (st & 1) * 32 + (swz % 64) / 2; }
__host__ __device__ __forceinline__ int perm32(int rho) { const int n = rho >> 4, i = rho & 15; return 8 * (i >> 2) + 4 * n + (i & 3); }

struct Unit { int pm, pn, am, bn, z; };
struct Gemm { const void* A; const void* Bt; int K; int sa, sb; };
typedef int v8i_t __attribute__((ext_vector_type(8))); typedef int v4i_t __attribute__((ext_vector_type(4)));

__device__ __forceinline__ void decode_tile(int wgid, int nM, int nN, int& pm, int& pn) {
    const int nwg = nM * nN;
    { const int q = nwg / NXCD, r = nwg % NXCD, xcd = wgid % NXCD, off = wgid / NXCD; wgid = (xcd < r ? xcd * (q + 1) : r * (q + 1) + (xcd - r) * q) + off; }
    const int nig = WGM * nN, gid = wgid / nig, fm = gid * WGM, gsz = (nM - fm) < WGM ? (nM - fm) : WGM;
    pm = fm + ((wgid % nig) % gsz); pn = (wgid % nig) / gsz;
}
struct SchedStd {
    int nM, nN, G, c;
    __device__ __forceinline__ void init(int nM_, int nN_, int G_, int c_) { nM = nM_; nN = nN_; G = G_; c = c_; }
    __device__ __forceinline__ bool next(int i, Unit& u) const {
        const long L = (long)i * G + c; if (L >= (long)nM * nN) return false;
        decode_tile((int)L, nM, nN, u.pm, u.pn); u.am = u.pm; u.bn = u.pn; u.z = 0; return true;
    }
};
struct SchedWin {
    int G, c, mode;
    __device__ __forceinline__ void init(int G_, int c_, int mode_) { G = G_; c = c_; mode = mode_; }
    __device__ __forceinline__ bool next(int i, Unit& u) const {
        const int L = i * G + c; u.z = 0;
        if (mode == 1) { if (L >= 16) return false; u.pm = 128 + L; u.pn = 8; }
        else if (L < 1152) decode_tile(L, 128, 9, u.pm, u.pn);
        else if (mode == 0) { if (L >= 1280) return false; decode_tile(L - 1152, 16, 8, u.pm, u.pn); u.pm += 128; }
        else { if (L >= 1232) return false; int q; decode_tile(L - 1152, 16, 5, u.pm, q); u.pm += 128; u.pn = q < 2 ? q : (q == 2 ? 3 : q + 2); }
        u.am = u.pm; u.bn = u.pn; return true;
    }
};
struct SchedBr {
    int nM, G, c;
    __device__ __forceinline__ void init(int nM_, int G_, int c_) { nM = nM_; G = G_; c = c_; }
    __device__ __forceinline__ bool next(int i, Unit& u) const {
        const long L = (long)i * G + c; if (L >= (long)nM * 20) return false;
        int pm, pa; decode_tile((int)L, nM, 20, pm, pa);
        const int z = pa < 4 ? 0 : (pa < 12 ? 1 : (pa < 16 ? 2 : 3)), st = z == 0 ? 0 : (z == 1 ? 4 : (z == 2 ? 12 : 16));
        u.pm = pm; u.pn = pa - st; u.am = z * (RT / 256) + pm; u.bn = pa; u.z = z; return true;
    }
};
struct SchedGate {
    int nM, G, c;
    __device__ __forceinline__ void init(int nM_, int G_, int c_) { nM = nM_; G = G_; c = c_; }
    __device__ __forceinline__ bool next(int i, Unit& u) const {
        const long L = (long)(i >> 2) * G + c; if (L >= (long)nM * 4) return false;
        decode_tile((int)L, nM, 4, u.pm, u.pn); u.z = i & 3; u.am = u.pm; u.bn = u.z * 4 + u.pn; return true;
    }
};
struct SchedMoe {
    int nM, nN, G, c; const int* tile_e;
    __device__ __forceinline__ void init(int nM_, int nN_, int G_, int c_, const int* te) { nM = nM_; nN = nN_; G = G_; c = c_; tile_e = te; }
    __device__ __forceinline__ bool next(int i, Unit& u) const {
        const long L = (long)i * G + c; if (L >= (long)nM * nN) return false;
        decode_tile((int)L, nM, nN, u.pm, u.pn); u.am = u.pm; u.z = 0;
        const int e = __builtin_amdgcn_readfirstlane(__hip_atomic_load(tile_e + u.pm, __ATOMIC_RELAXED, __HIP_MEMORY_SCOPE_AGENT));
        u.bn = e * nN + u.pn; return true;
    }
};

#define EPI_ROWS(...) _Pragma("unroll") for (int ai = 0; ai < 2; ++ai) _Pragma("unroll") for (int m = 0; m < 4; ++m) { const int row = u.pm * BM + wr * 64 + fr + ai * HALF + m * 16; _Pragma("unroll") for (int bj = 0; bj < 2; ++bj) { const f32x4 v0 = acc[ai][bj][m][0], v1 = acc[ai][bj][m][1]; const int cb = 128 * bj + 32 * wc + 8 * fq; __VA_ARGS__ } }
typedef GAS u32x4* gq4; typedef GAS u32x2* gq2; typedef const GAS u32x4* cgq4; typedef const GAS f32x4* cgf4;

struct EpiF32 {
    static constexpr bool PERM = false;
    float* C; int ldc;
    __device__ __forceinline__ void operator()(const f32x4 (&acc)[2][2][4][2], const Unit& u, int wr, int wc, int fr, int fq) const {
        const int row0 = u.pm * BM + wr * 64 + fr, col0 = u.pn * BM + wc * 32 + 4 * fq;
#pragma unroll
        for (int ai = 0; ai < 2; ++ai)
#pragma unroll
            for (int m = 0; m < 4; ++m) { GAS float* rowp = (GAS float*)C + (size_t)(row0 + ai * HALF + m * 16) * ldc + col0;
#pragma unroll
                for (int bj = 0; bj < 2; ++bj)
#pragma unroll
                    for (int n = 0; n < 2; ++n) *(GAS f32x4*)(rowp + bj * HALF + n * 16) = acc[ai][bj][m][n]; }
    }
};
struct EpiBf16 {
    static constexpr bool PERM = true;
    bf16* O; int ldc;
    __device__ __forceinline__ void operator()(const f32x4 (&acc)[2][2][4][2], const Unit& u, int wr, int wc, int fr, int fq) const {
        EPI_ROWS({ u32x4 w; w.x = cvt_pk_bf16(v0[0], v0[1]); w.y = cvt_pk_bf16(v0[2], v0[3]); w.z = cvt_pk_bf16(v1[0], v1[1]); w.w = cvt_pk_bf16(v1[2], v1[3]);
                   *(gq4)((GAS bf16*)O + (size_t)row * ldc + u.pn * BM + cb) = w; })
    }
};
struct EpiSwiGLU {
    static constexpr bool PERM = true;
    bf16* O; int ldc;
    __device__ __forceinline__ void operator()(const f32x4 (&acc)[2][2][4][2], const Unit& u, int wr, int wc, int fr, int fq) const {
        const float kq = opaque_f(-1.44269504f);
        EPI_ROWS({ u32x2 w; w.x = cvt_pk_bf16(silk(v0[0], kq) * v0[1], silk(v0[2], kq) * v0[3]); w.y = cvt_pk_bf16(silk(v1[0], kq) * v1[1], silk(v1[2], kq) * v1[3]);
                   *(gq2)((GAS bf16*)O + (size_t)row * ldc + ((u.pn * BM + cb) >> 1)) = w; })
    }
};
struct EpiSwiGLU8 {
    static constexpr bool PERM = true;
    unsigned char* O; int ldc;
    __device__ __forceinline__ void operator()(const f32x4 (&acc)[2][2][4][2], const Unit& u, int wr, int wc, int fr, int fq) const {
        const float kq = opaque_f(-1.44269504f), k8 = opaque_f(8.0f);
        EPI_ROWS({ unsigned w = 0; w = __builtin_amdgcn_cvt_pk_fp8_f32(k8 * silk(v0[0], kq) * v0[1], k8 * silk(v0[2], kq) * v0[3], w, false); w = __builtin_amdgcn_cvt_pk_fp8_f32(k8 * silk(v1[0], kq) * v1[1], k8 * silk(v1[2], kq) * v1[3], w, true);
                   *(GAS unsigned*)((GAS unsigned char*)O + (size_t)row * ldc + ((u.pn * BM + cb) >> 1)) = w; })
    }
};
struct EpiWin {
    static constexpr bool PERM = true;
    bf16* Z; const float* rope;
    __device__ __forceinline__ void operator()(const f32x4 (&acc)[2][2][4][2], const Unit& u, int wr, int wc, int fr, int fq) const {
        const float kq = opaque_f(-1.44269504f);
        GAS bf16* Zg = (GAS bf16*)Z;
        if (u.pn >= 7) {
            EPI_ROWS({ u32x2 w; w.x = cvt_pk_bf16(v0[0] * sigk(v0[1], kq), v0[2] * sigk(v0[3], kq)); w.y = cvt_pk_bf16(v1[0] * sigk(v1[1], kq), v1[2] * sigk(v1[3], kq));
                       *(gq2)(Zg + (size_t)row * ZW + ZQ_CV + (u.pn - 7) * 128 + (cb >> 1)) = w; })
        } else if ((u.pn == 4 || u.pn == 5) && u.pm < RL / 256) {
#pragma unroll
            for (int ai = 0; ai < 2; ++ai) {
                f32x4 c0[4], c1[4];
#pragma unroll
                for (int m = 0; m < 4; ++m) { const int row = u.pm * BM + wr * 64 + fr + ai * HALF + m * 16; cgf4 rp = (cgf4)((const GAS float*)rope + (size_t)(row & (SEQ - 1)) * 32 + fq * 8); c0[m] = rp[0]; c1[m] = rp[1]; }
#pragma unroll
                for (int m = 0; m < 4; ++m) { const int row = u.pm * BM + wr * 64 + fr + ai * HALF + m * 16;
#pragma unroll
                    for (int bj = 0; bj < 2; ++bj) { const f32x4 v0 = acc[ai][bj][m][0], v1 = acc[ai][bj][m][1]; const int cb = 128 * bj + 32 * wc + 8 * fq; const f32x4 a = c0[m], b = c1[m];
                        u32x4 w; w.x = cvt_pk_bf16(v0[0] * a[0] - v0[1] * a[1], v0[1] * a[0] + v0[0] * a[1]); w.y = cvt_pk_bf16(v0[2] * a[2] - v0[3] * a[3], v0[3] * a[2] + v0[2] * a[3]);
                        w.z = cvt_pk_bf16(v1[0] * b[0] - v1[1] * b[1], v1[1] * b[0] + v1[0] * b[1]); w.w = cvt_pk_bf16(v1[2] * b[2] - v1[3] * b[3], v1[3] * b[2] + v1[2] * b[3]);
                        *(gq4)(Zg + (size_t)row * ZW + u.pn * BM + cb) = w; } }
            }
        } else {
            EPI_ROWS({ u32x4 w; w.x = cvt_pk_bf16(v0[0], v0[1]); w.y = cvt_pk_bf16(v0[2], v0[3]); w.z = cvt_pk_bf16(v1[0], v1[1]); w.w = cvt_pk_bf16(v1[2], v1[3]);
                       *(gq4)(Zg + (size_t)row * ZW + u.pn * BM + cb) = w; })
        }
    }
};
struct EpiBr {
    static constexpr bool PERM = true;
    bf16* BO;
    __device__ __forceinline__ void operator()(const f32x4 (&acc)[2][2][4][2], const Unit& u, int wr, int wc, int fr, int fq) const {
        const float kq = opaque_f(-1.44269504f);
        GAS unsigned char* base = (GAS unsigned char*)((GAS bf16*)BO + (size_t)u.z * RT * D) + (size_t)u.pm * (128 * 256 * 16) + (size_t)((wr * 64 + fr) * 16);
        if (u.z == 1) {
            GAS unsigned char* lp = base + (size_t)(16 * u.pn + 2 * wc + (fq >> 1)) * 4096 + (fq & 1) * 8;
#pragma unroll
            for (int ai = 0; ai < 2; ++ai)
#pragma unroll
                for (int m = 0; m < 4; ++m)
#pragma unroll
                    for (int bj = 0; bj < 2; ++bj) { const f32x4 v0 = acc[ai][bj][m][0], v1 = acc[ai][bj][m][1];
                        u32x2 w; w.x = cvt_pk_bf16(v0[0] * sigk(v0[1], kq), v0[2] * sigk(v0[3], kq)); w.y = cvt_pk_bf16(v1[0] * sigk(v1[1], kq), v1[2] * sigk(v1[3], kq));
                        *(gq2)(lp + bj * (8 * 4096) + (ai * 128 + m * 16) * 16) = w; }
        } else {
            GAS unsigned char* lp = base + (size_t)(32 * u.pn + 4 * wc + fq) * 4096;
#pragma unroll
            for (int ai = 0; ai < 2; ++ai)
#pragma unroll
                for (int m = 0; m < 4; ++m)
#pragma unroll
                    for (int bj = 0; bj < 2; ++bj) { const f32x4 v0 = acc[ai][bj][m][0], v1 = acc[ai][bj][m][1];
                        u32x4 w; w.x = cvt_pk_bf16(v0[0], v0[1]); w.y = cvt_pk_bf16(v0[2], v0[3]); w.z = cvt_pk_bf16(v1[0], v1[1]); w.w = cvt_pk_bf16(v1[2], v1[3]);
                        *(gq4)(lp + bj * (16 * 4096) + (ai * 128 + m * 16) * 16) = w; }
        }
    }
};
struct EpiGate {
    static constexpr bool PERM = true;
    const bf16* BO; bf16* MM; const float* bgate; LAS unsigned char* xl;
    __device__ __forceinline__ void operator()(const f32x4 (&acc)[2][2][4][2], const Unit& u, int wr, int wc, int fr, int fq) const {
        const float kq = opaque_f(-1.44269504f); fr = opaque_v(fr); fq = opaque_v(fq);
        const int oc = u.pn * 64 + 32 * (wc & 1) + 8 * fq, zlo = wc >> 1, lane = fr + 16 * fq;
        const GAS unsigned char* bo0 = (const GAS unsigned char*)((const GAS bf16*)BO + (size_t)zlo * RT * D) + ((size_t)u.pm * 128 + (oc >> 3)) * (256 * 16); const GAS unsigned char* bo1 = bo0 + (size_t)2 * RT * D * 2; GAS bf16* mm = (GAS bf16*)MM + oc;
        f32x4 bs[2][2];
#pragma unroll
        for (int bj = 0; bj < 2; ++bj) { const GAS float* bg = (const GAS float*)bgate + (2 * bj + zlo) * D + oc; bs[bj][0] = *(cgf4)bg; bs[bj][1] = *(cgf4)(bg + 4); }
        LAS u32x4* xs = (LAS u32x4*)xl + ((wr * 2 + (wc & 1)) * 4) * 64 + lane;
#pragma unroll
        for (int ai = 0; ai < 2; ++ai) {
            u32x4 bw[4][2];
#pragma unroll
            for (int m = 0; m < 4; ++m) { const size_t ro = (size_t)(wr * 64 + fr + ai * HALF + m * 16) * 16; bw[m][0] = *(cgq4)(bo0 + ro); bw[m][1] = *(cgq4)(bo1 + ro); }
            float r[4][8];
#pragma unroll
            for (int m = 0; m < 4; ++m) {
#pragma unroll
                for (int j = 0; j < 8; ++j) r[m][j] = 0.f;
#pragma unroll
                for (int bj = 0; bj < 2; ++bj) { const f32x4 v0 = acc[ai][bj][m][0] + bs[bj][0], v1 = acc[ai][bj][m][1] + bs[bj][1]; const u32x4 b = bw[m][bj];
                    r[m][0] += sigk(v0[0], kq) * bflo(b.x); r[m][1] += sigk(v0[1], kq) * bfhi(b.x); r[m][2] += sigk(v0[2], kq) * bflo(b.y); r[m][3] += sigk(v0[3], kq) * bfhi(b.y);
                    r[m][4] += sigk(v1[0], kq) * bflo(b.z); r[m][5] += sigk(v1[1], kq) * bfhi(b.z); r[m][6] += sigk(v1[2], kq) * bflo(b.w); r[m][7] += sigk(v1[3], kq) * bfhi(b.w); }
            }
            if (wc >= 2) {
#pragma unroll
                for (int m = 0; m < 4; ++m) { u32x4 w; w.x = cvt_pk_bf16(r[m][0], r[m][1]); w.y = cvt_pk_bf16(r[m][2], r[m][3]); w.z = cvt_pk_bf16(r[m][4], r[m][5]); w.w = cvt_pk_bf16(r[m][6], r[m][7]); xs[m * 64] = w; }
            }
            asm volatile("s_waitcnt lgkmcnt(0)" ::: "memory"); __builtin_amdgcn_s_barrier(); asm volatile("" ::: "memory");
            if (wc < 2) {
#pragma unroll
                for (int m = 0; m < 4; ++m) { const u32x4 q = xs[m * 64]; const size_t ro = (size_t)(u.pm * BM + wr * 64 + fr + ai * HALF + m * 16) * D;
                    u32x4 w; w.x = cvt_pk_bf16(r[m][0] + bflo(q.x), r[m][1] + bfhi(q.x)); w.y = cvt_pk_bf16(r[m][2] + bflo(q.y), r[m][3] + bfhi(q.y));
                    w.z = cvt_pk_bf16(r[m][4] + bflo(q.z), r[m][5] + bfhi(q.z)); w.w = cvt_pk_bf16(r[m][6] + bflo(q.w), r[m][7] + bfhi(q.w));
                    *(gq4)(mm + ro) = w; }
            }
            if (ai == 0) { asm volatile("s_waitcnt lgkmcnt(0)" ::: "memory"); __builtin_amdgcn_s_barrier(); asm volatile("" ::: "memory"); }
        }
    }
};

template <class Epi, class Sched, bool F8 = false>
__device__ __forceinline__ void gemm_phase(LAS unsigned char* lds, const Gemm g, const Sched& S, const Epi& E, int tid_in) {
    const int tid = opaque_v(tid_in), wid = __builtin_amdgcn_readfirstlane(tid >> 6), lane = tid & 63, wr = wid >> 2, wc = wid & 3, fr = lane & 15, fq = lane >> 4;
    const int K = opaque_s(g.K), rowb = F8 ? K : 2 * K, nt = rowb / 128;
    unsigned voffA[2], voffB[2];
#pragma unroll
    for (int i = 0; i < 2; ++i) { int R, C; stage_rc(tid * 16 + i * 8192, R, C); const int Rb = Epi::PERM ? ((R & ~31) + perm32(R & 31)) : R;
        voffA[i] = (unsigned)(R * rowb + C * 2); voffB[i] = (unsigned)(Rb * rowb + C * 2); }
    const size_t kstep = (size_t)(BK * 2);
    const size_t hstep = (size_t)HALF * rowb;
    const size_t tstep = 2 * hstep;
    const unsigned ldsw = (unsigned)wid * 1024u;
    const int aoff = lds_byte(wr * 64 + fr, fq * 8), boff = lds_byte(wc * 32 + fr, fq * 8);
#define PG8_SA(b, h) (((b) * 2 + (h)) * HTB)
#define PG8_SB(b, h) ((4 + (b) * 2 + (h)) * HTB)
#define PG8_STAGE(bufoff, gbase, voff) do { _Pragma("unroll") for (int _i = 0; _i < 2; ++_i) \
        __builtin_amdgcn_global_load_lds((const unsigned*)((const char*)(gbase) + (voff)[_i]), (LAS unsigned*)(lds + (bufoff) + ldsw + _i * 8192), 16, 0, 0); } while (0)
#define PG8_LD1(off) (*(const LAS v4i_t*)(lds + (off)))
#define PG8_LDA(dst, b, h) do { if constexpr (F8) { _Pragma("unroll") for (int m = 0; m < 4; ++m) dst##8[m] = __builtin_shufflevector(PG8_LD1(PG8_SA(b, h) + aoff + m * 2048), PG8_LD1(PG8_SA(b, h) + aoff + m * 2048 + 1024), 0, 1, 2, 3, 4, 5, 6, 7); } \
        else { _Pragma("unroll") for (int m = 0; m < 4; ++m) _Pragma("unroll") for (int k = 0; k < 2; ++k) dst[m][k] = *(const LAS bf16x8*)(lds + PG8_SA(b, h) + aoff + m * 2048 + k * 1024); } } while (0)
#define PG8_LDB(dst, b, h) do { if constexpr (F8) { _Pragma("unroll") for (int n = 0; n < 2; ++n) dst##8[n] = __builtin_shufflevector(PG8_LD1(PG8_SB(b, h) + boff + n * 2048), PG8_LD1(PG8_SB(b, h) + boff + n * 2048 + 1024), 0, 1, 2, 3, 4, 5, 6, 7); } \
        else { _Pragma("unroll") for (int n = 0; n < 2; ++n) _Pragma("unroll") for (int k = 0; k < 2; ++k) dst[n][k] = *(const LAS bf16x8*)(lds + PG8_SB(b, h) + boff + n * 2048 + k * 1024); } } while (0)
#define PG8_MMA(ai, bj, At, Bt) do { __builtin_amdgcn_s_setprio(1); _Pragma("unroll") for (int m = 0; m < 4; ++m) _Pragma("unroll") for (int n = 0; n < 2; ++n) { \
        if constexpr (F8) { asm volatile("v_mfma_scale_f32_16x16x128_f8f6f4 %0, %1, %2, %0, %3, %4 op_sel_hi:[0,0,0]" : "+v"(acc[ai][bj][m][n]) : "v"(Bt##8[n]), "v"(At##8[m]), "v"(sclB), "v"(sclA)); } \
        else { _Pragma("unroll") for (int k = 0; k < 2; ++k) acc[ai][bj][m][n] = __builtin_amdgcn_mfma_f32_16x16x32_bf16(Bt[n][k], At[m][k], acc[ai][bj][m][n], 0, 0, 0); } } \
        __builtin_amdgcn_s_setprio(0); } while (0)
#define PG8_WAIT_V(n) asm volatile("s_waitcnt vmcnt(" #n ")" ::: "memory")
#define PG8_WAIT_L(n) asm volatile("s_waitcnt lgkmcnt(" #n ")" ::: "memory")
#define PG8_BAR __builtin_amdgcn_s_barrier()
#define PG8_SCHED __builtin_amdgcn_sched_barrier(0)
    const int sclB = g.sa * 0x01010101, sclA = g.sb * 0x01010101;
    Unit cur, nxt; int ui = 0;
    if (!S.next(0, cur)) return;
#ifndef GEMM_STAGGER
#define GEMM_STAGGER 0
#endif
    if (GEMM_STAGGER) {
        const unsigned long long t0 = __builtin_amdgcn_s_memrealtime(); const unsigned long long dl = (unsigned long long)(((blockIdx.x >> 3) & 3) * ((K >> 6) * 29 + 350));
        while (__builtin_amdgcn_s_memrealtime() - t0 < dl) __builtin_amdgcn_s_sleep(16);
    }
    f32x4 acc[2][2][4][2];
#pragma unroll
    for (int a = 0; a < 2; ++a)
#pragma unroll
        for (int b = 0; b < 2; ++b)
#pragma unroll
            for (int m = 0; m < 4; ++m)
#pragma unroll
                for (int n = 0; n < 2; ++n) acc[a][b][m][n] = (f32x4){0.f, 0.f, 0.f, 0.f};
    bf16x8 At[4][2], B0[2][2], B1[2][2]; v8i_t At8[4], B08[2], B18[2];
    const char* cA = (const char*)g.A + (size_t)cur.am * tstep; const char* cB = (const char*)g.Bt + (size_t)cur.bn * tstep;
    PG8_STAGE(PG8_SB(0, 0), cB, voffB); PG8_STAGE(PG8_SB(0, 1), cB + hstep, voffB); PG8_STAGE(PG8_SA(0, 0), cA, voffA); PG8_STAGE(PG8_SA(0, 1), cA + hstep, voffA);
    if (wr == 1) PG8_BAR;
    PG8_WAIT_V(2); PG8_BAR;
    PG8_STAGE(PG8_SB(1, 0), cB + kstep, voffB); PG8_STAGE(PG8_SA(1, 0), cA + kstep, voffA); PG8_STAGE(PG8_SB(1, 1), cB + hstep + kstep, voffB);
    PG8_WAIT_V(6); PG8_BAR;
    for (;;) {
        const bool has_next = S.next(ui + 1, nxt);
        const char* nA = has_next ? (const char*)g.A + (size_t)nxt.am * tstep : cA; const char* nB = has_next ? (const char*)g.Bt + (size_t)nxt.bn * tstep : cB;
        for (int t = 0; t < nt; t += 2) {
            const bool last = (t == nt - 2);
            const char* a1 = cA + (size_t)(t + 1) * kstep;
            const char* a2 = last ? nA : cA + (size_t)(t + 2) * kstep; const char* b2 = last ? nB : cB + (size_t)(t + 2) * kstep;
            const char* a3 = a2 + kstep; const char* b3 = b2 + kstep;
            PG8_LDB(B0, 0, 0); PG8_LDB(B1, 0, 1); PG8_SCHED; PG8_LDA(At, 0, 0); PG8_STAGE(PG8_SA(1, 1), a1 + hstep, voffA);
            PG8_WAIT_V(8); PG8_WAIT_L(0); PG8_BAR; PG8_MMA(0, 0, At, B0); PG8_MMA(0, 1, At, B1); PG8_BAR; PG8_SCHED;
            PG8_LDA(At, 0, 1); PG8_STAGE(PG8_SB(0, 0), b2, voffB); PG8_STAGE(PG8_SB(0, 1), b2 + hstep, voffB); PG8_STAGE(PG8_SA(0, 0), a2, voffA);
            PG8_WAIT_V(8); PG8_WAIT_L(0); PG8_BAR; PG8_MMA(1, 0, At, B0); PG8_MMA(1, 1, At, B1); PG8_BAR; PG8_SCHED;
            PG8_LDB(B0, 1, 0); PG8_LDB(B1, 1, 1); PG8_SCHED; PG8_LDA(At, 1, 0); PG8_STAGE(PG8_SA(0, 1), a2 + hstep, voffA);
            PG8_WAIT_V(8); PG8_WAIT_L(0); PG8_BAR; PG8_MMA(0, 0, At, B0); PG8_MMA(0, 1, At, B1); PG8_BAR; PG8_SCHED;
            PG8_LDA(At, 1, 1); PG8_STAGE(PG8_SB(1, 0), b3, voffB); PG8_STAGE(PG8_SB(1, 1), b3 + hstep, voffB); PG8_STAGE(PG8_SA(1, 0), a3, voffA);
            PG8_WAIT_V(8); PG8_WAIT_L(0); PG8_BAR; PG8_MMA(1, 0, At, B0); PG8_MMA(1, 1, At, B1); PG8_BAR; PG8_SCHED;
        }
        if (wr == 0) PG8_BAR;
        if constexpr (F8) asm volatile("s_nop 15\n\ts_nop 15" ::: "memory");
        E(acc, cur, wr, wc, fr, fq);
        if (!has_next) break;
#pragma unroll
        for (int a = 0; a < 2; ++a)
#pragma unroll
            for (int b = 0; b < 2; ++b)
#pragma unroll
                for (int m = 0; m < 4; ++m)
#pragma unroll
                    for (int n = 0; n < 2; ++n) acc[a][b][m][n] = (f32x4){0.f, 0.f, 0.f, 0.f};
        cur = nxt; cA = nA; cB = nB; ++ui;
        if (wr == 1) PG8_BAR;
    }
    PG8_WAIT_V(0);
    PG8_BAR;
#undef PG8_SA
#undef PG8_SB
#undef PG8_STAGE
#undef PG8_LD1
#undef PG8_LDA
#undef PG8_LDB
#undef PG8_MMA
#undef PG8_WAIT_V
#undef PG8_WAIT_L
#undef PG8_BAR
#undef PG8_SCHED
}
}
constexpr size_t al256(size_t x) { return (x + 255) & ~(size_t)255; }
constexpr size_t WS_CTL = 0, CTL_ZERO_BYTES = 1u << 20;
constexpr size_t E_WIN = (size_t)NIN * D, E_WG = (size_t)4 * D * D, E_WBR = (size_t)5120 * 256, E_WOUT = (size_t)D * D;
constexpr size_t E_WGU = (size_t)2 * FFD * D, E_WD = (size_t)D * FFD, E_MGU = (size_t)2 * FFE * D, E_MWD = (size_t)D * FFE;
constexpr size_t WS_WIN = CTL_ZERO_BYTES;
constexpr size_t WS_WG = WS_WIN + 2 * DEPTH * E_WIN;
constexpr size_t WS_WBR = WS_WG + 2 * DEPTH * E_WG;
constexpr size_t WS_WOUT = WS_WBR + 2 * DEPTH * E_WBR;
constexpr size_t WS_WGU = WS_WOUT + 2 * DEPTH * E_WOUT;
constexpr size_t WS_WD = WS_WGU + 2 * 2 * E_WGU;
constexpr size_t WS_MGU = WS_WD + 2 * 2 * E_WD;
constexpr size_t WS_MWD = WS_MGU + 2 * 2 * NE * E_MGU;
constexpr size_t WS_WEND = WS_MWD + 2 * 2 * NE * E_MWD;
constexpr size_t WS_MODS = al256(WS_WEND);
constexpr size_t WS_ROPE = WS_MODS + al256((size_t)DEPTH * 17 * 6 * D * 4);
constexpr size_t S5P_ABAR = 0, S5P_A128 = 16384, S5P_BP = 32768, S5P_CH = S5P_BP + 2 * 16 * 128 * 16 * 2, S5P_BYTES = S5P_CH + 16 * 16 * 128 * 2;
constexpr size_t WS_S5P = WS_ROPE + (size_t)SEQ * 32 * 4;
constexpr size_t WS_LAYP = WS_S5P + DEPTH * S5P_BYTES;
constexpr size_t WS_RETSUM = al256(WS_LAYP + DEPTH * 64 * 4);
constexpr size_t WS_RETST = WS_RETSUM + (size_t)NB * NCH * 2 * 4 * 2048 * 4;
constexpr size_t WS_S5E = WS_RETST + (size_t)NB * NCH * 2 * 4 * 2048 * 2;
constexpr size_t WS_S5C = WS_S5E + (size_t)NB * NCH * 16 * 2 * 64 * 8;
constexpr size_t WS_REC = WS_S5C + (size_t)NB * NCH * 16 * 2 * 64 * 8;
constexpr size_t WS_HIST = WS_REC + (size_t)RT * 32;
constexpr size_t WS_TILEE = WS_HIST + 256 * 8 * 4;
constexpr size_t WS_H = al256(WS_TILEE + 512 * 4);
constexpr size_t WS_AF = WS_H + (size_t)RT * D * 4;
constexpr size_t WS_AF8 = WS_AF + (size_t)RT * D * 2;
constexpr size_t WS_RA = WS_AF8 + (size_t)RT * D;
constexpr size_t WS_Z = WS_RA;
constexpr size_t WS_XB = WS_Z + (size_t)RT * ZW * 2;
constexpr size_t WS_BO = WS_XB + (size_t)4 * RT * 256 * 2;
constexpr size_t WS_MM = WS_BO + (size_t)4 * RT * D * 2;
constexpr size_t WS_Y = WS_MM + (size_t)RT * D * 2;
constexpr size_t WS_RA_END = WS_Y + (size_t)RT * D * 4;
constexpr size_t WS_G = WS_RA;
constexpr size_t WS_FS = WS_RA;
constexpr size_t WS_GS = WS_FS + (size_t)MOE_ROWS * D * 2;
constexpr size_t WS_YS = WS_GS + (size_t)MOE_ROWS * FFE * 2;
constexpr size_t WS_RB_END = WS_YS + (size_t)MOE_ROWS * D * 2;
constexpr size_t WS_END = WS_RA_END > WS_RB_END ? WS_RA_END : WS_RB_END;
static_assert(WS_G + (size_t)RT * FFD * 2 <= WS_Y, "dense hidden must not reach Y");
constexpr int CW_DEP = 12288;
constexpr int CW_BAR = 4096;

constexpr int SCRATCH_BYTES = 153600;
constexpr int LDSCTL_OFF = SCRATCH_BYTES, MISC_OFF = LDSCTL_OFF + 320;
constexpr int LDS_BYTES = 155648;
constexpr int NWAVES = 8;

typedef GAS unsigned gu32;
#define RLX_AGENT __ATOMIC_RELAXED, __HIP_MEMORY_SCOPE_AGENT

#define XB_TMO      128
#define XB_XCNT(j)  (256  + 64 * (j))
#define XB_XSUB(j)  (1280 + 64 * (j))
#define XB_XGEN(j)  (2304 + 64 * (j))
#define XB_TOP      3328
#define XB_TOPGEN   3392
#define XCD_BAR_WORDS 3456
#define XB_SPIN_CAP (1u << 20)

__device__ __forceinline__ unsigned xb_ld(unsigned* p)              { return __hip_atomic_load(p, __ATOMIC_RELAXED, __HIP_MEMORY_SCOPE_AGENT); }
__device__ __forceinline__ unsigned xb_add(unsigned* p, unsigned v) { return __hip_atomic_fetch_add(p, v, __ATOMIC_RELAXED, __HIP_MEMORY_SCOPE_AGENT); }
__device__ __forceinline__ unsigned xb_xcc_id() { return (unsigned)__builtin_amdgcn_s_getreg((3 << 11) | 20) & 0xFu; }
#define XB_SPIN(cond, bar) do { unsigned _sp = 0; while (cond) { __builtin_amdgcn_s_sleep(1); \
    if ((++_sp & 255u) == 0u) { if (xb_ld(&(bar)[XB_TMO])) break; if (_sp > XB_SPIN_CAP) { atomicAdd(&(bar)[XB_TMO], 1u); break; } } } } while (0)

struct XcdBarrier {
    unsigned* bar; unsigned x;
    volatile LAS unsigned* st;
};
__device__ __forceinline__ XcdBarrier xcd_barrier_post(unsigned* bar, volatile LAS unsigned* st, int tid) {
    XcdBarrier b; b.bar = bar; b.x = xb_xcc_id(); b.st = st;
    if (tid == 0) (void)xb_add(&bar[XB_XCNT(b.x)], 1u);
    return b;
}
__device__ __forceinline__ void xcd_barrier_complete(unsigned* bar, unsigned x, unsigned& nloc, unsigned& nx) {
    const unsigned G = gridDim.x * gridDim.y * gridDim.z;
    unsigned sum, cnt, mine, sp = 0u;
    for (;;) {
        sum = 0u; cnt = 0u; mine = 0u;
#pragma unroll
        for (unsigned j = 0; j < 16; ++j) { const unsigned c = xb_ld(&bar[XB_XCNT(j)]); sum += c; cnt += (c > 0u) ? 1u : 0u; mine = (j == x) ? c : mine; }
        if (sum == G) break;
        __builtin_amdgcn_s_sleep(1);
        if ((++sp & 255u) == 0u) { if (xb_ld(&bar[XB_TMO])) break; if (sp > XB_SPIN_CAP) { atomicAdd(&bar[XB_TMO], 1u); break; } }
    }
    nloc = mine > 0u ? mine : 1u; nx = cnt > 0u ? cnt : 1u;
}
__device__ __forceinline__ void xcd_barrier(const XcdBarrier& b, int tid) {
    asm volatile("s_waitcnt vmcnt(0)" ::: "memory");
    __syncthreads();
    if (tid == 0) {
        unsigned* bar = b.bar;
        __builtin_amdgcn_s_waitcnt(0);
        unsigned nloc = b.st[0], nx = b.st[1];
        if (nloc == 0u) { xcd_barrier_complete(bar, b.x, nloc, nx); b.st[0] = nloc; b.st[1] = nx; }
        const unsigned old = xb_add(&bar[XB_XSUB(b.x)], 1u);
        const unsigned gen = old / nloc;
        if (old + 1u == (gen + 1u) * nloc) {
            __builtin_amdgcn_fence(__ATOMIC_RELEASE, "agent");
            asm volatile("s_waitcnt vmcnt(0)" ::: "memory");
            const unsigned og = xb_add(&bar[XB_TOP], 1u);
            const unsigned tg = og / nx;
            if (og + 1u == (tg + 1u) * nx) xb_add(&bar[XB_TOPGEN], 1u);
            else XB_SPIN(xb_ld(&bar[XB_TOPGEN]) == tg, bar);
            __builtin_amdgcn_fence(__ATOMIC_ACQUIRE, "agent");
            xb_add(&bar[XB_XGEN(b.x)], 1u);
            asm volatile("s_waitcnt vmcnt(0)" ::: "memory");
        } else {
            XB_SPIN(xb_ld(&bar[XB_XGEN(b.x)]) == gen, bar);
            __builtin_amdgcn_fence(__ATOMIC_ACQUIRE, "agent");
            asm volatile("s_waitcnt vmcnt(0)" ::: "memory");
        }
    }
    __syncthreads();
}

struct Frame {
    LAS unsigned char* lds;
    volatile LAS unsigned* MISC;
    int tid, lane, wave;
    int vcu, G;
    unsigned char* ws;
};

__device__ __forceinline__ void dep_signal(Frame& F, unsigned* ctr, unsigned n) {
    asm volatile("s_waitcnt vmcnt(0)" ::: "memory");
    __syncthreads();
    if (F.tid == 0) { __builtin_amdgcn_fence(__ATOMIC_RELEASE, "agent"); asm volatile("s_waitcnt vmcnt(0)" ::: "memory"); (void)xb_add(ctr, n); }
}
__device__ __forceinline__ void dep_wait(Frame& F, unsigned* ctr, unsigned target) {
    if (F.tid == 0) { unsigned sp = 0u; while (xb_ld(ctr) < target) { __builtin_amdgcn_s_sleep(2); if (++sp > (1u << 22)) break; }
        __builtin_amdgcn_fence(__ATOMIC_ACQUIRE, "agent"); asm volatile("s_waitcnt vmcnt(0)" ::: "memory"); }
    __syncthreads();
}
__device__ __forceinline__ int permqk(int c) { const int hm = c >> 5, d = c & 31, axis = d >> 4, half = (d >> 3) & 1, f = d & 7; return hm * 32 + axis * 16 + f * 2 + half; }
__device__ __forceinline__ int win_dest(int n, float& sc) {
    sc = 1.0f;
    if (n < 128) { sc = 0.17677669529663687f; return 128 + n; }
    if (n < 384) return 256 + (n - 128);
    if (n < 640) return 768 + (n - 384);
    if (n < 896) return 1280 + permqk(n - 640);
    if (n < 1152) return 1536 + (n - 896);
    if (n < 1280) return n - 1152;
    if (n < 1536) return 512 + (n - 1280);
    if (n < 1792) { sc = 0.17677669529663687f; return 1024 + permqk(n - 1536); }
    const int j = (n - 1792) & 255, half = (n - 1792) >> 8; return 1792 + 2 * j + half;
}
template <int MODE, bool OUT8 = false>
__device__ __forceinline__ void transpose_item(const float* __restrict__ W, int K, int N, bf16* WT, int row_off, LAS float* scr, int item, int lane) {
    const int nblk = N / 32, kb = item / nblk, nb = item % nblk, k0 = 64 * kb, n0 = 32 * nb;
    float wreg[32];
#pragma unroll
    for (int i = 0; i < 32; ++i) { const int kk = 2 * i + (lane >> 5); wreg[i] = __builtin_nontemporal_load(W + (size_t)(k0 + kk) * N + n0 + (lane & 31)); }
#pragma unroll
    for (int i = 0; i < 32; ++i) { const int kk = 2 * i + (lane >> 5); scr[kk * 33 + (lane & 31)] = wreg[i]; }
    LDS_WAIT(); asm volatile("" ::: "memory");
    const int c = lane & 7;
#pragma unroll
    for (int j = 0; j < 4; ++j) { const int n = (lane >> 3) + 8 * j; const LAS float* s = scr + (8 * c) * 33 + n;
        int dr; float sc = 1.0f; const int ng = n0 + n;
        if (MODE == 0) dr = row_off + ng; else if (MODE == 3) dr = ((ng >> 6) << 8) + row_off + (ng & 63); else if (MODE == 1) { const int Hh = N >> 1; dr = row_off + 2 * (ng % Hh) + ng / Hh; } else dr = win_dest(ng, sc);
        if (OUT8) { unsigned w0 = 0, w1 = 0;
            w0 = __builtin_amdgcn_cvt_pk_fp8_f32(64.f * s[0 * 33], 64.f * s[1 * 33], w0, false); w0 = __builtin_amdgcn_cvt_pk_fp8_f32(64.f * s[2 * 33], 64.f * s[3 * 33], w0, true);
            w1 = __builtin_amdgcn_cvt_pk_fp8_f32(64.f * s[4 * 33], 64.f * s[5 * 33], w1, false); w1 = __builtin_amdgcn_cvt_pk_fp8_f32(64.f * s[6 * 33], 64.f * s[7 * 33], w1, true);
            *(u32x2*)((unsigned char*)WT + (size_t)dr * K + k0 + 8 * c) = (u32x2){w0, w1}; }
        else { u32x4 o; o.x = pk2(s[0 * 33] * sc, s[1 * 33] * sc); o.y = pk2(s[2 * 33] * sc, s[3 * 33] * sc); o.z = pk2(s[4 * 33] * sc, s[5 * 33] * sc); o.w = pk2(s[6 * 33] * sc, s[7 * 33] * sc);
        *(u32x4*)(WT + (size_t)dr * K + k0 + 8 * c) = o; } }
    LDS_WAIT(); asm volatile("" ::: "memory");
}
__device__ __forceinline__ void sincos_d(double x, double& s, double& c) {
    const double tp = 6.283185307179586476925287; x -= tp * rint(x / tp);
    const double x2 = x * x; double cs = 1.0, sn = 1.0;
    double tc = 1.0, ts = 1.0; cs = 1.0; sn = 1.0;
#pragma unroll
    for (int k = 1; k <= 17; ++k) { tc *= -x2 / (double)((2 * k - 1) * (2 * k)); ts *= -x2 / (double)((2 * k) * (2 * k + 1)); cs += tc; sn += ts; }
    s = sn * x; c = cs;
}

struct P0Args {
    const float *c, *c_ctx, *ada_w, *ada_b, *w_in, *w_gate, *ret_w_o, *s5_w_glu, *diff_w_o, *conv_w_o, *w_out, *ffn_w_gu, *ffn_w_d, *moe_w_gu, *moe_w_d;
    int f8mask;
    const float *ret_decay, *s5_a_re, *s5_a_im, *s5_log_dt, *s5_b_re, *s5_b_im, *s5_c_re, *s5_c_im, *diff_lambda;
};
__device__ __forceinline__ void p0_prologue(Frame& F, const P0Args& P) {
    unsigned char* ws = F.ws;
    {
        LAS float* scr = (LAS float*)(F.lds + F.wave * 8448);
        const int gw = F.vcu * NWAVES + F.wave, NGW = F.G * NWAVES;
        constexpr int I_WIN = 16 * (NIN / 32), I_WG = 16 * 32, I_BR1 = 4 * 32, I_BR2 = 4 * 64, I_WOUT = 16 * 32;
        constexpr int I_LAYER = I_WIN + 4 * I_WG + I_BR1 + I_BR2 + I_BR1 + I_BR1 + I_WOUT;
        constexpr int I_GU = 16 * (2 * FFD / 32), I_DD = (FFD / 64) * 32, I_DENSE = I_GU + I_DD;
        constexpr int I_MGU = 16 * (2 * FFE / 32), I_MD = (FFE / 64) * 32, I_EXP = I_MGU + I_MD;
        constexpr int NITEMS = DEPTH * I_LAYER + 2 * I_DENSE + 2 * NE * I_EXP;
        for (int it = gw; it < NITEMS; it += NGW) {
            int r = it;
            if (r < DEPTH * I_LAYER) {
                const int l = r / I_LAYER; r -= l * I_LAYER;
                if (r < I_WIN) { transpose_item<2>(P.w_in + (size_t)l * D * NIN, D, NIN, (bf16*)(ws + WS_WIN) + (size_t)l * E_WIN, 0, scr, r, F.lane); continue; } r -= I_WIN;
                if (r < 4 * I_WG) { const int z = r / I_WG; transpose_item<3, true>(P.w_gate + ((size_t)l * 4 + z) * D * D, D, D, (bf16*)(ws + WS_WG) + (size_t)l * E_WG, z * 64, scr, r % I_WG, F.lane); continue; } r -= 4 * I_WG;
                bf16* wbr = (bf16*)(ws + WS_WBR) + (size_t)l * E_WBR;
                if (r < I_BR1) { transpose_item<0>(P.ret_w_o + (size_t)l * 256 * D, 256, D, wbr, 0, scr, r, F.lane); continue; } r -= I_BR1;
                if (r < I_BR2) { transpose_item<1>(P.s5_w_glu + (size_t)l * 256 * 2 * D, 256, 2 * D, wbr, 1024, scr, r, F.lane); continue; } r -= I_BR2;
                if (r < I_BR1) { transpose_item<0>(P.diff_w_o + (size_t)l * 256 * D, 256, D, wbr, 3072, scr, r, F.lane); continue; } r -= I_BR1;
                if (r < I_BR1) { transpose_item<0>(P.conv_w_o + (size_t)l * 256 * D, 256, D, wbr, 4096, scr, r, F.lane); continue; } r -= I_BR1;
                transpose_item<0>(P.w_out + (size_t)l * D * D, D, D, (bf16*)(ws + WS_WOUT) + (size_t)l * E_WOUT, 0, scr, r, F.lane); continue;
            }
            r -= DEPTH * I_LAYER;
            if (r < 2 * I_DENSE) {
                const int j = r / I_DENSE; r -= j * I_DENSE;
                const bool f8 = (P.f8mask >> (2 * j)) & 1; bf16* wgu = (bf16*)(ws + WS_WGU + (size_t)j * E_WGU * 2); bf16* wd = (bf16*)(ws + WS_WD + (size_t)j * E_WD * 2);
                if (r < I_GU) { if (f8) transpose_item<1, true>(P.ffn_w_gu + (size_t)j * D * 2 * FFD, D, 2 * FFD, wgu, 0, scr, r, F.lane); else transpose_item<1, false>(P.ffn_w_gu + (size_t)j * D * 2 * FFD, D, 2 * FFD, wgu, 0, scr, r, F.lane); continue; } r -= I_GU;
                if (f8) transpose_item<0, true>(P.ffn_w_d + (size_t)j * FFD * D, FFD, D, wd, 0, scr, r, F.lane); else transpose_item<0, false>(P.ffn_w_d + (size_t)j * FFD * D, FFD, D, wd, 0, scr, r, F.lane); continue;
            }
            r -= 2 * I_DENSE;
            { const int je = r / I_EXP; r -= je * I_EXP;
              const int jj = je >> 3, ee = je & 7; const bool f8 = (P.f8mask >> (2 * jj + 1)) & 1; const size_t esz = f8 ? 1 : 2;
              bf16* wgu = (bf16*)(ws + WS_MGU + (size_t)jj * NE * E_MGU * 2 + (size_t)ee * E_MGU * esz); bf16* wd = (bf16*)(ws + WS_MWD + (size_t)jj * NE * E_MWD * 2 + (size_t)ee * E_MWD * esz);
              if (r < I_MGU) { if (f8) transpose_item<1, true>(P.moe_w_gu + (size_t)je * D * 2 * FFE, D, 2 * FFE, wgu, 0, scr, r, F.lane); else transpose_item<1, false>(P.moe_w_gu + (size_t)je * D * 2 * FFE, D, 2 * FFE, wgu, 0, scr, r, F.lane); continue; } r -= I_MGU;
              if (f8) transpose_item<0, true>(P.moe_w_d + (size_t)je * FFE * D, FFE, D, wd, 0, scr, r, F.lane); else transpose_item<0, false>(P.moe_w_d + (size_t)je * FFE * D, FFE, D, wd, 0, scr, r, F.lane); }
        }
    }
    __syncthreads();
    {
        LAS float* sc = (LAS float*)F.lds;
        LAS float* part = (LAS float*)(F.lds + 17 * 1024 * 4);
        for (int i = F.tid; i < 17 * D; i += 512) { const int r = i >> 10, k = i & 1023; const float v = r < 16 ? P.c[r * D + k] : P.c_ctx[k]; sc[i] = v / (1.0f + __expf(-v)); }
        __syncthreads();
        float* mods = (float*)(ws + WS_MODS);
        for (int u = F.vcu; u < DEPTH * 96; u += F.G) {
            const int l = u / 96, n0 = (u % 96) * 64;
            const float* w = P.ada_w + (size_t)l * D * 6 * D + n0 + F.lane;
            float acc[17];
#pragma unroll
            for (int r = 0; r < 17; ++r) acc[r] = 0.f;
            const int kb = F.wave * 128;
#pragma unroll 2
            for (int k4 = 0; k4 < 128; k4 += 4) {
                float wv[4];
#pragma unroll
                for (int j = 0; j < 4; ++j) wv[j] = w[(size_t)(kb + k4 + j) * 6 * D];
#pragma unroll
                for (int r = 0; r < 17; ++r) { const f32x4 s = *(const LAS f32x4*)(sc + r * 1024 + kb + k4); acc[r] += wv[0] * s[0] + wv[1] * s[1] + wv[2] * s[2] + wv[3] * s[3]; }
            }
#pragma unroll
            for (int r = 0; r < 17; ++r) part[(F.wave * 17 + r) * 64 + F.lane] = acc[r];
            __syncthreads();
            for (int i = F.tid; i < 17 * 64; i += 512) { float s = 0.f;
#pragma unroll
                for (int w8 = 0; w8 < 8; ++w8) s += part[w8 * 17 * 64 + i];
                const int r = i >> 6, n = n0 + (i & 63); mods[((size_t)l * 17 + r) * 6 * D + n] = s + P.ada_b[(size_t)l * 6 * D + n]; }
            __syncthreads();
        }
    }
    {
        const int gt = F.vcu * 512 + F.tid, NGT = F.G * 512;
        float* rope = (float*)(ws + WS_ROPE);
        for (int i = gt; i < SEQ * 16; i += NGT) { const int t = i >> 4, pi = i & 15, axis = pi >> 3, f = pi & 7;
            const float inv = exp2f(-(float)f * (13.287712379549449f / 8.0f));
            const float ang = (float)(axis ? (t & 63) : (t >> 6)) * inv; float s, c; sincosf(ang, &s, &c); rope[2 * i] = c; rope[2 * i + 1] = s; }
        for (int i = gt; i < DEPTH * 2048; i += NGT) {
            const int l = i >> 11, d = (i >> 10) & 1, g = (i >> 6) & 15, p = i & 63;
            unsigned char* sp = ws + WS_S5P + (size_t)l * S5P_BYTES;
            const float are = fminf(P.s5_a_re[i], -1e-4f), aim = P.s5_a_im[i];
            const float dt = expf(P.s5_log_dt[(l * 2 + d) * 16 + g]);
            const float zre = dt * are; const double zim = (double)dt * (double)aim;
            double sn, cs; sincos_d(zim, sn, cs);
            const float mag = expf(zre), abre = mag * (float)cs, abim = mag * (float)sn;
            double sn2, cs2; sincos_d(128.0 * zim, sn2, cs2); const float mag2 = expf(128.0f * zre);
            ((f32x2*)(sp + S5P_ABAR))[i & 2047] = (f32x2){abre, abim};
            ((f32x2*)(sp + S5P_A128))[i & 2047] = (f32x2){mag2 * (float)cs2, mag2 * (float)sn2};
            const float den = are * are + aim * aim, nre = abre - 1.0f;
            const float cfre = (nre * are + abim * aim) / den, cfim = (abim * are - nre * aim) / den;
            const float* bre = P.s5_b_re + (((size_t)l * 16 + g) * 64 + p) * 16; const float* bim = P.s5_b_im + (((size_t)l * 16 + g) * 64 + p) * 16;
            bf16* bp = (bf16*)(sp + S5P_BP) + (((size_t)d * 16 + g) * 128 + 2 * p) * 16;
#pragma unroll
            for (int c = 0; c < 16; ++c) { const float br = bre[c], bi = bim[c]; bp[c] = (bf16)f2bf(cfre * br - cfim * bi); bp[16 + c] = (bf16)f2bf(cfre * bi + cfim * br); }
            if (d == 0) { bf16* ch = (bf16*)(sp + S5P_CH) + (size_t)g * 16 * 128;
#pragma unroll
                for (int c = 0; c < 16; ++c) { const size_t ci = (((size_t)l * 16 + g) * 16 + c) * 64 + p; ch[c * 128 + 2 * p] = (bf16)f2bf(P.s5_c_re[ci]); ch[c * 128 + 2 * p + 1] = (bf16)f2bf(-P.s5_c_im[ci]); } }
        }
        if (gt < DEPTH) { const int l = gt; float* lp = (float*)(ws + WS_LAYP) + l * 64;
            for (int j = 0; j < 8; ++j) { const float x = P.ret_decay[l * 8 + j]; lp[j] = -log2f(1.0f + expf(-x)); }
            const float* dl = P.diff_lambda + l * 128; float d01 = 0.f, d23 = 0.f;
            for (int j = 0; j < 32; ++j) { d01 += dl[j] * dl[32 + j]; d23 += dl[64 + j] * dl[96 + j]; }
            const float li = 0.8f - 0.6f * expf(-0.3f * (float)l);
            lp[8] = expf(d01) - expf(d23) + li; lp[9] = 1.0f - li; }
    }
}
struct RowArgs {
    const float *x, *ctx;
    const float *post_g;
    const float *pre_g;
    const float *router_w, *router_b;
    float* out;
    int l, nrows, moe, last, f8, dry;
};
template <int MODE>
__device__ __forceinline__ void row_pass(Frame& F, const RowArgs& A) {
    unsigned char* ws = F.ws;
    float* H = (float*)(ws + WS_H); bf16* AF = (bf16*)(ws + WS_AF); const float* Y = (const float*)(ws + WS_Y);
    float* Hst = A.dry ? (float*)(ws + WS_END) : H; if (A.dry) AF = (bf16*)(ws + WS_END + (size_t)RT * D * 2);
    const float* mods = (const float*)(ws + WS_MODS);
    const int gw = F.vcu * NWAVES + F.wave, NGW = F.G * NWAVES, lane = opaque_v(F.lane);
    volatile LAS unsigned* cnt = F.MISC + 16;
    if (MODE == 1 && A.moe) { if (F.tid < 8) cnt[F.tid] = 0u; __syncthreads(); }
    const int lg = A.l, lm = (MODE == 2) ? A.l + 1 : A.l;
    const int goff = (MODE == 1) ? 2 * D : 5 * D, shoff = (MODE == 1) ? 3 * D : 0, scoff = (MODE == 1) ? 4 * D : D;
    LAS float* rwL = (LAS float*)F.lds;
    if (MODE == 1 && A.moe) {
        for (int i = F.tid; i < D * NE; i += 512) rwL[(i & 7) * D + (i >> 3)] = A.router_w[i];
        __syncthreads();
    }
    const bool wr_af = !(MODE == 2 && A.last);
    f32x4 pg[4], pg2[4];
#pragma unroll
    for (int j = 0; j < 4; ++j) { const int c = 4 * lane + 256 * j; pg[j] = (MODE != 0) ? *(const GAS f32x4*)((const GAS float*)A.post_g + c) : (f32x4){0.f, 0.f, 0.f, 0.f}; pg2[j] = wr_af ? *(const GAS f32x4*)((const GAS float*)A.pre_g + c) : (f32x4){0.f, 0.f, 0.f, 0.f}; }
    struct Raw { u32x2 ya[4], yb[4], hw[4]; f32x4 gv[4], sh[4], sc[4], x[4]; };
    Raw cur, nx;
    u32x4 recn = (u32x4){0u, 0u, 0u, 0u}; u32x2 posn = (u32x2){0u, 0u};
    u32x4 recc = recn, recx = recn; u32x2 posc = posn, posx = posn;
#define ROW_REC(R4, P2, rw) do { if (false) { const GAS int* rec_ = (const GAS int*)(ws + WS_REC) + (size_t)(rw) * 8; R4 = (u32x4){0u, 0u, (unsigned)rec_[2], (unsigned)rec_[3]}; P2 = (u32x2){(unsigned)rec_[6], (unsigned)rec_[7]}; } } while (0)
#define ROW_LOAD(R, rw, R4, P2) do { const int br_ = (rw) < RL ? ((rw) >> 11) : 16; \
        if (wr_af) { const GAS float* mrow_ = (const GAS float*)mods + ((size_t)lm * 17 + br_) * 6 * D; _Pragma("unroll") for (int j = 0; j < 4; ++j) { const int c = 4 * lane + 256 * j; R.sh[j] = *(const GAS f32x4*)(mrow_ + shoff + c); R.sc[j] = *(const GAS f32x4*)(mrow_ + scoff + c); } } \
        if (MODE == 0) { const GAS float* src_ = (rw) < RL ? (const GAS float*)A.x + (size_t)(rw) * D : (const GAS float*)A.ctx + (size_t)((rw) - RL) * D; _Pragma("unroll") for (int j = 0; j < 4; ++j) R.x[j] = *(const GAS f32x4*)(src_ + 4 * lane + 256 * j); } \
        else { const GAS float* gate_ = (const GAS float*)mods + ((size_t)lg * 17 + br_) * 6 * D + goff; \
            _Pragma("unroll") for (int j = 0; j < 4; ++j) { const int c = 4 * lane + 256 * j; R.hw[j] = *(const GAS u32x2*)((const GAS bf16*)H + (size_t)(rw) * D + c); R.gv[j] = *(const GAS f32x4*)(gate_ + c); } \
            if (MODE == 2 && A.moe) { } else if (false) { const GAS bf16* ys_ = (const GAS bf16*)(ws + WS_YS); const size_t p0_ = (size_t)P2.x, p1_ = (size_t)P2.y; \
                _Pragma("unroll") for (int j = 0; j < 4; ++j) { R.ya[j] = *(const GAS u32x2*)(ys_ + p0_ * D + 4 * lane + 256 * j); R.yb[j] = *(const GAS u32x2*)(ys_ + p1_ * D + 4 * lane + 256 * j); } } \
            else { _Pragma("unroll") for (int j = 0; j < 4; ++j) R.ya[j] = *(const GAS u32x2*)((const GAS bf16*)Y + (size_t)(rw) * D + 4 * lane + 256 * j); } } } while (0)
    if (gw < A.nrows) { ROW_REC(recc, posc, gw); if (gw + NGW < A.nrows) ROW_REC(recx, posx, gw + NGW); ROW_LOAD(cur, gw, recc, posc); }
    for (int row = gw; row < A.nrows; row += NGW) {
        const int nrow = row + NGW;
        if (nrow + NGW < A.nrows) ROW_REC(recn, posn, nrow + NGW);
        if (nrow < A.nrows) ROW_LOAD(nx, nrow, recx, posx);
        f32x4 h[4]; f32x4 sh[4], sc[4];
#pragma unroll
        for (int j = 0; j < 4; ++j) { sh[j] = cur.sh[j]; sc[j] = cur.sc[j]; }
        if (MODE == 0) {
#pragma unroll
            for (int j = 0; j < 4; ++j) h[j] = cur.x[j];
        } else {
            f32x4 y[4]; float ss = 0.f;
            if (MODE == 2 && A.moe) { const GAS int* rec = (const GAS int*)(ws + WS_REC) + (size_t)row * 8;
                const int p0 = rec[6], p1 = rec[7]; const float w0 = __builtin_bit_cast(float, rec[2]), w1 = __builtin_bit_cast(float, rec[3]);
                const GAS bf16* ys = (const GAS bf16*)(ws + WS_YS);
#pragma unroll
                for (int j = 0; j < 4; ++j) { const u32x2 a = *(const GAS u32x2*)(ys + (size_t)p0 * D + 4 * lane + 256 * j), b = *(const GAS u32x2*)(ys + (size_t)p1 * D + 4 * lane + 256 * j);
                    y[j] = (f32x4){w0 * bflo(a.x) + w1 * bflo(b.x), w0 * bfhi(a.x) + w1 * bfhi(b.x), w0 * bflo(a.y) + w1 * bflo(b.y), w0 * bfhi(a.y) + w1 * bfhi(b.y)}; }
            } else {
#pragma unroll
                for (int j = 0; j < 4; ++j) { const u32x2 a = cur.ya[j]; y[j] = (f32x4){bflo(a.x), bfhi(a.x), bflo(a.y), bfhi(a.y)}; }
            }
#pragma unroll
            for (int j = 0; j < 4; ++j) ss += (y[j][0] * y[j][0] + y[j][1] * y[j][1]) + (y[j][2] * y[j][2] + y[j][3] * y[j][3]);
            const float rstd = 1.0f / sqrtf(wave_sum(ss) * (1.0f / D) + EPS);
#pragma unroll
            for (int j = 0; j < 4; ++j) { const u32x2 hw = cur.hw[j]; const f32x4 hv = (f32x4){bflo(hw.x), bfhi(hw.x), bflo(hw.y), bfhi(hw.y)}; h[j] = hv + cur.gv[j] * (y[j] * rstd * pg[j]); }
        }
        cur = nx; recc = recx; posc = posx; recx = recn; posx = posn;
        if (!wr_af) {
#pragma unroll
            for (int j = 0; j < 4; ++j) if (!A.dry) *(GAS f32x4*)((GAS float*)A.out + (size_t)row * D + 4 * lane + 256 * j) = h[j];
            continue;
        }
#pragma unroll
        for (int j = 0; j < 4; ++j) { u32x2 hw; hw.x = pk2(h[j][0], h[j][1]); hw.y = pk2(h[j][2], h[j][3]); *(GAS u32x2*)((GAS bf16*)Hst + (size_t)row * D + 4 * lane + 256 * j) = hw; }
        float s2 = 0.f;
#pragma unroll
        for (int j = 0; j < 4; ++j) s2 += (h[j][0] * h[j][0] + h[j][1] * h[j][1]) + (h[j][2] * h[j][2] + h[j][3] * h[j][3]);
        const float rs2 = 1.0f / sqrtf(wave_sum(s2) * (1.0f / D) + EPS);
        f32x4 f[4];
#pragma unroll
        for (int j = 0; j < 4; ++j) { const int c = 4 * lane + 256 * j;
            f[j] = (h[j] * rs2 * pg2[j]) * (1.0f + sc[j]) + sh[j];
            if (MODE == 1 && A.f8) { unsigned w = 0; w = __builtin_amdgcn_cvt_pk_fp8_f32(4.f * f[j][0], 4.f * f[j][1], w, false); w = __builtin_amdgcn_cvt_pk_fp8_f32(4.f * f[j][2], 4.f * f[j][3], w, true);
                *(GAS unsigned*)((GAS unsigned char*)AF + (size_t)row * D + c) = w; }
            else { u32x2 w; w.x = pk2(f[j][0], f[j][1]); w.y = pk2(f[j][2], f[j][3]); *(GAS u32x2*)((GAS bf16*)AF + (size_t)row * D + c) = w;
                if (MODE != 1) { unsigned w8 = 0; w8 = __builtin_amdgcn_cvt_pk_fp8_f32(4.f * f[j][0], 4.f * f[j][1], w8, false); w8 = __builtin_amdgcn_cvt_pk_fp8_f32(4.f * f[j][2], 4.f * f[j][3], w8, true);
                    *(GAS unsigned*)((GAS unsigned char*)(ws + (A.dry ? WS_END + (size_t)RT * D * 4 : WS_AF8)) + (size_t)row * D + c) = w8; } } }
        if (MODE == 1 && A.moe) {
            float pl[8];
#pragma unroll
            for (int e = 0; e < 8; ++e) pl[e] = 0.f;
#pragma unroll
            for (int j = 0; j < 4; ++j)
#pragma unroll
                for (int e = 0; e < 8; ++e) { const f32x4 w4 = *(const LAS f32x4*)(rwL + e * D + 4 * lane + 256 * j); pl[e] += (f[j][0] * w4[0] + f[j][1] * w4[1]) + (f[j][2] * w4[2] + f[j][3] * w4[3]); }
            float a4[4], a2[2], a1;
            { const bool hi = (lane & 32) != 0;
#pragma unroll
              for (int k = 0; k < 4; ++k) { const float mine = hi ? pl[4 + k] : pl[k], theirs = hi ? pl[k] : pl[4 + k]; a4[k] = mine + __shfl_xor(theirs, 32); } }
            { const bool hi = (lane & 16) != 0;
#pragma unroll
              for (int k = 0; k < 2; ++k) { const float mine = hi ? a4[2 + k] : a4[k], theirs = hi ? a4[k] : a4[2 + k]; a2[k] = mine + __shfl_xor(theirs, 16); } }
            { const bool hi = (lane & 8) != 0; const float mine = hi ? a2[1] : a2[0], theirs = hi ? a2[0] : a2[1]; a1 = mine + __shfl_xor(theirs, 8); }
            a1 += __shfl_xor(a1, 4); a1 += __shfl_xor(a1, 2); a1 += __shfl_xor(a1, 1);
            float lg8[8];
#pragma unroll
            for (int e = 0; e < 8; ++e) lg8[e] = __builtin_bit_cast(float, __builtin_amdgcn_readlane(__builtin_bit_cast(int, a1), 8 * e)) + A.router_b[e];
            int e0 = 0; float v0 = lg8[0];
#pragma unroll
            for (int e = 1; e < 8; ++e) if (lg8[e] > v0) { v0 = lg8[e]; e0 = e; }
            int e1 = -1; float v1 = -3.0e38f;
#pragma unroll
            for (int e = 0; e < 8; ++e) if (e != e0 && lg8[e] > v1) { v1 = lg8[e]; e1 = e; }
            const float w0 = 1.0f / (1.0f + __expf(v1 - v0)), w1 = 1.0f - w0;
            if (lane == 0) {
                const unsigned r0 = __hip_atomic_fetch_add((LAS unsigned*)(cnt + e0), 1u, __ATOMIC_RELAXED, __HIP_MEMORY_SCOPE_WORKGROUP);
                const unsigned r1 = __hip_atomic_fetch_add((LAS unsigned*)(cnt + e1), 1u, __ATOMIC_RELAXED, __HIP_MEMORY_SCOPE_WORKGROUP);
                int* rec = (int*)(ws + (A.dry ? WS_END + (size_t)RT * D * 5 : WS_REC)) + (size_t)row * 8;
                rec[0] = e0; rec[1] = e1; rec[2] = __builtin_bit_cast(int, w0); rec[3] = __builtin_bit_cast(int, w1); rec[4] = (int)r0; rec[5] = (int)r1;
            }
        }
    }
#undef ROW_REC
#undef ROW_LOAD
    if (MODE == 1 && A.moe) { __syncthreads(); if (F.tid < 8 && !A.dry) ((int*)(ws + WS_HIST))[blockIdx.x * 8 + F.tid] = (int)cnt[F.tid]; }
}

__device__ __forceinline__ void moe_dispatch(Frame& F, int nrows, int f8) {
    unsigned char* ws = F.ws;
    volatile LAS int* sh = (volatile LAS int*)F.lds;
    const int* hist = (const int*)(ws + WS_HIST);
    if (F.tid < 16) sh[F.tid] = 0;
    __syncthreads();
    { const int e = F.tid & 7; int tot = 0, pre = 0;
      int v[4];
#pragma unroll
      for (int q = 0; q < 4; ++q) { const int b = (F.tid >> 3) + 64 * q; v[q] = b < (int)gridDim.x ? __hip_atomic_load(hist + b * 8 + e, __ATOMIC_RELAXED, __HIP_MEMORY_SCOPE_AGENT) : 0; }
#pragma unroll
      for (int q = 0; q < 4; ++q) { const int b = (F.tid >> 3) + 64 * q; tot += v[q]; if (b < (int)blockIdx.x) pre += v[q]; }
      __hip_atomic_fetch_add((LAS int*)(sh + e), tot, __ATOMIC_RELAXED, __HIP_MEMORY_SCOPE_WORKGROUP); __hip_atomic_fetch_add((LAS int*)(sh + 8 + e), pre, __ATOMIC_RELAXED, __HIP_MEMORY_SCOPE_WORKGROUP); }
    __syncthreads();
    if (F.tid == 0) { int base = 0; for (int e = 0; e < 8; ++e) { sh[24 + e] = base; sh[16 + e] = base + sh[8 + e]; base += (sh[e] + 255) & ~255; } sh[32] = base; }
    __syncthreads();
    if (blockIdx.x == 0) {
        int* te = (int*)(ws + WS_TILEE); const int ntile = sh[32] >> 8;
        int bs[7];
#pragma unroll
        for (int q = 1; q < 8; ++q) bs[q - 1] = sh[24 + q];
        for (int t = F.tid; t < ntile; t += 512) { int e = 0;
#pragma unroll
            for (int q = 0; q < 7; ++q) e += (t * 256 >= bs[q]) ? 1 : 0;
            te[t] = e; }
        if (F.tid == 0) te[400] = ntile;
    }
    const int gw = F.vcu * NWAVES + F.wave, NGW = F.G * NWAVES, lane = F.lane;
    const GAS unsigned char* AFb = (const GAS unsigned char*)(ws + WS_AF); GAS unsigned char* FSb = (GAS unsigned char*)(ws + WS_FS);
    const int nmine = (nrows - gw + NGW - 1) / NGW;
    for (int k0 = 0; k0 < nmine; k0 += 64) {
        int p0v = 0, p1v = 0;
        if (k0 + lane < nmine) { GAS int* rec = (GAS int*)(ws + WS_REC) + (size_t)(gw + (k0 + lane) * NGW) * 8;
            const u32x4 ra = *(const GAS u32x4*)rec; const u32x2 rb = *(const GAS u32x2*)(rec + 4);
            p0v = sh[16 + (int)ra.x] + (int)rb.x; p1v = sh[16 + (int)ra.y] + (int)rb.y; *(GAS u32x2*)(rec + 6) = (u32x2){(unsigned)p0v, (unsigned)p1v}; }
        const int nk = (nmine - k0) < 64 ? (nmine - k0) : 64;
        for (int kb = 0; kb < nk; kb += 6) {
            u32x4 a[6], b[6];
#pragma unroll
            for (int q = 0; q < 6; ++q) if (kb + q < nk) { const size_t row = (size_t)(gw + (k0 + kb + q) * NGW);
                if (f8) a[q] = *(const GAS u32x4*)(AFb + row * D + 16 * lane);
                else { a[q] = *(const GAS u32x4*)(AFb + row * 2 * D + 16 * lane); b[q] = *(const GAS u32x4*)(AFb + row * 2 * D + 1024 + 16 * lane); } }
#pragma unroll
            for (int q = 0; q < 6; ++q) if (kb + q < nk) { const size_t p0 = (size_t)__builtin_amdgcn_readlane(p0v, kb + q), p1 = (size_t)__builtin_amdgcn_readlane(p1v, kb + q);
                if (f8) { *(GAS u32x4*)(FSb + p0 * D + 16 * lane) = a[q]; *(GAS u32x4*)(FSb + p1 * D + 16 * lane) = a[q]; }
                else { *(GAS u32x4*)(FSb + p0 * 2 * D + 16 * lane) = a[q]; *(GAS u32x4*)(FSb + p0 * 2 * D + 1024 + 16 * lane) = b[q];
                       *(GAS u32x4*)(FSb + p1 * 2 * D + 16 * lane) = a[q]; *(GAS u32x4*)(FSb + p1 * 2 * D + 1024 + 16 * lane) = b[q]; } }
        }
    }
}
__device__ __forceinline__ int chunk_row0(int b, int c) { return c < 2 ? RL + b * NCTX + c * 128 : b * SEQ + (c - 2) * 128; }
__device__ __forceinline__ bf16x8 tr_read2(unsigned a0, unsigned a1) {
    s16x4 lo, hi; asm volatile("ds_read_b64_tr_b16 %0, %2\n\tds_read_b64_tr_b16 %1, %3\n\ts_waitcnt lgkmcnt(0)" : "=&v"(lo), "=&v"(hi) : "v"(a0), "v"(a1) : "memory");
    return __builtin_shufflevector(lo, hi, 0, 1, 2, 3, 4, 5, 6, 7);
}
__device__ __forceinline__ unsigned scale_pk(unsigned w, float s) { return pk2(bflo(w) * s, bfhi(w) * s); }

constexpr int RS_KSTR = 288, RS_VSTR = 544, RS_KF = 0, RS_KB = 128 * RS_KSTR, RS_V = 2 * 128 * RS_KSTR;

__device__ __forceinline__ void ret_summary_unit(Frame& F, int b, int c, const float* lp) {
    const bf16* Z = (const bf16*)(F.ws + WS_Z); const int row0 = chunk_row0(b, c);
    LAS unsigned char* L = F.lds;
    for (int i = F.tid; i < 2048; i += 512) { const int a = i >> 4, ch = i & 15, hd = ch >> 2;
        const u32x4 kv = *(const u32x4*)(Z + (size_t)(row0 + a) * ZW + ZQ_RK + ch * 8);
        const float wf = __builtin_amdgcn_exp2f((float)(127 - a) * lp[hd]), wb = __builtin_amdgcn_exp2f((float)a * lp[4 + hd]);
        u32x4 f, g; f.x = scale_pk(kv.x, wf); f.y = scale_pk(kv.y, wf); f.z = scale_pk(kv.z, wf); f.w = scale_pk(kv.w, wf);
        g.x = scale_pk(kv.x, wb); g.y = scale_pk(kv.y, wb); g.z = scale_pk(kv.z, wb); g.w = scale_pk(kv.w, wb);
        *(LAS u32x4*)(L + RS_KF + a * RS_KSTR + ch * 16) = f; *(LAS u32x4*)(L + RS_KB + a * RS_KSTR + ch * 16) = g; }
    for (int i = F.tid; i < 4096; i += 512) { const int a = i >> 5, ch = i & 31;
        *(LAS u32x4*)(L + RS_V + a * RS_VSTR + ch * 16) = *(const u32x4*)(Z + (size_t)(row0 + a) * ZW + ZQ_RV + ch * 8); }
    __syncthreads();
    const int h = F.wave & 3, dir = F.wave >> 2, l = opaque_v(F.lane), hh = l >> 5, blk = (l >> 4) & 1, q = (l & 15) >> 2, p = l & 3;
    const unsigned lb = (unsigned)(size_t)L;
    f32x16 acc0, acc1;
#pragma unroll
    for (int r = 0; r < 16; ++r) { acc0[r] = 0.f; acc1[r] = 0.f; }
    const unsigned kbase = lb + (dir ? RS_KB : RS_KF) + (h * 32 + 16 * blk) * 2 + 8 * p;
    const unsigned vbase = lb + RS_V + (h * 64 + 16 * blk) * 2 + 8 * p;
#pragma unroll 2
    for (int ks = 0; ks < 8; ++ks) {
        const int r0 = 16 * ks + 8 * hh + q, r1 = r0 + 4;
        const bf16x8 bk = tr_read2(kbase + r0 * RS_KSTR, kbase + r1 * RS_KSTR);
        const bf16x8 a0 = tr_read2(vbase + r0 * RS_VSTR, vbase + r1 * RS_VSTR);
        const bf16x8 a1 = tr_read2(vbase + 64 + r0 * RS_VSTR, vbase + 64 + r1 * RS_VSTR);
        acc0 = __builtin_amdgcn_mfma_f32_32x32x16_bf16(a0, bk, acc0, 0, 0, 0);
        acc1 = __builtin_amdgcn_mfma_f32_32x32x16_bf16(a1, bk, acc1, 0, 0, 0);
    }
    float* out = (float*)(F.ws + WS_RETSUM) + ((((size_t)b * NCH + c) * 2 + dir) * 4 + h) * 2048;
#pragma unroll
    for (int r = 0; r < 16; ++r) { const int e = (r & 3) + 8 * (r >> 2) + 4 * hh; out[e * 32 + (l & 31)] = acc0[r]; out[(32 + e) * 32 + (l & 31)] = acc1[r]; }
    __syncthreads();
}

__device__ __forceinline__ int prefix_chunk(int dir, int i) { return dir == 0 ? i : (i == 0 ? 1 : (i == 1 ? 0 : 19 - i)); }
__device__ __forceinline__ void ret_prefix_unit(Frame& F, int b, int h, int dir, const float* lp) {
    const int lane_ = opaque_v(F.lane);
    const float g128 = __builtin_amdgcn_exp2f(128.0f * lp[dir * 4 + h]);
    f32x4 S[8], nx[8]; const float z0 = opaque_f(0.f);
#pragma unroll
    for (int j = 0; j < 8; ++j) S[j] = (f32x4){z0, z0, z0, z0};
    { const size_t idx = ((((size_t)b * NCH + prefix_chunk(dir, 0)) * 2 + dir) * 4 + h) * 2048; const GAS float* kv = (const GAS float*)(F.ws + WS_RETSUM) + idx;
#pragma unroll
      for (int j = 0; j < 8; ++j) nx[j] = *(const GAS f32x4*)(kv + 4 * lane_ + 256 * j); }
#pragma unroll 1
    for (int i = 0; i < NCH; ++i) {
        const size_t idx = ((((size_t)b * NCH + prefix_chunk(dir, i)) * 2 + dir) * 4 + h) * 2048;
        GAS bf16* st = (GAS bf16*)(F.ws + WS_RETST) + idx;
        f32x4 cur[8];
#pragma unroll
        for (int j = 0; j < 8; ++j) cur[j] = nx[j];
        if (i + 1 < NCH) { const size_t idn = ((((size_t)b * NCH + prefix_chunk(dir, i + 1)) * 2 + dir) * 4 + h) * 2048; const GAS float* kv = (const GAS float*)(F.ws + WS_RETSUM) + idn;
#pragma unroll
            for (int j = 0; j < 8; ++j) nx[j] = *(const GAS f32x4*)(kv + 4 * lane_ + 256 * j); }
#pragma unroll
        for (int j = 0; j < 8; ++j) { const int o = 4 * lane_ + 256 * j;
            u32x2 w; w.x = pk2(S[j][0], S[j][1]); w.y = pk2(S[j][2], S[j][3]); *(GAS u32x2*)(st + o) = w;
            S[j] = S[j] * g128 + cur[j]; }
    }
}
__device__ __forceinline__ void s5_prefix_unit(Frame& F, int b, int g, int d, int l) {
    const int lane_ = opaque_v(F.lane);
    const f32x2 a = ((const GAS f32x2*)(F.ws + WS_S5P + (size_t)l * S5P_BYTES + S5P_A128))[(d * 16 + g) * 64 + lane_];
    f32x2 e[NCH];
#pragma unroll
    for (int i = 0; i < NCH; ++i) e[i] = ((const GAS f32x2*)(F.ws + WS_S5E))[((((size_t)b * NCH + prefix_chunk(d, i)) * 16 + g) * 2 + d) * 64 + lane_];
    float cr = opaque_f(0.f), ci = cr;
#pragma unroll
    for (int i = 0; i < NCH; ++i) {
        ((GAS f32x2*)(F.ws + WS_S5C))[((((size_t)b * NCH + prefix_chunk(d, i)) * 16 + g) * 2 + d) * 64 + lane_] = (f32x2){cr, ci};
        const float nr = a.x * cr - a.y * ci + e[i].x, ni = a.x * ci + a.y * cr + e[i].y; cr = nr; ci = ni;
    }
}

constexpr int S5_XSTR = 132  , S5_HSTR = 272  , S5_WAVE_LDS = 16 * S5_XSTR * 4 + 16 * S5_HSTR;
template <bool OUT, int DIR>
__device__ __forceinline__ void s5_scan_dir(const unsigned char* sp, unsigned char* wsb, LAS float* X, LAS unsigned char* Hb, int lane, int tk, int kg, int g, size_t sidx, const bf16x8 (&ufr)[8], const bf16x8 (&chf)[4], f32x4 (&yacc)[8]) {
    const bf16x8 zero8 = (bf16x8){0, 0, 0, 0, 0, 0, 0, 0};
    const f32x2 ab = ((const GAS f32x2*)(sp + S5P_ABAR))[(DIR * 16 + g) * 64 + lane];
    bf16x8 af[8];
#pragma unroll
    for (int rb = 0; rb < 8; ++rb) af[rb] = kg < 2 ? *(const GAS bf16x8*)((const GAS bf16*)(sp + S5P_BP) + (((size_t)DIR * 16 + g) * 128 + 16 * rb + tk) * 16 + 8 * kg) : zero8;
    float hr = 0.f, hi = 0.f;
    if (OUT) { const f32x2 cin = ((const GAS f32x2*)(wsb + WS_S5C))[sidx + DIR * 64]; hr = cin.x; hi = cin.y; }
#pragma unroll
    for (int si = 0; si < 8; ++si) {
        const int sub = DIR ? 7 - si : si;
#pragma unroll
        for (int rb = 0; rb < 8; ++rb) { const f32x4 xa = __builtin_amdgcn_mfma_f32_16x16x32_bf16(af[rb], ufr[sub], (f32x4){0.f, 0.f, 0.f, 0.f}, 0, 0, 0);
            *(LAS f32x4*)(X + tk * S5_XSTR + 16 * rb + 4 * kg) = xa; }
        asm volatile("" ::: "memory");
#pragma unroll
        for (int ti = 0; ti < 16; ++ti) {
            const int tok = DIR ? 15 - ti : ti;
            const f32x2 x = *(const LAS f32x2*)(X + tok * S5_XSTR + 2 * lane);
            const float nr = ab.x * hr - ab.y * hi + x.x, ni = ab.x * hi + ab.y * hr + x.y; hr = nr; hi = ni;
            if (OUT) *(LAS unsigned*)(Hb + tok * S5_HSTR + 4 * lane) = cvt_pk_bf16(hr, hi);
        }
        asm volatile("" ::: "memory");
        if (OUT) {
#pragma unroll
            for (int ks = 0; ks < 4; ++ks) { const bf16x8 hf = *(const LAS bf16x8*)(Hb + tk * S5_HSTR + (32 * ks + 8 * kg) * 2); yacc[sub] = __builtin_amdgcn_mfma_f32_16x16x32_bf16(hf, chf[ks], yacc[sub], 0, 0, 0); }
        }
        asm volatile("" ::: "memory");
    }
    if (!OUT) ((GAS f32x2*)(wsb + WS_S5E))[sidx + DIR * 64] = (f32x2){hr, hi};
}
template <bool OUT>
__device__ __forceinline__ void s5_wave_unit(Frame& F, int b, int c, int g, int l, const float* s5_d) {
    const unsigned char* sp = F.ws + WS_S5P + (size_t)l * S5P_BYTES;
    const bf16* Z = (const bf16*)(F.ws + WS_Z); const int row0 = chunk_row0(b, c);
    LAS float* X = (LAS float*)(F.lds + F.wave * S5_WAVE_LDS);
    LAS unsigned char* Hb = (LAS unsigned char*)X + 16 * S5_XSTR * 4;
    const int lane = opaque_v(F.lane), tk = lane & 15, kg = lane >> 4;
    const bf16x8 zero8 = (bf16x8){0, 0, 0, 0, 0, 0, 0, 0};
    f32x4 yacc[8]; bf16x8 chf[4];
#pragma unroll
    for (int s8 = 0; s8 < 8; ++s8) yacc[s8] = (f32x4){0.f, 0.f, 0.f, 0.f};
#pragma unroll
    for (int ks = 0; ks < 4; ++ks) chf[ks] = OUT ? *(const GAS bf16x8*)((const GAS bf16*)(sp + S5P_CH) + ((size_t)g * 16 + tk) * 128 + 32 * ks + 8 * kg) : zero8;
    bf16x8 ufr[8];
#pragma unroll
    for (int sb = 0; sb < 8; ++sb) ufr[sb] = kg < 2 ? *(const GAS bf16x8*)((const GAS bf16*)Z + (size_t)(row0 + 16 * sb + tk) * ZW + ZQ_SU + g * 16 + 8 * kg) : zero8;
    const size_t sidx = ((((size_t)b * NCH + c) * 16 + g) * 2) * 64 + lane;
    s5_scan_dir<OUT, 0>(sp, F.ws, X, Hb, lane, tk, kg, g, sidx, ufr, chf, yacc);
    s5_scan_dir<OUT, 1>(sp, F.ws, X, Hb, lane, tk, kg, g, sidx, ufr, chf, yacc);
    if (OUT) {
        GAS bf16* xb = (GAS bf16*)(F.ws + WS_XB) + (size_t)1 * RT * 256;
        const float dsk = s5_d[((size_t)l * 16 + g) * 16 + tk];
#pragma unroll
        for (int s8 = 0; s8 < 8; ++s8)
#pragma unroll
            for (int r = 0; r < 4; ++r) { const int row = row0 + 16 * s8 + 4 * kg + r;
                const float u = bf2f(((const GAS bf16*)Z)[(size_t)row * ZW + ZQ_SU + g * 16 + tk]);
                const float y = yacc[s8][r] + dsk * u;
                const float o = y * sigmoidf_(1.5957691216f * (y + 0.044715f * y * y * y));
                xb[(size_t)row * 256 + g * 16 + tk] = (bf16)f2bf(o); }
    }
}
__device__ __forceinline__ bf16x8 pack8(const f32x16& x, int s) {
    u32x4 p;
    if (s == 0) { p.x = cvt_pk_bf16(x[0], x[1]); p.y = cvt_pk_bf16(x[2], x[3]); p.z = cvt_pk_bf16(x[4], x[5]); p.w = cvt_pk_bf16(x[6], x[7]); }
    else { p.x = cvt_pk_bf16(x[8], x[9]); p.y = cvt_pk_bf16(x[10], x[11]); p.z = cvt_pk_bf16(x[12], x[13]); p.w = cvt_pk_bf16(x[14], x[15]); }
    return __builtin_bit_cast(bf16x8, p);
}
#define MFMA32(a, b, c) __builtin_amdgcn_mfma_f32_32x32x16_bf16((a), (b), (c), 0, 0, 0)

__device__ __forceinline__ void ret_out_unit(Frame& F, int b, int c, const float* lp) {
    const bf16* Z = (const bf16*)(F.ws + WS_Z); const int row0 = chunk_row0(b, c);
    LAS unsigned char* L = F.lds;
    for (int i = F.tid; i < 4096; i += 512) { const int a = i >> 5, ch = i & 31;
        *(LAS u32x4*)(L + a * RS_VSTR + ch * 16) = *(const u32x4*)(Z + (size_t)(row0 + a) * ZW + ZQ_RV + ch * 8); }
    __syncthreads();
    const int h = F.wave >> 1, ih = F.wave & 1, l = opaque_v(F.lane), li = l & 31, hh = l >> 5, blk = (l >> 4) & 1, q = (l & 15) >> 2, p = l & 3;
    const float lgf = lp[h], lgb = lp[4 + h];
    bf16x8 qf[2][2];
#pragma unroll
    for (int ib = 0; ib < 2; ++ib)
#pragma unroll
        for (int ks = 0; ks < 2; ++ks) qf[ib][ks] = *(const bf16x8*)(Z + (size_t)(row0 + 64 * ih + 32 * ib + li) * ZW + ZQ_RQ + 32 * h + 16 * ks + 8 * hh);
    f32x16 o[2][2];
#pragma unroll
    for (int eb = 0; eb < 2; ++eb)
#pragma unroll
        for (int ib = 0; ib < 2; ++ib)
#pragma unroll
            for (int r = 0; r < 16; ++r) o[eb][ib][r] = 0.f;
    const unsigned vbase = (unsigned)(size_t)L + (h * 64 + 16 * blk) * 2 + 8 * p;
    bf16x8 kfa[4][2];
#pragma unroll
    for (int jb = 0; jb < 4; ++jb)
#pragma unroll
        for (int ks = 0; ks < 2; ++ks) kfa[jb][ks] = *(const GAS bf16x8*)((const GAS bf16*)Z + (size_t)(row0 + 32 * jb + li) * ZW + ZQ_RK + 32 * h + 16 * ks + 8 * hh);
#pragma unroll
    for (int jb = 0; jb < 4; ++jb) {
        bf16x8 kf[2]; kf[0] = kfa[jb][0]; kf[1] = kfa[jb][1];
        bf16x8 vf[2][2];
#pragma unroll
        for (int s2 = 0; s2 < 2; ++s2) { const int r0 = 32 * jb + 16 * s2 + 4 * hh + q, r1 = r0 + 8;
            vf[0][s2] = tr_read2(vbase + r0 * RS_VSTR, vbase + r1 * RS_VSTR); vf[1][s2] = tr_read2(vbase + 64 + r0 * RS_VSTR, vbase + 64 + r1 * RS_VSTR); }
#pragma unroll
        for (int ib = 0; ib < 2; ++ib) {
            f32x16 s;
#pragma unroll
            for (int r = 0; r < 16; ++r) s[r] = 0.f;
            s = MFMA32(kf[0], qf[ib][0], s); s = MFMA32(kf[1], qf[ib][1], s);
            const int iq = 64 * ih + 32 * ib + li;
#pragma unroll
            for (int r = 0; r < 16; ++r) { const int j = 32 * jb + (r & 3) + 8 * (r >> 2) + 4 * hh; const int dl = iq - j;
                s[r] *= dl >= 0 ? __builtin_amdgcn_exp2f((float)dl * lgf) : __builtin_amdgcn_exp2f((float)(-dl) * lgb); }
            const bf16x8 p0 = pack8(s, 0), p1 = pack8(s, 1);
            o[0][ib] = MFMA32(vf[0][0], p0, o[0][ib]); o[0][ib] = MFMA32(vf[0][1], p1, o[0][ib]);
            o[1][ib] = MFMA32(vf[1][0], p0, o[1][ib]); o[1][ib] = MFMA32(vf[1][1], p1, o[1][ib]);
        }
    }
#pragma unroll
    for (int dir = 0; dir < 2; ++dir) {
        const bf16* st = (const bf16*)(F.ws + WS_RETST) + ((((size_t)b * NCH + c) * 2 + dir) * 4 + h) * 2048;
#pragma unroll
        for (int eb = 0; eb < 2; ++eb) {
            const bf16x8 s0 = *(const bf16x8*)(st + (32 * eb + li) * 32 + 8 * hh), s1 = *(const bf16x8*)(st + (32 * eb + li) * 32 + 16 + 8 * hh);
#pragma unroll
            for (int ib = 0; ib < 2; ++ib) {
                f32x16 x;
#pragma unroll
                for (int r = 0; r < 16; ++r) x[r] = 0.f;
                x = MFMA32(s0, qf[ib][0], x); x = MFMA32(s1, qf[ib][1], x);
                const int a = 64 * ih + 32 * ib + li;
                const float wq = dir == 0 ? __builtin_amdgcn_exp2f((float)(a + 1) * lgf) : __builtin_amdgcn_exp2f((float)(128 - a) * lgb);
#pragma unroll
                for (int r = 0; r < 16; ++r) o[eb][ib][r] += wq * x[r];
            }
        }
    }
    bf16* xb = (bf16*)(F.ws + WS_XB);
#pragma unroll
    for (int ib = 0; ib < 2; ++ib) {
        float sm = 0.f;
#pragma unroll
        for (int r = 0; r < 16; ++r) sm += o[0][ib][r] + o[1][ib][r];
        sm += __shfl_xor(sm, 32); const float mean = sm * (1.0f / 64.0f);
        float sq = 0.f;
#pragma unroll
        for (int r = 0; r < 16; ++r) { const float d0 = o[0][ib][r] - mean, d1 = o[1][ib][r] - mean; sq += d0 * d0 + d1 * d1; }
        sq += __shfl_xor(sq, 32); const float rstd = 1.0f / sqrtf(sq * (1.0f / 64.0f) + EPS);
        const size_t row = (size_t)(row0 + 64 * ih + 32 * ib + li);
#pragma unroll
        for (int eb = 0; eb < 2; ++eb)
#pragma unroll
            for (int g4 = 0; g4 < 4; ++g4) { const int e = 32 * eb + 8 * g4 + 4 * hh;
                const u32x2 gw = *(const u32x2*)(Z + row * ZW + ZQ_RG + h * 64 + e);
                const float y0 = (o[eb][ib][4 * g4 + 0] - mean) * rstd * siluf_(bflo(gw.x)), y1 = (o[eb][ib][4 * g4 + 1] - mean) * rstd * siluf_(bfhi(gw.x));
                const float y2 = (o[eb][ib][4 * g4 + 2] - mean) * rstd * siluf_(bflo(gw.y)), y3 = (o[eb][ib][4 * g4 + 3] - mean) * rstd * siluf_(bfhi(gw.y));
                u32x2 w; w.x = cvt_pk_bf16(y0, y1); w.y = cvt_pk_bf16(y2, y3); *(u32x2*)(xb + row * 256 + h * 64 + e) = w; }
    }
    __syncthreads();
}

__device__ __forceinline__ void tr_read_vtile(unsigned base, bf16x8 (&vf)[2][4]) {
    s16x4 r[16];
    asm volatile("ds_read_b64_tr_b16 %0, %16 offset:0\n\t" "ds_read_b64_tr_b16 %1, %16 offset:1152\n\t" "ds_read_b64_tr_b16 %2, %16 offset:2304\n\t" "ds_read_b64_tr_b16 %3, %16 offset:3456\n\t" "ds_read_b64_tr_b16 %4, %16 offset:4608\n\t" "ds_read_b64_tr_b16 %5, %16 offset:5760\n\t" "ds_read_b64_tr_b16 %6, %16 offset:6912\n\t" "ds_read_b64_tr_b16 %7, %16 offset:8064\n\t" "ds_read_b64_tr_b16 %8, %16 offset:64\n\t" "ds_read_b64_tr_b16 %9, %16 offset:1216\n\t" "ds_read_b64_tr_b16 %10, %16 offset:2368\n\t" "ds_read_b64_tr_b16 %11, %16 offset:3520\n\t" "ds_read_b64_tr_b16 %12, %16 offset:4672\n\t" "ds_read_b64_tr_b16 %13, %16 offset:5824\n\t" "ds_read_b64_tr_b16 %14, %16 offset:6976\n\t" "ds_read_b64_tr_b16 %15, %16 offset:8128\n\t" "s_waitcnt lgkmcnt(0)" : "=&v"(r[0]), "=&v"(r[1]), "=&v"(r[2]), "=&v"(r[3]), "=&v"(r[4]), "=&v"(r[5]), "=&v"(r[6]), "=&v"(r[7]), "=&v"(r[8]), "=&v"(r[9]), "=&v"(r[10]), "=&v"(r[11]), "=&v"(r[12]), "=&v"(r[13]), "=&v"(r[14]), "=&v"(r[15]) : "v"(base) : "memory");
#pragma unroll
    for (int eb = 0; eb < 2; ++eb)
#pragma unroll
        for (int k4 = 0; k4 < 4; ++k4) vf[eb][k4] = __builtin_shufflevector(r[(eb * 4 + k4) * 2], r[(eb * 4 + k4) * 2 + 1], 0, 1, 2, 3, 4, 5, 6, 7);
}
constexpr int AT_STR = 144, AT_TILE = 64 * AT_STR;
__device__ __forceinline__ void attn_unit(Frame& F, int b, int h, int qrow0, int nkt, bool ctx_only, float lam, float omli, const float* subln_g) {
    const bf16* Z = (const bf16*)(F.ws + WS_Z);
    LAS unsigned char* L = F.lds; const unsigned lb = (unsigned)(size_t)L;
    const int l = opaque_v(F.lane), li = l & 31, hh = l >> 5, blk = (l >> 4) & 1, q4 = (l & 15) >> 2, p = l & 3;
    const int qrow = qrow0 + 32 * F.wave + li;
    bf16x8 qf[2][2];
#pragma unroll
    for (int mp = 0; mp < 2; ++mp)
#pragma unroll
        for (int ks = 0; ks < 2; ++ks) qf[mp][ks] = *(const bf16x8*)(Z + (size_t)qrow * ZW + ZQ_DQ + h * 64 + mp * 32 + 16 * ks + 8 * hh);
    f32x16 o[2][2];
#pragma unroll
    for (int mp = 0; mp < 2; ++mp)
#pragma unroll
        for (int eb = 0; eb < 2; ++eb)
#pragma unroll
            for (int r = 0; r < 16; ++r) o[mp][eb][r] = 0.f;
    float mx[2] = {-3.0e38f, -3.0e38f}, ls[2] = {0.f, 0.f};
    const int stid = opaque_v(F.tid), skey = stid >> 3, sch = stid & 7;
    auto key_row = [&](int kt) -> int { const int k0 = kt * 64; return (ctx_only || k0 < NCTX) ? RL + b * NCTX + k0 : b * SEQ + (k0 - NCTX); };
    u32x4 kreg, vreg;
    { const size_t r = (size_t)(key_row(0) + skey); kreg = *(const u32x4*)(Z + r * ZW + ZQ_DK + h * 64 + sch * 8); vreg = *(const u32x4*)(Z + r * ZW + ZQ_DV + h * 64 + sch * 8); }
#pragma unroll 1
    for (int kt = 0; kt < nkt; ++kt) {
        const int buf = kt & 1;
        *(LAS u32x4*)(L + buf * 2 * AT_TILE + skey * AT_STR + sch * 16) = kreg;
        *(LAS u32x4*)(L + buf * 2 * AT_TILE + AT_TILE + skey * AT_STR + sch * 16) = vreg;
        __syncthreads();
        if (kt + 1 < nkt) { const size_t r = (size_t)(key_row(kt + 1) + skey); kreg = *(const u32x4*)(Z + r * ZW + ZQ_DK + h * 64 + sch * 8); vreg = *(const u32x4*)(Z + r * ZW + ZQ_DV + h * 64 + sch * 8); }
        const LAS unsigned char* Kt = L + buf * 2 * AT_TILE; const unsigned vb = lb + buf * 2 * AT_TILE + AT_TILE + 16 * blk * 2 + 8 * p;
        bf16x8 vf[2][4];
        tr_read_vtile(vb + (4 * hh + q4) * AT_STR, vf);
#pragma unroll
        for (int mp = 0; mp < 2; ++mp) {
            f32x16 s[2];
#pragma unroll
            for (int kb = 0; kb < 2; ++kb) {
#pragma unroll
                for (int r = 0; r < 16; ++r) s[kb][r] = 0.f;
#pragma unroll
                for (int ks = 0; ks < 2; ++ks) { const bf16x8 ka = *(const LAS bf16x8*)(Kt + (32 * kb + li) * AT_STR + (mp * 32 + 16 * ks + 8 * hh) * 2); s[kb] = MFMA32(ka, qf[mp][ks], s[kb]); }
            }
            if (kt < 4 || (kt & 3) == 0) {
                float tm = s[0][0];
#pragma unroll
                for (int r = 1; r < 16; ++r) tm = fmaxf(tm, s[0][r]);
#pragma unroll
                for (int r = 0; r < 16; ++r) tm = fmaxf(tm, s[1][r]);
                tm = fmaxf(tm, __shfl_xor(tm, 32));
                if (__any(tm > mx[mp])) {
                    const float mn = fmaxf(mx[mp], tm), al = __builtin_amdgcn_exp2f((mx[mp] - mn) * 1.44269504f);
                    mx[mp] = mn; ls[mp] *= al;
#pragma unroll
                    for (int eb = 0; eb < 2; ++eb)
#pragma unroll
                        for (int r = 0; r < 16; ++r) o[mp][eb][r] *= al;
                }
            }
            const float mb = mx[mp] * 1.44269504f; f32x2 rs2 = (f32x2){0.f, 0.f};
#pragma unroll
            for (int kb = 0; kb < 2; ++kb)
#pragma unroll
                for (int r = 0; r < 16; r += 2) { const float p0 = __builtin_amdgcn_exp2f(s[kb][r] * 1.44269504f - mb), p1 = __builtin_amdgcn_exp2f(s[kb][r + 1] * 1.44269504f - mb);
                    s[kb][r] = p0; s[kb][r + 1] = p1; rs2 += (f32x2){p0, p1}; }
            const float rs = rs2.x + rs2.y;
            ls[mp] += rs;
#pragma unroll
            for (int kb = 0; kb < 2; ++kb)
#pragma unroll
                for (int s2 = 0; s2 < 2; ++s2) { const bf16x8 pb = pack8(s[kb], s2);
                    o[mp][0] = MFMA32(vf[0][2 * kb + s2], pb, o[mp][0]); o[mp][1] = MFMA32(vf[1][2 * kb + s2], pb, o[mp][1]); }
        }
    }
    const float l0 = ls[0] + __shfl_xor(ls[0], 32), l1 = ls[1] + __shfl_xor(ls[1], 32);
    const float i0 = 1.0f / l0, i1 = lam / l1;
    float sq = 0.f;
#pragma unroll
    for (int eb = 0; eb < 2; ++eb)
#pragma unroll
        for (int r = 0; r < 16; ++r) { const float v = o[0][eb][r] * i0 - o[1][eb][r] * i1; o[0][eb][r] = v; sq += v * v; }
    sq += __shfl_xor(sq, 32);
    const float rstd = omli / sqrtf(sq * (1.0f / 64.0f) + EPS);
    bf16* xb = (bf16*)(F.ws + WS_XB) + (size_t)2 * RT * 256;
#pragma unroll
    for (int eb = 0; eb < 2; ++eb)
#pragma unroll
        for (int g4 = 0; g4 < 4; ++g4) { const int e = 32 * eb + 8 * g4 + 4 * hh; const f32x4 sg = *(const f32x4*)(subln_g + e);
            u32x2 w; w.x = cvt_pk_bf16(o[0][eb][4 * g4] * rstd * sg[0], o[0][eb][4 * g4 + 1] * rstd * sg[1]); w.y = cvt_pk_bf16(o[0][eb][4 * g4 + 2] * rstd * sg[2], o[0][eb][4 * g4 + 3] * rstd * sg[3]);
            *(u32x2*)(xb + (size_t)qrow * 256 + h * 64 + e) = w; }
    __syncthreads();
}

__device__ __forceinline__ void conv_unit(Frame& F, int seq_row0, int seq_len, int tok0, const float* dw, const float* db, const float* lng, const float* lnb) {
    const bf16* Z = (const bf16*)(F.ws + WS_Z);
    LAS unsigned short* U = (LAS unsigned short*)F.lds;
    LAS float* Yt = (LAS float*)(F.lds + 94 * 512);
    for (int i = F.tid; i < 94 * 32; i += 512) { const int tt = i >> 5, ch = i & 31; const int t = tok0 - 15 + tt;
        u32x4 v = (u32x4){0u, 0u, 0u, 0u}; if (t >= 0 && t < seq_len) v = *(const u32x4*)(Z + (size_t)(seq_row0 + t) * ZW + ZQ_CV + ch * 8);
        *(LAS u32x4*)(U + tt * 256 + ch * 8) = v; }
    __syncthreads();
    const int ctid = opaque_v(F.tid), ch = ctid & 255, half = ctid >> 8;
    float w[31];
#pragma unroll
    for (int k = 0; k < 31; ++k) w[k] = dw[k * 256 + ch];
    const float bias = db[ch];
#pragma unroll 1
    for (int g = 0; g < 2; ++g) {
        const int t0 = half * 32 + g * 16;
        float x[46];
#pragma unroll
        for (int i = 0; i < 46; ++i) x[i] = bf2f(U[(t0 + i) * 256 + ch]);
#pragma unroll
        for (int j = 0; j < 16; ++j) { float a = bias;
#pragma unroll
            for (int k = 0; k < 31; ++k) a += w[k] * x[j + k];
            Yt[(t0 + j) * 256 + ch] = a; }
    }
    __syncthreads();
    bf16* xb = (bf16*)(F.ws + WS_XB) + (size_t)3 * RT * 256;
    for (int t = F.wave; t < 64; t += 8) {
        const f32x4 y = *(const LAS f32x4*)(Yt + t * 256 + 4 * F.lane);
        const float mean = wave_sum((y[0] + y[1]) + (y[2] + y[3])) * (1.0f / 256.0f);
        const f32x4 dv = y - mean; const float var = wave_sum((dv[0] * dv[0] + dv[1] * dv[1]) + (dv[2] * dv[2] + dv[3] * dv[3])) * (1.0f / 256.0f);
        const float rstd = 1.0f / sqrtf(var + EPS);
        const f32x4 g4 = *(const f32x4*)(lng + 4 * F.lane), b4 = *(const f32x4*)(lnb + 4 * F.lane);
        const f32x4 z = dv * rstd * g4 + b4;
        u32x2 wv; wv.x = cvt_pk_bf16(siluf_(z[0]), siluf_(z[1])); wv.y = cvt_pk_bf16(siluf_(z[2]), siluf_(z[3]));
        *(u32x2*)(xb + (size_t)(seq_row0 + tok0 + t) * 256 + 4 * F.lane) = wv;
    }
    __syncthreads();
}
#ifndef F8_LAYER_MASK
#define F8_LAYER_MASK 0xF
#endif
constexpr int F8MASK = F8_LAYER_MASK;
constexpr int NSTEP_L = 12, NSTEPS = 2 + DEPTH * NSTEP_L;
struct Args { const float* in[39]; float* out; unsigned char* ws; int s_lo, s_hi; };
static_assert(sizeof(Args) == 39 * 8 + 8 + 8 + 8, "Args has no padding");

template <int OFF> __device__ __forceinline__ unsigned long long ka64() { unsigned long long v; asm volatile("s_load_dwordx2 %0, %1, %2\n\ts_waitcnt lgkmcnt(0)" : "=s"(v) : "s"(__builtin_amdgcn_kernarg_segment_ptr()), "n"(OFF)); return v; }
template <int OFF> __device__ __forceinline__ int ka32() { int v; asm volatile("s_load_dword %0, %1, %2\n\ts_waitcnt lgkmcnt(0)" : "=s"(v) : "s"(__builtin_amdgcn_kernarg_segment_ptr()), "n"(OFF)); return v; }
#define KIN(k) ((const float*)ka64<8 * (k)>())
#define KOUT ((float*)ka64<312>())
#define KWS ((unsigned char*)ka64<320>())
__global__ void __launch_bounds__(NWAVES * 64, 2) fwd_kernel(Args) {
    extern __shared__ __attribute__((aligned(16))) unsigned char lds[];
    Frame F;
    F.lds = (LAS unsigned char*)lds;
    F.MISC = (volatile LAS unsigned*)(F.lds + MISC_OFF);
    F.tid = threadIdx.x; F.lane = F.tid & 63; F.wave = __builtin_amdgcn_readfirstlane(F.tid >> 6);
    F.G = gridDim.x; { const int bx = blockIdx.x; F.vcu = (F.G % 8 == 0) ? (bx % 8) * (F.G / 8) + bx / 8 : bx; }
    F.ws = KWS;
    unsigned char* ws = F.ws;
    for (int u = F.tid; u < (LDS_BYTES - LDSCTL_OFF) / 4; u += NWAVES * 64) ((LAS unsigned*)(F.lds + LDSCTL_OFF))[u] = 0u;
    __syncthreads();
    unsigned* barw = (unsigned*)(ws + WS_CTL) + CW_BAR; asm volatile("" : "+s"(barw));
    const int lo = ka32<328>(), hi = ka32<332>();
    XcdBarrier bar; bar.bar = barw; bar.x = 0; bar.st = nullptr;
    if (hi - lo > 1) bar = xcd_barrier_post(barw, F.MISC + 8, F.tid);
#ifndef BR_REP
#define BR_REP 0
#endif
#ifndef PH_MASK
#define PH_MASK 0xFFFFF
#endif
#define EN(j) (((PH_MASK) >> (j)) & 1)
#define IN(k) (lo <= (k) && (k) < hi)
#define FRESH() do { int ln_; asm volatile("v_mbcnt_lo_u32_b32 %0, -1, 0\n\tv_mbcnt_hi_u32_b32 %0, -1, %0" : "=v"(ln_)); F.wave = opaque_s(F.wave); F.lane = ln_; F.tid = F.wave * 64 + ln_; \
    F.vcu = opaque_s(F.vcu); F.G = opaque_s(F.G); asm volatile("" : "+s"(F.ws)); ws = F.ws; } while (0)
#define GW (F.vcu * NWAVES + F.wave)
#define NGW_ (F.G * NWAVES)
#define SEAM(k) do { if (IN(k) && IN((k) + 1)) { FRESH(); xcd_barrier(bar, F.tid); } } while (0)

    if (EN(12) && IN(0)) { FRESH();
        P0Args P; P.c = KIN(1); P.c_ctx = KIN(3); P.ada_w = KIN(4); P.ada_b = KIN(5); P.w_in = KIN(10); P.w_gate = KIN(11); P.ret_w_o = KIN(14); P.s5_w_glu = KIN(23);
        P.diff_w_o = KIN(26); P.conv_w_o = KIN(31); P.w_out = KIN(32); P.ffn_w_gu = KIN(33); P.ffn_w_d = KIN(34); P.moe_w_gu = KIN(37); P.moe_w_d = KIN(38);
        P.ret_decay = KIN(13); P.s5_a_re = KIN(15); P.s5_a_im = KIN(16); P.s5_log_dt = KIN(17); P.s5_b_re = KIN(18); P.s5_b_im = KIN(19); P.s5_c_re = KIN(20); P.s5_c_im = KIN(21); P.diff_lambda = KIN(24);
        P.f8mask = F8MASK;
        p0_prologue(F, P);
    }
    SEAM(0);
    if (EN(13) && IN(1)) { FRESH(); RowArgs A{}; A.x = KIN(0); A.ctx = KIN(2); A.pre_g = KIN(6); A.l = 0; A.nrows = RT; row_pass<0>(F, A); }
    SEAM(1);

#pragma unroll 1
    for (int l = 0; l < DEPTH; ++l) {
        const int s0 = 2 + l * NSTEP_L;
        if (hi <= s0 || lo >= s0 + NSTEP_L) continue;
        const bool need_ctx = l < DEPTH - 1, moe = (l & 1) != 0;
        const int nrows = need_ctx ? RT : RL, nM = nrows / 256, j2 = l >> 1;
#define lp ((const float*)(ws + WS_LAYP) + l * 64)
#define AF ((bf16*)(ws + WS_AF))
#define Z ((bf16*)(ws + WS_Z))

        if (EN(0) && IN(s0 + 0)) { FRESH();
            pg8::Gemm g{AF, (const bf16*)(ws + WS_WIN) + (size_t)l * E_WIN, D, 0, 0}; pg8::SchedWin S; S.init(F.G, opaque_s((int)blockIdx.x), need_ctx ? 0 : 2);
            pg8::EpiWin E{Z, (const float*)(ws + WS_ROPE)};
            pg8::gemm_phase(F.lds, g, S, E, F.tid);
        }
        SEAM(s0 + 0);
        if (EN(1) && IN(s0 + 1)) { FRESH();
            unsigned* dep = (unsigned*)(ws + WS_CTL) + CW_DEP + 1024 * l;
            if (need_ctx) {
                pg8::Gemm g{AF, (const bf16*)(ws + WS_WIN) + (size_t)l * E_WIN, D, 0, 0}; pg8::SchedWin S; S.init(F.G, opaque_s((int)blockIdx.x), 1);
                pg8::EpiWin E{Z, (const float*)(ws + WS_ROPE)};
                pg8::gemm_phase(F.lds, g, S, E, F.tid);
                __syncthreads(); FRESH();
                const int bx = opaque_s((int)blockIdx.x), nmine = bx < 16 ? (16 - bx + F.G - 1) / F.G : 0;
                if (nmine > 0) dep_signal(F, dep + 128, (unsigned)nmine);
            }
            unsigned* ctr = (unsigned*)(ws + WS_CTL) + 8192 + 64 * (l * 2 + 0);
            const int n_rs = NB * NCH, nS = n_rs + NB * NCH * 2, nP = 80, e0 = nS + nP;
            const int c_lo = need_ctx ? 0 : 2, nch = NCH - c_lo;
            const int n_at = 512, n_ret = NB * nch, n_s5 = NB * nch * 2, n_cv = need_ctx ? 576 : 512, n_ac = need_ctx ? 64 : 0;
            const int e1 = e0 + n_at, e2 = e1 + n_ret, e3 = e2 + n_s5, e4 = e3 + n_cv, total = e4 + n_ac;
            int u = F.vcu, nsum = 0;
            while (u < total) {
                int nx = 0; if (F.tid == 0) nx = F.G + (int)__hip_atomic_fetch_add(ctr, 1u, RLX_AGENT);
                FRESH();
                if (u < n_rs) { for (int rp_ = 0; rp_ < 1 + ((BR_REP >> 4) & 1); ++rp_) ret_summary_unit(F, u / NCH, u % NCH, lp); }
                else if (u < nS) { const int wu = (u - n_rs) * 8 + F.wave; const int g = wu & 15, bc = wu >> 4; for (int rp_ = 0; rp_ < 1 + ((BR_REP >> 5) & 1); ++rp_) s5_wave_unit<false>(F, bc / NCH, bc % NCH, g, l, nullptr); }
                else if (u < e0) { dep_wait(F, dep, (unsigned)nS); FRESH();
                    const int wu = (u - nS) * 8 + F.wave;
                    if (wu < 128) ret_prefix_unit(F, wu >> 3, (wu >> 1) & 3, wu & 1, lp);
                    else { const int v = wu - 128; s5_prefix_unit(F, v >> 5, (v >> 1) & 15, v & 1, l); } }
                else if (u < e1) { const int v = u - e0; for (int rp_ = 0; rp_ < 1 + ((BR_REP >> 0) & 1); ++rp_) attn_unit(F, v >> 5, (v >> 3) & 3, (v >> 5) * SEQ + (v & 7) * 256, 36, false, lp[8], lp[9], KIN(25) + l * 64); }
                else if (u < e2) { dep_wait(F, dep + 64, (unsigned)nP); FRESH(); const int v = u - e1; for (int rp_ = 0; rp_ < 1 + ((BR_REP >> 1) & 1); ++rp_) ret_out_unit(F, v / nch, c_lo + v % nch, lp); }
                else if (u < e3) { dep_wait(F, dep + 64, (unsigned)nP); FRESH(); const int wu = (u - e2) * 8 + F.wave; const int g = wu & 15, bc = wu >> 4; for (int rp_ = 0; rp_ < 1 + ((BR_REP >> 2) & 1); ++rp_) s5_wave_unit<true>(F, bc / nch, c_lo + bc % nch, g, l, KIN(22)); }
                else if (u < e4) { const int v = u - e3; const float* dw = KIN(27) + (size_t)l * 31 * 256; const float* db = KIN(28) + l * 256; const float* lng = KIN(29) + l * 256; const float* lnb = KIN(30) + l * 256;
                    if (v >= 512) { dep_wait(F, dep + 128, 16u); FRESH(); }
                    for (int rp_ = 0; rp_ < 1 + ((BR_REP >> 3) & 1); ++rp_)
                    if (v < 512) conv_unit(F, (v >> 5) * SEQ, SEQ, (v & 31) * 64, dw, db, lng, lnb);
                    else { const int v2 = v - 512; conv_unit(F, RL + (v2 >> 2) * NCTX, NCTX, (v2 & 3) * 64, dw, db, lng, lnb); } }
                else { const int v = u - e4; attn_unit(F, v >> 2, v & 3, RL + (v >> 2) * NCTX, 4, true, lp[8], lp[9], KIN(25) + l * 64); }
                if (F.tid == 0) F.MISC[24] = (unsigned)nx;
                __syncthreads(); const int un = (int)F.MISC[24]; __syncthreads();
                if (u < nS) { ++nsum; if (un >= nS) dep_signal(F, dep, (unsigned)nsum); }
                else if (u < e0) dep_signal(F, dep + 64, 1u);
                u = un;
            }
        }
        SEAM(s0 + 3);
        if (EN(4) && IN(s0 + 4)) { FRESH();
            pg8::Gemm g{(const bf16*)(ws + WS_XB), (const bf16*)(ws + WS_WBR) + (size_t)l * E_WBR, 256}; pg8::SchedBr S; S.init(nM, F.G, opaque_s((int)blockIdx.x));
            pg8::EpiBr E{(bf16*)(ws + WS_BO)};
            pg8::gemm_phase(F.lds, g, S, E, F.tid);
        }
        SEAM(s0 + 4);
        if (EN(5) && IN(s0 + 5)) { FRESH();
            pg8::Gemm g{ws + WS_AF8, ws + WS_WG + (size_t)l * E_WG * 2, D, 121, 125}; pg8::SchedStd S; S.init(nM, 16, F.G, opaque_s((int)blockIdx.x));
            pg8::EpiGate E{(const bf16*)(ws + WS_BO), (bf16*)(ws + WS_MM), KIN(12) + (size_t)l * 4 * D, F.lds + 131072};
            pg8::gemm_phase<pg8::EpiGate, pg8::SchedStd, true>(F.lds, g, S, E, F.tid);
        }
        SEAM(s0 + 5);
        if (EN(6) && IN(s0 + 6)) { FRESH();
            pg8::Gemm g{(const bf16*)(ws + WS_MM), (const bf16*)(ws + WS_WOUT) + (size_t)l * E_WOUT, D}; pg8::SchedStd S; S.init(nM, 4, F.G, opaque_s((int)blockIdx.x));
            pg8::EpiBf16 E{(bf16*)(ws + WS_Y), D};
            pg8::gemm_phase(F.lds, g, S, E, F.tid);
        }
        SEAM(s0 + 6);
        if (EN(7) && IN(s0 + 7)) { FRESH(); RowArgs A{}; A.post_g = KIN(7) + l * D; A.pre_g = KIN(8) + l * D; A.l = l; A.nrows = nrows; A.moe = moe ? 1 : 0;
            A.f8 = (F8MASK >> l) & 1; A.router_w = KIN(35) + (size_t)j2 * D * NE; A.router_b = KIN(36) + j2 * NE;
#if defined(PROBE_DRY) && (PROBE_DRY & 1)
            if ((PROBE_DRY_L >> l) & 1) { for (int rp_ = 0; rp_ < PROBE_DRY_N; ++rp_) { A.dry = 1; row_pass<1>(F, A); A.dry = 0; __syncthreads(); FRESH(); } }
#endif
            row_pass<1>(F, A); }
        SEAM(s0 + 7);
        if (moe) {
            if (EN(8) && IN(s0 + 8)) { FRESH(); moe_dispatch(F, nrows, (F8MASK >> l) & 1); }
            SEAM(s0 + 8);
            if (EN(9) && IN(s0 + 9)) { FRESH();
                const int* te = (const int*)(ws + WS_TILEE); const int nt = __builtin_amdgcn_readfirstlane(__hip_atomic_load(te + 400, RLX_AGENT));
                pg8::SchedMoe S; S.init(nt, 2 * FFE / 256, F.G, opaque_s((int)blockIdx.x), te);
                if ((F8MASK & 0xA) && ((F8MASK >> l) & 1)) {
                    pg8::Gemm g{ws + WS_FS, ws + WS_MGU + (size_t)j2 * NE * E_MGU * 2, D, 121, 125}; pg8::EpiSwiGLU8 E{ws + WS_GS, FFE};
                    pg8::gemm_phase<pg8::EpiSwiGLU8, pg8::SchedMoe, true>(F.lds, g, S, E, F.tid);
                } else if ((~F8MASK) & 0xA) {
                    pg8::Gemm g{ws + WS_FS, ws + WS_MGU + (size_t)j2 * NE * E_MGU * 2, D, 0, 0}; pg8::EpiSwiGLU E{(bf16*)(ws + WS_GS), FFE};
                    pg8::gemm_phase(F.lds, g, S, E, F.tid);
                }
            }
            SEAM(s0 + 9);
            if (EN(10) && IN(s0 + 10)) { FRESH();
                const int* te = (const int*)(ws + WS_TILEE); const int nt = __builtin_amdgcn_readfirstlane(__hip_atomic_load(te + 400, RLX_AGENT));
                pg8::SchedMoe S; S.init(nt, 4, F.G, opaque_s((int)blockIdx.x), te); pg8::EpiBf16 E{(bf16*)(ws + WS_YS), D};
                if ((F8MASK & 0xA) && ((F8MASK >> l) & 1)) {
                    pg8::Gemm g{ws + WS_GS, ws + WS_MWD + (size_t)j2 * NE * E_MWD * 2, FFE, 121, 124};
                    pg8::gemm_phase<pg8::EpiBf16, pg8::SchedMoe, true>(F.lds, g, S, E, F.tid);
                } else if ((~F8MASK) & 0xA) {
                    pg8::Gemm g{ws + WS_GS, ws + WS_MWD + (size_t)j2 * NE * E_MWD * 2, FFE, 0, 0};
                    pg8::gemm_phase(F.lds, g, S, E, F.tid);
                }
            }
            SEAM(s0 + 10);
        } else {
            if (EN(9) && IN(s0 + 9)) { FRESH();
                pg8::SchedStd S; S.init(nM, 2 * FFD / 256, F.G, opaque_s((int)blockIdx.x));
                if ((F8MASK & 0x5) && ((F8MASK >> l) & 1)) {
                    pg8::Gemm g{AF, ws + WS_WGU + (size_t)j2 * E_WGU * 2, D, 121, 125}; pg8::EpiSwiGLU8 E{ws + WS_G, FFD};
                    pg8::gemm_phase<pg8::EpiSwiGLU8, pg8::SchedStd, true>(F.lds, g, S, E, F.tid);
                } else if ((~F8MASK) & 0x5) {
                    pg8::Gemm g{AF, ws + WS_WGU + (size_t)j2 * E_WGU * 2, D, 0, 0}; pg8::EpiSwiGLU E{(bf16*)(ws + WS_G), FFD};
                    pg8::gemm_phase(F.lds, g, S, E, F.tid);
                }
            }
            SEAM(s0 + 9);
            if (EN(10) && IN(s0 + 10)) { FRESH();
                pg8::SchedStd S; S.init(nM, 4, F.G, opaque_s((int)blockIdx.x)); pg8::EpiBf16 E{(bf16*)(ws + WS_Y), D};
                if ((F8MASK & 0x5) && ((F8MASK >> l) & 1)) {
                    pg8::Gemm g{ws + WS_G, ws + WS_WD + (size_t)j2 * E_WD * 2, FFD, 121, 124};
                    pg8::gemm_phase<pg8::EpiBf16, pg8::SchedStd, true>(F.lds, g, S, E, F.tid);
                } else if ((~F8MASK) & 0x5) {
                    pg8::Gemm g{ws + WS_G, ws + WS_WD + (size_t)j2 * E_WD * 2, FFD, 0, 0};
                    pg8::gemm_phase(F.lds, g, S, E, F.tid);
                }
            }
            SEAM(s0 + 10);
        }
        if (EN(11) && IN(s0 + 11)) { FRESH(); RowArgs A{}; A.post_g = KIN(9) + l * D; A.pre_g = KIN(6) + (l + 1 < DEPTH ? l + 1 : l) * D; A.l = l; A.nrows = nrows; A.moe = moe ? 1 : 0; A.last = need_ctx ? 0 : 1; A.out = KOUT;
#if defined(PROBE_DRY) && (PROBE_DRY & 2)
            if ((PROBE_DRY_L >> l) & 1) { for (int rp_ = 0; rp_ < PROBE_DRY_N; ++rp_) { A.dry = 1; row_pass<2>(F, A); A.dry = 0; __syncthreads(); FRESH(); } }
#endif
            row_pass<2>(F, A); }
        if (l + 1 < DEPTH) SEAM(s0 + 11);
    }
#undef lp
#undef AF
#undef Z
#undef IN
#undef SEAM
}

#ifndef MK_LAUNCH_PER_STEP
#define MK_LAUNCH_PER_STEP 0
#endif
extern "C" void kernel_launch(void* const* d_in, const int* in_sizes, int n_in, void* d_out, int out_size, void* d_ws, size_t ws_size, hipStream_t stream) {
    static int grid = 0;
    if (grid == 0) {
        if (n_in != 39 || out_size != RL * D || ws_size < WS_END) { fprintf(stderr, "kernel_launch: unexpected shapes: n_in %d out %d ws %zu (need %zu)\n", n_in, out_size, ws_size, (size_t)WS_END); grid = -1; return; }
        int dev = 0, cus = 0, per_cu = 0;
        if (hipGetDevice(&dev) != hipSuccess || hipDeviceGetAttribute(&cus, hipDeviceAttributeMultiprocessorCount, dev) != hipSuccess) { grid = -1; return; }
        if (hipFuncSetAttribute((const void*)fwd_kernel, hipFuncAttributeMaxDynamicSharedMemorySize, LDS_BYTES) != hipSuccess) { fprintf(stderr, "kernel_launch: hipFuncSetAttribute failed\n"); grid = -1; return; }
        if (hipOccupancyMaxActiveBlocksPerMultiprocessor(&per_cu, (const void*)fwd_kernel, NWAVES * 64, LDS_BYTES) != hipSuccess || per_cu < 1) { fprintf(stderr, "kernel_launch: occupancy query says %d\n", per_cu); }
        (void)hipGetLastError();
        grid = cus;
    }
    if (grid < 0) return;
    if (hipMemsetAsync((char*)d_ws + WS_CTL, 0, CTL_ZERO_BYTES, stream) != hipSuccess) return;
    Args a{};
    for (int i = 0; i < 39; ++i) a.in[i] = (const float*)d_in[i];
    a.out = (float*)d_out; a.ws = (unsigned char*)d_ws;
#if MK_LAUNCH_PER_STEP
    for (int s = 0; s < NSTEPS; ++s) { a.s_lo = s; a.s_hi = s + 1;
        int rep = 1;
#ifdef PROBE_REP_MASK
        if (s >= 2) { const int j = (s - 2) % NSTEP_L, l = (s - 2) / NSTEP_L; if (((PROBE_REP_MASK) >> j) & 1 && ((PROBE_LAYER_MASK) >> l) & 1) rep = 2; } else if (((PROBE_REP_MASK) >> (12 + s)) & 1) rep = 2;
#endif
        for (int r = 0; r < rep; ++r) hipLaunchKernelGGL(fwd_kernel, dim3(grid), dim3(NWAVES * 64), LDS_BYTES, stream, a); }
#else
    a.s_lo = 0; a.s_hi = NSTEPS;
    hipLaunchKernelGGL(fwd_kernel, dim3(grid), dim3(NWAVES * 64), LDS_BYTES, stream, a);
#endif
    const hipError_t le = hipPeekAtLastError();
    if (le != hipSuccess) fprintf(stderr, "kernel_launch: launch failed: %s\n", hipGetErrorName(le));
}
```

```cpp
#include <hip/hip_runtime.h>
#include <cstdio>
#include <cstdint>

#define LAS __attribute__((address_space(3)))
#define GAS __attribute__((address_space(1)))
typedef unsigned short bf16;
typedef short bf16x8 __attribute__((ext_vector_type(8)));
typedef short s16x4 __attribute__((ext_vector_type(4)));
typedef float f32x4 __attribute__((ext_vector_type(4)));
typedef float f32x2 __attribute__((ext_vector_type(2)));
typedef float f32x16 __attribute__((ext_vector_type(16)));
typedef unsigned u32x4 __attribute__((ext_vector_type(4)));
typedef unsigned u32x2 __attribute__((ext_vector_type(2)));

constexpr int D = 1024, NB = 16, SEQ = 2048, NCTX = 256, DEPTH = 4;
constexpr int RL = NB * SEQ;
constexpr int RC = NB * NCTX;
constexpr int RT = RL + RC;
constexpr int NIN = 2304;
constexpr int ZW = 2048;
constexpr int ZQ_RQ = 0, ZQ_RK = 128, ZQ_RV = 256, ZQ_RG = 512, ZQ_SU = 768, ZQ_DQ = 1024, ZQ_DK = 1280, ZQ_DV = 1536, ZQ_CV = 1792;
constexpr int FFD = 2816, FFE = 3584, NE = 8;
constexpr int MOE_ROWS = 2 * RT + NE * 256;
constexpr int NCH = 18;
constexpr float EPS = 1e-6f;

__device__ __forceinline__ unsigned f2bf(float f) { unsigned u = __builtin_bit_cast(unsigned, f); return (u + 0x7fffu + ((u >> 16) & 1u)) >> 16; }
__device__ __forceinline__ unsigned pk2(float lo, float hi) { return f2bf(lo) | (f2bf(hi) << 16); }
__device__ __forceinline__ float bf2f(unsigned short b) { return __builtin_bit_cast(float, ((unsigned)b) << 16); }
__device__ __forceinline__ float bflo(unsigned w) { return __builtin_bit_cast(float, w << 16); }
__device__ __forceinline__ float bfhi(unsigned w) { return __builtin_bit_cast(float, w & 0xffff0000u); }
__device__ __forceinline__ unsigned cvt_pk_bf16(float lo, float hi) { unsigned r; asm volatile("v_cvt_pk_bf16_f32 %0, %1, %2" : "=v"(r) : "v"(lo), "v"(hi)); return r; }
__device__ __forceinline__ float sigmoidf_(float x) { return __builtin_amdgcn_rcpf(1.0f + __builtin_amdgcn_exp2f(-1.44269504f * x)); }
__device__ __forceinline__ float siluf_(float x) { return x * sigmoidf_(x); }
__device__ __forceinline__ float wave_sum(float v) {
#pragma unroll
    for (int o = 1; o < 64; o <<= 1) v += __shfl_xor(v, o);
    return v;
}
__device__ __forceinline__ float opaque_f(float x) { asm volatile("" : "+v"(x)); return x; }
__device__ __forceinline__ float sigk(float x, float k) { return __builtin_amdgcn_rcpf(1.0f + __builtin_amdgcn_exp2f(k * x)); }
__device__ __forceinline__ float silk(float x, float k) { return x * sigk(x, k); }
__device__ __forceinline__ int opaque_v(int x) { asm volatile("" : "+v"(x)); return x; }
__device__ __forceinline__ int opaque_s(int x) { asm volatile("" : "+s"(x)); return x; }
#define LDS_WAIT() asm volatile("s_waitcnt lgkmcnt(0)" ::: "memory")
#define VM_WAIT() asm volatile("s_waitcnt vmcnt(0)" ::: "memory")
namespace pg8 {
constexpr int BM = 256, BK = 64, HALF = 128, HTB = HALF * BK * 2  , STAGE_BYTES = 8 * HTB, NXCD = 8, WGM = 8;

__host__ __device__ __forceinline__ int lds_byte(int r, int c) { const int st = (r >> 4) * 2 + (c >> 5), rr = r & 15, cc = c & 31, ob = rr * 64 + cc * 2; return st * 1024 + (ob ^ (((ob >> 9) & 1) << 5)); }
__host__ __device__ __forceinline__ void stage_rc(int b, int& R, int& C) { const int st = b / 1024, sb = b % 1024, swz = sb ^ (((sb >> 9) & 1) << 5); R = (st >> 1) * 16 + swz / 64; C = (st & 1) * 32 + (swz % 64) / 2; }
__host__ __device__ __forceinline__ int perm32(int rho) { const int n = rho >> 4, i = rho & 15; return 8 * (i >> 2) + 4 * n + (i & 3); }

struct Unit { int pm, pn, am, bn, z; };
struct Gemm { const void* A; const void* Bt; int K; int sa, sb; };
typedef int v8i_t __attribute__((ext_vector_type(8))); typedef int v4i_t __attribute__((ext_vector_type(4)));

__device__ __forceinline__ void decode_tile(int wgid, int nM, int nN, int& pm, int& pn) {
    const int nwg = nM * nN;
    { const int q = nwg / NXCD, r = nwg % NXCD, xcd = wgid % NXCD, off = wgid / NXCD; wgid = (xcd < r ? xcd * (q + 1) : r * (q + 1) + (xcd - r) * q) + off; }
    const int nig = WGM * nN, gid = wgid / nig, fm = gid * WGM, gsz = (nM - fm) < WGM ? (nM - fm) : WGM;
    pm = fm + ((wgid % nig) % gsz); pn = (wgid % nig) / gsz;
}
struct SchedStd {
    int nM, nN, G, c, rev;
    __device__ __forceinline__ void init(int nM_, int nN_, int G_, int c_, int rev_ = 0) { nM = nM_; nN = nN_; G = G_; c = c_; rev = rev_; }
    __device__ __forceinline__ bool next(int i, Unit& u) const {
        const long L = (long)i * G + c; if (L >= (long)nM * nN) return false;
        decode_tile((int)L, nM, nN, u.pm, u.pn); if (rev) u.pm = nM - 1 - u.pm; u.am = u.pm; u.bn = u.pn; u.z = 0; return true;
    }
};
struct SchedWin {
    int G, c, mode;
    __device__ __forceinline__ void init(int G_, int c_, int mode_) { G = G_; c = c_; mode = mode_; }
    __device__ __forceinline__ bool next(int i, Unit& u) const {
        const int L = i * G + c; u.z = 0;
        if (mode == 1) { if (L >= 16) return false; u.pm = 128 + L; u.pn = 8; }
        else if (L < 1152) decode_tile(L, 128, 9, u.pm, u.pn);
        else if (mode == 0) { if (L >= 1280) return false; decode_tile(L - 1152, 16, 8, u.pm, u.pn); u.pm += 128; }
        else { if (L >= 1232) return false; int q; decode_tile(L - 1152, 16, 5, u.pm, q); u.pm += 128; u.pn = q < 2 ? q : (q == 2 ? 3 : q + 2); }
        u.am = u.pm; u.bn = u.pn; return true;
    }
};
struct SchedBr {
    int nM, G, c;
    __device__ __forceinline__ void init(int nM_, int G_, int c_) { nM = nM_; G = G_; c = c_; }
    __device__ __forceinline__ bool next(int i, Unit& u) const {
        const long L = (long)i * G + c; if (L >= (long)nM * 20) return false;
        int pm, pa; decode_tile((int)L, nM, 20, pm, pa);
        const int z = pa < 4 ? 0 : (pa < 12 ? 1 : (pa < 16 ? 2 : 3)), st = z == 0 ? 0 : (z == 1 ? 4 : (z == 2 ? 12 : 16));
        u.pm = pm; u.pn = pa - st; u.am = z * (RT / 256) + pm; u.bn = pa; u.z = z; return true;
    }
};
struct SchedGate {
    int nM, G, c;
    __device__ __forceinline__ void init(int nM_, int G_, int c_) { nM = nM_; G = G_; c = c_; }
    __device__ __forceinline__ bool next(int i, Unit& u) const {
        const long L = (long)(i >> 2) * G + c; if (L >= (long)nM * 4) return false;
        decode_tile((int)L, nM, 4, u.pm, u.pn); u.z = i & 3; u.am = u.pm; u.bn = u.z * 4 + u.pn; return true;
    }
};
struct SchedMoe {
    int nM, nN, G, c, rev; const int* tile_e;
    __device__ __forceinline__ void init(int nM_, int nN_, int G_, int c_, const int* te, int rev_ = 0) { nM = nM_; nN = nN_; G = G_; c = c_; tile_e = te; rev = rev_; }
    __device__ __forceinline__ bool next(int i, Unit& u) const {
        const long L = (long)i * G + c; if (L >= (long)nM * nN) return false;
        decode_tile((int)L, nM, nN, u.pm, u.pn); if (rev) u.pm = nM - 1 - u.pm; u.am = u.pm; u.z = 0;
        const int e = __builtin_amdgcn_readfirstlane(__hip_atomic_load(tile_e + u.pm, __ATOMIC_RELAXED, __HIP_MEMORY_SCOPE_AGENT));
        u.bn = e * nN + u.pn; return true;
    }
};

#define EPI_ROWS(...) _Pragma("unroll") for (int ai = 0; ai < 2; ++ai) _Pragma("unroll") for (int m = 0; m < 4; ++m) { const int row = u.pm * BM + wr * 64 + fr + ai * HALF + m * 16; _Pragma("unroll") for (int bj = 0; bj < 2; ++bj) { const f32x4 v0 = acc[ai][bj][m][0], v1 = acc[ai][bj][m][1]; const int cb = 128 * bj + 32 * wc + 8 * fq; __VA_ARGS__ } }
typedef GAS u32x4* gq4; typedef GAS u32x2* gq2; typedef const GAS u32x4* cgq4; typedef const GAS f32x4* cgf4;

struct EpiF32 {
    static constexpr bool PERM = false;
    float* C; int ldc;
    __device__ __forceinline__ void operator()(const f32x4 (&acc)[2][2][4][2], const Unit& u, int wr, int wc, int fr, int fq) const {
        const int row0 = u.pm * BM + wr * 64 + fr, col0 = u.pn * BM + wc * 32 + 4 * fq;
#pragma unroll
        for (int ai = 0; ai < 2; ++ai)
#pragma unroll
            for (int m = 0; m < 4; ++m) { GAS float* rowp = (GAS float*)C + (size_t)(row0 + ai * HALF + m * 16) * ldc + col0;
#pragma unroll
                for (int bj = 0; bj < 2; ++bj)
#pragma unroll
                    for (int n = 0; n < 2; ++n) *(GAS f32x4*)(rowp + bj * HALF + n * 16) = acc[ai][bj][m][n]; }
    }
};
struct EpiBf16 {
    static constexpr bool PERM = true;
    bf16* O; int ldc;
    __device__ __forceinline__ void operator()(const f32x4 (&acc)[2][2][4][2], const Unit& u, int wr, int wc, int fr, int fq) const {
        EPI_ROWS({ u32x4 w; w.x = cvt_pk_bf16(v0[0], v0[1]); w.y = cvt_pk_bf16(v0[2], v0[3]); w.z = cvt_pk_bf16(v1[0], v1[1]); w.w = cvt_pk_bf16(v1[2], v1[3]);
                   *(gq4)((GAS bf16*)O + (size_t)row * ldc + u.pn * BM + cb) = w; })
    }
};
struct EpiSwiGLU {
    static constexpr bool PERM = true;
    bf16* O; int ldc;
    __device__ __forceinline__ void operator()(const f32x4 (&acc)[2][2][4][2], const Unit& u, int wr, int wc, int fr, int fq) const {
        const float kq = opaque_f(-1.44269504f);
        EPI_ROWS({ u32x2 w; w.x = cvt_pk_bf16(silk(v0[0], kq) * v0[1], silk(v0[2], kq) * v0[3]); w.y = cvt_pk_bf16(silk(v1[0], kq) * v1[1], silk(v1[2], kq) * v1[3]);
                   *(gq2)((GAS bf16*)O + (size_t)row * ldc + ((u.pn * BM + cb) >> 1)) = w; })
    }
};
struct EpiSwiGLU8 {
    static constexpr bool PERM = true;
    unsigned char* O; int ldc;
    __device__ __forceinline__ void operator()(const f32x4 (&acc)[2][2][4][2], const Unit& u, int wr, int wc, int fr, int fq) const {
        const float kq = opaque_f(-1.44269504f), k8 = opaque_f(8.0f);
        EPI_ROWS({ unsigned w = 0; w = __builtin_amdgcn_cvt_pk_fp8_f32(k8 * silk(v0[0], kq) * v0[1], k8 * silk(v0[2], kq) * v0[3], w, false); w = __builtin_amdgcn_cvt_pk_fp8_f32(k8 * silk(v1[0], kq) * v1[1], k8 * silk(v1[2], kq) * v1[3], w, true);
                   *(GAS unsigned*)((GAS unsigned char*)O + (size_t)row * ldc + ((u.pn * BM + cb) >> 1)) = w; })
    }
};
struct EpiWin {
    static constexpr bool PERM = true;
    bf16* Z; const float* rope;
    __device__ __forceinline__ void operator()(const f32x4 (&acc)[2][2][4][2], const Unit& u, int wr, int wc, int fr, int fq) const {
        const float kq = opaque_f(-1.44269504f);
        GAS bf16* Zg = (GAS bf16*)Z;
        if (u.pn >= 7) {
            EPI_ROWS({ u32x2 w; w.x = cvt_pk_bf16(v0[0] * sigk(v0[1], kq), v0[2] * sigk(v0[3], kq)); w.y = cvt_pk_bf16(v1[0] * sigk(v1[1], kq), v1[2] * sigk(v1[3], kq));
                       *(gq2)(Zg + (size_t)row * ZW + ZQ_CV + (u.pn - 7) * 128 + (cb >> 1)) = w; })
        } else if ((u.pn == 4 || u.pn == 5) && u.pm < RL / 256) {
#pragma unroll
            for (int ai = 0; ai < 2; ++ai) {
                f32x4 c0[4], c1[4];
#pragma unroll
                for (int m = 0; m < 4; ++m) { const int row = u.pm * BM + wr * 64 + fr + ai * HALF + m * 16; cgf4 rp = (cgf4)((const GAS float*)rope + (size_t)(row & (SEQ - 1)) * 32 + fq * 8); c0[m] = rp[0]; c1[m] = rp[1]; }
#pragma unroll
                for (int m = 0; m < 4; ++m) { const int row = u.pm * BM + wr * 64 + fr + ai * HALF + m * 16;
#pragma unroll
                    for (int bj = 0; bj < 2; ++bj) { const f32x4 v0 = acc[ai][bj][m][0], v1 = acc[ai][bj][m][1]; const int cb = 128 * bj + 32 * wc + 8 * fq; const f32x4 a = c0[m], b = c1[m];
                        u32x4 w; w.x = cvt_pk_bf16(v0[0] * a[0] - v0[1] * a[1], v0[1] * a[0] + v0[0] * a[1]); w.y = cvt_pk_bf16(v0[2] * a[2] - v0[3] * a[3], v0[3] * a[2] + v0[2] * a[3]);
                        w.z = cvt_pk_bf16(v1[0] * b[0] - v1[1] * b[1], v1[1] * b[0] + v1[0] * b[1]); w.w = cvt_pk_bf16(v1[2] * b[2] - v1[3] * b[3], v1[3] * b[2] + v1[2] * b[3]);
                        *(gq4)(Zg + (size_t)row * ZW + u.pn * BM + cb) = w; } }
            }
        } else {
            EPI_ROWS({ u32x4 w; w.x = cvt_pk_bf16(v0[0], v0[1]); w.y = cvt_pk_bf16(v0[2], v0[3]); w.z = cvt_pk_bf16(v1[0], v1[1]); w.w = cvt_pk_bf16(v1[2], v1[3]);
                       *(gq4)(Zg + (size_t)row * ZW + u.pn * BM + cb) = w; })
        }
    }
};
struct EpiBr {
    static constexpr bool PERM = true;
    bf16* BO;
    __device__ __forceinline__ void operator()(const f32x4 (&acc)[2][2][4][2], const Unit& u, int wr, int wc, int fr, int fq) const {
        const float kq = opaque_f(-1.44269504f);
        GAS unsigned char* base = (GAS unsigned char*)((GAS bf16*)BO + (size_t)u.z * RT * D) + (size_t)u.pm * (128 * 256 * 16) + (size_t)((wr * 64 + fr) * 16);
        if (u.z == 1) {
            GAS unsigned char* lp = base + (size_t)(16 * u.pn + 2 * wc + (fq >> 1)) * 4096 + (fq & 1) * 8;
#pragma unroll
            for (int ai = 0; ai < 2; ++ai)
#pragma unroll
                for (int m = 0; m < 4; ++m)
#pragma unroll
                    for (int bj = 0; bj < 2; ++bj) { const f32x4 v0 = acc[ai][bj][m][0], v1 = acc[ai][bj][m][1];
                        u32x2 w; w.x = cvt_pk_bf16(v0[0] * sigk(v0[1], kq), v0[2] * sigk(v0[3], kq)); w.y = cvt_pk_bf16(v1[0] * sigk(v1[1], kq), v1[2] * sigk(v1[3], kq));
                        *(gq2)(lp + bj * (8 * 4096) + (ai * 128 + m * 16) * 16) = w; }
        } else {
            GAS unsigned char* lp = base + (size_t)(32 * u.pn + 4 * wc + fq) * 4096;
#pragma unroll
            for (int ai = 0; ai < 2; ++ai)
#pragma unroll
                for (int m = 0; m < 4; ++m)
#pragma unroll
                    for (int bj = 0; bj < 2; ++bj) { const f32x4 v0 = acc[ai][bj][m][0], v1 = acc[ai][bj][m][1];
                        u32x4 w; w.x = cvt_pk_bf16(v0[0], v0[1]); w.y = cvt_pk_bf16(v0[2], v0[3]); w.z = cvt_pk_bf16(v1[0], v1[1]); w.w = cvt_pk_bf16(v1[2], v1[3]);
                        *(gq4)(lp + bj * (16 * 4096) + (ai * 128 + m * 16) * 16) = w; }
        }
    }
};
struct EpiGate {
    static constexpr bool PERM = true;
    const bf16* BO; bf16* MM; const float* bgate; LAS unsigned char* xl;
    __device__ __forceinline__ void operator()(const f32x4 (&acc)[2][2][4][2], const Unit& u, int wr, int wc, int fr, int fq) const {
        const float kq = opaque_f(-1.44269504f); fr = opaque_v(fr); fq = opaque_v(fq);
        const int oc = u.pn * 64 + 32 * (wc & 1) + 8 * fq, zlo = wc >> 1, lane = fr + 16 * fq;
        const GAS unsigned char* bo0 = (const GAS unsigned char*)((const GAS bf16*)BO + (size_t)zlo * RT * D) + ((size_t)u.pm * 128 + (oc >> 3)) * (256 * 16); const GAS unsigned char* bo1 = bo0 + (size_t)2 * RT * D * 2; GAS bf16* mm = (GAS bf16*)MM + oc;
        f32x4 bs[2][2];
#pragma unroll
        for (int bj = 0; bj < 2; ++bj) { const GAS float* bg = (const GAS float*)bgate + (2 * bj + zlo) * D + oc; bs[bj][0] = *(cgf4)bg; bs[bj][1] = *(cgf4)(bg + 4); }
        LAS u32x4* xs = (LAS u32x4*)xl + ((wr * 2 + (wc & 1)) * 4) * 64 + lane;
#pragma unroll
        for (int ai = 0; ai < 2; ++ai) {
            u32x4 bw[4][2];
#pragma unroll
            for (int m = 0; m < 4; ++m) { const size_t ro = (size_t)(wr * 64 + fr + ai * HALF + m * 16) * 16; bw[m][0] = *(cgq4)(bo0 + ro); bw[m][1] = *(cgq4)(bo1 + ro); }
            float r[4][8];
#pragma unroll
            for (int m = 0; m < 4; ++m) {
#pragma unroll
                for (int j = 0; j < 8; ++j) r[m][j] = 0.f;
#pragma unroll
                for (int bj = 0; bj < 2; ++bj) { const f32x4 v0 = acc[ai][bj][m][0] + bs[bj][0], v1 = acc[ai][bj][m][1] + bs[bj][1]; const u32x4 b = bw[m][bj];
                    r[m][0] += sigk(v0[0], kq) * bflo(b.x); r[m][1] += sigk(v0[1], kq) * bfhi(b.x); r[m][2] += sigk(v0[2], kq) * bflo(b.y); r[m][3] += sigk(v0[3], kq) * bfhi(b.y);
                    r[m][4] += sigk(v1[0], kq) * bflo(b.z); r[m][5] += sigk(v1[1], kq) * bfhi(b.z); r[m][6] += sigk(v1[2], kq) * bflo(b.w); r[m][7] += sigk(v1[3], kq) * bfhi(b.w); }
            }
            if (wc >= 2) {
#pragma unroll
                for (int m = 0; m < 4; ++m) { u32x4 w; w.x = cvt_pk_bf16(r[m][0], r[m][1]); w.y = cvt_pk_bf16(r[m][2], r[m][3]); w.z = cvt_pk_bf16(r[m][4], r[m][5]); w.w = cvt_pk_bf16(r[m][6], r[m][7]); xs[m * 64] = w; }
            }
            asm volatile("s_waitcnt lgkmcnt(0)" ::: "memory"); __builtin_amdgcn_s_barrier(); asm volatile("" ::: "memory");
            if (wc < 2) {
#pragma unroll
                for (int m = 0; m < 4; ++m) { const u32x4 q = xs[m * 64]; const size_t ro = (size_t)(u.pm * BM + wr * 64 + fr + ai * HALF + m * 16) * D;
                    u32x4 w; w.x = cvt_pk_bf16(r[m][0] + bflo(q.x), r[m][1] + bfhi(q.x)); w.y = cvt_pk_bf16(r[m][2] + bflo(q.y), r[m][3] + bfhi(q.y));
                    w.z = cvt_pk_bf16(r[m][4] + bflo(q.z), r[m][5] + bfhi(q.z)); w.w = cvt_pk_bf16(r[m][6] + bflo(q.w), r[m][7] + bfhi(q.w));
                    *(gq4)(mm + ro) = w; }
            }
            if (ai == 0) { asm volatile("s_waitcnt lgkmcnt(0)" ::: "memory"); __builtin_amdgcn_s_barrier(); asm volatile("" ::: "memory"); }
        }
    }
};

template <class Epi, class Sched, bool F8 = false>
__device__ __forceinline__ void gemm_phase(LAS unsigned char* lds, const Gemm g, const Sched& S, const Epi& E, int tid_in) {
    const int tid = opaque_v(tid_in), wid = __builtin_amdgcn_readfirstlane(tid >> 6), lane = tid & 63, wr = wid >> 2, wc = wid & 3, fr = lane & 15, fq = lane >> 4;
    const int K = opaque_s(g.K), rowb = F8 ? K : 2 * K, nt = rowb / 128;
    unsigned voffA[2], voffB[2];
#pragma unroll
    for (int i = 0; i < 2; ++i) { int R, C; stage_rc(tid * 16 + i * 8192, R, C); const int Rb = Epi::PERM ? ((R & ~31) + perm32(R & 31)) : R;
        voffA[i] = (unsigned)(R * rowb + C * 2); voffB[i] = (unsigned)(Rb * rowb + C * 2); }
    const size_t kstep = (size_t)(BK * 2);
    const size_t hstep = (size_t)HALF * rowb;
    const size_t tstep = 2 * hstep;
    const unsigned ldsw = (unsigned)wid * 1024u;
    const int aoff = lds_byte(wr * 64 + fr, fq * 8), boff = lds_byte(wc * 32 + fr, fq * 8);
#define PG8_SA(b, h) (((b) * 2 + (h)) * HTB)
#define PG8_SB(b, h) ((4 + (b) * 2 + (h)) * HTB)
#define PG8_STAGE(bufoff, gbase, voff) do { _Pragma("unroll") for (int _i = 0; _i < 2; ++_i) \
        __builtin_amdgcn_global_load_lds((const unsigned*)((const char*)(gbase) + (voff)[_i]), (LAS unsigned*)(lds + (bufoff) + ldsw + _i * 8192), 16, 0, 0); } while (0)
#define PG8_LD1(off) (*(const LAS v4i_t*)(lds + (off)))
#define PG8_LDA(dst, b, h) do { if constexpr (F8) { _Pragma("unroll") for (int m = 0; m < 4; ++m) dst##8[m] = __builtin_shufflevector(PG8_LD1(PG8_SA(b, h) + aoff + m * 2048), PG8_LD1(PG8_SA(b, h) + aoff + m * 2048 + 1024), 0, 1, 2, 3, 4, 5, 6, 7); } \
        else { _Pragma("unroll") for (int m = 0; m < 4; ++m) _Pragma("unroll") for (int k = 0; k < 2; ++k) dst[m][k] = *(const LAS bf16x8*)(lds + PG8_SA(b, h) + aoff + m * 2048 + k * 1024); } } while (0)
#define PG8_LDB(dst, b, h) do { if constexpr (F8) { _Pragma("unroll") for (int n = 0; n < 2; ++n) dst##8[n] = __builtin_shufflevector(PG8_LD1(PG8_SB(b, h) + boff + n * 2048), PG8_LD1(PG8_SB(b, h) + boff + n * 2048 + 1024), 0, 1, 2, 3, 4, 5, 6, 7); } \
        else { _Pragma("unroll") for (int n = 0; n < 2; ++n) _Pragma("unroll") for (int k = 0; k < 2; ++k) dst[n][k] = *(const LAS bf16x8*)(lds + PG8_SB(b, h) + boff + n * 2048 + k * 1024); } } while (0)
#define PG8_MMA(ai, bj, At, Bt) do { __builtin_amdgcn_s_setprio(1); _Pragma("unroll") for (int m = 0; m < 4; ++m) _Pragma("unroll") for (int n = 0; n < 2; ++n) { \
        if constexpr (F8) { asm volatile("v_mfma_scale_f32_16x16x128_f8f6f4 %0, %1, %2, %0, %3, %4 op_sel_hi:[0,0,0]" : "+v"(acc[ai][bj][m][n]) : "v"(Bt##8[n]), "v"(At##8[m]), "v"(sclB), "v"(sclA)); } \
        else { _Pragma("unroll") for (int k = 0; k < 2; ++k) acc[ai][bj][m][n] = __builtin_amdgcn_mfma_f32_16x16x32_bf16(Bt[n][k], At[m][k], acc[ai][bj][m][n], 0, 0, 0); } } \
        __builtin_amdgcn_s_setprio(0); } while (0)
#define PG8_WAIT_V(n) asm volatile("s_waitcnt vmcnt(" #n ")" ::: "memory")
#define PG8_WAIT_L(n) asm volatile("s_waitcnt lgkmcnt(" #n ")" ::: "memory")
#define PG8_BAR __builtin_amdgcn_s_barrier()
#define PG8_SCHED __builtin_amdgcn_sched_barrier(0)
    const int sclB = g.sa * 0x01010101, sclA = g.sb * 0x01010101;
    Unit cur, nxt; int ui = 0;
    if (!S.next(0, cur)) return;
#ifndef GEMM_STAGGER
#define GEMM_STAGGER 0
#endif
    if (GEMM_STAGGER) {
        const unsigned long long t0 = __builtin_amdgcn_s_memrealtime(); const unsigned long long dl = (unsigned long long)(((blockIdx.x >> 3) & 3) * ((K >> 6) * 29 + 350));
        while (__builtin_amdgcn_s_memrealtime() - t0 < dl) __builtin_amdgcn_s_sleep(16);
    }
    f32x4 acc[2][2][4][2];
#pragma unroll
    for (int a = 0; a < 2; ++a)
#pragma unroll
        for (int b = 0; b < 2; ++b)
#pragma unroll
            for (int m = 0; m < 4; ++m)
#pragma unroll
                for (int n = 0; n < 2; ++n) acc[a][b][m][n] = (f32x4){0.f, 0.f, 0.f, 0.f};
    bf16x8 At[4][2], B0[2][2], B1[2][2]; v8i_t At8[4], B08[2], B18[2];
    const char* cA = (const char*)g.A + (size_t)cur.am * tstep; const char* cB = (const char*)g.Bt + (size_t)cur.bn * tstep;
    PG8_STAGE(PG8_SB(0, 0), cB, voffB); PG8_STAGE(PG8_SB(0, 1), cB + hstep, voffB); PG8_STAGE(PG8_SA(0, 0), cA, voffA); PG8_STAGE(PG8_SA(0, 1), cA + hstep, voffA);
    if (wr == 1) PG8_BAR;
    PG8_WAIT_V(2); PG8_BAR;
    PG8_STAGE(PG8_SB(1, 0), cB + kstep, voffB); PG8_STAGE(PG8_SA(1, 0), cA + kstep, voffA); PG8_STAGE(PG8_SB(1, 1), cB + hstep + kstep, voffB);
    PG8_WAIT_V(6); PG8_BAR;
    for (;;) {
        const bool has_next = S.next(ui + 1, nxt);
        const char* nA = has_next ? (const char*)g.A + (size_t)nxt.am * tstep : cA; const char* nB = has_next ? (const char*)g.Bt + (size_t)nxt.bn * tstep : cB;
        for (int t = 0; t < nt; t += 2) {
            const bool last = (t == nt - 2);
            const char* a1 = cA + (size_t)(t + 1) * kstep;
            const char* a2 = last ? nA : cA + (size_t)(t + 2) * kstep; const char* b2 = last ? nB : cB + (size_t)(t + 2) * kstep;
            const char* a3 = a2 + kstep; const char* b3 = b2 + kstep;
            PG8_LDB(B0, 0, 0); PG8_LDB(B1, 0, 1); PG8_SCHED; PG8_LDA(At, 0, 0); PG8_STAGE(PG8_SA(1, 1), a1 + hstep, voffA);
            PG8_WAIT_V(8); PG8_WAIT_L(0); PG8_BAR; PG8_MMA(0, 0, At, B0); PG8_MMA(0, 1, At, B1); PG8_BAR; PG8_SCHED;
            PG8_LDA(At, 0, 1); PG8_STAGE(PG8_SB(0, 0), b2, voffB); PG8_STAGE(PG8_SB(0, 1), b2 + hstep, voffB); PG8_STAGE(PG8_SA(0, 0), a2, voffA);
            PG8_WAIT_V(8); PG8_WAIT_L(0); PG8_BAR; PG8_MMA(1, 0, At, B0); PG8_MMA(1, 1, At, B1); PG8_BAR; PG8_SCHED;
            PG8_LDB(B0, 1, 0); PG8_LDB(B1, 1, 1); PG8_SCHED; PG8_LDA(At, 1, 0); PG8_STAGE(PG8_SA(0, 1), a2 + hstep, voffA);
            PG8_WAIT_V(8); PG8_WAIT_L(0); PG8_BAR; PG8_MMA(0, 0, At, B0); PG8_MMA(0, 1, At, B1); PG8_BAR; PG8_SCHED;
            PG8_LDA(At, 1, 1); PG8_STAGE(PG8_SB(1, 0), b3, voffB); PG8_STAGE(PG8_SB(1, 1), b3 + hstep, voffB); PG8_STAGE(PG8_SA(1, 0), a3, voffA);
            PG8_WAIT_V(8); PG8_WAIT_L(0); PG8_BAR; PG8_MMA(1, 0, At, B0); PG8_MMA(1, 1, At, B1); PG8_BAR; PG8_SCHED;
        }
        if (wr == 0) PG8_BAR;
        if constexpr (F8) asm volatile("s_nop 15\n\ts_nop 15" ::: "memory");
        E(acc, cur, wr, wc, fr, fq);
        if (!has_next) break;
#pragma unroll
        for (int a = 0; a < 2; ++a)
#pragma unroll
            for (int b = 0; b < 2; ++b)
#pragma unroll
                for (int m = 0; m < 4; ++m)
#pragma unroll
                    for (int n = 0; n < 2; ++n) acc[a][b][m][n] = (f32x4){0.f, 0.f, 0.f, 0.f};
        cur = nxt; cA = nA; cB = nB; ++ui;
        if (wr == 1) PG8_BAR;
    }
    PG8_WAIT_V(0);
    PG8_BAR;
#undef PG8_SA
#undef PG8_SB
#undef PG8_STAGE
#undef PG8_LD1
#undef PG8_LDA
#undef PG8_LDB
#undef PG8_MMA
#undef PG8_WAIT_V
#undef PG8_WAIT_L
#undef PG8_BAR
#undef PG8_SCHED
}
}
constexpr size_t al256(size_t x) { return (x + 255) & ~(size_t)255; }
constexpr size_t WS_CTL = 0, CTL_ZERO_BYTES = 1u << 20;
constexpr size_t E_WIN = (size_t)NIN * D, E_WG = (size_t)4 * D * D, E_WBR = (size_t)5120 * 256, E_WOUT = (size_t)D * D;
constexpr size_t E_WGU = (size_t)2 * FFD * D, E_WD = (size_t)D * FFD, E_MGU = (size_t)2 * FFE * D, E_MWD = (size_t)D * FFE;
constexpr size_t WS_WIN = CTL_ZERO_BYTES;
constexpr size_t WS_WG = WS_WIN + 2 * DEPTH * E_WIN;
constexpr size_t WS_WBR = WS_WG + 2 * DEPTH * E_WG;
constexpr size_t WS_WOUT = WS_WBR + 2 * DEPTH * E_WBR;
constexpr size_t WS_WGU = WS_WOUT + 2 * DEPTH * E_WOUT;
constexpr size_t WS_WD = WS_WGU + 2 * 2 * E_WGU;
constexpr size_t WS_MGU = WS_WD + 2 * 2 * E_WD;
constexpr size_t WS_MWD = WS_MGU + 2 * 2 * NE * E_MGU;
constexpr size_t WS_WEND = WS_MWD + 2 * 2 * NE * E_MWD;
constexpr size_t WS_MODS = al256(WS_WEND);
constexpr size_t WS_ROPE = WS_MODS + al256((size_t)DEPTH * 17 * 6 * D * 4);
constexpr size_t S5P_ABAR = 0, S5P_A128 = 16384, S5P_BP = 32768, S5P_CH = S5P_BP + 2 * 16 * 128 * 16 * 2, S5P_BYTES = S5P_CH + 16 * 16 * 128 * 2;
constexpr size_t WS_S5P = WS_ROPE + (size_t)SEQ * 32 * 4;
constexpr size_t WS_LAYP = WS_S5P + DEPTH * S5P_BYTES;
constexpr size_t WS_RETSUM = al256(WS_LAYP + DEPTH * 64 * 4);
constexpr size_t WS_RETST = WS_RETSUM + (size_t)NB * NCH * 2 * 4 * 2048 * 4;
constexpr size_t WS_S5E = WS_RETST + (size_t)NB * NCH * 2 * 4 * 2048 * 2;
constexpr size_t WS_S5C = WS_S5E + (size_t)NB * NCH * 16 * 2 * 64 * 8;
constexpr size_t WS_REC = WS_S5C + (size_t)NB * NCH * 16 * 2 * 64 * 8;
constexpr size_t WS_HIST = WS_REC + (size_t)RT * 32;
constexpr size_t WS_TILEE = WS_HIST + 256 * 8 * 4;
constexpr size_t WS_H = al256(WS_TILEE + 512 * 4);
constexpr size_t WS_AF = WS_H + (size_t)RT * D * 4;
constexpr size_t WS_AF8 = WS_AF + (size_t)RT * D * 2;
constexpr size_t WS_RA = WS_AF8 + (size_t)RT * D;
constexpr size_t WS_Z = WS_RA;
constexpr size_t WS_XB = WS_Z + (size_t)RT * ZW * 2;
constexpr size_t WS_BO = WS_XB + (size_t)4 * RT * 256 * 2;
constexpr size_t WS_MM = WS_BO + (size_t)4 * RT * D * 2;
constexpr size_t WS_Y = WS_MM + (size_t)RT * D * 2;
constexpr size_t WS_RA_END = WS_Y + (size_t)RT * D * 4;
constexpr size_t WS_G = WS_RA;
constexpr size_t WS_FS = WS_RA;
constexpr size_t WS_GS = WS_FS + (size_t)MOE_ROWS * D * 2;
constexpr size_t WS_YS = WS_GS + (size_t)MOE_ROWS * FFE * 2;
constexpr size_t WS_RB_END = WS_YS + (size_t)MOE_ROWS * D * 2;
constexpr size_t WS_END = WS_RA_END > WS_RB_END ? WS_RA_END : WS_RB_END;
static_assert(WS_G + (size_t)RT * FFD * 2 <= WS_Y, "dense hidden must not reach Y");
constexpr int CW_DEP = 12288;
constexpr int CW_BAR = 4096;

constexpr int SCRATCH_BYTES = 153600;
constexpr int LDSCTL_OFF = SCRATCH_BYTES, MISC_OFF = LDSCTL_OFF + 320;
constexpr int LDS_BYTES = 155648;
constexpr int NWAVES = 8;

typedef GAS unsigned gu32;
#define RLX_AGENT __ATOMIC_RELAXED, __HIP_MEMORY_SCOPE_AGENT

#define XB_TMO      128
#define XB_XCNT(j)  (256  + 64 * (j))
#define XB_XSUB(j)  (1280 + 64 * (j))
#define XB_XGEN(j)  (2304 + 64 * (j))
#define XB_TOP      3328
#define XB_TOPGEN   3392
#define XCD_BAR_WORDS 3456
#define XB_SPIN_CAP (1u << 20)

__device__ __forceinline__ unsigned xb_ld(unsigned* p)              { return __hip_atomic_load(p, __ATOMIC_RELAXED, __HIP_MEMORY_SCOPE_AGENT); }
__device__ __forceinline__ unsigned xb_add(unsigned* p, unsigned v) { return __hip_atomic_fetch_add(p, v, __ATOMIC_RELAXED, __HIP_MEMORY_SCOPE_AGENT); }
__device__ __forceinline__ unsigned xb_xcc_id() { return (unsigned)__builtin_amdgcn_s_getreg((3 << 11) | 20) & 0xFu; }
#define XB_SPIN(cond, bar) do { unsigned _sp = 0; while (cond) { __builtin_amdgcn_s_sleep(1); \
    if ((++_sp & 255u) == 0u) { if (xb_ld(&(bar)[XB_TMO])) break; if (_sp > XB_SPIN_CAP) { atomicAdd(&(bar)[XB_TMO], 1u); break; } } } } while (0)

struct XcdBarrier {
    unsigned* bar; unsigned x;
    volatile LAS unsigned* st;
};
__device__ __forceinline__ XcdBarrier xcd_barrier_post(unsigned* bar, volatile LAS unsigned* st, int tid) {
    XcdBarrier b; b.bar = bar; b.x = xb_xcc_id(); b.st = st;
    if (tid == 0) (void)xb_add(&bar[XB_XCNT(b.x)], 1u);
    return b;
}
__device__ __forceinline__ void xcd_barrier_complete(unsigned* bar, unsigned x, unsigned& nloc, unsigned& nx) {
    const unsigned G = gridDim.x * gridDim.y * gridDim.z;
    unsigned sum, cnt, mine, sp = 0u;
    for (;;) {
        sum = 0u; cnt = 0u; mine = 0u;
#pragma unroll
        for (unsigned j = 0; j < 16; ++j) { const unsigned c = xb_ld(&bar[XB_XCNT(j)]); sum += c; cnt += (c > 0u) ? 1u : 0u; mine = (j == x) ? c : mine; }
        if (sum == G) break;
        __builtin_amdgcn_s_sleep(1);
        if ((++sp & 255u) == 0u) { if (xb_ld(&bar[XB_TMO])) break; if (sp > XB_SPIN_CAP) { atomicAdd(&bar[XB_TMO], 1u); break; } }
    }
    nloc = mine > 0u ? mine : 1u; nx = cnt > 0u ? cnt : 1u;
}
__device__ __forceinline__ void xcd_barrier(const XcdBarrier& b, int tid) {
    asm volatile("s_waitcnt vmcnt(0)" ::: "memory");
    __syncthreads();
    if (tid == 0) {
        unsigned* bar = b.bar;
        __builtin_amdgcn_s_waitcnt(0);
        unsigned nloc = b.st[0], nx = b.st[1];
        if (nloc == 0u) { xcd_barrier_complete(bar, b.x, nloc, nx); b.st[0] = nloc; b.st[1] = nx; }
        const unsigned old = xb_add(&bar[XB_XSUB(b.x)], 1u);
        const unsigned gen = old / nloc;
        if (old + 1u == (gen + 1u) * nloc) {
            __builtin_amdgcn_fence(__ATOMIC_RELEASE, "agent");
            asm volatile("s_waitcnt vmcnt(0)" ::: "memory");
            const unsigned og = xb_add(&bar[XB_TOP], 1u);
            const unsigned tg = og / nx;
            if (og + 1u == (tg + 1u) * nx) xb_add(&bar[XB_TOPGEN], 1u);
            else XB_SPIN(xb_ld(&bar[XB_TOPGEN]) == tg, bar);
            __builtin_amdgcn_fence(__ATOMIC_ACQUIRE, "agent");
            xb_add(&bar[XB_XGEN(b.x)], 1u);
            asm volatile("s_waitcnt vmcnt(0)" ::: "memory");
        } else {
            XB_SPIN(xb_ld(&bar[XB_XGEN(b.x)]) == gen, bar);
            __builtin_amdgcn_fence(__ATOMIC_ACQUIRE, "agent");
            asm volatile("s_waitcnt vmcnt(0)" ::: "memory");
        }
    }
    __syncthreads();
}

struct Frame {
    LAS unsigned char* lds;
    volatile LAS unsigned* MISC;
    int tid, lane, wave;
    int vcu, G;
    unsigned char* ws;
};

__device__ __forceinline__ void dep_signal(Frame& F, unsigned* ctr, unsigned n) {
    asm volatile("s_waitcnt vmcnt(0)" ::: "memory");
    __syncthreads();
    if (F.tid == 0) { __builtin_amdgcn_fence(__ATOMIC_RELEASE, "agent"); asm volatile("s_waitcnt vmcnt(0)" ::: "memory"); (void)xb_add(ctr, n); }
}
__device__ __forceinline__ void dep_wait(Frame& F, unsigned* ctr, unsigned target) {
    if (F.tid == 0) { unsigned sp = 0u; while (xb_ld(ctr) < target) { __builtin_amdgcn_s_sleep(2); if (++sp > (1u << 22)) break; }
        __builtin_amdgcn_fence(__ATOMIC_ACQUIRE, "agent"); asm volatile("s_waitcnt vmcnt(0)" ::: "memory"); }
    __syncthreads();
}
__device__ __forceinline__ int permqk(int c) { const int hm = c >> 5, d = c & 31, axis = d >> 4, half = (d >> 3) & 1, f = d & 7; return hm * 32 + axis * 16 + f * 2 + half; }
__device__ __forceinline__ int win_dest(int n, float& sc) {
    sc = 1.0f;
    if (n < 128) { sc = 0.17677669529663687f; return 128 + n; }
    if (n < 384) return 256 + (n - 128);
    if (n < 640) return 768 + (n - 384);
    if (n < 896) return 1280 + permqk(n - 640);
    if (n < 1152) return 1536 + (n - 896);
    if (n < 1280) return n - 1152;
    if (n < 1536) return 512 + (n - 1280);
    if (n < 1792) { sc = 0.17677669529663687f; return 1024 + permqk(n - 1536); }
    const int j = (n - 1792) & 255, half = (n - 1792) >> 8; return 1792 + 2 * j + half;
}
template <int MODE, bool OUT8 = false>
__device__ __forceinline__ void transpose_item(const float* __restrict__ W, int K, int N, bf16* WT, int row_off, LAS float* scr, int item, int lane) {
    const int nblk = N / 32, kb = item / nblk, nb = item % nblk, k0 = 64 * kb, n0 = 32 * nb;
    float wreg[32];
#pragma unroll
    for (int i = 0; i < 32; ++i) { const int kk = 2 * i + (lane >> 5); wreg[i] = __builtin_nontemporal_load(W + (size_t)(k0 + kk) * N + n0 + (lane & 31)); }
#pragma unroll
    for (int i = 0; i < 32; ++i) { const int kk = 2 * i + (lane >> 5); scr[kk * 33 + (lane & 31)] = wreg[i]; }
    LDS_WAIT(); asm volatile("" ::: "memory");
    const int c = lane & 7;
#pragma unroll
    for (int j = 0; j < 4; ++j) { const int n = (lane >> 3) + 8 * j; const LAS float* s = scr + (8 * c) * 33 + n;
        int dr; float sc = 1.0f; const int ng = n0 + n;
        if (MODE == 0) dr = row_off + ng; else if (MODE == 3) dr = ((ng >> 6) << 8) + row_off + (ng & 63); else if (MODE == 1) { const int Hh = N >> 1; dr = row_off + 2 * (ng % Hh) + ng / Hh; } else dr = win_dest(ng, sc);
        if (OUT8) { unsigned w0 = 0, w1 = 0;
            w0 = __builtin_amdgcn_cvt_pk_fp8_f32(64.f * s[0 * 33], 64.f * s[1 * 33], w0, false); w0 = __builtin_amdgcn_cvt_pk_fp8_f32(64.f * s[2 * 33], 64.f * s[3 * 33], w0, true);
            w1 = __builtin_amdgcn_cvt_pk_fp8_f32(64.f * s[4 * 33], 64.f * s[5 * 33], w1, false); w1 = __builtin_amdgcn_cvt_pk_fp8_f32(64.f * s[6 * 33], 64.f * s[7 * 33], w1, true);
            *(u32x2*)((unsigned char*)WT + (size_t)dr * K + k0 + 8 * c) = (u32x2){w0, w1}; }
        else { u32x4 o; o.x = pk2(s[0 * 33] * sc, s[1 * 33] * sc); o.y = pk2(s[2 * 33] * sc, s[3 * 33] * sc); o.z = pk2(s[4 * 33] * sc, s[5 * 33] * sc); o.w = pk2(s[6 * 33] * sc, s[7 * 33] * sc);
        *(u32x4*)(WT + (size_t)dr * K + k0 + 8 * c) = o; } }
    LDS_WAIT(); asm volatile("" ::: "memory");
}
__device__ __forceinline__ void sincos_d(double x, double& s, double& c) {
    const double tp = 6.283185307179586476925287; x -= tp * rint(x / tp);
    const double x2 = x * x; double cs = 1.0, sn = 1.0;
    double tc = 1.0, ts = 1.0; cs = 1.0; sn = 1.0;
#pragma unroll
    for (int k = 1; k <= 17; ++k) { tc *= -x2 / (double)((2 * k - 1) * (2 * k)); ts *= -x2 / (double)((2 * k) * (2 * k + 1)); cs += tc; sn += ts; }
    s = sn * x; c = cs;
}

struct P0Args {
    const float *c, *c_ctx, *ada_w, *ada_b, *w_in, *w_gate, *ret_w_o, *s5_w_glu, *diff_w_o, *conv_w_o, *w_out, *ffn_w_gu, *ffn_w_d, *moe_w_gu, *moe_w_d;
    int f8mask;
    const float *ret_decay, *s5_a_re, *s5_a_im, *s5_log_dt, *s5_b_re, *s5_b_im, *s5_c_re, *s5_c_im, *diff_lambda;
};
__device__ __forceinline__ void p0_prologue(Frame& F, const P0Args& P) {
    unsigned char* ws = F.ws;
    {
        LAS float* scr = (LAS float*)(F.lds + F.wave * 8448);
        const int gw = F.vcu * NWAVES + F.wave, NGW = F.G * NWAVES;
        constexpr int I_WIN = 16 * (NIN / 32), I_WG = 16 * 32, I_BR1 = 4 * 32, I_BR2 = 4 * 64, I_WOUT = 16 * 32;
        constexpr int I_LAYER = I_WIN + 4 * I_WG + I_BR1 + I_BR2 + I_BR1 + I_BR1 + I_WOUT;
        constexpr int I_GU = 16 * (2 * FFD / 32), I_DD = (FFD / 64) * 32, I_DENSE = I_GU + I_DD;
        constexpr int I_MGU = 16 * (2 * FFE / 32), I_MD = (FFE / 64) * 32, I_EXP = I_MGU + I_MD;
        constexpr int NITEMS = DEPTH * I_LAYER + 2 * I_DENSE + 2 * NE * I_EXP;
        for (int it = gw; it < NITEMS; it += NGW) {
            int r = it;
            if (r < DEPTH * I_LAYER) {
                const int l = r / I_LAYER; r -= l * I_LAYER;
                if (r < I_WIN) { transpose_item<2>(P.w_in + (size_t)l * D * NIN, D, NIN, (bf16*)(ws + WS_WIN) + (size_t)l * E_WIN, 0, scr, r, F.lane); continue; } r -= I_WIN;
                if (r < 4 * I_WG) { const int z = r / I_WG; transpose_item<3, true>(P.w_gate + ((size_t)l * 4 + z) * D * D, D, D, (bf16*)(ws + WS_WG) + (size_t)l * E_WG, z * 64, scr, r % I_WG, F.lane); continue; } r -= 4 * I_WG;
                bf16* wbr = (bf16*)(ws + WS_WBR) + (size_t)l * E_WBR;
                if (r < I_BR1) { transpose_item<0>(P.ret_w_o + (size_t)l * 256 * D, 256, D, wbr, 0, scr, r, F.lane); continue; } r -= I_BR1;
                if (r < I_BR2) { transpose_item<1>(P.s5_w_glu + (size_t)l * 256 * 2 * D, 256, 2 * D, wbr, 1024, scr, r, F.lane); continue; } r -= I_BR2;
                if (r < I_BR1) { transpose_item<0>(P.diff_w_o + (size_t)l * 256 * D, 256, D, wbr, 3072, scr, r, F.lane); continue; } r -= I_BR1;
                if (r < I_BR1) { transpose_item<0>(P.conv_w_o + (size_t)l * 256 * D, 256, D, wbr, 4096, scr, r, F.lane); continue; } r -= I_BR1;
                transpose_item<0>(P.w_out + (size_t)l * D * D, D, D, (bf16*)(ws + WS_WOUT) + (size_t)l * E_WOUT, 0, scr, r, F.lane); continue;
            }
            r -= DEPTH * I_LAYER;
            if (r < 2 * I_DENSE) {
                const int j = r / I_DENSE; r -= j * I_DENSE;
                const bool f8 = (P.f8mask >> (2 * j)) & 1; bf16* wgu = (bf16*)(ws + WS_WGU + (size_t)j * E_WGU * 2); bf16* wd = (bf16*)(ws + WS_WD + (size_t)j * E_WD * 2);
                if (r < I_GU) { if (f8) transpose_item<1, true>(P.ffn_w_gu + (size_t)j * D * 2 * FFD, D, 2 * FFD, wgu, 0, scr, r, F.lane); else transpose_item<1, false>(P.ffn_w_gu + (size_t)j * D * 2 * FFD, D, 2 * FFD, wgu, 0, scr, r, F.lane); continue; } r -= I_GU;
                if (f8) transpose_item<0, true>(P.ffn_w_d + (size_t)j * FFD * D, FFD, D, wd, 0, scr, r, F.lane); else transpose_item<0, false>(P.ffn_w_d + (size_t)j * FFD * D, FFD, D, wd, 0, scr, r, F.lane); continue;
            }
            r -= 2 * I_DENSE;
            { const int je = r / I_EXP; r -= je * I_EXP;
              const int jj = je >> 3, ee = je & 7; const bool f8 = (P.f8mask >> (2 * jj + 1)) & 1; const size_t esz = f8 ? 1 : 2;
              bf16* wgu = (bf16*)(ws + WS_MGU + (size_t)jj * NE * E_MGU * 2 + (size_t)ee * E_MGU * esz); bf16* wd = (bf16*)(ws + WS_MWD + (size_t)jj * NE * E_MWD * 2 + (size_t)ee * E_MWD * esz);
              if (r < I_MGU) { if (f8) transpose_item<1, true>(P.moe_w_gu + (size_t)je * D * 2 * FFE, D, 2 * FFE, wgu, 0, scr, r, F.lane); else transpose_item<1, false>(P.moe_w_gu + (size_t)je * D * 2 * FFE, D, 2 * FFE, wgu, 0, scr, r, F.lane); continue; } r -= I_MGU;
              if (f8) transpose_item<0, true>(P.moe_w_d + (size_t)je * FFE * D, FFE, D, wd, 0, scr, r, F.lane); else transpose_item<0, false>(P.moe_w_d + (size_t)je * FFE * D, FFE, D, wd, 0, scr, r, F.lane); }
        }
    }
    __syncthreads();
    {
        LAS float* sc = (LAS float*)F.lds;
        LAS float* part = (LAS float*)(F.lds + 17 * 1024 * 4);
        for (int i = F.tid; i < 17 * D; i += 512) { const int r = i >> 10, k = i & 1023; const float v = r < 16 ? P.c[r * D + k] : P.c_ctx[k]; sc[i] = v / (1.0f + __expf(-v)); }
        __syncthreads();
        float* mods = (float*)(ws + WS_MODS);
        for (int u = F.vcu; u < DEPTH * 96; u += F.G) {
            const int l = u / 96, n0 = (u % 96) * 64;
            const float* w = P.ada_w + (size_t)l * D * 6 * D + n0 + F.lane;
            float acc[17];
#pragma unroll
            for (int r = 0; r < 17; ++r) acc[r] = 0.f;
            const int kb = F.wave * 128;
#pragma unroll 2
            for (int k4 = 0; k4 < 128; k4 += 4) {
                float wv[4];
#pragma unroll
                for (int j = 0; j < 4; ++j) wv[j] = w[(size_t)(kb + k4 + j) * 6 * D];
#pragma unroll
                for (int r = 0; r < 17; ++r) { const f32x4 s = *(const LAS f32x4*)(sc + r * 1024 + kb + k4); acc[r] += wv[0] * s[0] + wv[1] * s[1] + wv[2] * s[2] + wv[3] * s[3]; }
            }
#pragma unroll
            for (int r = 0; r < 17; ++r) part[(F.wave * 17 + r) * 64 + F.lane] = acc[r];
            __syncthreads();
            for (int i = F.tid; i < 17 * 64; i += 512) { float s = 0.f;
#pragma unroll
                for (int w8 = 0; w8 < 8; ++w8) s += part[w8 * 17 * 64 + i];
                const int r = i >> 6, n = n0 + (i & 63); mods[((size_t)l * 17 + r) * 6 * D + n] = s + P.ada_b[(size_t)l * 6 * D + n]; }
            __syncthreads();
        }
    }
    {
        const int gt = F.vcu * 512 + F.tid, NGT = F.G * 512;
        float* rope = (float*)(ws + WS_ROPE);
        for (int i = gt; i < SEQ * 16; i += NGT) { const int t = i >> 4, pi = i & 15, axis = pi >> 3, f = pi & 7;
            const float inv = exp2f(-(float)f * (13.287712379549449f / 8.0f));
            const float ang = (float)(axis ? (t & 63) : (t >> 6)) * inv; float s, c; sincosf(ang, &s, &c); rope[2 * i] = c; rope[2 * i + 1] = s; }
        for (int i = gt; i < DEPTH * 2048; i += NGT) {
            const int l = i >> 11, d = (i >> 10) & 1, g = (i >> 6) & 15, p = i & 63;
            unsigned char* sp = ws + WS_S5P + (size_t)l * S5P_BYTES;
            const float are = fminf(P.s5_a_re[i], -1e-4f), aim = P.s5_a_im[i];
            const float dt = expf(P.s5_log_dt[(l * 2 + d) * 16 + g]);
            const float zre = dt * are; const double zim = (double)dt * (double)aim;
            double sn, cs; sincos_d(zim, sn, cs);
            const float mag = expf(zre), abre = mag * (float)cs, abim = mag * (float)sn;
            double sn2, cs2; sincos_d(128.0 * zim, sn2, cs2); const float mag2 = expf(128.0f * zre);
            ((f32x2*)(sp + S5P_ABAR))[i & 2047] = (f32x2){abre, abim};
            ((f32x2*)(sp + S5P_A128))[i & 2047] = (f32x2){mag2 * (float)cs2, mag2 * (float)sn2};
            const float den = are * are + aim * aim, nre = abre - 1.0f;
            const float cfre = (nre * are + abim * aim) / den, cfim = (abim * are - nre * aim) / den;
            const float* bre = P.s5_b_re + (((size_t)l * 16 + g) * 64 + p) * 16; const float* bim = P.s5_b_im + (((size_t)l * 16 + g) * 64 + p) * 16;
            bf16* bp = (bf16*)(sp + S5P_BP) + (((size_t)d * 16 + g) * 128 + 2 * p) * 16;
#pragma unroll
            for (int c = 0; c < 16; ++c) { const float br = bre[c], bi = bim[c]; bp[c] = (bf16)f2bf(cfre * br - cfim * bi); bp[16 + c] = (bf16)f2bf(cfre * bi + cfim * br); }
            if (d == 0) { bf16* ch = (bf16*)(sp + S5P_CH) + (size_t)g * 16 * 128;
#pragma unroll
                for (int c = 0; c < 16; ++c) { const size_t ci = (((size_t)l * 16 + g) * 16 + c) * 64 + p; ch[c * 128 + 2 * p] = (bf16)f2bf(P.s5_c_re[ci]); ch[c * 128 + 2 * p + 1] = (bf16)f2bf(-P.s5_c_im[ci]); } }
        }
        if (gt < DEPTH) { const int l = gt; float* lp = (float*)(ws + WS_LAYP) + l * 64;
            for (int j = 0; j < 8; ++j) { const float x = P.ret_decay[l * 8 + j]; lp[j] = -log2f(1.0f + expf(-x)); }
            const float* dl = P.diff_lambda + l * 128; float d01 = 0.f, d23 = 0.f;
            for (int j = 0; j < 32; ++j) { d01 += dl[j] * dl[32 + j]; d23 += dl[64 + j] * dl[96 + j]; }
            const float li = 0.8f - 0.6f * expf(-0.3f * (float)l);
            lp[8] = expf(d01) - expf(d23) + li; lp[9] = 1.0f - li; }
    }
}
struct RowArgs {
    const float *x, *ctx;
    const float *post_g;
    const float *pre_g;
    const float *router_w, *router_b;
    float* out;
    int l, nrows, moe, last, f8, dry;
};
template <int MODE>
__device__ __forceinline__ void row_pass(Frame& F, const RowArgs& A) {
    unsigned char* ws = F.ws;
    float* H = (float*)(ws + WS_H); bf16* AF = (bf16*)(ws + WS_AF); const float* Y = (const float*)(ws + WS_Y);
    float* Hst = A.dry ? (float*)(ws + WS_END) : H; if (A.dry) AF = (bf16*)(ws + WS_END + (size_t)RT * D * 2);
    const float* mods = (const float*)(ws + WS_MODS);
    const int gw = F.vcu * NWAVES + F.wave, NGW = F.G * NWAVES, lane = opaque_v(F.lane);
    volatile LAS unsigned* cnt = F.MISC + 16;
    if (MODE == 1 && A.moe) { if (F.tid < 8) cnt[F.tid] = 0u; __syncthreads(); }
    const int lg = A.l, lm = (MODE == 2) ? A.l + 1 : A.l;
    const int goff = (MODE == 1) ? 2 * D : 5 * D, shoff = (MODE == 1) ? 3 * D : 0, scoff = (MODE == 1) ? 4 * D : D;
    LAS float* rwL = (LAS float*)F.lds;
    if (MODE == 1 && A.moe) {
        for (int i = F.tid; i < D * NE; i += 512) rwL[(i & 7) * D + (i >> 3)] = A.router_w[i];
        __syncthreads();
    }
    const bool wr_af = !(MODE == 2 && A.last);
    f32x4 pg[4], pg2[4];
#pragma unroll
    for (int j = 0; j < 4; ++j) { const int c = 4 * lane + 256 * j; pg[j] = (MODE != 0) ? *(const GAS f32x4*)((const GAS float*)A.post_g + c) : (f32x4){0.f, 0.f, 0.f, 0.f}; pg2[j] = wr_af ? *(const GAS f32x4*)((const GAS float*)A.pre_g + c) : (f32x4){0.f, 0.f, 0.f, 0.f}; }
    struct Raw { u32x2 ya[4], yb[4], hw[4]; f32x4 gv[4], sh[4], sc[4], x[4]; };
    Raw cur, nx;
    u32x4 recn = (u32x4){0u, 0u, 0u, 0u}; u32x2 posn = (u32x2){0u, 0u};
    u32x4 recc = recn, recx = recn; u32x2 posc = posn, posx = posn;
#define ROW_REC(R4, P2, rw) do { if (false) { const GAS int* rec_ = (const GAS int*)(ws + WS_REC) + (size_t)(rw) * 8; R4 = (u32x4){0u, 0u, (unsigned)rec_[2], (unsigned)rec_[3]}; P2 = (u32x2){(unsigned)rec_[6], (unsigned)rec_[7]}; } } while (0)
#define ROW_LOAD(R, rw, R4, P2) do { const int br_ = (rw) < RL ? ((rw) >> 11) : 16; \
        if (wr_af) { const GAS float* mrow_ = (const GAS float*)mods + ((size_t)lm * 17 + br_) * 6 * D; _Pragma("unroll") for (int j = 0; j < 4; ++j) { const int c = 4 * lane + 256 * j; R.sh[j] = *(const GAS f32x4*)(mrow_ + shoff + c); R.sc[j] = *(const GAS f32x4*)(mrow_ + scoff + c); } } \
        if (MODE == 0) { const GAS float* src_ = (rw) < RL ? (const GAS float*)A.x + (size_t)(rw) * D : (const GAS float*)A.ctx + (size_t)((rw) - RL) * D; _Pragma("unroll") for (int j = 0; j < 4; ++j) R.x[j] = *(const GAS f32x4*)(src_ + 4 * lane + 256 * j); } \
        else { const GAS float* gate_ = (const GAS float*)mods + ((size_t)lg * 17 + br_) * 6 * D + goff; \
            _Pragma("unroll") for (int j = 0; j < 4; ++j) { const int c = 4 * lane + 256 * j; R.hw[j] = *(const GAS u32x2*)((const GAS bf16*)H + (size_t)(rw) * D + c); R.gv[j] = *(const GAS f32x4*)(gate_ + c); } \
            if (MODE == 2 && A.moe) { } else if (false) { const GAS bf16* ys_ = (const GAS bf16*)(ws + WS_YS); const size_t p0_ = (size_t)P2.x, p1_ = (size_t)P2.y; \
                _Pragma("unroll") for (int j = 0; j < 4; ++j) { R.ya[j] = *(const GAS u32x2*)(ys_ + p0_ * D + 4 * lane + 256 * j); R.yb[j] = *(const GAS u32x2*)(ys_ + p1_ * D + 4 * lane + 256 * j); } } \
            else { _Pragma("unroll") for (int j = 0; j < 4; ++j) R.ya[j] = *(const GAS u32x2*)((const GAS bf16*)Y + (size_t)(rw) * D + 4 * lane + 256 * j); } } } while (0)
    if (gw < A.nrows) { ROW_REC(recc, posc, gw); if (gw + NGW < A.nrows) ROW_REC(recx, posx, gw + NGW); ROW_LOAD(cur, gw, recc, posc); }
    for (int row = gw; row < A.nrows; row += NGW) {
        const int nrow = row + NGW;
        if (nrow + NGW < A.nrows) ROW_REC(recn, posn, nrow + NGW);
        if (nrow < A.nrows) ROW_LOAD(nx, nrow, recx, posx);
        f32x4 h[4]; f32x4 sh[4], sc[4];
#pragma unroll
        for (int j = 0; j < 4; ++j) { sh[j] = cur.sh[j]; sc[j] = cur.sc[j]; }
        if (MODE == 0) {
#pragma unroll
            for (int j = 0; j < 4; ++j) h[j] = cur.x[j];
        } else {
            f32x4 y[4]; float ss = 0.f;
            if (MODE == 2 && A.moe) { const GAS int* rec = (const GAS int*)(ws + WS_REC) + (size_t)row * 8;
                const int p0 = rec[6], p1 = rec[7]; const float w0 = __builtin_bit_cast(float, rec[2]), w1 = __builtin_bit_cast(float, rec[3]);
                const GAS bf16* ys = (const GAS bf16*)(ws + WS_YS);
#pragma unroll
                for (int j = 0; j < 4; ++j) { const u32x2 a = *(const GAS u32x2*)(ys + (size_t)p0 * D + 4 * lane + 256 * j), b = *(const GAS u32x2*)(ys + (size_t)p1 * D + 4 * lane + 256 * j);
                    y[j] = (f32x4){w0 * bflo(a.x) + w1 * bflo(b.x), w0 * bfhi(a.x) + w1 * bfhi(b.x), w0 * bflo(a.y) + w1 * bflo(b.y), w0 * bfhi(a.y) + w1 * bfhi(b.y)}; }
            } else {
#pragma unroll
                for (int j = 0; j < 4; ++j) { const u32x2 a = cur.ya[j]; y[j] = (f32x4){bflo(a.x), bfhi(a.x), bflo(a.y), bfhi(a.y)}; }
            }
#pragma unroll
            for (int j = 0; j < 4; ++j) ss += (y[j][0] * y[j][0] + y[j][1] * y[j][1]) + (y[j][2] * y[j][2] + y[j][3] * y[j][3]);
            const float rstd = 1.0f / sqrtf(wave_sum(ss) * (1.0f / D) + EPS);
#pragma unroll
            for (int j = 0; j < 4; ++j) { const u32x2 hw = cur.hw[j]; const f32x4 hv = (f32x4){bflo(hw.x), bfhi(hw.x), bflo(hw.y), bfhi(hw.y)}; h[j] = hv + cur.gv[j] * (y[j] * rstd * pg[j]); }
        }
        cur = nx; recc = recx; posc = posx; recx = recn; posx = posn;
        if (!wr_af) {
#pragma unroll
            for (int j = 0; j < 4; ++j) if (!A.dry) *(GAS f32x4*)((GAS float*)A.out + (size_t)row * D + 4 * lane + 256 * j) = h[j];
            continue;
        }
#pragma unroll
        for (int j = 0; j < 4; ++j) { u32x2 hw; hw.x = pk2(h[j][0], h[j][1]); hw.y = pk2(h[j][2], h[j][3]); *(GAS u32x2*)((GAS bf16*)Hst + (size_t)row * D + 4 * lane + 256 * j) = hw; }
        float s2 = 0.f;
#pragma unroll
        for (int j = 0; j < 4; ++j) s2 += (h[j][0] * h[j][0] + h[j][1] * h[j][1]) + (h[j][2] * h[j][2] + h[j][3] * h[j][3]);
        const float rs2 = 1.0f / sqrtf(wave_sum(s2) * (1.0f / D) + EPS);
        f32x4 f[4];
#pragma unroll
        for (int j = 0; j < 4; ++j) { const int c = 4 * lane + 256 * j;
            f[j] = (h[j] * rs2 * pg2[j]) * (1.0f + sc[j]) + sh[j];
            if (MODE == 1 && A.f8) { unsigned w = 0; w = __builtin_amdgcn_cvt_pk_fp8_f32(4.f * f[j][0], 4.f * f[j][1], w, false); w = __builtin_amdgcn_cvt_pk_fp8_f32(4.f * f[j][2], 4.f * f[j][3], w, true);
                *(GAS unsigned*)((GAS unsigned char*)AF + (size_t)row * D + c) = w; }
            else { u32x2 w; w.x = pk2(f[j][0], f[j][1]); w.y = pk2(f[j][2], f[j][3]); *(GAS u32x2*)((GAS bf16*)AF + (size_t)row * D + c) = w;
                if (MODE != 1) { unsigned w8 = 0; w8 = __builtin_amdgcn_cvt_pk_fp8_f32(4.f * f[j][0], 4.f * f[j][1], w8, false); w8 = __builtin_amdgcn_cvt_pk_fp8_f32(4.f * f[j][2], 4.f * f[j][3], w8, true);
                    *(GAS unsigned*)((GAS unsigned char*)(ws + (A.dry ? WS_END + (size_t)RT * D * 4 : WS_AF8)) + (size_t)row * D + c) = w8; } } }
        if (MODE == 1 && A.moe) {
            float pl[8];
#pragma unroll
            for (int e = 0; e < 8; ++e) pl[e] = 0.f;
#pragma unroll
            for (int j = 0; j < 4; ++j)
#pragma unroll
                for (int e = 0; e < 8; ++e) { const f32x4 w4 = *(const LAS f32x4*)(rwL + e * D + 4 * lane + 256 * j); pl[e] += (f[j][0] * w4[0] + f[j][1] * w4[1]) + (f[j][2] * w4[2] + f[j][3] * w4[3]); }
            float a4[4], a2[2], a1;
            { const bool hi = (lane & 32) != 0;
#pragma unroll
              for (int k = 0; k < 4; ++k) { const float mine = hi ? pl[4 + k] : pl[k], theirs = hi ? pl[k] : pl[4 + k]; a4[k] = mine + __shfl_xor(theirs, 32); } }
            { const bool hi = (lane & 16) != 0;
#pragma unroll
              for (int k = 0; k < 2; ++k) { const float mine = hi ? a4[2 + k] : a4[k], theirs = hi ? a4[k] : a4[2 + k]; a2[k] = mine + __shfl_xor(theirs, 16); } }
            { const bool hi = (lane & 8) != 0; const float mine = hi ? a2[1] : a2[0], theirs = hi ? a2[0] : a2[1]; a1 = mine + __shfl_xor(theirs, 8); }
            a1 += __shfl_xor(a1, 4); a1 += __shfl_xor(a1, 2); a1 += __shfl_xor(a1, 1);
            float lg8[8];
#pragma unroll
            for (int e = 0; e < 8; ++e) lg8[e] = __builtin_bit_cast(float, __builtin_amdgcn_readlane(__builtin_bit_cast(int, a1), 8 * e)) + A.router_b[e];
            int e0 = 0; float v0 = lg8[0];
#pragma unroll
            for (int e = 1; e < 8; ++e) if (lg8[e] > v0) { v0 = lg8[e]; e0 = e; }
            int e1 = -1; float v1 = -3.0e38f;
#pragma unroll
            for (int e = 0; e < 8; ++e) if (e != e0 && lg8[e] > v1) { v1 = lg8[e]; e1 = e; }
            const float w0 = 1.0f / (1.0f + __expf(v1 - v0)), w1 = 1.0f - w0;
            if (lane == 0) {
                const unsigned r0 = __hip_atomic_fetch_add((LAS unsigned*)(cnt + e0), 1u, __ATOMIC_RELAXED, __HIP_MEMORY_SCOPE_WORKGROUP);
                const unsigned r1 = __hip_atomic_fetch_add((LAS unsigned*)(cnt + e1), 1u, __ATOMIC_RELAXED, __HIP_MEMORY_SCOPE_WORKGROUP);
                int* rec = (int*)(ws + (A.dry ? WS_END + (size_t)RT * D * 5 : WS_REC)) + (size_t)row * 8;
                rec[0] = e0; rec[1] = e1; rec[2] = __builtin_bit_cast(int, w0); rec[3] = __builtin_bit_cast(int, w1); rec[4] = (int)r0; rec[5] = (int)r1;
            }
        }
    }
#undef ROW_REC
#undef ROW_LOAD
    if (MODE == 1 && A.moe) { __syncthreads(); if (F.tid < 8 && !A.dry) ((int*)(ws + WS_HIST))[blockIdx.x * 8 + F.tid] = (int)cnt[F.tid]; }
}

__device__ __forceinline__ void moe_dispatch(Frame& F, int nrows, int f8) {
    unsigned char* ws = F.ws;
    volatile LAS int* sh = (volatile LAS int*)F.lds;
    const int* hist = (const int*)(ws + WS_HIST);
    if (F.tid < 16) sh[F.tid] = 0;
    __syncthreads();
    { const int e = F.tid & 7; int tot = 0, pre = 0;
      int v[4];
#pragma unroll
      for (int q = 0; q < 4; ++q) { const int b = (F.tid >> 3) + 64 * q; v[q] = b < (int)gridDim.x ? __hip_atomic_load(hist + b * 8 + e, __ATOMIC_RELAXED, __HIP_MEMORY_SCOPE_AGENT) : 0; }
#pragma unroll
      for (int q = 0; q < 4; ++q) { const int b = (F.tid >> 3) + 64 * q; tot += v[q]; if (b < (int)blockIdx.x) pre += v[q]; }
      __hip_atomic_fetch_add((LAS int*)(sh + e), tot, __ATOMIC_RELAXED, __HIP_MEMORY_SCOPE_WORKGROUP); __hip_atomic_fetch_add((LAS int*)(sh + 8 + e), pre, __ATOMIC_RELAXED, __HIP_MEMORY_SCOPE_WORKGROUP); }
    __syncthreads();
    if (F.tid == 0) { int base = 0; for (int e = 0; e < 8; ++e) { sh[24 + e] = base; sh[16 + e] = base + sh[8 + e]; base += (sh[e] + 255) & ~255; } sh[32] = base; }
    __syncthreads();
    if (blockIdx.x == 0) {
        int* te = (int*)(ws + WS_TILEE); const int ntile = sh[32] >> 8;
        int bs[7];
#pragma unroll
        for (int q = 1; q < 8; ++q) bs[q - 1] = sh[24 + q];
        for (int t = F.tid; t < ntile; t += 512) { int e = 0;
#pragma unroll
            for (int q = 0; q < 7; ++q) e += (t * 256 >= bs[q]) ? 1 : 0;
            te[t] = e; }
        if (F.tid == 0) te[400] = ntile;
    }
    const int gw = F.vcu * NWAVES + F.wave, NGW = F.G * NWAVES, lane = F.lane;
    const GAS unsigned char* AFb = (const GAS unsigned char*)(ws + WS_AF); GAS unsigned char* FSb = (GAS unsigned char*)(ws + WS_FS);
    const int nmine = (nrows - gw + NGW - 1) / NGW;
    for (int k0 = 0; k0 < nmine; k0 += 64) {
        int p0v = 0, p1v = 0;
        if (k0 + lane < nmine) { GAS int* rec = (GAS int*)(ws + WS_REC) + (size_t)(gw + (k0 + lane) * NGW) * 8;
            const u32x4 ra = *(const GAS u32x4*)rec; const u32x2 rb = *(const GAS u32x2*)(rec + 4);
            p0v = sh[16 + (int)ra.x] + (int)rb.x; p1v = sh[16 + (int)ra.y] + (int)rb.y; *(GAS u32x2*)(rec + 6) = (u32x2){(unsigned)p0v, (unsigned)p1v}; }
        const int nk = (nmine - k0) < 64 ? (nmine - k0) : 64;
        for (int kb = 0; kb < nk; kb += 6) {
            u32x4 a[6], b[6];
#pragma unroll
            for (int q = 0; q < 6; ++q) if (kb + q < nk) { const size_t row = (size_t)(gw + (k0 + kb + q) * NGW);
                if (f8) a[q] = *(const GAS u32x4*)(AFb + row * D + 16 * lane);
                else { a[q] = *(const GAS u32x4*)(AFb + row * 2 * D + 16 * lane); b[q] = *(const GAS u32x4*)(AFb + row * 2 * D + 1024 + 16 * lane); } }
#pragma unroll
            for (int q = 0; q < 6; ++q) if (kb + q < nk) { const size_t p0 = (size_t)__builtin_amdgcn_readlane(p0v, kb + q), p1 = (size_t)__builtin_amdgcn_readlane(p1v, kb + q);
                if (f8) { *(GAS u32x4*)(FSb + p0 * D + 16 * lane) = a[q]; *(GAS u32x4*)(FSb + p1 * D + 16 * lane) = a[q]; }
                else { *(GAS u32x4*)(FSb + p0 * 2 * D + 16 * lane) = a[q]; *(GAS u32x4*)(FSb + p0 * 2 * D + 1024 + 16 * lane) = b[q];
                       *(GAS u32x4*)(FSb + p1 * 2 * D + 16 * lane) = a[q]; *(GAS u32x4*)(FSb + p1 * 2 * D + 1024 + 16 * lane) = b[q]; } }
        }
    }
}
__device__ __forceinline__ int chunk_row0(int b, int c) { return c < 2 ? RL + b * NCTX + c * 128 : b * SEQ + (c - 2) * 128; }
__device__ __forceinline__ bf16x8 tr_read2(unsigned a0, unsigned a1) {
    s16x4 lo, hi; asm volatile("ds_read_b64_tr_b16 %0, %2\n\tds_read_b64_tr_b16 %1, %3\n\ts_waitcnt lgkmcnt(0)" : "=&v"(lo), "=&v"(hi) : "v"(a0), "v"(a1) : "memory");
    return __builtin_shufflevector(lo, hi, 0, 1, 2, 3, 4, 5, 6, 7);
}
__device__ __forceinline__ unsigned scale_pk(unsigned w, float s) { return pk2(bflo(w) * s, bfhi(w) * s); }

constexpr int RS_KSTR = 288, RS_VSTR = 544, RS_KF = 0, RS_KB = 128 * RS_KSTR, RS_V = 2 * 128 * RS_KSTR;

__device__ __forceinline__ void ret_summary_unit(Frame& F, int b, int c, const float* lp) {
    const bf16* Z = (const bf16*)(F.ws + WS_Z); const int row0 = chunk_row0(b, c);
    LAS unsigned char* L = F.lds;
    for (int i = F.tid; i < 2048; i += 512) { const int a = i >> 4, ch = i & 15, hd = ch >> 2;
        const u32x4 kv = *(const u32x4*)(Z + (size_t)(row0 + a) * ZW + ZQ_RK + ch * 8);
        const float wf = __builtin_amdgcn_exp2f((float)(127 - a) * lp[hd]), wb = __builtin_amdgcn_exp2f((float)a * lp[4 + hd]);
        u32x4 f, g; f.x = scale_pk(kv.x, wf); f.y = scale_pk(kv.y, wf); f.z = scale_pk(kv.z, wf); f.w = scale_pk(kv.w, wf);
        g.x = scale_pk(kv.x, wb); g.y = scale_pk(kv.y, wb); g.z = scale_pk(kv.z, wb); g.w = scale_pk(kv.w, wb);
        *(LAS u32x4*)(L + RS_KF + a * RS_KSTR + ch * 16) = f; *(LAS u32x4*)(L + RS_KB + a * RS_KSTR + ch * 16) = g; }
    for (int i = F.tid; i < 4096; i += 512) { const int a = i >> 5, ch = i & 31;
        *(LAS u32x4*)(L + RS_V + a * RS_VSTR + ch * 16) = *(const u32x4*)(Z + (size_t)(row0 + a) * ZW + ZQ_RV + ch * 8); }
    __syncthreads();
    const int h = F.wave & 3, dir = F.wave >> 2, l = opaque_v(F.lane), hh = l >> 5, blk = (l >> 4) & 1, q = (l & 15) >> 2, p = l & 3;
    const unsigned lb = (unsigned)(size_t)L;
    f32x16 acc0, acc1;
#pragma unroll
    for (int r = 0; r < 16; ++r) { acc0[r] = 0.f; acc1[r] = 0.f; }
    const unsigned kbase = lb + (dir ? RS_KB : RS_KF) + (h * 32 + 16 * blk) * 2 + 8 * p;
    const unsigned vbase = lb + RS_V + (h * 64 + 16 * blk) * 2 + 8 * p;
#pragma unroll 2
    for (int ks = 0; ks < 8; ++ks) {
        const int r0 = 16 * ks + 8 * hh + q, r1 = r0 + 4;
        const bf16x8 bk = tr_read2(kbase + r0 * RS_KSTR, kbase + r1 * RS_KSTR);
        const bf16x8 a0 = tr_read2(vbase + r0 * RS_VSTR, vbase + r1 * RS_VSTR);
        const bf16x8 a1 = tr_read2(vbase + 64 + r0 * RS_VSTR, vbase + 64 + r1 * RS_VSTR);
        acc0 = __builtin_amdgcn_mfma_f32_32x32x16_bf16(a0, bk, acc0, 0, 0, 0);
        acc1 = __builtin_amdgcn_mfma_f32_32x32x16_bf16(a1, bk, acc1, 0, 0, 0);
    }
    float* out = (float*)(F.ws + WS_RETSUM) + ((((size_t)b * NCH + c) * 2 + dir) * 4 + h) * 2048;
#pragma unroll
    for (int r = 0; r < 16; ++r) { const int e = (r & 3) + 8 * (r >> 2) + 4 * hh; out[e * 32 + (l & 31)] = acc0[r]; out[(32 + e) * 32 + (l & 31)] = acc1[r]; }
    __syncthreads();
}

__device__ __forceinline__ int prefix_chunk(int dir, int i) { return dir == 0 ? i : (i == 0 ? 1 : (i == 1 ? 0 : 19 - i)); }
__device__ __forceinline__ void ret_prefix_unit(Frame& F, int b, int h, int dir, const float* lp) {
    const int lane_ = opaque_v(F.lane);
    const float g128 = __builtin_amdgcn_exp2f(128.0f * lp[dir * 4 + h]);
    f32x4 S[8], nx[8]; const float z0 = opaque_f(0.f);
#pragma unroll
    for (int j = 0; j < 8; ++j) S[j] = (f32x4){z0, z0, z0, z0};
    { const size_t idx = ((((size_t)b * NCH + prefix_chunk(dir, 0)) * 2 + dir) * 4 + h) * 2048; const GAS float* kv = (const GAS float*)(F.ws + WS_RETSUM) + idx;
#pragma unroll
      for (int j = 0; j < 8; ++j) nx[j] = *(const GAS f32x4*)(kv + 4 * lane_ + 256 * j); }
#pragma unroll 1
    for (int i = 0; i < NCH; ++i) {
        const size_t idx = ((((size_t)b * NCH + prefix_chunk(dir, i)) * 2 + dir) * 4 + h) * 2048;
        GAS bf16* st = (GAS bf16*)(F.ws + WS_RETST) + idx;
        f32x4 cur[8];
#pragma unroll
        for (int j = 0; j < 8; ++j) cur[j] = nx[j];
        if (i + 1 < NCH) { const size_t idn = ((((size_t)b * NCH + prefix_chunk(dir, i + 1)) * 2 + dir) * 4 + h) * 2048; const GAS float* kv = (const GAS float*)(F.ws + WS_RETSUM) + idn;
#pragma unroll
            for (int j = 0; j < 8; ++j) nx[j] = *(const GAS f32x4*)(kv + 4 * lane_ + 256 * j); }
#pragma unroll
        for (int j = 0; j < 8; ++j) { const int o = 4 * lane_ + 256 * j;
            u32x2 w; w.x = pk2(S[j][0], S[j][1]); w.y = pk2(S[j][2], S[j][3]); *(GAS u32x2*)(st + o) = w;
            S[j] = S[j] * g128 + cur[j]; }
    }
}
__device__ __forceinline__ void s5_prefix_unit(Frame& F, int b, int g, int d, int l) {
    const int lane_ = opaque_v(F.lane);
    const f32x2 a = ((const GAS f32x2*)(F.ws + WS_S5P + (size_t)l * S5P_BYTES + S5P_A128))[(d * 16 + g) * 64 + lane_];
    f32x2 e[NCH];
#pragma unroll
    for (int i = 0; i < NCH; ++i) e[i] = ((const GAS f32x2*)(F.ws + WS_S5E))[((((size_t)b * NCH + prefix_chunk(d, i)) * 16 + g) * 2 + d) * 64 + lane_];
    float cr = opaque_f(0.f), ci = cr;
#pragma unroll
    for (int i = 0; i < NCH; ++i) {
        ((GAS f32x2*)(F.ws + WS_S5C))[((((size_t)b * NCH + prefix_chunk(d, i)) * 16 + g) * 2 + d) * 64 + lane_] = (f32x2){cr, ci};
        const float nr = a.x * cr - a.y * ci + e[i].x, ni = a.x * ci + a.y * cr + e[i].y; cr = nr; ci = ni;
    }
}

constexpr int S5_XSTR = 132  , S5_HSTR = 272  , S5_WAVE_LDS = 16 * S5_XSTR * 4 + 16 * S5_HSTR;
template <bool OUT, int DIR>
__device__ __forceinline__ void s5_scan_dir(const unsigned char* sp, unsigned char* wsb, LAS float* X, LAS unsigned char* Hb, int lane, int tk, int kg, int g, size_t sidx, const bf16x8 (&ufr)[8], const bf16x8 (&chf)[4], f32x4 (&yacc)[8]) {
    const bf16x8 zero8 = (bf16x8){0, 0, 0, 0, 0, 0, 0, 0};
    const f32x2 ab = ((const GAS f32x2*)(sp + S5P_ABAR))[(DIR * 16 + g) * 64 + lane];
    bf16x8 af[8];
#pragma unroll
    for (int rb = 0; rb < 8; ++rb) af[rb] = kg < 2 ? *(const GAS bf16x8*)((const GAS bf16*)(sp + S5P_BP) + (((size_t)DIR * 16 + g) * 128 + 16 * rb + tk) * 16 + 8 * kg) : zero8;
    float hr = 0.f, hi = 0.f;
    if (OUT) { const f32x2 cin = ((const GAS f32x2*)(wsb + WS_S5C))[sidx + DIR * 64]; hr = cin.x; hi = cin.y; }
#pragma unroll
    for (int si = 0; si < 8; ++si) {
        const int sub = DIR ? 7 - si : si;
#pragma unroll
        for (int rb = 0; rb < 8; ++rb) { const f32x4 xa = __builtin_amdgcn_mfma_f32_16x16x32_bf16(af[rb], ufr[sub], (f32x4){0.f, 0.f, 0.f, 0.f}, 0, 0, 0);
            *(LAS f32x4*)(X + tk * S5_XSTR + 16 * rb + 4 * kg) = xa; }
        asm volatile("" ::: "memory");
#pragma unroll
        for (int ti = 0; ti < 16; ++ti) {
            const int tok = DIR ? 15 - ti : ti;
            const f32x2 x = *(const LAS f32x2*)(X + tok * S5_XSTR + 2 * lane);
            const float nr = ab.x * hr - ab.y * hi + x.x, ni = ab.x * hi + ab.y * hr + x.y; hr = nr; hi = ni;
            if (OUT) *(LAS unsigned*)(Hb + tok * S5_HSTR + 4 * lane) = cvt_pk_bf16(hr, hi);
        }
        asm volatile("" ::: "memory");
        if (OUT) {
#pragma unroll
            for (int ks = 0; ks < 4; ++ks) { const bf16x8 hf = *(const LAS bf16x8*)(Hb + tk * S5_HSTR + (32 * ks + 8 * kg) * 2); yacc[sub] = __builtin_amdgcn_mfma_f32_16x16x32_bf16(hf, chf[ks], yacc[sub], 0, 0, 0); }
        }
        asm volatile("" ::: "memory");
    }
    if (!OUT) ((GAS f32x2*)(wsb + WS_S5E))[sidx + DIR * 64] = (f32x2){hr, hi};
}
template <bool OUT>
__device__ __forceinline__ void s5_wave_unit(Frame& F, int b, int c, int g, int l, const float* s5_d) {
    const unsigned char* sp = F.ws + WS_S5P + (size_t)l * S5P_BYTES;
    const bf16* Z = (const bf16*)(F.ws + WS_Z); const int row0 = chunk_row0(b, c);
    LAS float* X = (LAS float*)(F.lds + F.wave * S5_WAVE_LDS);
    LAS unsigned char* Hb = (LAS unsigned char*)X + 16 * S5_XSTR * 4;
    const int lane = opaque_v(F.lane), tk = lane & 15, kg = lane >> 4;
    const bf16x8 zero8 = (bf16x8){0, 0, 0, 0, 0, 0, 0, 0};
    f32x4 yacc[8]; bf16x8 chf[4];
#pragma unroll
    for (int s8 = 0; s8 < 8; ++s8) yacc[s8] = (f32x4){0.f, 0.f, 0.f, 0.f};
#pragma unroll
    for (int ks = 0; ks < 4; ++ks) chf[ks] = OUT ? *(const GAS bf16x8*)((const GAS bf16*)(sp + S5P_CH) + ((size_t)g * 16 + tk) * 128 + 32 * ks + 8 * kg) : zero8;
    bf16x8 ufr[8];
#pragma unroll
    for (int sb = 0; sb < 8; ++sb) ufr[sb] = kg < 2 ? *(const GAS bf16x8*)((const GAS bf16*)Z + (size_t)(row0 + 16 * sb + tk) * ZW + ZQ_SU + g * 16 + 8 * kg) : zero8;
    const size_t sidx = ((((size_t)b * NCH + c) * 16 + g) * 2) * 64 + lane;
    s5_scan_dir<OUT, 0>(sp, F.ws, X, Hb, lane, tk, kg, g, sidx, ufr, chf, yacc);
    s5_scan_dir<OUT, 1>(sp, F.ws, X, Hb, lane, tk, kg, g, sidx, ufr, chf, yacc);
    if (OUT) {
        GAS bf16* xb = (GAS bf16*)(F.ws + WS_XB) + (size_t)1 * RT * 256;
        const float dsk = s5_d[((size_t)l * 16 + g) * 16 + tk];
#pragma unroll
        for (int s8 = 0; s8 < 8; ++s8)
#pragma unroll
            for (int r = 0; r < 4; ++r) { const int row = row0 + 16 * s8 + 4 * kg + r;
                const float u = bf2f(((const GAS bf16*)Z)[(size_t)row * ZW + ZQ_SU + g * 16 + tk]);
                const float y = yacc[s8][r] + dsk * u;
                const float o = y * sigmoidf_(1.5957691216f * (y + 0.044715f * y * y * y));
                xb[(size_t)row * 256 + g * 16 + tk] = (bf16)f2bf(o); }
    }
}
__device__ __forceinline__ bf16x8 pack8(const f32x16& x, int s) {
    u32x4 p;
    if (s == 0) { p.x = cvt_pk_bf16(x[0], x[1]); p.y = cvt_pk_bf16(x[2], x[3]); p.z = cvt_pk_bf16(x[4], x[5]); p.w = cvt_pk_bf16(x[6], x[7]); }
    else { p.x = cvt_pk_bf16(x[8], x[9]); p.y = cvt_pk_bf16(x[10], x[11]); p.z = cvt_pk_bf16(x[12], x[13]); p.w = cvt_pk_bf16(x[14], x[15]); }
    return __builtin_bit_cast(bf16x8, p);
}
#define MFMA32(a, b, c) __builtin_amdgcn_mfma_f32_32x32x16_bf16((a), (b), (c), 0, 0, 0)

__device__ __forceinline__ void ret_out_unit(Frame& F, int b, int c, const float* lp) {
    const bf16* Z = (const bf16*)(F.ws + WS_Z); const int row0 = chunk_row0(b, c);
    LAS unsigned char* L = F.lds;
    for (int i = F.tid; i < 4096; i += 512) { const int a = i >> 5, ch = i & 31;
        *(LAS u32x4*)(L + a * RS_VSTR + ch * 16) = *(const u32x4*)(Z + (size_t)(row0 + a) * ZW + ZQ_RV + ch * 8); }
    __syncthreads();
    const int h = F.wave >> 1, ih = F.wave & 1, l = opaque_v(F.lane), li = l & 31, hh = l >> 5, blk = (l >> 4) & 1, q = (l & 15) >> 2, p = l & 3;
    const float lgf = lp[h], lgb = lp[4 + h];
    bf16x8 qf[2][2];
#pragma unroll
    for (int ib = 0; ib < 2; ++ib)
#pragma unroll
        for (int ks = 0; ks < 2; ++ks) qf[ib][ks] = *(const bf16x8*)(Z + (size_t)(row0 + 64 * ih + 32 * ib + li) * ZW + ZQ_RQ + 32 * h + 16 * ks + 8 * hh);
    f32x16 o[2][2];
#pragma unroll
    for (int eb = 0; eb < 2; ++eb)
#pragma unroll
        for (int ib = 0; ib < 2; ++ib)
#pragma unroll
            for (int r = 0; r < 16; ++r) o[eb][ib][r] = 0.f;
    const unsigned vbase = (unsigned)(size_t)L + (h * 64 + 16 * blk) * 2 + 8 * p;
    bf16x8 kfa[4][2];
#pragma unroll
    for (int jb = 0; jb < 4; ++jb)
#pragma unroll
        for (int ks = 0; ks < 2; ++ks) kfa[jb][ks] = *(const GAS bf16x8*)((const GAS bf16*)Z + (size_t)(row0 + 32 * jb + li) * ZW + ZQ_RK + 32 * h + 16 * ks + 8 * hh);
#pragma unroll
    for (int jb = 0; jb < 4; ++jb) {
        bf16x8 kf[2]; kf[0] = kfa[jb][0]; kf[1] = kfa[jb][1];
        bf16x8 vf[2][2];
#pragma unroll
        for (int s2 = 0; s2 < 2; ++s2) { const int r0 = 32 * jb + 16 * s2 + 4 * hh + q, r1 = r0 + 8;
            vf[0][s2] = tr_read2(vbase + r0 * RS_VSTR, vbase + r1 * RS_VSTR); vf[1][s2] = tr_read2(vbase + 64 + r0 * RS_VSTR, vbase + 64 + r1 * RS_VSTR); }
#pragma unroll
        for (int ib = 0; ib < 2; ++ib) {
            f32x16 s;
#pragma unroll
            for (int r = 0; r < 16; ++r) s[r] = 0.f;
            s = MFMA32(kf[0], qf[ib][0], s); s = MFMA32(kf[1], qf[ib][1], s);
            const int iq = 64 * ih + 32 * ib + li;
#pragma unroll
            for (int r = 0; r < 16; ++r) { const int j = 32 * jb + (r & 3) + 8 * (r >> 2) + 4 * hh; const int dl = iq - j;
                s[r] *= dl >= 0 ? __builtin_amdgcn_exp2f((float)dl * lgf) : __builtin_amdgcn_exp2f((float)(-dl) * lgb); }
            const bf16x8 p0 = pack8(s, 0), p1 = pack8(s, 1);
            o[0][ib] = MFMA32(vf[0][0], p0, o[0][ib]); o[0][ib] = MFMA32(vf[0][1], p1, o[0][ib]);
            o[1][ib] = MFMA32(vf[1][0], p0, o[1][ib]); o[1][ib] = MFMA32(vf[1][1], p1, o[1][ib]);
        }
    }
#pragma unroll
    for (int dir = 0; dir < 2; ++dir) {
        const bf16* st = (const bf16*)(F.ws + WS_RETST) + ((((size_t)b * NCH + c) * 2 + dir) * 4 + h) * 2048;
#pragma unroll
        for (int eb = 0; eb < 2; ++eb) {
            const bf16x8 s0 = *(const bf16x8*)(st + (32 * eb + li) * 32 + 8 * hh), s1 = *(const bf16x8*)(st + (32 * eb + li) * 32 + 16 + 8 * hh);
#pragma unroll
            for (int ib = 0; ib < 2; ++ib) {
                f32x16 x;
#pragma unroll
                for (int r = 0; r < 16; ++r) x[r] = 0.f;
                x = MFMA32(s0, qf[ib][0], x); x = MFMA32(s1, qf[ib][1], x);
                const int a = 64 * ih + 32 * ib + li;
                const float wq = dir == 0 ? __builtin_amdgcn_exp2f((float)(a + 1) * lgf) : __builtin_amdgcn_exp2f((float)(128 - a) * lgb);
#pragma unroll
                for (int r = 0; r < 16; ++r) o[eb][ib][r] += wq * x[r];
            }
        }
    }
    bf16* xb = (bf16*)(F.ws + WS_XB);
#pragma unroll
    for (int ib = 0; ib < 2; ++ib) {
        float sm = 0.f;
#pragma unroll
        for (int r = 0; r < 16; ++r) sm += o[0][ib][r] + o[1][ib][r];
        sm += __shfl_xor(sm, 32); const float mean = sm * (1.0f / 64.0f);
        float sq = 0.f;
#pragma unroll
        for (int r = 0; r < 16; ++r) { const float d0 = o[0][ib][r] - mean, d1 = o[1][ib][r] - mean; sq += d0 * d0 + d1 * d1; }
        sq += __shfl_xor(sq, 32); const float rstd = 1.0f / sqrtf(sq * (1.0f / 64.0f) + EPS);
        const size_t row = (size_t)(row0 + 64 * ih + 32 * ib + li);
#pragma unroll
        for (int eb = 0; eb < 2; ++eb)
#pragma unroll
            for (int g4 = 0; g4 < 4; ++g4) { const int e = 32 * eb + 8 * g4 + 4 * hh;
                const u32x2 gw = *(const u32x2*)(Z + row * ZW + ZQ_RG + h * 64 + e);
                const float y0 = (o[eb][ib][4 * g4 + 0] - mean) * rstd * siluf_(bflo(gw.x)), y1 = (o[eb][ib][4 * g4 + 1] - mean) * rstd * siluf_(bfhi(gw.x));
                const float y2 = (o[eb][ib][4 * g4 + 2] - mean) * rstd * siluf_(bflo(gw.y)), y3 = (o[eb][ib][4 * g4 + 3] - mean) * rstd * siluf_(bfhi(gw.y));
                u32x2 w; w.x = cvt_pk_bf16(y0, y1); w.y = cvt_pk_bf16(y2, y3); *(u32x2*)(xb + row * 256 + h * 64 + e) = w; }
    }
    __syncthreads();
}

__device__ __forceinline__ void tr_read_vtile(unsigned base, bf16x8 (&vf)[2][4]) {
    s16x4 r[16];
    asm volatile("ds_read_b64_tr_b16 %0, %16 offset:0\n\t" "ds_read_b64_tr_b16 %1, %16 offset:1152\n\t" "ds_read_b64_tr_b16 %2, %16 offset:2304\n\t" "ds_read_b64_tr_b16 %3, %16 offset:3456\n\t" "ds_read_b64_tr_b16 %4, %16 offset:4608\n\t" "ds_read_b64_tr_b16 %5, %16 offset:5760\n\t" "ds_read_b64_tr_b16 %6, %16 offset:6912\n\t" "ds_read_b64_tr_b16 %7, %16 offset:8064\n\t" "ds_read_b64_tr_b16 %8, %16 offset:64\n\t" "ds_read_b64_tr_b16 %9, %16 offset:1216\n\t" "ds_read_b64_tr_b16 %10, %16 offset:2368\n\t" "ds_read_b64_tr_b16 %11, %16 offset:3520\n\t" "ds_read_b64_tr_b16 %12, %16 offset:4672\n\t" "ds_read_b64_tr_b16 %13, %16 offset:5824\n\t" "ds_read_b64_tr_b16 %14, %16 offset:6976\n\t" "ds_read_b64_tr_b16 %15, %16 offset:8128\n\t" "s_waitcnt lgkmcnt(0)" : "=&v"(r[0]), "=&v"(r[1]), "=&v"(r[2]), "=&v"(r[3]), "=&v"(r[4]), "=&v"(r[5]), "=&v"(r[6]), "=&v"(r[7]), "=&v"(r[8]), "=&v"(r[9]), "=&v"(r[10]), "=&v"(r[11]), "=&v"(r[12]), "=&v"(r[13]), "=&v"(r[14]), "=&v"(r[15]) : "v"(base) : "memory");
#pragma unroll
    for (int eb = 0; eb < 2; ++eb)
#pragma unroll
        for (int k4 = 0; k4 < 4; ++k4) vf[eb][k4] = __builtin_shufflevector(r[(eb * 4 + k4) * 2], r[(eb * 4 + k4) * 2 + 1], 0, 1, 2, 3, 4, 5, 6, 7);
}
constexpr int AT_STR = 144, AT_TILE = 64 * AT_STR;
__device__ __forceinline__ void attn_unit(Frame& F, int b, int h, int qrow0, int nkt, bool ctx_only, float lam, float omli, const float* subln_g) {
    const bf16* Z = (const bf16*)(F.ws + WS_Z);
    LAS unsigned char* L = F.lds; const unsigned lb = (unsigned)(size_t)L;
    const int l = opaque_v(F.lane), li = l & 31, hh = l >> 5, blk = (l >> 4) & 1, q4 = (l & 15) >> 2, p = l & 3;
    const int qrow = qrow0 + 32 * F.wave + li;
    bf16x8 qf[2][2];
#pragma unroll
    for (int mp = 0; mp < 2; ++mp)
#pragma unroll
        for (int ks = 0; ks < 2; ++ks) qf[mp][ks] = *(const bf16x8*)(Z + (size_t)qrow * ZW + ZQ_DQ + h * 64 + mp * 32 + 16 * ks + 8 * hh);
    f32x16 o[2][2];
#pragma unroll
    for (int mp = 0; mp < 2; ++mp)
#pragma unroll
        for (int eb = 0; eb < 2; ++eb)
#pragma unroll
            for (int r = 0; r < 16; ++r) o[mp][eb][r] = 0.f;
    float mx[2] = {-3.0e38f, -3.0e38f}, ls[2] = {0.f, 0.f};
    const int stid = opaque_v(F.tid), skey = stid >> 3, sch = stid & 7;
    auto key_row = [&](int kt) -> int { const int k0 = kt * 64; return (ctx_only || k0 < NCTX) ? RL + b * NCTX + k0 : b * SEQ + (k0 - NCTX); };
    u32x4 kreg, vreg;
    { const size_t r = (size_t)(key_row(0) + skey); kreg = *(const u32x4*)(Z + r * ZW + ZQ_DK + h * 64 + sch * 8); vreg = *(const u32x4*)(Z + r * ZW + ZQ_DV + h * 64 + sch * 8); }
#pragma unroll 1
    for (int kt = 0; kt < nkt; ++kt) {
        const int buf = kt & 1;
        *(LAS u32x4*)(L + buf * 2 * AT_TILE + skey * AT_STR + sch * 16) = kreg;
        *(LAS u32x4*)(L + buf * 2 * AT_TILE + AT_TILE + skey * AT_STR + sch * 16) = vreg;
        __syncthreads();
        if (kt + 1 < nkt) { const size_t r = (size_t)(key_row(kt + 1) + skey); kreg = *(const u32x4*)(Z + r * ZW + ZQ_DK + h * 64 + sch * 8); vreg = *(const u32x4*)(Z + r * ZW + ZQ_DV + h * 64 + sch * 8); }
        const LAS unsigned char* Kt = L + buf * 2 * AT_TILE; const unsigned vb = lb + buf * 2 * AT_TILE + AT_TILE + 16 * blk * 2 + 8 * p;
        bf16x8 vf[2][4];
        tr_read_vtile(vb + (4 * hh + q4) * AT_STR, vf);
#pragma unroll
        for (int mp = 0; mp < 2; ++mp) {
            f32x16 s[2];
#pragma unroll
            for (int kb = 0; kb < 2; ++kb) {
#pragma unroll
                for (int r = 0; r < 16; ++r) s[kb][r] = 0.f;
#pragma unroll
                for (int ks = 0; ks < 2; ++ks) { const bf16x8 ka = *(const LAS bf16x8*)(Kt + (32 * kb + li) * AT_STR + (mp * 32 + 16 * ks + 8 * hh) * 2); s[kb] = MFMA32(ka, qf[mp][ks], s[kb]); }
            }
            if (kt < 4 || (kt & 3) == 0) {
                float tm = s[0][0];
#pragma unroll
                for (int r = 1; r < 16; ++r) tm = fmaxf(tm, s[0][r]);
#pragma unroll
                for (int r = 0; r < 16; ++r) tm = fmaxf(tm, s[1][r]);
                tm = fmaxf(tm, __shfl_xor(tm, 32));
                if (__any(tm > mx[mp])) {
                    const float mn = fmaxf(mx[mp], tm), al = __builtin_amdgcn_exp2f((mx[mp] - mn) * 1.44269504f);
                    mx[mp] = mn; ls[mp] *= al;
#pragma unroll
                    for (int eb = 0; eb < 2; ++eb)
#pragma unroll
                        for (int r = 0; r < 16; ++r) o[mp][eb][r] *= al;
                }
            }
            const float mb = mx[mp] * 1.44269504f; f32x2 rs2 = (f32x2){0.f, 0.f};
#pragma unroll
            for (int kb = 0; kb < 2; ++kb)
#pragma unroll
                for (int r = 0; r < 16; r += 2) { const float p0 = __builtin_amdgcn_exp2f(s[kb][r] * 1.44269504f - mb), p1 = __builtin_amdgcn_exp2f(s[kb][r + 1] * 1.44269504f - mb);
                    s[kb][r] = p0; s[kb][r + 1] = p1; rs2 += (f32x2){p0, p1}; }
            const float rs = rs2.x + rs2.y;
            ls[mp] += rs;
#pragma unroll
            for (int kb = 0; kb < 2; ++kb)
#pragma unroll
                for (int s2 = 0; s2 < 2; ++s2) { const bf16x8 pb = pack8(s[kb], s2);
                    o[mp][0] = MFMA32(vf[0][2 * kb + s2], pb, o[mp][0]); o[mp][1] = MFMA32(vf[1][2 * kb + s2], pb, o[mp][1]); }
        }
    }
    const float l0 = ls[0] + __shfl_xor(ls[0], 32), l1 = ls[1] + __shfl_xor(ls[1], 32);
    const float i0 = 1.0f / l0, i1 = lam / l1;
    float sq = 0.f;
#pragma unroll
    for (int eb = 0; eb < 2; ++eb)
#pragma unroll
        for (int r = 0; r < 16; ++r) { const float v = o[0][eb][r] * i0 - o[1][eb][r] * i1; o[0][eb][r] = v; sq += v * v; }
    sq += __shfl_xor(sq, 32);
    const float rstd = omli / sqrtf(sq * (1.0f / 64.0f) + EPS);
    bf16* xb = (bf16*)(F.ws + WS_XB) + (size_t)2 * RT * 256;
#pragma unroll
    for (int eb = 0; eb < 2; ++eb)
#pragma unroll
        for (int g4 = 0; g4 < 4; ++g4) { const int e = 32 * eb + 8 * g4 + 4 * hh; const f32x4 sg = *(const f32x4*)(subln_g + e);
            u32x2 w; w.x = cvt_pk_bf16(o[0][eb][4 * g4] * rstd * sg[0], o[0][eb][4 * g4 + 1] * rstd * sg[1]); w.y = cvt_pk_bf16(o[0][eb][4 * g4 + 2] * rstd * sg[2], o[0][eb][4 * g4 + 3] * rstd * sg[3]);
            *(u32x2*)(xb + (size_t)qrow * 256 + h * 64 + e) = w; }
    __syncthreads();
}

__device__ __forceinline__ void conv_unit(Frame& F, int seq_row0, int seq_len, int tok0, const float* dw, const float* db, const float* lng, const float* lnb) {
    const bf16* Z = (const bf16*)(F.ws + WS_Z);
    LAS unsigned short* U = (LAS unsigned short*)F.lds;
    LAS float* Yt = (LAS float*)(F.lds + 94 * 512);
    for (int i = F.tid; i < 94 * 32; i += 512) { const int tt = i >> 5, ch = i & 31; const int t = tok0 - 15 + tt;
        u32x4 v = (u32x4){0u, 0u, 0u, 0u}; if (t >= 0 && t < seq_len) v = *(const u32x4*)(Z + (size_t)(seq_row0 + t) * ZW + ZQ_CV + ch * 8);
        *(LAS u32x4*)(U + tt * 256 + ch * 8) = v; }
    __syncthreads();
    const int ctid = opaque_v(F.tid), ch = ctid & 255, half = ctid >> 8;
    float w[31];
#pragma unroll
    for (int k = 0; k < 31; ++k) w[k] = dw[k * 256 + ch];
    const float bias = db[ch];
#pragma unroll 1
    for (int g = 0; g < 2; ++g) {
        const int t0 = half * 32 + g * 16;
        float x[46];
#pragma unroll
        for (int i = 0; i < 46; ++i) x[i] = bf2f(U[(t0 + i) * 256 + ch]);
#pragma unroll
        for (int j = 0; j < 16; ++j) { float a = bias;
#pragma unroll
            for (int k = 0; k < 31; ++k) a += w[k] * x[j + k];
            Yt[(t0 + j) * 256 + ch] = a; }
    }
    __syncthreads();
    bf16* xb = (bf16*)(F.ws + WS_XB) + (size_t)3 * RT * 256;
    for (int t = F.wave; t < 64; t += 8) {
        const f32x4 y = *(const LAS f32x4*)(Yt + t * 256 + 4 * F.lane);
        const float mean = wave_sum((y[0] + y[1]) + (y[2] + y[3])) * (1.0f / 256.0f);
        const f32x4 dv = y - mean; const float var = wave_sum((dv[0] * dv[0] + dv[1] * dv[1]) + (dv[2] * dv[2] + dv[3] * dv[3])) * (1.0f / 256.0f);
        const float rstd = 1.0f / sqrtf(var + EPS);
        const f32x4 g4 = *(const f32x4*)(lng + 4 * F.lane), b4 = *(const f32x4*)(lnb + 4 * F.lane);
        const f32x4 z = dv * rstd * g4 + b4;
        u32x2 wv; wv.x = cvt_pk_bf16(siluf_(z[0]), siluf_(z[1])); wv.y = cvt_pk_bf16(siluf_(z[2]), siluf_(z[3]));
        *(u32x2*)(xb + (size_t)(seq_row0 + tok0 + t) * 256 + 4 * F.lane) = wv;
    }
    __syncthreads();
}
#ifndef F8_LAYER_MASK
#define F8_LAYER_MASK 0xF
#endif
constexpr int F8MASK = F8_LAYER_MASK;
constexpr int NSTEP_L = 12, NSTEPS = 2 + DEPTH * NSTEP_L;
struct Args { const float* in[39]; float* out; unsigned char* ws; int s_lo, s_hi; };
static_assert(sizeof(Args) == 39 * 8 + 8 + 8 + 8, "Args has no padding");

template <int OFF> __device__ __forceinline__ unsigned long long ka64() { unsigned long long v; asm volatile("s_load_dwordx2 %0, %1, %2\n\ts_waitcnt lgkmcnt(0)" : "=s"(v) : "s"(__builtin_amdgcn_kernarg_segment_ptr()), "n"(OFF)); return v; }
template <int OFF> __device__ __forceinline__ int ka32() { int v; asm volatile("s_load_dword %0, %1, %2\n\ts_waitcnt lgkmcnt(0)" : "=s"(v) : "s"(__builtin_amdgcn_kernarg_segment_ptr()), "n"(OFF)); return v; }
#define KIN(k) ((const float*)ka64<8 * (k)>())
#define KOUT ((float*)ka64<312>())
#define KWS ((unsigned char*)ka64<320>())
__global__ void __launch_bounds__(NWAVES * 64, 2) fwd_kernel(Args) {
    extern __shared__ __attribute__((aligned(16))) unsigned char lds[];
    Frame F;
    F.lds = (LAS unsigned char*)lds;
    F.MISC = (volatile LAS unsigned*)(F.lds + MISC_OFF);
    F.tid = threadIdx.x; F.lane = F.tid & 63; F.wave = __builtin_amdgcn_readfirstlane(F.tid >> 6);
    F.G = gridDim.x; { const int bx = blockIdx.x; F.vcu = (F.G % 8 == 0) ? (bx % 8) * (F.G / 8) + bx / 8 : bx; }
    F.ws = KWS;
    unsigned char* ws = F.ws;
    for (int u = F.tid; u < (LDS_BYTES - LDSCTL_OFF) / 4; u += NWAVES * 64) ((LAS unsigned*)(F.lds + LDSCTL_OFF))[u] = 0u;
    __syncthreads();
    unsigned* barw = (unsigned*)(ws + WS_CTL) + CW_BAR; asm volatile("" : "+s"(barw));
    const int lo = ka32<328>(), hi = ka32<332>();
    XcdBarrier bar; bar.bar = barw; bar.x = 0; bar.st = nullptr;
    if (hi - lo > 1) bar = xcd_barrier_post(barw, F.MISC + 8, F.tid);
#ifndef BR_REP
#define BR_REP 0
#endif
#ifndef PH_MASK
#define PH_MASK 0xFFFFF
#endif
#define EN(j) (((PH_MASK) >> (j)) & 1)
#define IN(k) (lo <= (k) && (k) < hi)
#define FRESH() do { int ln_; asm volatile("v_mbcnt_lo_u32_b32 %0, -1, 0\n\tv_mbcnt_hi_u32_b32 %0, -1, %0" : "=v"(ln_)); F.wave = opaque_s(F.wave); F.lane = ln_; F.tid = F.wave * 64 + ln_; \
    F.vcu = opaque_s(F.vcu); F.G = opaque_s(F.G); asm volatile("" : "+s"(F.ws)); ws = F.ws; } while (0)
#define GW (F.vcu * NWAVES + F.wave)
#define NGW_ (F.G * NWAVES)
#define SEAM(k) do { if (IN(k) && IN((k) + 1)) { FRESH(); xcd_barrier(bar, F.tid); } } while (0)

    if (EN(12) && IN(0)) { FRESH();
        P0Args P; P.c = KIN(1); P.c_ctx = KIN(3); P.ada_w = KIN(4); P.ada_b = KIN(5); P.w_in = KIN(10); P.w_gate = KIN(11); P.ret_w_o = KIN(14); P.s5_w_glu = KIN(23);
        P.diff_w_o = KIN(26); P.conv_w_o = KIN(31); P.w_out = KIN(32); P.ffn_w_gu = KIN(33); P.ffn_w_d = KIN(34); P.moe_w_gu = KIN(37); P.moe_w_d = KIN(38);
        P.ret_decay = KIN(13); P.s5_a_re = KIN(15); P.s5_a_im = KIN(16); P.s5_log_dt = KIN(17); P.s5_b_re = KIN(18); P.s5_b_im = KIN(19); P.s5_c_re = KIN(20); P.s5_c_im = KIN(21); P.diff_lambda = KIN(24);
        P.f8mask = F8MASK;
        p0_prologue(F, P);
    }
    SEAM(0);
    if (EN(13) && IN(1)) { FRESH(); RowArgs A{}; A.x = KIN(0); A.ctx = KIN(2); A.pre_g = KIN(6); A.l = 0; A.nrows = RT; row_pass<0>(F, A); }
    SEAM(1);

#pragma unroll 1
    for (int l = 0; l < DEPTH; ++l) {
        const int s0 = 2 + l * NSTEP_L;
        if (hi <= s0 || lo >= s0 + NSTEP_L) continue;
        const bool need_ctx = l < DEPTH - 1, moe = (l & 1) != 0;
        const int nrows = need_ctx ? RT : RL, nM = nrows / 256, j2 = l >> 1;
#define lp ((const float*)(ws + WS_LAYP) + l * 64)
#define AF ((bf16*)(ws + WS_AF))
#define Z ((bf16*)(ws + WS_Z))

        if (EN(0) && IN(s0 + 0)) { FRESH();
            pg8::Gemm g{AF, (const bf16*)(ws + WS_WIN) + (size_t)l * E_WIN, D, 0, 0}; pg8::SchedWin S; S.init(F.G, opaque_s((int)blockIdx.x), need_ctx ? 0 : 2);
            pg8::EpiWin E{Z, (const float*)(ws + WS_ROPE)};
            pg8::gemm_phase(F.lds, g, S, E, F.tid);
        }
        SEAM(s0 + 0);
        if (EN(1) && IN(s0 + 1)) { FRESH();
            unsigned* dep = (unsigned*)(ws + WS_CTL) + CW_DEP + 1024 * l;
            if (need_ctx) {
                pg8::Gemm g{AF, (const bf16*)(ws + WS_WIN) + (size_t)l * E_WIN, D, 0, 0}; pg8::SchedWin S; S.init(F.G, opaque_s((int)blockIdx.x), 1);
                pg8::EpiWin E{Z, (const float*)(ws + WS_ROPE)};
                pg8::gemm_phase(F.lds, g, S, E, F.tid);
                __syncthreads(); FRESH();
                const int bx = opaque_s((int)blockIdx.x), nmine = bx < 16 ? (16 - bx + F.G - 1) / F.G : 0;
                if (nmine > 0) dep_signal(F, dep + 128, (unsigned)nmine);
            }
            unsigned* ctr = (unsigned*)(ws + WS_CTL) + 8192 + 64 * (l * 2 + 0);
            const int n_rs = NB * NCH, nS = n_rs + NB * NCH * 2, nP = 80, e0 = nS + nP;
            const int c_lo = need_ctx ? 0 : 2, nch = NCH - c_lo;
            const int n_at = 512, n_ret = NB * nch, n_s5 = NB * nch * 2, n_cv = need_ctx ? 576 : 512, n_ac = need_ctx ? 64 : 0;
            const int e1 = e0 + n_at, e2 = e1 + n_ret, e3 = e2 + n_s5, e4 = e3 + n_cv, total = e4 + n_ac;
            int u = F.vcu, nsum = 0;
            while (u < total) {
                int nx = 0; if (F.tid == 0) nx = F.G + (int)__hip_atomic_fetch_add(ctr, 1u, RLX_AGENT);
                FRESH();
                if (u < n_rs) { for (int rp_ = 0; rp_ < 1 + ((BR_REP >> 4) & 1); ++rp_) ret_summary_unit(F, u / NCH, u % NCH, lp); }
                else if (u < nS) { const int wu = (u - n_rs) * 8 + F.wave; const int g = wu & 15, bc = wu >> 4; for (int rp_ = 0; rp_ < 1 + ((BR_REP >> 5) & 1); ++rp_) s5_wave_unit<false>(F, bc / NCH, bc % NCH, g, l, nullptr); }
                else if (u < e0) { dep_wait(F, dep, (unsigned)nS); FRESH();
                    const int wu = (u - nS) * 8 + F.wave;
                    if (wu < 128) ret_prefix_unit(F, wu >> 3, (wu >> 1) & 3, wu & 1, lp);
                    else { const int v = wu - 128; s5_prefix_unit(F, v >> 5, (v >> 1) & 15, v & 1, l); } }
                else if (u < e1) { const int v = u - e0; for (int rp_ = 0; rp_ < 1 + ((BR_REP >> 0) & 1); ++rp_) attn_unit(F, v >> 5, (v >> 3) & 3, (v >> 5) * SEQ + (v & 7) * 256, 36, false, lp[8], lp[9], KIN(25) + l * 64); }
                else if (u < e2) { dep_wait(F, dep + 64, (unsigned)nP); FRESH(); const int v = u - e1; for (int rp_ = 0; rp_ < 1 + ((BR_REP >> 1) & 1); ++rp_) ret_out_unit(F, v / nch, c_lo + v % nch, lp); }
                else if (u < e3) { dep_wait(F, dep + 64, (unsigned)nP); FRESH(); const int wu = (u - e2) * 8 + F.wave; const int g = wu & 15, bc = wu >> 4; for (int rp_ = 0; rp_ < 1 + ((BR_REP >> 2) & 1); ++rp_) s5_wave_unit<true>(F, bc / nch, c_lo + bc % nch, g, l, KIN(22)); }
                else if (u < e4) { const int v = u - e3; const float* dw = KIN(27) + (size_t)l * 31 * 256; const float* db = KIN(28) + l * 256; const float* lng = KIN(29) + l * 256; const float* lnb = KIN(30) + l * 256;
                    if (v >= 512) { dep_wait(F, dep + 128, 16u); FRESH(); }
                    for (int rp_ = 0; rp_ < 1 + ((BR_REP >> 3) & 1); ++rp_)
                    if (v < 512) conv_unit(F, (v >> 5) * SEQ, SEQ, (v & 31) * 64, dw, db, lng, lnb);
                    else { const int v2 = v - 512; conv_unit(F, RL + (v2 >> 2) * NCTX, NCTX, (v2 & 3) * 64, dw, db, lng, lnb); } }
                else { const int v = u - e4; attn_unit(F, v >> 2, v & 3, RL + (v >> 2) * NCTX, 4, true, lp[8], lp[9], KIN(25) + l * 64); }
                if (F.tid == 0) F.MISC[24] = (unsigned)nx;
                __syncthreads(); const int un = (int)F.MISC[24]; __syncthreads();
                if (u < nS) { ++nsum; if (un >= nS) dep_signal(F, dep, (unsigned)nsum); }
                else if (u < e0) dep_signal(F, dep + 64, 1u);
                u = un;
            }
        }
        SEAM(s0 + 3);
        if (EN(4) && IN(s0 + 4)) { FRESH();
            pg8::Gemm g{(const bf16*)(ws + WS_XB), (const bf16*)(ws + WS_WBR) + (size_t)l * E_WBR, 256}; pg8::SchedBr S; S.init(nM, F.G, opaque_s((int)blockIdx.x));
            pg8::EpiBr E{(bf16*)(ws + WS_BO)};
            pg8::gemm_phase(F.lds, g, S, E, F.tid);
        }
        SEAM(s0 + 4);
        if (EN(5) && IN(s0 + 5)) { FRESH();
            pg8::Gemm g{ws + WS_AF8, ws + WS_WG + (size_t)l * E_WG * 2, D, 121, 125}; pg8::SchedStd S; S.init(nM, 16, F.G, opaque_s((int)blockIdx.x), 1);
            pg8::EpiGate E{(const bf16*)(ws + WS_BO), (bf16*)(ws + WS_MM), KIN(12) + (size_t)l * 4 * D, F.lds + 131072};
            pg8::gemm_phase<pg8::EpiGate, pg8::SchedStd, true>(F.lds, g, S, E, F.tid);
        }
        SEAM(s0 + 5);
        if (EN(6) && IN(s0 + 6)) { FRESH();
            pg8::Gemm g{(const bf16*)(ws + WS_MM), (const bf16*)(ws + WS_WOUT) + (size_t)l * E_WOUT, D}; pg8::SchedStd S; S.init(nM, 4, F.G, opaque_s((int)blockIdx.x));
            pg8::EpiBf16 E{(bf16*)(ws + WS_Y), D};
            pg8::gemm_phase(F.lds, g, S, E, F.tid);
        }
        SEAM(s0 + 6);
        if (EN(7) && IN(s0 + 7)) { FRESH(); RowArgs A{}; A.post_g = KIN(7) + l * D; A.pre_g = KIN(8) + l * D; A.l = l; A.nrows = nrows; A.moe = moe ? 1 : 0;
            A.f8 = (F8MASK >> l) & 1; A.router_w = KIN(35) + (size_t)j2 * D * NE; A.router_b = KIN(36) + j2 * NE;
#if defined(PROBE_DRY) && (PROBE_DRY & 1)
            if ((PROBE_DRY_L >> l) & 1) { for (int rp_ = 0; rp_ < PROBE_DRY_N; ++rp_) { A.dry = 1; row_pass<1>(F, A); A.dry = 0; __syncthreads(); FRESH(); } }
#endif
            row_pass<1>(F, A); }
        SEAM(s0 + 7);
        if (moe) {
            if (EN(8) && IN(s0 + 8)) { FRESH(); moe_dispatch(F, nrows, (F8MASK >> l) & 1); }
            SEAM(s0 + 8);
            if (EN(9) && IN(s0 + 9)) { FRESH();
                const int* te = (const int*)(ws + WS_TILEE); const int nt = __builtin_amdgcn_readfirstlane(__hip_atomic_load(te + 400, RLX_AGENT));
                pg8::SchedMoe S; S.init(nt, 2 * FFE / 256, F.G, opaque_s((int)blockIdx.x), te);
                if ((F8MASK & 0xA) && ((F8MASK >> l) & 1)) {
                    pg8::Gemm g{ws + WS_FS, ws + WS_MGU + (size_t)j2 * NE * E_MGU * 2, D, 121, 125}; pg8::EpiSwiGLU8 E{ws + WS_GS, FFE};
                    pg8::gemm_phase<pg8::EpiSwiGLU8, pg8::SchedMoe, true>(F.lds, g, S, E, F.tid);
                } else if ((~F8MASK) & 0xA) {
                    pg8::Gemm g{ws + WS_FS, ws + WS_MGU + (size_t)j2 * NE * E_MGU * 2, D, 0, 0}; pg8::EpiSwiGLU E{(bf16*)(ws + WS_GS), FFE};
                    pg8::gemm_phase(F.lds, g, S, E, F.tid);
                }
            }
            SEAM(s0 + 9);
            if (EN(10) && IN(s0 + 10)) { FRESH();
                const int* te = (const int*)(ws + WS_TILEE); const int nt = __builtin_amdgcn_readfirstlane(__hip_atomic_load(te + 400, RLX_AGENT));
                pg8::SchedMoe S; S.init(nt, 4, F.G, opaque_s((int)blockIdx.x), te, 1); pg8::EpiBf16 E{(bf16*)(ws + WS_YS), D};
                if ((F8MASK & 0xA) && ((F8MASK >> l) & 1)) {
                    pg8::Gemm g{ws + WS_GS, ws + WS_MWD + (size_t)j2 * NE * E_MWD * 2, FFE, 121, 124};
                    pg8::gemm_phase<pg8::EpiBf16, pg8::SchedMoe, true>(F.lds, g, S, E, F.tid);
                } else if ((~F8MASK) & 0xA) {
                    pg8::Gemm g{ws + WS_GS, ws + WS_MWD + (size_t)j2 * NE * E_MWD * 2, FFE, 0, 0};
                    pg8::gemm_phase(F.lds, g, S, E, F.tid);
                }
            }
            SEAM(s0 + 10);
        } else {
            if (EN(9) && IN(s0 + 9)) { FRESH();
                pg8::SchedStd S; S.init(nM, 2 * FFD / 256, F.G, opaque_s((int)blockIdx.x));
                if ((F8MASK & 0x5) && ((F8MASK >> l) & 1)) {
                    pg8::Gemm g{AF, ws + WS_WGU + (size_t)j2 * E_WGU * 2, D, 121, 125}; pg8::EpiSwiGLU8 E{ws + WS_G, FFD};
                    pg8::gemm_phase<pg8::EpiSwiGLU8, pg8::SchedStd, true>(F.lds, g, S, E, F.tid);
                } else if ((~F8MASK) & 0x5) {
                    pg8::Gemm g{AF, ws + WS_WGU + (size_t)j2 * E_WGU * 2, D, 0, 0}; pg8::EpiSwiGLU E{(bf16*)(ws + WS_G), FFD};
                    pg8::gemm_phase(F.lds, g, S, E, F.tid);
                }
            }
            SEAM(s0 + 9);
            if (EN(10) && IN(s0 + 10)) { FRESH();
                pg8::SchedStd S; S.init(nM, 4, F.G, opaque_s((int)blockIdx.x)); pg8::EpiBf16 E{(bf16*)(ws + WS_Y), D};
                if ((F8MASK & 0x5) && ((F8MASK >> l) & 1)) {
                    pg8::Gemm g{ws + WS_G, ws + WS_WD + (size_t)j2 * E_WD * 2, FFD, 121, 124};
                    pg8::gemm_phase<pg8::EpiBf16, pg8::SchedStd, true>(F.lds, g, S, E, F.tid);
                } else if ((~F8MASK) & 0x5) {
                    pg8::Gemm g{ws + WS_G, ws + WS_WD + (size_t)j2 * E_WD * 2, FFD, 0, 0};
                    pg8::gemm_phase(F.lds, g, S, E, F.tid);
                }
            }
            SEAM(s0 + 10);
        }
        if (EN(11) && IN(s0 + 11)) { FRESH(); RowArgs A{}; A.post_g = KIN(9) + l * D; A.pre_g = KIN(6) + (l + 1 < DEPTH ? l + 1 : l) * D; A.l = l; A.nrows = nrows; A.moe = moe ? 1 : 0; A.last = need_ctx ? 0 : 1; A.out = KOUT;
#if defined(PROBE_DRY) && (PROBE_DRY & 2)
            if ((PROBE_DRY_L >> l) & 1) { for (int rp_ = 0; rp_ < PROBE_DRY_N; ++rp_) { A.dry = 1; row_pass<2>(F, A); A.dry = 0; __syncthreads(); FRESH(); } }
#endif
            row_pass<2>(F, A); }
        if (l + 1 < DEPTH) SEAM(s0 + 11);
    }
#undef lp
#undef AF
#undef Z
#undef IN
#undef SEAM
}

#ifndef MK_LAUNCH_PER_STEP
#define MK_LAUNCH_PER_STEP 0
#endif
extern "C" void kernel_launch(void* const* d_in, const int* in_sizes, int n_in, void* d_out, int out_size, void* d_ws, size_t ws_size, hipStream_t stream) {
    static int grid = 0;
    if (grid == 0) {
        if (n_in != 39 || out_size != RL * D || ws_size < WS_END) { fprintf(stderr, "kernel_launch: unexpected shapes: n_in %d out %d ws %zu (need %zu)\n", n_in, out_size, ws_size, (size_t)WS_END); grid = -1; return; }
        int dev = 0, cus = 0, per_cu = 0;
        if (hipGetDevice(&dev) != hipSuccess || hipDeviceGetAttribute(&cus, hipDeviceAttributeMultiprocessorCount, dev) != hipSuccess) { grid = -1; return; }
        if (hipFuncSetAttribute((const void*)fwd_kernel, hipFuncAttributeMaxDynamicSharedMemorySize, LDS_BYTES) != hipSuccess) { fprintf(stderr, "kernel_launch: hipFuncSetAttribute failed\n"); grid = -1; return; }
        if (hipOccupancyMaxActiveBlocksPerMultiprocessor(&per_cu, (const void*)fwd_kernel, NWAVES * 64, LDS_BYTES) != hipSuccess || per_cu < 1) { fprintf(stderr, "kernel_launch: occupancy query says %d\n", per_cu); }
        (void)hipGetLastError();
        grid = cus;
    }
    if (grid < 0) return;
    if (hipMemsetAsync((char*)d_ws + WS_CTL, 0, CTL_ZERO_BYTES, stream) != hipSuccess) return;
    Args a{};
    for (int i = 0; i < 39; ++i) a.in[i] = (const float*)d_in[i];
    a.out = (float*)d_out; a.ws = (unsigned char*)d_ws;
#if MK_LAUNCH_PER_STEP
    for (int s = 0; s < NSTEPS; ++s) { a.s_lo = s; a.s_hi = s + 1;
        int rep = 1;
#ifdef PROBE_REP_MASK
        if (s >= 2) { const int j = (s - 2) % NSTEP_L, l = (s - 2) / NSTEP_L; if (((PROBE_REP_MASK) >> j) & 1 && ((PROBE_LAYER_MASK) >> l) & 1) rep = 2; } else if (((PROBE_REP_MASK) >> (12 + s)) & 1) rep = 2;
#endif
        for (int r = 0; r < rep; ++r) hipLaunchKernelGGL(fwd_kernel, dim3(grid), dim3(NWAVES * 64), LDS_BYTES, stream, a); }
#else
    a.s_lo = 0; a.s_hi = NSTEPS;
    hipLaunchKernelGGL(fwd_kernel, dim3(grid), dim3(NWAVES * 64), LDS_BYTES, stream, a);
#endif
    const hipError_t le = hipPeekAtLastError();
    if (le != hipSuccess) fprintf(stderr, "kernel_launch: launch failed: %s\n", hipGetErrorName(le));
}
```

```cpp
#include <hip/hip_runtime.h>
#include <cstdio>
#include <cstdint>

#define LAS __attribute__((address_space(3)))
#define GAS __attribute__((address_space(1)))
typedef unsigned short bf16;
typedef short bf16x8 __attribute__((ext_vector_type(8)));
typedef short s16x4 __attribute__((ext_vector_type(4)));
typedef float f32x4 __attribute__((ext_vector_type(4)));
typedef float f32x2 __attribute__((ext_vector_type(2)));
typedef float f32x16 __attribute__((ext_vector_type(16)));
typedef unsigned u32x4 __attribute__((ext_vector_type(4)));
typedef unsigned u32x2 __attribute__((ext_vector_type(2)));

constexpr int D = 1024, NB = 16, SEQ = 2048, NCTX = 256, DEPTH = 4;
constexpr int RL = NB * SEQ;
constexpr int RC = NB * NCTX;
constexpr int RT = RL + RC;
constexpr int NIN = 2304;
constexpr int ZW = 2048;
constexpr int ZQ_RQ = 0, ZQ_RK = 128, ZQ_RV = 256, ZQ_RG = 512, ZQ_SU = 768, ZQ_DQ = 1024, ZQ_DK = 1280, ZQ_DV = 1536, ZQ_CV = 1792;
constexpr int FFD = 2816, FFE = 3584, NE = 8;
constexpr int MOE_ROWS = 2 * RT + NE * 256;
constexpr int NCH = 18;
constexpr float EPS = 1e-6f;

__device__ __forceinline__ unsigned f2bf(float f) { unsigned u = __builtin_bit_cast(unsigned, f); return (u + 0x7fffu + ((u >> 16) & 1u)) >> 16; }
__device__ __forceinline__ unsigned pk2(float lo, float hi) { return f2bf(lo) | (f2bf(hi) << 16); }
__device__ __forceinline__ float bf2f(unsigned short b) { return __builtin_bit_cast(float, ((unsigned)b) << 16); }
__device__ __forceinline__ float bflo(unsigned w) { return __builtin_bit_cast(float, w << 16); }
__device__ __forceinline__ float bfhi(unsigned w) { return __builtin_bit_cast(float, w & 0xffff0000u); }
__device__ __forceinline__ unsigned cvt_pk_bf16(float lo, float hi) { unsigned r; asm volatile("v_cvt_pk_bf16_f32 %0, %1, %2" : "=v"(r) : "v"(lo), "v"(hi)); return r; }
__device__ __forceinline__ float sigmoidf_(float x) { return __builtin_amdgcn_rcpf(1.0f + __builtin_amdgcn_exp2f(-1.44269504f * x)); }
__device__ __forceinline__ float siluf_(float x) { return x * sigmoidf_(x); }
__device__ __forceinline__ float wave_sum(float v) {
#pragma unroll
    for (int o = 1; o < 64; o <<= 1) v += __shfl_xor(v, o);
    return v;
}
__device__ __forceinline__ float opaque_f(float x) { asm volatile("" : "+v"(x)); return x; }
__device__ __forceinline__ float sigk(float x, float k) { return __builtin_amdgcn_rcpf(1.0f + __builtin_amdgcn_exp2f(k * x)); }
__device__ __forceinline__ float silk(float x, float k) { return x * sigk(x, k); }
__device__ __forceinline__ int opaque_v(int x) { asm volatile("" : "+v"(x)); return x; }
__device__ __forceinline__ int opaque_s(int x) { asm volatile("" : "+s"(x)); return x; }
#define LDS_WAIT() asm volatile("s_waitcnt lgkmcnt(0)" ::: "memory")
#define VM_WAIT() asm volatile("s_waitcnt vmcnt(0)" ::: "memory")
namespace pg8 {
constexpr int BM = 256, BK = 64, HALF = 128, HTB = HALF * BK * 2  , STAGE_BYTES = 8 * HTB, NXCD = 8, WGM = 8;

__host__ __device__ __forceinline__ int lds_byte(int r, int c) { const int st = (r >> 4) * 2 + (c >> 5), rr = r & 15, cc = c & 31, ob = rr * 64 + cc * 2; return st * 1024 + (ob ^ (((ob >> 9) & 1) << 5)); }
__host__ __device__ __forceinline__ void stage_rc(int b, int& R, int& C) { const int st = b / 1024, sb = b % 1024, swz = sb ^ (((sb >> 9) & 1) << 5); R = (st >> 1) * 16 + swz / 64; C = (st & 1) * 32 + (swz % 64) / 2; }
__host__ __device__ __forceinline__ int perm32(int rho) { const int n = rho >> 4, i = rho & 15; return 8 * (i >> 2) + 4 * n + (i & 3); }

struct Unit { int pm, pn, am, bn, z; };
struct Gemm { const void* A; const void* Bt; int K; int sa, sb; };
typedef int v8i_t __attribute__((ext_vector_type(8))); typedef int v4i_t __attribute__((ext_vector_type(4)));

__device__ __forceinline__ void decode_tile(int wgid, int nM, int nN, int& pm, int& pn) {
    const int nwg = nM * nN;
    { const int q = nwg / NXCD, r = nwg % NXCD, xcd = wgid % NXCD, off = wgid / NXCD; wgid = (xcd < r ? xcd * (q + 1) : r * (q + 1) + (xcd - r) * q) + off; }
    const int nig = WGM * nN, gid = wgid / nig, fm = gid * WGM, gsz = (nM - fm) < WGM ? (nM - fm) : WGM;
    pm = fm + ((wgid % nig) % gsz); pn = (wgid % nig) / gsz;
}
struct SchedStd {
    int nM, nN, G, c;
    __device__ __forceinline__ void init(int nM_, int nN_, int G_, int c_) { nM = nM_; nN = nN_; G = G_; c = c_; }
    __device__ __forceinline__ bool next(int i, Unit& u) const {
        const long L = (long)i * G + c; if (L >= (long)nM * nN) return false;
        decode_tile((int)L, nM, nN, u.pm, u.pn); u.am = u.pm; u.bn = u.pn; u.z = 0; return true;
    }
};
struct SchedWin {
    int G, c, mode;
    __device__ __forceinline__ void init(int G_, int c_, int mode_) { G = G_; c = c_; mode = mode_; }
    __device__ __forceinline__ bool next(int i, Unit& u) const {
        const int L = i * G + c; u.z = 0;
        if (mode == 1) { if (L >= 16) return false; u.pm = 128 + L; u.pn = 8; }
        else if (L < 1152) decode_tile(L, 128, 9, u.pm, u.pn);
        else if (mode == 0) { if (L >= 1280) return false; decode_tile(L - 1152, 16, 8, u.pm, u.pn); u.pm += 128; }
        else { if (L >= 1232) return false; int q; decode_tile(L - 1152, 16, 5, u.pm, q); u.pm += 128; u.pn = q < 2 ? q : (q == 2 ? 3 : q + 2); }
        u.am = u.pm; u.bn = u.pn; return true;
    }
};
struct SchedBr {
    int nM, G, c;
    __device__ __forceinline__ void init(int nM_, int G_, int c_) { nM = nM_; G = G_; c = c_; }
    __device__ __forceinline__ bool next(int i, Unit& u) const {
        const long L = (long)i * G + c; if (L >= (long)nM * 20) return false;
        int pm, pa; decode_tile((int)L, nM, 20, pm, pa);
        const int z = pa < 4 ? 0 : (pa < 12 ? 1 : (pa < 16 ? 2 : 3)), st = z == 0 ? 0 : (z == 1 ? 4 : (z == 2 ? 12 : 16));
        u.pm = pm; u.pn = pa - st; u.am = z * (RT / 256) + pm; u.bn = pa; u.z = z; return true;
    }
};
struct SchedGate {
    int nM, G, c;
    __device__ __forceinline__ void init(int nM_, int G_, int c_) { nM = nM_; G = G_; c = c_; }
    __device__ __forceinline__ bool next(int i, Unit& u) const {
        const long L = (long)(i >> 2) * G + c; if (L >= (long)nM * 4) return false;
        decode_tile((int)L, nM, 4, u.pm, u.pn); u.z = i & 3; u.am = u.pm; u.bn = u.z * 4 + u.pn; return true;
    }
};
struct SchedMoe {
    int nM, nN, G, c; const int* tile_e;
    __device__ __forceinline__ void init(int nM_, int nN_, int G_, int c_, const int* te) { nM = nM_; nN = nN_; G = G_; c = c_; tile_e = te; }
    __device__ __forceinline__ bool next(int i, Unit& u) const {
        const long L = (long)i * G + c; if (L >= (long)nM * nN) return false;
        decode_tile((int)L, nM, nN, u.pm, u.pn); u.am = u.pm; u.z = 0;
        const int e = __builtin_amdgcn_readfirstlane(__hip_atomic_load(tile_e + u.pm, __ATOMIC_RELAXED, __HIP_MEMORY_SCOPE_AGENT));
        u.bn = e * nN + u.pn; return true;
    }
};

#define EPI_ROWS(...) _Pragma("unroll") for (int ai = 0; ai < 2; ++ai) _Pragma("unroll") for (int m = 0; m < 4; ++m) { const int row = u.pm * BM + wr * 64 + fr + ai * HALF + m * 16; _Pragma("unroll") for (int bj = 0; bj < 2; ++bj) { const f32x4 v0 = acc[ai][bj][m][0], v1 = acc[ai][bj][m][1]; const int cb = 128 * bj + 32 * wc + 8 * fq; __VA_ARGS__ } }
typedef GAS u32x4* gq4; typedef GAS u32x2* gq2; typedef const GAS u32x4* cgq4; typedef const GAS f32x4* cgf4;

struct EpiF32 {
    static constexpr bool PERM = false;
    float* C; int ldc;
    __device__ __forceinline__ void operator()(const f32x4 (&acc)[2][2][4][2], const Unit& u, int wr, int wc, int fr, int fq) const {
        const int row0 = u.pm * BM + wr * 64 + fr, col0 = u.pn * BM + wc * 32 + 4 * fq;
#pragma unroll
        for (int ai = 0; ai < 2; ++ai)
#pragma unroll
            for (int m = 0; m < 4; ++m) { GAS float* rowp = (GAS float*)C + (size_t)(row0 + ai * HALF + m * 16) * ldc + col0;
#pragma unroll
                for (int bj = 0; bj < 2; ++bj)
#pragma unroll
                    for (int n = 0; n < 2; ++n) *(GAS f32x4*)(rowp + bj * HALF + n * 16) = acc[ai][bj][m][n]; }
    }
};
struct EpiBf16 {
    static constexpr bool PERM = true;
    bf16* O; int ldc;
    __device__ __forceinline__ void operator()(const f32x4 (&acc)[2][2][4][2], const Unit& u, int wr, int wc, int fr, int fq) const {
        EPI_ROWS({ u32x4 w; w.x = cvt_pk_bf16(v0[0], v0[1]); w.y = cvt_pk_bf16(v0[2], v0[3]); w.z = cvt_pk_bf16(v1[0], v1[1]); w.w = cvt_pk_bf16(v1[2], v1[3]);
                   *(gq4)((GAS bf16*)O + (size_t)row * ldc + u.pn * BM + cb) = w; })
    }
};
struct EpiSwiGLU {
    static constexpr bool PERM = true;
    bf16* O; int ldc;
    __device__ __forceinline__ void operator()(const f32x4 (&acc)[2][2][4][2], const Unit& u, int wr, int wc, int fr, int fq) const {
        const float kq = opaque_f(-1.44269504f);
        EPI_ROWS({ u32x2 w; w.x = cvt_pk_bf16(silk(v0[0], kq) * v0[1], silk(v0[2], kq) * v0[3]); w.y = cvt_pk_bf16(silk(v1[0], kq) * v1[1], silk(v1[2], kq) * v1[3]);
                   *(gq2)((GAS bf16*)O + (size_t)row * ldc + ((u.pn * BM + cb) >> 1)) = w; })
    }
};
struct EpiSwiGLU8 {
    static constexpr bool PERM = true;
    unsigned char* O; int ldc;
    __device__ __forceinline__ void operator()(const f32x4 (&acc)[2][2][4][2], const Unit& u, int wr, int wc, int fr, int fq) const {
        const float one = opaque_f(1.0f);
#define SG8(x, y) ((x) * __builtin_amdgcn_rcpf(one + __builtin_amdgcn_exp2f(x)) * (y))
        EPI_ROWS({ unsigned w = 0; w = __builtin_amdgcn_cvt_pk_fp8_f32(SG8(v0[0], v0[1]), SG8(v0[2], v0[3]), w, false); w = __builtin_amdgcn_cvt_pk_fp8_f32(SG8(v1[0], v1[1]), SG8(v1[2], v1[3]), w, true);
                   *(GAS unsigned*)((GAS unsigned char*)O + (size_t)row * ldc + ((u.pn * BM + cb) >> 1)) = w; })
#undef SG8
    }
};
struct EpiWin {
    static constexpr bool PERM = true;
    bf16* Z; const float* rope;
    __device__ __forceinline__ void operator()(const f32x4 (&acc)[2][2][4][2], const Unit& u, int wr, int wc, int fr, int fq) const {
        const float kq = opaque_f(-1.44269504f);
        GAS bf16* Zg = (GAS bf16*)Z;
        if (u.pn >= 7) {
            EPI_ROWS({ u32x2 w; w.x = cvt_pk_bf16(v0[0] * sigk(v0[1], kq), v0[2] * sigk(v0[3], kq)); w.y = cvt_pk_bf16(v1[0] * sigk(v1[1], kq), v1[2] * sigk(v1[3], kq));
                       *(gq2)(Zg + (size_t)row * ZW + ZQ_CV + (u.pn - 7) * 128 + (cb >> 1)) = w; })
        } else if ((u.pn == 4 || u.pn == 5) && u.pm < RL / 256) {
#pragma unroll
            for (int ai = 0; ai < 2; ++ai) {
                f32x4 c0[4], c1[4];
#pragma unroll
                for (int m = 0; m < 4; ++m) { const int row = u.pm * BM + wr * 64 + fr + ai * HALF + m * 16; cgf4 rp = (cgf4)((const GAS float*)rope + (size_t)(row & (SEQ - 1)) * 32 + fq * 8); c0[m] = rp[0]; c1[m] = rp[1]; }
#pragma unroll
                for (int m = 0; m < 4; ++m) { const int row = u.pm * BM + wr * 64 + fr + ai * HALF + m * 16;
#pragma unroll
                    for (int bj = 0; bj < 2; ++bj) { const f32x4 v0 = acc[ai][bj][m][0], v1 = acc[ai][bj][m][1]; const int cb = 128 * bj + 32 * wc + 8 * fq; const f32x4 a = c0[m], b = c1[m];
                        u32x4 w; w.x = cvt_pk_bf16(v0[0] * a[0] - v0[1] * a[1], v0[1] * a[0] + v0[0] * a[1]); w.y = cvt_pk_bf16(v0[2] * a[2] - v0[3] * a[3], v0[3] * a[2] + v0[2] * a[3]);
                        w.z = cvt_pk_bf16(v1[0] * b[0] - v1[1] * b[1], v1[1] * b[0] + v1[0] * b[1]); w.w = cvt_pk_bf16(v1[2] * b[2] - v1[3] * b[3], v1[3] * b[2] + v1[2] * b[3]);
                        *(gq4)(Zg + (size_t)row * ZW + u.pn * BM + cb) = w; } }
            }
        } else {
            EPI_ROWS({ u32x4 w; w.x = cvt_pk_bf16(v0[0], v0[1]); w.y = cvt_pk_bf16(v0[2], v0[3]); w.z = cvt_pk_bf16(v1[0], v1[1]); w.w = cvt_pk_bf16(v1[2], v1[3]);
                       *(gq4)(Zg + (size_t)row * ZW + u.pn * BM + cb) = w; })
        }
    }
};
struct EpiBr {
    static constexpr bool PERM = true;
    bf16* BO;
    __device__ __forceinline__ void operator()(const f32x4 (&acc)[2][2][4][2], const Unit& u, int wr, int wc, int fr, int fq) const {
        const float kq = opaque_f(-1.44269504f);
        GAS unsigned char* base = (GAS unsigned char*)((GAS bf16*)BO + (size_t)u.z * RT * D) + (size_t)u.pm * (128 * 256 * 16) + (size_t)((wr * 64 + fr) * 16);
        if (u.z == 1) {
            GAS unsigned char* lp = base + (size_t)(16 * u.pn + 2 * wc + (fq >> 1)) * 4096 + (fq & 1) * 8;
#pragma unroll
            for (int ai = 0; ai < 2; ++ai)
#pragma unroll
                for (int m = 0; m < 4; ++m)
#pragma unroll
                    for (int bj = 0; bj < 2; ++bj) { const f32x4 v0 = acc[ai][bj][m][0], v1 = acc[ai][bj][m][1];
                        u32x2 w; w.x = cvt_pk_bf16(v0[0] * sigk(v0[1], kq), v0[2] * sigk(v0[3], kq)); w.y = cvt_pk_bf16(v1[0] * sigk(v1[1], kq), v1[2] * sigk(v1[3], kq));
                        *(gq2)(lp + bj * (8 * 4096) + (ai * 128 + m * 16) * 16) = w; }
        } else {
            GAS unsigned char* lp = base + (size_t)(32 * u.pn + 4 * wc + fq) * 4096;
#pragma unroll
            for (int ai = 0; ai < 2; ++ai)
#pragma unroll
                for (int m = 0; m < 4; ++m)
#pragma unroll
                    for (int bj = 0; bj < 2; ++bj) { const f32x4 v0 = acc[ai][bj][m][0], v1 = acc[ai][bj][m][1];
                        u32x4 w; w.x = cvt_pk_bf16(v0[0], v0[1]); w.y = cvt_pk_bf16(v0[2], v0[3]); w.z = cvt_pk_bf16(v1[0], v1[1]); w.w = cvt_pk_bf16(v1[2], v1[3]);
                        *(gq4)(lp + bj * (16 * 4096) + (ai * 128 + m * 16) * 16) = w; }
        }
    }
};
struct EpiGate {
    static constexpr bool PERM = true;
    const bf16* BO; bf16* MM; const float* bgate; LAS unsigned char* xl;
    __device__ __forceinline__ void operator()(const f32x4 (&acc)[2][2][4][2], const Unit& u, int wr, int wc, int fr, int fq) const {
        const float kq = opaque_f(-1.44269504f); fr = opaque_v(fr); fq = opaque_v(fq);
        const int oc = u.pn * 64 + 32 * (wc & 1) + 8 * fq, zlo = wc >> 1, lane = fr + 16 * fq;
        const GAS unsigned char* bo0 = (const GAS unsigned char*)((const GAS bf16*)BO + (size_t)zlo * RT * D) + ((size_t)u.pm * 128 + (oc >> 3)) * (256 * 16); const GAS unsigned char* bo1 = bo0 + (size_t)2 * RT * D * 2; GAS bf16* mm = (GAS bf16*)MM + oc;
        f32x4 bs[2][2];
#pragma unroll
        for (int bj = 0; bj < 2; ++bj) { const GAS float* bg = (const GAS float*)bgate + (2 * bj + zlo) * D + oc; bs[bj][0] = *(cgf4)bg; bs[bj][1] = *(cgf4)(bg + 4); }
        LAS u32x4* xs = (LAS u32x4*)xl + ((wr * 2 + (wc & 1)) * 4) * 64 + lane;
#pragma unroll
        for (int ai = 0; ai < 2; ++ai) {
            u32x4 bw[4][2];
#pragma unroll
            for (int m = 0; m < 4; ++m) { const size_t ro = (size_t)(wr * 64 + fr + ai * HALF + m * 16) * 16; bw[m][0] = *(cgq4)(bo0 + ro); bw[m][1] = *(cgq4)(bo1 + ro); }
            float r[4][8];
#pragma unroll
            for (int m = 0; m < 4; ++m) {
#pragma unroll
                for (int j = 0; j < 8; ++j) r[m][j] = 0.f;
#pragma unroll
                for (int bj = 0; bj < 2; ++bj) { const f32x4 v0 = acc[ai][bj][m][0] + bs[bj][0], v1 = acc[ai][bj][m][1] + bs[bj][1]; const u32x4 b = bw[m][bj];
                    r[m][0] += sigk(v0[0], kq) * bflo(b.x); r[m][1] += sigk(v0[1], kq) * bfhi(b.x); r[m][2] += sigk(v0[2], kq) * bflo(b.y); r[m][3] += sigk(v0[3], kq) * bfhi(b.y);
                    r[m][4] += sigk(v1[0], kq) * bflo(b.z); r[m][5] += sigk(v1[1], kq) * bfhi(b.z); r[m][6] += sigk(v1[2], kq) * bflo(b.w); r[m][7] += sigk(v1[3], kq) * bfhi(b.w); }
            }
            if (wc >= 2) {
#pragma unroll
                for (int m = 0; m < 4; ++m) { u32x4 w; w.x = cvt_pk_bf16(r[m][0], r[m][1]); w.y = cvt_pk_bf16(r[m][2], r[m][3]); w.z = cvt_pk_bf16(r[m][4], r[m][5]); w.w = cvt_pk_bf16(r[m][6], r[m][7]); xs[m * 64] = w; }
            }
            asm volatile("s_waitcnt lgkmcnt(0)" ::: "memory"); __builtin_amdgcn_s_barrier(); asm volatile("" ::: "memory");
            if (wc < 2) {
#pragma unroll
                for (int m = 0; m < 4; ++m) { const u32x4 q = xs[m * 64]; const size_t ro = (size_t)(u.pm * BM + wr * 64 + fr + ai * HALF + m * 16) * D;
                    u32x4 w; w.x = cvt_pk_bf16(r[m][0] + bflo(q.x), r[m][1] + bfhi(q.x)); w.y = cvt_pk_bf16(r[m][2] + bflo(q.y), r[m][3] + bfhi(q.y));
                    w.z = cvt_pk_bf16(r[m][4] + bflo(q.z), r[m][5] + bfhi(q.z)); w.w = cvt_pk_bf16(r[m][6] + bflo(q.w), r[m][7] + bfhi(q.w));
                    *(gq4)(mm + ro) = w; }
            }
            if (ai == 0) { asm volatile("s_waitcnt lgkmcnt(0)" ::: "memory"); __builtin_amdgcn_s_barrier(); asm volatile("" ::: "memory"); }
        }
    }
};

template <class Epi, class Sched, bool F8 = false>
__device__ __forceinline__ void gemm_phase(LAS unsigned char* lds, const Gemm g, const Sched& S, const Epi& E, int tid_in) {
    const int tid = opaque_v(tid_in), wid = __builtin_amdgcn_readfirstlane(tid >> 6), lane = tid & 63, wr = wid >> 2, wc = wid & 3, fr = lane & 15, fq = lane >> 4;
    const int K = opaque_s(g.K), rowb = F8 ? K : 2 * K, nt = rowb / 128;
    unsigned voffA[2], voffB[2];
#pragma unroll
    for (int i = 0; i < 2; ++i) { int R, C; stage_rc(tid * 16 + i * 8192, R, C); const int Rb = Epi::PERM ? ((R & ~31) + perm32(R & 31)) : R;
        voffA[i] = (unsigned)(R * rowb + C * 2); voffB[i] = (unsigned)(Rb * rowb + C * 2); }
    const size_t kstep = (size_t)(BK * 2);
    const size_t hstep = (size_t)HALF * rowb;
    const size_t tstep = 2 * hstep;
    const unsigned ldsw = (unsigned)wid * 1024u;
    const int aoff = lds_byte(wr * 64 + fr, fq * 8), boff = lds_byte(wc * 32 + fr, fq * 8);
#define PG8_SA(b, h) (((b) * 2 + (h)) * HTB)
#define PG8_SB(b, h) ((4 + (b) * 2 + (h)) * HTB)
#define PG8_STAGE(bufoff, gbase, voff) do { _Pragma("unroll") for (int _i = 0; _i < 2; ++_i) \
        __builtin_amdgcn_global_load_lds((const unsigned*)((const char*)(gbase) + (voff)[_i]), (LAS unsigned*)(lds + (bufoff) + ldsw + _i * 8192), 16, 0, 0); } while (0)
#define PG8_LD1(off) (*(const LAS v4i_t*)(lds + (off)))
#define PG8_LDA(dst, b, h) do { if constexpr (F8) { _Pragma("unroll") for (int m = 0; m < 4; ++m) dst##8[m] = __builtin_shufflevector(PG8_LD1(PG8_SA(b, h) + aoff + m * 2048), PG8_LD1(PG8_SA(b, h) + aoff + m * 2048 + 1024), 0, 1, 2, 3, 4, 5, 6, 7); } \
        else { _Pragma("unroll") for (int m = 0; m < 4; ++m) _Pragma("unroll") for (int k = 0; k < 2; ++k) dst[m][k] = *(const LAS bf16x8*)(lds + PG8_SA(b, h) + aoff + m * 2048 + k * 1024); } } while (0)
#define PG8_LDB(dst, b, h) do { if constexpr (F8) { _Pragma("unroll") for (int n = 0; n < 2; ++n) dst##8[n] = __builtin_shufflevector(PG8_LD1(PG8_SB(b, h) + boff + n * 2048), PG8_LD1(PG8_SB(b, h) + boff + n * 2048 + 1024), 0, 1, 2, 3, 4, 5, 6, 7); } \
        else { _Pragma("unroll") for (int n = 0; n < 2; ++n) _Pragma("unroll") for (int k = 0; k < 2; ++k) dst[n][k] = *(const LAS bf16x8*)(lds + PG8_SB(b, h) + boff + n * 2048 + k * 1024); } } while (0)
#define PG8_MMA(ai, bj, At, Bt) do { __builtin_amdgcn_s_setprio(1); _Pragma("unroll") for (int m = 0; m < 4; ++m) _Pragma("unroll") for (int n = 0; n < 2; ++n) { \
        if constexpr (F8) { asm volatile("v_mfma_scale_f32_16x16x128_f8f6f4 %0, %1, %2, %0, %3, %4 op_sel_hi:[0,0,0]" : "+v"(acc[ai][bj][m][n]) : "v"(Bt##8[n]), "v"(At##8[m]), "v"(sclB), "v"(sclA)); } \
        else { _Pragma("unroll") for (int k = 0; k < 2; ++k) acc[ai][bj][m][n] = __builtin_amdgcn_mfma_f32_16x16x32_bf16(Bt[n][k], At[m][k], acc[ai][bj][m][n], 0, 0, 0); } } \
        __builtin_amdgcn_s_setprio(0); } while (0)
#define PG8_WAIT_V(n) asm volatile("s_waitcnt vmcnt(" #n ")" ::: "memory")
#define PG8_WAIT_L(n) asm volatile("s_waitcnt lgkmcnt(" #n ")" ::: "memory")
#define PG8_BAR __builtin_amdgcn_s_barrier()
#define PG8_SCHED __builtin_amdgcn_sched_barrier(0)
    const int sclB = g.sa * 0x01010101, sclA = g.sb * 0x01010101;
    Unit cur, nxt; int ui = 0;
    if (!S.next(0, cur)) return;
#ifndef GEMM_STAGGER
#define GEMM_STAGGER 0
#endif
    if (GEMM_STAGGER) {
        const unsigned long long t0 = __builtin_amdgcn_s_memrealtime(); const unsigned long long dl = (unsigned long long)(((blockIdx.x >> 3) & 3) * ((K >> 6) * 29 + 350));
        while (__builtin_amdgcn_s_memrealtime() - t0 < dl) __builtin_amdgcn_s_sleep(16);
    }
    f32x4 acc[2][2][4][2];
#pragma unroll
    for (int a = 0; a < 2; ++a)
#pragma unroll
        for (int b = 0; b < 2; ++b)
#pragma unroll
            for (int m = 0; m < 4; ++m)
#pragma unroll
                for (int n = 0; n < 2; ++n) acc[a][b][m][n] = (f32x4){0.f, 0.f, 0.f, 0.f};
    bf16x8 At[4][2], B0[2][2], B1[2][2]; v8i_t At8[4], B08[2], B18[2];
    const char* cA = (const char*)g.A + (size_t)cur.am * tstep; const char* cB = (const char*)g.Bt + (size_t)cur.bn * tstep;
    PG8_STAGE(PG8_SB(0, 0), cB, voffB); PG8_STAGE(PG8_SB(0, 1), cB + hstep, voffB); PG8_STAGE(PG8_SA(0, 0), cA, voffA); PG8_STAGE(PG8_SA(0, 1), cA + hstep, voffA);
    if (wr == 1) PG8_BAR;
    PG8_WAIT_V(2); PG8_BAR;
    PG8_STAGE(PG8_SB(1, 0), cB + kstep, voffB); PG8_STAGE(PG8_SA(1, 0), cA + kstep, voffA); PG8_STAGE(PG8_SB(1, 1), cB + hstep + kstep, voffB);
    PG8_WAIT_V(6); PG8_BAR;
    for (;;) {
        const bool has_next = S.next(ui + 1, nxt);
        const char* nA = has_next ? (const char*)g.A + (size_t)nxt.am * tstep : cA; const char* nB = has_next ? (const char*)g.Bt + (size_t)nxt.bn * tstep : cB;
        for (int t = 0; t < nt; t += 2) {
            const bool last = (t == nt - 2);
            const char* a1 = cA + (size_t)(t + 1) * kstep;
            const char* a2 = last ? nA : cA + (size_t)(t + 2) * kstep; const char* b2 = last ? nB : cB + (size_t)(t + 2) * kstep;
            const char* a3 = a2 + kstep; const char* b3 = b2 + kstep;
            PG8_LDB(B0, 0, 0); PG8_LDB(B1, 0, 1); PG8_SCHED; PG8_LDA(At, 0, 0); PG8_STAGE(PG8_SA(1, 1), a1 + hstep, voffA);
            PG8_WAIT_V(8); PG8_WAIT_L(0); PG8_BAR; PG8_MMA(0, 0, At, B0); PG8_MMA(0, 1, At, B1); PG8_BAR; PG8_SCHED;
            PG8_LDA(At, 0, 1); PG8_STAGE(PG8_SB(0, 0), b2, voffB); PG8_STAGE(PG8_SB(0, 1), b2 + hstep, voffB); PG8_STAGE(PG8_SA(0, 0), a2, voffA);
            PG8_WAIT_V(8); PG8_WAIT_L(0); PG8_BAR; PG8_MMA(1, 0, At, B0); PG8_MMA(1, 1, At, B1); PG8_BAR; PG8_SCHED;
            PG8_LDB(B0, 1, 0); PG8_LDB(B1, 1, 1); PG8_SCHED; PG8_LDA(At, 1, 0); PG8_STAGE(PG8_SA(0, 1), a2 + hstep, voffA);
            PG8_WAIT_V(8); PG8_WAIT_L(0); PG8_BAR; PG8_MMA(0, 0, At, B0); PG8_MMA(0, 1, At, B1); PG8_BAR; PG8_SCHED;
            PG8_LDA(At, 1, 1); PG8_STAGE(PG8_SB(1, 0), b3, voffB); PG8_STAGE(PG8_SB(1, 1), b3 + hstep, voffB); PG8_STAGE(PG8_SA(1, 0), a3, voffA);
            PG8_WAIT_V(8); PG8_WAIT_L(0); PG8_BAR; PG8_MMA(1, 0, At, B0); PG8_MMA(1, 1, At, B1); PG8_BAR; PG8_SCHED;
        }
        if (wr == 0) PG8_BAR;
        if constexpr (F8) asm volatile("s_nop 15\n\ts_nop 15" ::: "memory");
        E(acc, cur, wr, wc, fr, fq);
        if (!has_next) break;
#pragma unroll
        for (int a = 0; a < 2; ++a)
#pragma unroll
            for (int b = 0; b < 2; ++b)
#pragma unroll
                for (int m = 0; m < 4; ++m)
#pragma unroll
                    for (int n = 0; n < 2; ++n) acc[a][b][m][n] = (f32x4){0.f, 0.f, 0.f, 0.f};
        cur = nxt; cA = nA; cB = nB; ++ui;
        if (wr == 1) PG8_BAR;
    }
    PG8_WAIT_V(0);
    PG8_BAR;
#undef PG8_SA
#undef PG8_SB
#undef PG8_STAGE
#undef PG8_LD1
#undef PG8_LDA
#undef PG8_LDB
#undef PG8_MMA
#undef PG8_WAIT_V
#undef PG8_WAIT_L
#undef PG8_BAR
#undef PG8_SCHED
}
}
constexpr size_t al256(size_t x) { return (x + 255) & ~(size_t)255; }
constexpr size_t WS_CTL = 0, CTL_ZERO_BYTES = 1u << 20;
constexpr size_t E_WIN = (size_t)NIN * D, E_WG = (size_t)4 * D * D, E_WBR = (size_t)5120 * 256, E_WOUT = (size_t)D * D;
constexpr size_t E_WGU = (size_t)2 * FFD * D, E_WD = (size_t)D * FFD, E_MGU = (size_t)2 * FFE * D, E_MWD = (size_t)D * FFE;
constexpr size_t WS_WIN = CTL_ZERO_BYTES;
constexpr size_t WS_WG = WS_WIN + 2 * DEPTH * E_WIN;
constexpr size_t WS_WBR = WS_WG + 2 * DEPTH * E_WG;
constexpr size_t WS_WOUT = WS_WBR + 2 * DEPTH * E_WBR;
constexpr size_t WS_WGU = WS_WOUT + 2 * DEPTH * E_WOUT;
constexpr size_t WS_WD = WS_WGU + 2 * 2 * E_WGU;
constexpr size_t WS_MGU = WS_WD + 2 * 2 * E_WD;
constexpr size_t WS_MWD = WS_MGU + 2 * 2 * NE * E_MGU;
constexpr size_t WS_WEND = WS_MWD + 2 * 2 * NE * E_MWD;
constexpr size_t WS_MODS = al256(WS_WEND);
constexpr size_t WS_ROPE = WS_MODS + al256((size_t)DEPTH * 17 * 6 * D * 4);
constexpr size_t S5P_ABAR = 0, S5P_A128 = 16384, S5P_BP = 32768, S5P_CH = S5P_BP + 2 * 16 * 128 * 16 * 2, S5P_BYTES = S5P_CH + 16 * 16 * 128 * 2;
constexpr size_t WS_S5P = WS_ROPE + (size_t)SEQ * 32 * 4;
constexpr size_t WS_LAYP = WS_S5P + DEPTH * S5P_BYTES;
constexpr size_t WS_RETSUM = al256(WS_LAYP + DEPTH * 64 * 4);
constexpr size_t WS_RETST = WS_RETSUM + (size_t)NB * NCH * 2 * 4 * 2048 * 4;
constexpr size_t WS_S5E = WS_RETST + (size_t)NB * NCH * 2 * 4 * 2048 * 2;
constexpr size_t WS_S5C = WS_S5E + (size_t)NB * NCH * 16 * 2 * 64 * 8;
constexpr size_t WS_REC = WS_S5C + (size_t)NB * NCH * 16 * 2 * 64 * 8;
constexpr size_t WS_HIST = WS_REC + (size_t)RT * 32;
constexpr size_t WS_TILEE = WS_HIST + 256 * 8 * 4;
constexpr size_t WS_H = al256(WS_TILEE + 512 * 4);
constexpr size_t WS_AF = WS_H + (size_t)RT * D * 4;
constexpr size_t WS_AF8 = WS_AF + (size_t)RT * D * 2;
constexpr size_t WS_RA = WS_AF8 + (size_t)RT * D;
constexpr size_t WS_Z = WS_RA;
constexpr size_t WS_XB = WS_Z + (size_t)RT * ZW * 2;
constexpr size_t WS_BO = WS_XB + (size_t)4 * RT * 256 * 2;
constexpr size_t WS_MM = WS_BO + (size_t)4 * RT * D * 2;
constexpr size_t WS_Y = WS_MM + (size_t)RT * D * 2;
constexpr size_t WS_RA_END = WS_Y + (size_t)RT * D * 4;
constexpr size_t WS_G = WS_RA;
constexpr size_t WS_FS = WS_RA;
constexpr size_t WS_GS = WS_FS + (size_t)MOE_ROWS * D * 2;
constexpr size_t WS_YS = WS_GS + (size_t)MOE_ROWS * FFE * 2;
constexpr size_t WS_RB_END = WS_YS + (size_t)MOE_ROWS * D * 2;
constexpr size_t WS_END = WS_RA_END > WS_RB_END ? WS_RA_END : WS_RB_END;
static_assert(WS_G + (size_t)RT * FFD * 2 <= WS_Y, "dense hidden must not reach Y");
constexpr int CW_DEP = 12288;
constexpr int CW_BAR = 4096;

constexpr int SCRATCH_BYTES = 153600;
constexpr int LDSCTL_OFF = SCRATCH_BYTES, MISC_OFF = LDSCTL_OFF + 320;
constexpr int LDS_BYTES = 155648;
constexpr int NWAVES = 8;

typedef GAS unsigned gu32;
#define RLX_AGENT __ATOMIC_RELAXED, __HIP_MEMORY_SCOPE_AGENT

#define XB_TMO      128
#define XB_XCNT(j)  (256  + 64 * (j))
#define XB_XSUB(j)  (1280 + 64 * (j))
#define XB_XGEN(j)  (2304 + 64 * (j))
#define XB_TOP      3328
#define XB_TOPGEN   3392
#define XCD_BAR_WORDS 3456
#define XB_SPIN_CAP (1u << 20)

__device__ __forceinline__ unsigned xb_ld(unsigned* p)              { return __hip_atomic_load(p, __ATOMIC_RELAXED, __HIP_MEMORY_SCOPE_AGENT); }
__device__ __forceinline__ unsigned xb_add(unsigned* p, unsigned v) { return __hip_atomic_fetch_add(p, v, __ATOMIC_RELAXED, __HIP_MEMORY_SCOPE_AGENT); }
__device__ __forceinline__ unsigned xb_xcc_id() { return (unsigned)__builtin_amdgcn_s_getreg((3 << 11) | 20) & 0xFu; }
#define XB_SPIN(cond, bar) do { unsigned _sp = 0; while (cond) { __builtin_amdgcn_s_sleep(1); \
    if ((++_sp & 255u) == 0u) { if (xb_ld(&(bar)[XB_TMO])) break; if (_sp > XB_SPIN_CAP) { atomicAdd(&(bar)[XB_TMO], 1u); break; } } } } while (0)

struct XcdBarrier {
    unsigned* bar; unsigned x;
    volatile LAS unsigned* st;
};
__device__ __forceinline__ XcdBarrier xcd_barrier_post(unsigned* bar, volatile LAS unsigned* st, int tid) {
    XcdBarrier b; b.bar = bar; b.x = xb_xcc_id(); b.st = st;
    if (tid == 0) (void)xb_add(&bar[XB_XCNT(b.x)], 1u);
    return b;
}
__device__ __forceinline__ void xcd_barrier_complete(unsigned* bar, unsigned x, unsigned& nloc, unsigned& nx) {
    const unsigned G = gridDim.x * gridDim.y * gridDim.z;
    unsigned sum, cnt, mine, sp = 0u;
    for (;;) {
        sum = 0u; cnt = 0u; mine = 0u;
#pragma unroll
        for (unsigned j = 0; j < 16; ++j) { const unsigned c = xb_ld(&bar[XB_XCNT(j)]); sum += c; cnt += (c > 0u) ? 1u : 0u; mine = (j == x) ? c : mine; }
        if (sum == G) break;
        __builtin_amdgcn_s_sleep(1);
        if ((++sp & 255u) == 0u) { if (xb_ld(&bar[XB_TMO])) break; if (sp > XB_SPIN_CAP) { atomicAdd(&bar[XB_TMO], 1u); break; } }
    }
    nloc = mine > 0u ? mine : 1u; nx = cnt > 0u ? cnt : 1u;
}
__device__ __forceinline__ void xcd_barrier(const XcdBarrier& b, int tid) {
    asm volatile("s_waitcnt vmcnt(0)" ::: "memory");
    __syncthreads();
    if (tid == 0) {
        unsigned* bar = b.bar;
        __builtin_amdgcn_s_waitcnt(0);
        unsigned nloc = b.st[0], nx = b.st[1];
        if (nloc == 0u) { xcd_barrier_complete(bar, b.x, nloc, nx); b.st[0] = nloc; b.st[1] = nx; }
        const unsigned old = xb_add(&bar[XB_XSUB(b.x)], 1u);
        const unsigned gen = old / nloc;
        if (old + 1u == (gen + 1u) * nloc) {
            __builtin_amdgcn_fence(__ATOMIC_RELEASE, "agent");
            asm volatile("s_waitcnt vmcnt(0)" ::: "memory");
            const unsigned og = xb_add(&bar[XB_TOP], 1u);
            const unsigned tg = og / nx;
            if (og + 1u == (tg + 1u) * nx) xb_add(&bar[XB_TOPGEN], 1u);
            else XB_SPIN(xb_ld(&bar[XB_TOPGEN]) == tg, bar);
            __builtin_amdgcn_fence(__ATOMIC_ACQUIRE, "agent");
            xb_add(&bar[XB_XGEN(b.x)], 1u);
            asm volatile("s_waitcnt vmcnt(0)" ::: "memory");
        } else {
            XB_SPIN(xb_ld(&bar[XB_XGEN(b.x)]) == gen, bar);
            __builtin_amdgcn_fence(__ATOMIC_ACQUIRE, "agent");
            asm volatile("s_waitcnt vmcnt(0)" ::: "memory");
        }
    }
    __syncthreads();
}

struct Frame {
    LAS unsigned char* lds;
    volatile LAS unsigned* MISC;
    int tid, lane, wave;
    int vcu, G;
    unsigned char* ws;
};

__device__ __forceinline__ void dep_signal(Frame& F, unsigned* ctr, unsigned n) {
    asm volatile("s_waitcnt vmcnt(0)" ::: "memory");
    __syncthreads();
    if (F.tid == 0) { __builtin_amdgcn_fence(__ATOMIC_RELEASE, "agent"); asm volatile("s_waitcnt vmcnt(0)" ::: "memory"); (void)xb_add(ctr, n); }
}
__device__ __forceinline__ void dep_wait(Frame& F, unsigned* ctr, unsigned target) {
    if (F.tid == 0) { unsigned sp = 0u; while (xb_ld(ctr) < target) { __builtin_amdgcn_s_sleep(2); if (++sp > (1u << 22)) break; }
        __builtin_amdgcn_fence(__ATOMIC_ACQUIRE, "agent"); asm volatile("s_waitcnt vmcnt(0)" ::: "memory"); }
    __syncthreads();
}
__device__ __forceinline__ int permqk(int c) { const int hm = c >> 5, d = c & 31, axis = d >> 4, half = (d >> 3) & 1, f = d & 7; return hm * 32 + axis * 16 + f * 2 + half; }
__device__ __forceinline__ int win_dest(int n, float& sc) {
    sc = 1.0f;
    if (n < 128) { sc = 0.17677669529663687f; return 128 + n; }
    if (n < 384) return 256 + (n - 128);
    if (n < 640) return 768 + (n - 384);
    if (n < 896) return 1280 + permqk(n - 640);
    if (n < 1152) return 1536 + (n - 896);
    if (n < 1280) return n - 1152;
    if (n < 1536) return 512 + (n - 1280);
    if (n < 1792) { sc = 0.17677669529663687f; return 1024 + permqk(n - 1536); }
    const int j = (n - 1792) & 255, half = (n - 1792) >> 8; return 1792 + 2 * j + half;
}
template <int MODE, bool OUT8 = false>
__device__ __forceinline__ void transpose_item(const float* __restrict__ W, int K, int N, bf16* WT, int row_off, LAS float* scr, int item, int lane) {
    const int nblk = N / 32, kb = item / nblk, nb = item % nblk, k0 = 64 * kb, n0 = 32 * nb;
    float wreg[32];
#pragma unroll
    for (int i = 0; i < 32; ++i) { const int kk = 2 * i + (lane >> 5); wreg[i] = __builtin_nontemporal_load(W + (size_t)(k0 + kk) * N + n0 + (lane & 31)); }
#pragma unroll
    for (int i = 0; i < 32; ++i) { const int kk = 2 * i + (lane >> 5); scr[kk * 33 + (lane & 31)] = wreg[i]; }
    LDS_WAIT(); asm volatile("" ::: "memory");
    const int c = lane & 7;
#pragma unroll
    for (int j = 0; j < 4; ++j) { const int n = (lane >> 3) + 8 * j; const LAS float* s = scr + (8 * c) * 33 + n;
        int dr; float sc = 1.0f; const int ng = n0 + n;
        if (MODE == 0) dr = row_off + ng; else if (MODE == 3) dr = ((ng >> 6) << 8) + row_off + (ng & 63); else if (MODE == 1) { const int Hh = N >> 1; dr = row_off + 2 * (ng % Hh) + ng / Hh; } else dr = win_dest(ng, sc);
        if (OUT8) { unsigned w0 = 0, w1 = 0;
            const float q8 = (MODE == 1) ? ((ng >= (N >> 1)) ? 64.f * (-8.0f / 1.44269504f) : 64.f * -1.44269504f) : 64.f;
            w0 = __builtin_amdgcn_cvt_pk_fp8_f32(q8 * s[0 * 33], q8 * s[1 * 33], w0, false); w0 = __builtin_amdgcn_cvt_pk_fp8_f32(q8 * s[2 * 33], q8 * s[3 * 33], w0, true);
            w1 = __builtin_amdgcn_cvt_pk_fp8_f32(q8 * s[4 * 33], q8 * s[5 * 33], w1, false); w1 = __builtin_amdgcn_cvt_pk_fp8_f32(q8 * s[6 * 33], q8 * s[7 * 33], w1, true);
            *(u32x2*)((unsigned char*)WT + (size_t)dr * K + k0 + 8 * c) = (u32x2){w0, w1}; }
        else { u32x4 o; o.x = pk2(s[0 * 33] * sc, s[1 * 33] * sc); o.y = pk2(s[2 * 33] * sc, s[3 * 33] * sc); o.z = pk2(s[4 * 33] * sc, s[5 * 33] * sc); o.w = pk2(s[6 * 33] * sc, s[7 * 33] * sc);
        *(u32x4*)(WT + (size_t)dr * K + k0 + 8 * c) = o; } }
    LDS_WAIT(); asm volatile("" ::: "memory");
}
__device__ __forceinline__ void sincos_d(double x, double& s, double& c) {
    const double tp = 6.283185307179586476925287; x -= tp * rint(x / tp);
    const double x2 = x * x; double cs = 1.0, sn = 1.0;
    double tc = 1.0, ts = 1.0; cs = 1.0; sn = 1.0;
#pragma unroll
    for (int k = 1; k <= 17; ++k) { tc *= -x2 / (double)((2 * k - 1) * (2 * k)); ts *= -x2 / (double)((2 * k) * (2 * k + 1)); cs += tc; sn += ts; }
    s = sn * x; c = cs;
}

struct P0Args {
    const float *c, *c_ctx, *ada_w, *ada_b, *w_in, *w_gate, *ret_w_o, *s5_w_glu, *diff_w_o, *conv_w_o, *w_out, *ffn_w_gu, *ffn_w_d, *moe_w_gu, *moe_w_d;
    int f8mask;
    const float *ret_decay, *s5_a_re, *s5_a_im, *s5_log_dt, *s5_b_re, *s5_b_im, *s5_c_re, *s5_c_im, *diff_lambda;
};
__device__ __forceinline__ void p0_prologue(Frame& F, const P0Args& P) {
    unsigned char* ws = F.ws;
    {
        LAS float* scr = (LAS float*)(F.lds + F.wave * 8448);
        const int gw = F.vcu * NWAVES + F.wave, NGW = F.G * NWAVES;
        constexpr int I_WIN = 16 * (NIN / 32), I_WG = 16 * 32, I_BR1 = 4 * 32, I_BR2 = 4 * 64, I_WOUT = 16 * 32;
        constexpr int I_LAYER = I_WIN + 4 * I_WG + I_BR1 + I_BR2 + I_BR1 + I_BR1 + I_WOUT;
        constexpr int I_GU = 16 * (2 * FFD / 32), I_DD = (FFD / 64) * 32, I_DENSE = I_GU + I_DD;
        constexpr int I_MGU = 16 * (2 * FFE / 32), I_MD = (FFE / 64) * 32, I_EXP = I_MGU + I_MD;
        constexpr int NITEMS = DEPTH * I_LAYER + 2 * I_DENSE + 2 * NE * I_EXP;
        for (int it = gw; it < NITEMS; it += NGW) {
            int r = it;
            if (r < DEPTH * I_LAYER) {
                const int l = r / I_LAYER; r -= l * I_LAYER;
                if (r < I_WIN) { transpose_item<2>(P.w_in + (size_t)l * D * NIN, D, NIN, (bf16*)(ws + WS_WIN) + (size_t)l * E_WIN, 0, scr, r, F.lane); continue; } r -= I_WIN;
                if (r < 4 * I_WG) { const int z = r / I_WG; transpose_item<3, true>(P.w_gate + ((size_t)l * 4 + z) * D * D, D, D, (bf16*)(ws + WS_WG) + (size_t)l * E_WG, z * 64, scr, r % I_WG, F.lane); continue; } r -= 4 * I_WG;
                bf16* wbr = (bf16*)(ws + WS_WBR) + (size_t)l * E_WBR;
                if (r < I_BR1) { transpose_item<0>(P.ret_w_o + (size_t)l * 256 * D, 256, D, wbr, 0, scr, r, F.lane); continue; } r -= I_BR1;
                if (r < I_BR2) { transpose_item<1>(P.s5_w_glu + (size_t)l * 256 * 2 * D, 256, 2 * D, wbr, 1024, scr, r, F.lane); continue; } r -= I_BR2;
                if (r < I_BR1) { transpose_item<0>(P.diff_w_o + (size_t)l * 256 * D, 256, D, wbr, 3072, scr, r, F.lane); continue; } r -= I_BR1;
                if (r < I_BR1) { transpose_item<0>(P.conv_w_o + (size_t)l * 256 * D, 256, D, wbr, 4096, scr, r, F.lane); continue; } r -= I_BR1;
                transpose_item<0>(P.w_out + (size_t)l * D * D, D, D, (bf16*)(ws + WS_WOUT) + (size_t)l * E_WOUT, 0, scr, r, F.lane); continue;
            }
            r -= DEPTH * I_LAYER;
            if (r < 2 * I_DENSE) {
                const int j = r / I_DENSE; r -= j * I_DENSE;
                const bool f8 = (P.f8mask >> (2 * j)) & 1; bf16* wgu = (bf16*)(ws + WS_WGU + (size_t)j * E_WGU * 2); bf16* wd = (bf16*)(ws + WS_WD + (size_t)j * E_WD * 2);
                if (r < I_GU) { if (f8) transpose_item<1, true>(P.ffn_w_gu + (size_t)j * D * 2 * FFD, D, 2 * FFD, wgu, 0, scr, r, F.lane); else transpose_item<1, false>(P.ffn_w_gu + (size_t)j * D * 2 * FFD, D, 2 * FFD, wgu, 0, scr, r, F.lane); continue; } r -= I_GU;
                if (f8) transpose_item<0, true>(P.ffn_w_d + (size_t)j * FFD * D, FFD, D, wd, 0, scr, r, F.lane); else transpose_item<0, false>(P.ffn_w_d + (size_t)j * FFD * D, FFD, D, wd, 0, scr, r, F.lane); continue;
            }
            r -= 2 * I_DENSE;
            { const int je = r / I_EXP; r -= je * I_EXP;
              const int jj = je >> 3, ee = je & 7; const bool f8 = (P.f8mask >> (2 * jj + 1)) & 1; const size_t esz = f8 ? 1 : 2;
              bf16* wgu = (bf16*)(ws + WS_MGU + (size_t)jj * NE * E_MGU * 2 + (size_t)ee * E_MGU * esz); bf16* wd = (bf16*)(ws + WS_MWD + (size_t)jj * NE * E_MWD * 2 + (size_t)ee * E_MWD * esz);
              if (r < I_MGU) { if (f8) transpose_item<1, true>(P.moe_w_gu + (size_t)je * D * 2 * FFE, D, 2 * FFE, wgu, 0, scr, r, F.lane); else transpose_item<1, false>(P.moe_w_gu + (size_t)je * D * 2 * FFE, D, 2 * FFE, wgu, 0, scr, r, F.lane); continue; } r -= I_MGU;
              if (f8) transpose_item<0, true>(P.moe_w_d + (size_t)je * FFE * D, FFE, D, wd, 0, scr, r, F.lane); else transpose_item<0, false>(P.moe_w_d + (size_t)je * FFE * D, FFE, D, wd, 0, scr, r, F.lane); }
        }
    }
    __syncthreads();
    {
        LAS float* sc = (LAS float*)F.lds;
        LAS float* part = (LAS float*)(F.lds + 17 * 1024 * 4);
        for (int i = F.tid; i < 17 * D; i += 512) { const int r = i >> 10, k = i & 1023; const float v = r < 16 ? P.c[r * D + k] : P.c_ctx[k]; sc[i] = v / (1.0f + __expf(-v)); }
        __syncthreads();
        float* mods = (float*)(ws + WS_MODS);
        for (int u = F.vcu; u < DEPTH * 96; u += F.G) {
            const int l = u / 96, n0 = (u % 96) * 64;
            const float* w = P.ada_w + (size_t)l * D * 6 * D + n0 + F.lane;
            float acc[17];
#pragma unroll
            for (int r = 0; r < 17; ++r) acc[r] = 0.f;
            const int kb = F.wave * 128;
#pragma unroll 2
            for (int k4 = 0; k4 < 128; k4 += 4) {
                float wv[4];
#pragma unroll
                for (int j = 0; j < 4; ++j) wv[j] = w[(size_t)(kb + k4 + j) * 6 * D];
#pragma unroll
                for (int r = 0; r < 17; ++r) { const f32x4 s = *(const LAS f32x4*)(sc + r * 1024 + kb + k4); acc[r] += wv[0] * s[0] + wv[1] * s[1] + wv[2] * s[2] + wv[3] * s[3]; }
            }
#pragma unroll
            for (int r = 0; r < 17; ++r) part[(F.wave * 17 + r) * 64 + F.lane] = acc[r];
            __syncthreads();
            for (int i = F.tid; i < 17 * 64; i += 512) { float s = 0.f;
#pragma unroll
                for (int w8 = 0; w8 < 8; ++w8) s += part[w8 * 17 * 64 + i];
                const int r = i >> 6, n = n0 + (i & 63); mods[((size_t)l * 17 + r) * 6 * D + n] = s + P.ada_b[(size_t)l * 6 * D + n]; }
            __syncthreads();
        }
    }
    {
        const int gt = F.vcu * 512 + F.tid, NGT = F.G * 512;
        float* rope = (float*)(ws + WS_ROPE);
        for (int i = gt; i < SEQ * 16; i += NGT) { const int t = i >> 4, pi = i & 15, axis = pi >> 3, f = pi & 7;
            const float inv = exp2f(-(float)f * (13.287712379549449f / 8.0f));
            const float ang = (float)(axis ? (t & 63) : (t >> 6)) * inv; float s, c; sincosf(ang, &s, &c); rope[2 * i] = c; rope[2 * i + 1] = s; }
        for (int i = gt; i < DEPTH * 2048; i += NGT) {
            const int l = i >> 11, d = (i >> 10) & 1, g = (i >> 6) & 15, p = i & 63;
            unsigned char* sp = ws + WS_S5P + (size_t)l * S5P_BYTES;
            const float are = fminf(P.s5_a_re[i], -1e-4f), aim = P.s5_a_im[i];
            const float dt = expf(P.s5_log_dt[(l * 2 + d) * 16 + g]);
            const float zre = dt * are; const double zim = (double)dt * (double)aim;
            double sn, cs; sincos_d(zim, sn, cs);
            const float mag = expf(zre), abre = mag * (float)cs, abim = mag * (float)sn;
            double sn2, cs2; sincos_d(128.0 * zim, sn2, cs2); const float mag2 = expf(128.0f * zre);
            ((f32x2*)(sp + S5P_ABAR))[i & 2047] = (f32x2){abre, abim};
            ((f32x2*)(sp + S5P_A128))[i & 2047] = (f32x2){mag2 * (float)cs2, mag2 * (float)sn2};
            const float den = are * are + aim * aim, nre = abre - 1.0f;
            const float cfre = (nre * are + abim * aim) / den, cfim = (abim * are - nre * aim) / den;
            const float* bre = P.s5_b_re + (((size_t)l * 16 + g) * 64 + p) * 16; const float* bim = P.s5_b_im + (((size_t)l * 16 + g) * 64 + p) * 16;
            bf16* bp = (bf16*)(sp + S5P_BP) + (((size_t)d * 16 + g) * 128 + 2 * p) * 16;
#pragma unroll
            for (int c = 0; c < 16; ++c) { const float br = bre[c], bi = bim[c]; bp[c] = (bf16)f2bf(cfre * br - cfim * bi); bp[16 + c] = (bf16)f2bf(cfre * bi + cfim * br); }
            if (d == 0) { bf16* ch = (bf16*)(sp + S5P_CH) + (size_t)g * 16 * 128;
#pragma unroll
                for (int c = 0; c < 16; ++c) { const size_t ci = (((size_t)l * 16 + g) * 16 + c) * 64 + p; ch[c * 128 + 2 * p] = (bf16)f2bf(P.s5_c_re[ci]); ch[c * 128 + 2 * p + 1] = (bf16)f2bf(-P.s5_c_im[ci]); } }
        }
        if (gt < DEPTH) { const int l = gt; float* lp = (float*)(ws + WS_LAYP) + l * 64;
            for (int j = 0; j < 8; ++j) { const float x = P.ret_decay[l * 8 + j]; lp[j] = -log2f(1.0f + expf(-x)); }
            const float* dl = P.diff_lambda + l * 128; float d01 = 0.f, d23 = 0.f;
            for (int j = 0; j < 32; ++j) { d01 += dl[j] * dl[32 + j]; d23 += dl[64 + j] * dl[96 + j]; }
            const float li = 0.8f - 0.6f * expf(-0.3f * (float)l);
            lp[8] = expf(d01) - expf(d23) + li; lp[9] = 1.0f - li; }
    }
}
struct RowArgs {
    const float *x, *ctx;
    const float *post_g;
    const float *pre_g;
    const float *router_w, *router_b;
    float* out;
    int l, nrows, moe, last, f8, dry;
};
template <int MODE>
__device__ __forceinline__ void row_pass(Frame& F, const RowArgs& A) {
    unsigned char* ws = F.ws;
    float* H = (float*)(ws + WS_H); bf16* AF = (bf16*)(ws + WS_AF); const float* Y = (const float*)(ws + WS_Y);
    float* Hst = A.dry ? (float*)(ws + WS_END) : H; if (A.dry) AF = (bf16*)(ws + WS_END + (size_t)RT * D * 2);
    const float* mods = (const float*)(ws + WS_MODS);
    const int gw = F.vcu * NWAVES + F.wave, NGW = F.G * NWAVES, lane = opaque_v(F.lane);
    volatile LAS unsigned* cnt = F.MISC + 16;
    if (MODE == 1 && A.moe) { if (F.tid < 8) cnt[F.tid] = 0u; __syncthreads(); }
    const int lg = A.l, lm = (MODE == 2) ? A.l + 1 : A.l;
    const int goff = (MODE == 1) ? 2 * D : 5 * D, shoff = (MODE == 1) ? 3 * D : 0, scoff = (MODE == 1) ? 4 * D : D;
    LAS float* rwL = (LAS float*)F.lds;
    if (MODE == 1 && A.moe) {
        for (int i = F.tid; i < D * NE; i += 512) rwL[(i & 7) * D + (i >> 3)] = A.router_w[i];
        __syncthreads();
    }
    const bool wr_af = !(MODE == 2 && A.last);
    f32x4 pg[4], pg2[4];
#pragma unroll
    for (int j = 0; j < 4; ++j) { const int c = 4 * lane + 256 * j; pg[j] = (MODE != 0) ? *(const GAS f32x4*)((const GAS float*)A.post_g + c) : (f32x4){0.f, 0.f, 0.f, 0.f}; pg2[j] = wr_af ? *(const GAS f32x4*)((const GAS float*)A.pre_g + c) : (f32x4){0.f, 0.f, 0.f, 0.f}; }
    struct Raw { u32x2 ya[4], yb[4], hw[4]; f32x4 gv[4], sh[4], sc[4], x[4]; };
    Raw cur, nx;
    u32x4 recn = (u32x4){0u, 0u, 0u, 0u}; u32x2 posn = (u32x2){0u, 0u};
    u32x4 recc = recn, recx = recn; u32x2 posc = posn, posx = posn;
#define ROW_REC(R4, P2, rw) do { if (false) { const GAS int* rec_ = (const GAS int*)(ws + WS_REC) + (size_t)(rw) * 8; R4 = (u32x4){0u, 0u, (unsigned)rec_[2], (unsigned)rec_[3]}; P2 = (u32x2){(unsigned)rec_[6], (unsigned)rec_[7]}; } } while (0)
#define ROW_LOAD(R, rw, R4, P2) do { const int br_ = (rw) < RL ? ((rw) >> 11) : 16; \
        if (wr_af) { const GAS float* mrow_ = (const GAS float*)mods + ((size_t)lm * 17 + br_) * 6 * D; _Pragma("unroll") for (int j = 0; j < 4; ++j) { const int c = 4 * lane + 256 * j; R.sh[j] = *(const GAS f32x4*)(mrow_ + shoff + c); R.sc[j] = *(const GAS f32x4*)(mrow_ + scoff + c); } } \
        if (MODE == 0) { const GAS float* src_ = (rw) < RL ? (const GAS float*)A.x + (size_t)(rw) * D : (const GAS float*)A.ctx + (size_t)((rw) - RL) * D; _Pragma("unroll") for (int j = 0; j < 4; ++j) R.x[j] = *(const GAS f32x4*)(src_ + 4 * lane + 256 * j); } \
        else { const GAS float* gate_ = (const GAS float*)mods + ((size_t)lg * 17 + br_) * 6 * D + goff; \
            _Pragma("unroll") for (int j = 0; j < 4; ++j) { const int c = 4 * lane + 256 * j; R.hw[j] = *(const GAS u32x2*)((const GAS bf16*)H + (size_t)(rw) * D + c); R.gv[j] = *(const GAS f32x4*)(gate_ + c); } \
            if (MODE == 2 && A.moe) { } else if (false) { const GAS bf16* ys_ = (const GAS bf16*)(ws + WS_YS); const size_t p0_ = (size_t)P2.x, p1_ = (size_t)P2.y; \
                _Pragma("unroll") for (int j = 0; j < 4; ++j) { R.ya[j] = *(const GAS u32x2*)(ys_ + p0_ * D + 4 * lane + 256 * j); R.yb[j] = *(const GAS u32x2*)(ys_ + p1_ * D + 4 * lane + 256 * j); } } \
            else { _Pragma("unroll") for (int j = 0; j < 4; ++j) R.ya[j] = *(const GAS u32x2*)((const GAS bf16*)Y + (size_t)(rw) * D + 4 * lane + 256 * j); } } } while (0)
    if (gw < A.nrows) { ROW_REC(recc, posc, gw); if (gw + NGW < A.nrows) ROW_REC(recx, posx, gw + NGW); ROW_LOAD(cur, gw, recc, posc); }
    for (int row = gw; row < A.nrows; row += NGW) {
        const int nrow = row + NGW;
        if (nrow + NGW < A.nrows) ROW_REC(recn, posn, nrow + NGW);
        if (nrow < A.nrows) ROW_LOAD(nx, nrow, recx, posx);
        f32x4 h[4]; f32x4 sh[4], sc[4];
#pragma unroll
        for (int j = 0; j < 4; ++j) { sh[j] = cur.sh[j]; sc[j] = cur.sc[j]; }
        if (MODE == 0) {
#pragma unroll
            for (int j = 0; j < 4; ++j) h[j] = cur.x[j];
        } else {
            f32x4 y[4]; float ss = 0.f;
            if (MODE == 2 && A.moe) { const GAS int* rec = (const GAS int*)(ws + WS_REC) + (size_t)row * 8;
                const int p0 = rec[6], p1 = rec[7]; const float w0 = __builtin_bit_cast(float, rec[2]), w1 = __builtin_bit_cast(float, rec[3]);
                const GAS bf16* ys = (const GAS bf16*)(ws + WS_YS);
#pragma unroll
                for (int j = 0; j < 4; ++j) { const u32x2 a = *(const GAS u32x2*)(ys + (size_t)p0 * D + 4 * lane + 256 * j), b = *(const GAS u32x2*)(ys + (size_t)p1 * D + 4 * lane + 256 * j);
                    y[j] = (f32x4){w0 * bflo(a.x) + w1 * bflo(b.x), w0 * bfhi(a.x) + w1 * bfhi(b.x), w0 * bflo(a.y) + w1 * bflo(b.y), w0 * bfhi(a.y) + w1 * bfhi(b.y)}; }
            } else {
#pragma unroll
                for (int j = 0; j < 4; ++j) { const u32x2 a = cur.ya[j]; y[j] = (f32x4){bflo(a.x), bfhi(a.x), bflo(a.y), bfhi(a.y)}; }
            }
#pragma unroll
            for (int j = 0; j < 4; ++j) ss += (y[j][0] * y[j][0] + y[j][1] * y[j][1]) + (y[j][2] * y[j][2] + y[j][3] * y[j][3]);
            const float rstd = 1.0f / sqrtf(wave_sum(ss) * (1.0f / D) + EPS);
#pragma unroll
            for (int j = 0; j < 4; ++j) { const u32x2 hw = cur.hw[j]; const f32x4 hv = (f32x4){bflo(hw.x), bfhi(hw.x), bflo(hw.y), bfhi(hw.y)}; h[j] = hv + cur.gv[j] * (y[j] * rstd * pg[j]); }
        }
        cur = nx; recc = recx; posc = posx; recx = recn; posx = posn;
        if (!wr_af) {
#pragma unroll
            for (int j = 0; j < 4; ++j) if (!A.dry) *(GAS f32x4*)((GAS float*)A.out + (size_t)row * D + 4 * lane + 256 * j) = h[j];
            continue;
        }
#pragma unroll
        for (int j = 0; j < 4; ++j) { u32x2 hw; hw.x = pk2(h[j][0], h[j][1]); hw.y = pk2(h[j][2], h[j][3]); *(GAS u32x2*)((GAS bf16*)Hst + (size_t)row * D + 4 * lane + 256 * j) = hw; }
        float s2 = 0.f;
#pragma unroll
        for (int j = 0; j < 4; ++j) s2 += (h[j][0] * h[j][0] + h[j][1] * h[j][1]) + (h[j][2] * h[j][2] + h[j][3] * h[j][3]);
        const float rs2 = 1.0f / sqrtf(wave_sum(s2) * (1.0f / D) + EPS);
        f32x4 f[4];
#pragma unroll
        for (int j = 0; j < 4; ++j) { const int c = 4 * lane + 256 * j;
            f[j] = (h[j] * rs2 * pg2[j]) * (1.0f + sc[j]) + sh[j];
            if (MODE == 1 && A.f8) { unsigned w = 0; w = __builtin_amdgcn_cvt_pk_fp8_f32(4.f * f[j][0], 4.f * f[j][1], w, false); w = __builtin_amdgcn_cvt_pk_fp8_f32(4.f * f[j][2], 4.f * f[j][3], w, true);
                *(GAS unsigned*)((GAS unsigned char*)AF + (size_t)row * D + c) = w; }
            else { u32x2 w; w.x = pk2(f[j][0], f[j][1]); w.y = pk2(f[j][2], f[j][3]); *(GAS u32x2*)((GAS bf16*)AF + (size_t)row * D + c) = w;
                if (MODE != 1) { unsigned w8 = 0; w8 = __builtin_amdgcn_cvt_pk_fp8_f32(4.f * f[j][0], 4.f * f[j][1], w8, false); w8 = __builtin_amdgcn_cvt_pk_fp8_f32(4.f * f[j][2], 4.f * f[j][3], w8, true);
                    *(GAS unsigned*)((GAS unsigned char*)(ws + (A.dry ? WS_END + (size_t)RT * D * 4 : WS_AF8)) + (size_t)row * D + c) = w8; } } }
        if (MODE == 1 && A.moe) {
            float pl[8];
#pragma unroll
            for (int e = 0; e < 8; ++e) pl[e] = 0.f;
#pragma unroll
            for (int j = 0; j < 4; ++j)
#pragma unroll
                for (int e = 0; e < 8; ++e) { const f32x4 w4 = *(const LAS f32x4*)(rwL + e * D + 4 * lane + 256 * j); pl[e] += (f[j][0] * w4[0] + f[j][1] * w4[1]) + (f[j][2] * w4[2] + f[j][3] * w4[3]); }
            float a4[4], a2[2], a1;
            { const bool hi = (lane & 32) != 0;
#pragma unroll
              for (int k = 0; k < 4; ++k) { const float mine = hi ? pl[4 + k] : pl[k], theirs = hi ? pl[k] : pl[4 + k]; a4[k] = mine + __shfl_xor(theirs, 32); } }
            { const bool hi = (lane & 16) != 0;
#pragma unroll
              for (int k = 0; k < 2; ++k) { const float mine = hi ? a4[2 + k] : a4[k], theirs = hi ? a4[k] : a4[2 + k]; a2[k] = mine + __shfl_xor(theirs, 16); } }
            { const bool hi = (lane & 8) != 0; const float mine = hi ? a2[1] : a2[0], theirs = hi ? a2[0] : a2[1]; a1 = mine + __shfl_xor(theirs, 8); }
            a1 += __shfl_xor(a1, 4); a1 += __shfl_xor(a1, 2); a1 += __shfl_xor(a1, 1);
            float lg8[8];
#pragma unroll
            for (int e = 0; e < 8; ++e) lg8[e] = __builtin_bit_cast(float, __builtin_amdgcn_readlane(__builtin_bit_cast(int, a1), 8 * e)) + A.router_b[e];
            int e0 = 0; float v0 = lg8[0];
#pragma unroll
            for (int e = 1; e < 8; ++e) if (lg8[e] > v0) { v0 = lg8[e]; e0 = e; }
            int e1 = -1; float v1 = -3.0e38f;
#pragma unroll
            for (int e = 0; e < 8; ++e) if (e != e0 && lg8[e] > v1) { v1 = lg8[e]; e1 = e; }
            const float w0 = 1.0f / (1.0f + __expf(v1 - v0)), w1 = 1.0f - w0;
            if (lane == 0) {
                const unsigned r0 = __hip_atomic_fetch_add((LAS unsigned*)(cnt + e0), 1u, __ATOMIC_RELAXED, __HIP_MEMORY_SCOPE_WORKGROUP);
                const unsigned r1 = __hip_atomic_fetch_add((LAS unsigned*)(cnt + e1), 1u, __ATOMIC_RELAXED, __HIP_MEMORY_SCOPE_WORKGROUP);
                int* rec = (int*)(ws + (A.dry ? WS_END + (size_t)RT * D * 5 : WS_REC)) + (size_t)row * 8;
                rec[0] = e0; rec[1] = e1; rec[2] = __builtin_bit_cast(int, w0); rec[3] = __builtin_bit_cast(int, w1); rec[4] = (int)r0; rec[5] = (int)r1;
            }
        }
    }
#undef ROW_REC
#undef ROW_LOAD
    if (MODE == 1 && A.moe) { __syncthreads(); if (F.tid < 8 && !A.dry) ((int*)(ws + WS_HIST))[blockIdx.x * 8 + F.tid] = (int)cnt[F.tid]; }
}

__device__ __forceinline__ void moe_dispatch(Frame& F, int nrows, int f8) {
    unsigned char* ws = F.ws;
    volatile LAS int* sh = (volatile LAS int*)F.lds;
    const int* hist = (const int*)(ws + WS_HIST);
    if (F.tid < 16) sh[F.tid] = 0;
    __syncthreads();
    { const int e = F.tid & 7; int tot = 0, pre = 0;
      int v[4];
#pragma unroll
      for (int q = 0; q < 4; ++q) { const int b = (F.tid >> 3) + 64 * q; v[q] = b < (int)gridDim.x ? __hip_atomic_load(hist + b * 8 + e, __ATOMIC_RELAXED, __HIP_MEMORY_SCOPE_AGENT) : 0; }
#pragma unroll
      for (int q = 0; q < 4; ++q) { const int b = (F.tid >> 3) + 64 * q; tot += v[q]; if (b < (int)blockIdx.x) pre += v[q]; }
      __hip_atomic_fetch_add((LAS int*)(sh + e), tot, __ATOMIC_RELAXED, __HIP_MEMORY_SCOPE_WORKGROUP); __hip_atomic_fetch_add((LAS int*)(sh + 8 + e), pre, __ATOMIC_RELAXED, __HIP_MEMORY_SCOPE_WORKGROUP); }
    __syncthreads();
    if (F.tid == 0) { int base = 0; for (int e = 0; e < 8; ++e) { sh[24 + e] = base; sh[16 + e] = base + sh[8 + e]; base += (sh[e] + 255) & ~255; } sh[32] = base; }
    __syncthreads();
    if (blockIdx.x == 0) {
        int* te = (int*)(ws + WS_TILEE); const int ntile = sh[32] >> 8;
        int bs[7];
#pragma unroll
        for (int q = 1; q < 8; ++q) bs[q - 1] = sh[24 + q];
        for (int t = F.tid; t < ntile; t += 512) { int e = 0;
#pragma unroll
            for (int q = 0; q < 7; ++q) e += (t * 256 >= bs[q]) ? 1 : 0;
            te[t] = e; }
        if (F.tid == 0) te[400] = ntile;
    }
    const int gw = F.vcu * NWAVES + F.wave, NGW = F.G * NWAVES, lane = F.lane;
    const GAS unsigned char* AFb = (const GAS unsigned char*)(ws + WS_AF); GAS unsigned char* FSb = (GAS unsigned char*)(ws + WS_FS);
    const int nmine = (nrows - gw + NGW - 1) / NGW;
    for (int k0 = 0; k0 < nmine; k0 += 64) {
        int p0v = 0, p1v = 0;
        if (k0 + lane < nmine) { GAS int* rec = (GAS int*)(ws + WS_REC) + (size_t)(gw + (k0 + lane) * NGW) * 8;
            const u32x4 ra = *(const GAS u32x4*)rec; const u32x2 rb = *(const GAS u32x2*)(rec + 4);
            p0v = sh[16 + (int)ra.x] + (int)rb.x; p1v = sh[16 + (int)ra.y] + (int)rb.y; *(GAS u32x2*)(rec + 6) = (u32x2){(unsigned)p0v, (unsigned)p1v}; }
        const int nk = (nmine - k0) < 64 ? (nmine - k0) : 64;
        for (int kb = 0; kb < nk; kb += 6) {
            u32x4 a[6], b[6];
#pragma unroll
            for (int q = 0; q < 6; ++q) if (kb + q < nk) { const size_t row = (size_t)(gw + (k0 + kb + q) * NGW);
                if (f8) a[q] = *(const GAS u32x4*)(AFb + row * D + 16 * lane);
                else { a[q] = *(const GAS u32x4*)(AFb + row * 2 * D + 16 * lane); b[q] = *(const GAS u32x4*)(AFb + row * 2 * D + 1024 + 16 * lane); } }
#pragma unroll
            for (int q = 0; q < 6; ++q) if (kb + q < nk) { const size_t p0 = (size_t)__builtin_amdgcn_readlane(p0v, kb + q), p1 = (size_t)__builtin_amdgcn_readlane(p1v, kb + q);
                if (f8) { *(GAS u32x4*)(FSb + p0 * D + 16 * lane) = a[q]; *(GAS u32x4*)(FSb + p1 * D + 16 * lane) = a[q]; }
                else { *(GAS u32x4*)(FSb + p0 * 2 * D + 16 * lane) = a[q]; *(GAS u32x4*)(FSb + p0 * 2 * D + 1024 + 16 * lane) = b[q];
                       *(GAS u32x4*)(FSb + p1 * 2 * D + 16 * lane) = a[q]; *(GAS u32x4*)(FSb + p1 * 2 * D + 1024 + 16 * lane) = b[q]; } }
        }
    }
}
__device__ __forceinline__ int chunk_row0(int b, int c) { return c < 2 ? RL + b * NCTX + c * 128 : b * SEQ + (c - 2) * 128; }
__device__ __forceinline__ bf16x8 tr_read2(unsigned a0, unsigned a1) {
    s16x4 lo, hi; asm volatile("ds_read_b64_tr_b16 %0, %2\n\tds_read_b64_tr_b16 %1, %3\n\ts_waitcnt lgkmcnt(0)" : "=&v"(lo), "=&v"(hi) : "v"(a0), "v"(a1) : "memory");
    return __builtin_shufflevector(lo, hi, 0, 1, 2, 3, 4, 5, 6, 7);
}
__device__ __forceinline__ unsigned scale_pk(unsigned w, float s) { return pk2(bflo(w) * s, bfhi(w) * s); }

constexpr int RS_KSTR = 288, RS_VSTR = 544, RS_KF = 0, RS_KB = 128 * RS_KSTR, RS_V = 2 * 128 * RS_KSTR;

__device__ __forceinline__ void ret_summary_unit(Frame& F, int b, int c, const float* lp) {
    const bf16* Z = (const bf16*)(F.ws + WS_Z); const int row0 = chunk_row0(b, c);
    LAS unsigned char* L = F.lds;
    for (int i = F.tid; i < 2048; i += 512) { const int a = i >> 4, ch = i & 15, hd = ch >> 2;
        const u32x4 kv = *(const u32x4*)(Z + (size_t)(row0 + a) * ZW + ZQ_RK + ch * 8);
        const float wf = __builtin_amdgcn_exp2f((float)(127 - a) * lp[hd]), wb = __builtin_amdgcn_exp2f((float)a * lp[4 + hd]);
        u32x4 f, g; f.x = scale_pk(kv.x, wf); f.y = scale_pk(kv.y, wf); f.z = scale_pk(kv.z, wf); f.w = scale_pk(kv.w, wf);
        g.x = scale_pk(kv.x, wb); g.y = scale_pk(kv.y, wb); g.z = scale_pk(kv.z, wb); g.w = scale_pk(kv.w, wb);
        *(LAS u32x4*)(L + RS_KF + a * RS_KSTR + ch * 16) = f; *(LAS u32x4*)(L + RS_KB + a * RS_KSTR + ch * 16) = g; }
    for (int i = F.tid; i < 4096; i += 512) { const int a = i >> 5, ch = i & 31;
        *(LAS u32x4*)(L + RS_V + a * RS_VSTR + ch * 16) = *(const u32x4*)(Z + (size_t)(row0 + a) * ZW + ZQ_RV + ch * 8); }
    __syncthreads();
    const int h = F.wave & 3, dir = F.wave >> 2, l = opaque_v(F.lane), hh = l >> 5, blk = (l >> 4) & 1, q = (l & 15) >> 2, p = l & 3;
    const unsigned lb = (unsigned)(size_t)L;
    f32x16 acc0, acc1;
#pragma unroll
    for (int r = 0; r < 16; ++r) { acc0[r] = 0.f; acc1[r] = 0.f; }
    const unsigned kbase = lb + (dir ? RS_KB : RS_KF) + (h * 32 + 16 * blk) * 2 + 8 * p;
    const unsigned vbase = lb + RS_V + (h * 64 + 16 * blk) * 2 + 8 * p;
#pragma unroll 2
    for (int ks = 0; ks < 8; ++ks) {
        const int r0 = 16 * ks + 8 * hh + q, r1 = r0 + 4;
        const bf16x8 bk = tr_read2(kbase + r0 * RS_KSTR, kbase + r1 * RS_KSTR);
        const bf16x8 a0 = tr_read2(vbase + r0 * RS_VSTR, vbase + r1 * RS_VSTR);
        const bf16x8 a1 = tr_read2(vbase + 64 + r0 * RS_VSTR, vbase + 64 + r1 * RS_VSTR);
        acc0 = __builtin_amdgcn_mfma_f32_32x32x16_bf16(a0, bk, acc0, 0, 0, 0);
        acc1 = __builtin_amdgcn_mfma_f32_32x32x16_bf16(a1, bk, acc1, 0, 0, 0);
    }
    float* out = (float*)(F.ws + WS_RETSUM) + ((((size_t)b * NCH + c) * 2 + dir) * 4 + h) * 2048;
#pragma unroll
    for (int r = 0; r < 16; ++r) { const int e = (r & 3) + 8 * (r >> 2) + 4 * hh; out[e * 32 + (l & 31)] = acc0[r]; out[(32 + e) * 32 + (l & 31)] = acc1[r]; }
    __syncthreads();
}

__device__ __forceinline__ int prefix_chunk(int dir, int i) { return dir == 0 ? i : (i == 0 ? 1 : (i == 1 ? 0 : 19 - i)); }
__device__ __forceinline__ void ret_prefix_unit(Frame& F, int b, int h, int dir, const float* lp) {
    const int lane_ = opaque_v(F.lane);
    const float g128 = __builtin_amdgcn_exp2f(128.0f * lp[dir * 4 + h]);
    f32x4 S[8], nx[8]; const float z0 = opaque_f(0.f);
#pragma unroll
    for (int j = 0; j < 8; ++j) S[j] = (f32x4){z0, z0, z0, z0};
    { const size_t idx = ((((size_t)b * NCH + prefix_chunk(dir, 0)) * 2 + dir) * 4 + h) * 2048; const GAS float* kv = (const GAS float*)(F.ws + WS_RETSUM) + idx;
#pragma unroll
      for (int j = 0; j < 8; ++j) nx[j] = *(const GAS f32x4*)(kv + 4 * lane_ + 256 * j); }
#pragma unroll 1
    for (int i = 0; i < NCH; ++i) {
        const size_t idx = ((((size_t)b * NCH + prefix_chunk(dir, i)) * 2 + dir) * 4 + h) * 2048;
        GAS bf16* st = (GAS bf16*)(F.ws + WS_RETST) + idx;
        f32x4 cur[8];
#pragma unroll
        for (int j = 0; j < 8; ++j) cur[j] = nx[j];
        if (i + 1 < NCH) { const size_t idn = ((((size_t)b * NCH + prefix_chunk(dir, i + 1)) * 2 + dir) * 4 + h) * 2048; const GAS float* kv = (const GAS float*)(F.ws + WS_RETSUM) + idn;
#pragma unroll
            for (int j = 0; j < 8; ++j) nx[j] = *(const GAS f32x4*)(kv + 4 * lane_ + 256 * j); }
#pragma unroll
        for (int j = 0; j < 8; ++j) { const int o = 4 * lane_ + 256 * j;
            u32x2 w; w.x = pk2(S[j][0], S[j][1]); w.y = pk2(S[j][2], S[j][3]); *(GAS u32x2*)(st + o) = w;
            S[j] = S[j] * g128 + cur[j]; }
    }
}
__device__ __forceinline__ void s5_prefix_unit(Frame& F, int b, int g, int d, int l) {
    const int lane_ = opaque_v(F.lane);
    const f32x2 a = ((const GAS f32x2*)(F.ws + WS_S5P + (size_t)l * S5P_BYTES + S5P_A128))[(d * 16 + g) * 64 + lane_];
    f32x2 e[NCH];
#pragma unroll
    for (int i = 0; i < NCH; ++i) e[i] = ((const GAS f32x2*)(F.ws + WS_S5E))[((((size_t)b * NCH + prefix_chunk(d, i)) * 16 + g) * 2 + d) * 64 + lane_];
    float cr = opaque_f(0.f), ci = cr;
#pragma unroll
    for (int i = 0; i < NCH; ++i) {
        ((GAS f32x2*)(F.ws + WS_S5C))[((((size_t)b * NCH + prefix_chunk(d, i)) * 16 + g) * 2 + d) * 64 + lane_] = (f32x2){cr, ci};
        const float nr = a.x * cr - a.y * ci + e[i].x, ni = a.x * ci + a.y * cr + e[i].y; cr = nr; ci = ni;
    }
}

constexpr int S5_XSTR = 132  , S5_HSTR = 272  , S5_WAVE_LDS = 16 * S5_XSTR * 4 + 16 * S5_HSTR;
template <bool OUT, int DIR>
__device__ __forceinline__ void s5_scan_dir(const unsigned char* sp, unsigned char* wsb, LAS float* X, LAS unsigned char* Hb, int lane, int tk, int kg, int g, size_t sidx, const bf16x8 (&ufr)[8], const bf16x8 (&chf)[4], f32x4 (&yacc)[8]) {
    const bf16x8 zero8 = (bf16x8){0, 0, 0, 0, 0, 0, 0, 0};
    const f32x2 ab = ((const GAS f32x2*)(sp + S5P_ABAR))[(DIR * 16 + g) * 64 + lane];
    bf16x8 af[8];
#pragma unroll
    for (int rb = 0; rb < 8; ++rb) af[rb] = kg < 2 ? *(const GAS bf16x8*)((const GAS bf16*)(sp + S5P_BP) + (((size_t)DIR * 16 + g) * 128 + 16 * rb + tk) * 16 + 8 * kg) : zero8;
    float hr = 0.f, hi = 0.f;
    if (OUT) { const f32x2 cin = ((const GAS f32x2*)(wsb + WS_S5C))[sidx + DIR * 64]; hr = cin.x; hi = cin.y; }
#pragma unroll
    for (int si = 0; si < 8; ++si) {
        const int sub = DIR ? 7 - si : si;
#pragma unroll
        for (int rb = 0; rb < 8; ++rb) { const f32x4 xa = __builtin_amdgcn_mfma_f32_16x16x32_bf16(af[rb], ufr[sub], (f32x4){0.f, 0.f, 0.f, 0.f}, 0, 0, 0);
            *(LAS f32x4*)(X + tk * S5_XSTR + 16 * rb + 4 * kg) = xa; }
        asm volatile("" ::: "memory");
#pragma unroll
        for (int ti = 0; ti < 16; ++ti) {
            const int tok = DIR ? 15 - ti : ti;
            const f32x2 x = *(const LAS f32x2*)(X + tok * S5_XSTR + 2 * lane);
            const float nr = ab.x * hr - ab.y * hi + x.x, ni = ab.x * hi + ab.y * hr + x.y; hr = nr; hi = ni;
            if (OUT) *(LAS unsigned*)(Hb + tok * S5_HSTR + 4 * lane) = cvt_pk_bf16(hr, hi);
        }
        asm volatile("" ::: "memory");
        if (OUT) {
#pragma unroll
            for (int ks = 0; ks < 4; ++ks) { const bf16x8 hf = *(const LAS bf16x8*)(Hb + tk * S5_HSTR + (32 * ks + 8 * kg) * 2); yacc[sub] = __builtin_amdgcn_mfma_f32_16x16x32_bf16(hf, chf[ks], yacc[sub], 0, 0, 0); }
        }
        asm volatile("" ::: "memory");
    }
    if (!OUT) ((GAS f32x2*)(wsb + WS_S5E))[sidx + DIR * 64] = (f32x2){hr, hi};
}
template <bool OUT>
__device__ __forceinline__ void s5_wave_unit(Frame& F, int b, int c, int g, int l, const float* s5_d) {
    const unsigned char* sp = F.ws + WS_S5P + (size_t)l * S5P_BYTES;
    const bf16* Z = (const bf16*)(F.ws + WS_Z); const int row0 = chunk_row0(b, c);
    LAS float* X = (LAS float*)(F.lds + F.wave * S5_WAVE_LDS);
    LAS unsigned char* Hb = (LAS unsigned char*)X + 16 * S5_XSTR * 4;
    const int lane = opaque_v(F.lane), tk = lane & 15, kg = lane >> 4;
    const bf16x8 zero8 = (bf16x8){0, 0, 0, 0, 0, 0, 0, 0};
    f32x4 yacc[8]; bf16x8 chf[4];
#pragma unroll
    for (int s8 = 0; s8 < 8; ++s8) yacc[s8] = (f32x4){0.f, 0.f, 0.f, 0.f};
#pragma unroll
    for (int ks = 0; ks < 4; ++ks) chf[ks] = OUT ? *(const GAS bf16x8*)((const GAS bf16*)(sp + S5P_CH) + ((size_t)g * 16 + tk) * 128 + 32 * ks + 8 * kg) : zero8;
    bf16x8 ufr[8];
#pragma unroll
    for (int sb = 0; sb < 8; ++sb) ufr[sb] = kg < 2 ? *(const GAS bf16x8*)((const GAS bf16*)Z + (size_t)(row0 + 16 * sb + tk) * ZW + ZQ_SU + g * 16 + 8 * kg) : zero8;
    const size_t sidx = ((((size_t)b * NCH + c) * 16 + g) * 2) * 64 + lane;
    s5_scan_dir<OUT, 0>(sp, F.ws, X, Hb, lane, tk, kg, g, sidx, ufr, chf, yacc);
    s5_scan_dir<OUT, 1>(sp, F.ws, X, Hb, lane, tk, kg, g, sidx, ufr, chf, yacc);
    if (OUT) {
        GAS bf16* xb = (GAS bf16*)(F.ws + WS_XB) + (size_t)1 * RT * 256;
        const float dsk = s5_d[((size_t)l * 16 + g) * 16 + tk];
#pragma unroll
        for (int s8 = 0; s8 < 8; ++s8)
#pragma unroll
            for (int r = 0; r < 4; ++r) { const int row = row0 + 16 * s8 + 4 * kg + r;
                const float u = bf2f(((const GAS bf16*)Z)[(size_t)row * ZW + ZQ_SU + g * 16 + tk]);
                const float y = yacc[s8][r] + dsk * u;
                const float o = y * sigmoidf_(1.5957691216f * (y + 0.044715f * y * y * y));
                xb[(size_t)row * 256 + g * 16 + tk] = (bf16)f2bf(o); }
    }
}
__device__ __forceinline__ bf16x8 pack8(const f32x16& x, int s) {
    u32x4 p;
    if (s == 0) { p.x = cvt_pk_bf16(x[0], x[1]); p.y = cvt_pk_bf16(x[2], x[3]); p.z = cvt_pk_bf16(x[4], x[5]); p.w = cvt_pk_bf16(x[6], x[7]); }
    else { p.x = cvt_pk_bf16(x[8], x[9]); p.y = cvt_pk_bf16(x[10], x[11]); p.z = cvt_pk_bf16(x[12], x[13]); p.w = cvt_pk_bf16(x[14], x[15]); }
    return __builtin_bit_cast(bf16x8, p);
}
#define MFMA32(a, b, c) __builtin_amdgcn_mfma_f32_32x32x16_bf16((a), (b), (c), 0, 0, 0)

__device__ __forceinline__ void ret_out_unit(Frame& F, int b, int c, const float* lp) {
    const bf16* Z = (const bf16*)(F.ws + WS_Z); const int row0 = chunk_row0(b, c);
    LAS unsigned char* L = F.lds;
    for (int i = F.tid; i < 4096; i += 512) { const int a = i >> 5, ch = i & 31;
        *(LAS u32x4*)(L + a * RS_VSTR + ch * 16) = *(const u32x4*)(Z + (size_t)(row0 + a) * ZW + ZQ_RV + ch * 8); }
    __syncthreads();
    const int h = F.wave >> 1, ih = F.wave & 1, l = opaque_v(F.lane), li = l & 31, hh = l >> 5, blk = (l >> 4) & 1, q = (l & 15) >> 2, p = l & 3;
    const float lgf = lp[h], lgb = lp[4 + h];
    bf16x8 qf[2][2];
#pragma unroll
    for (int ib = 0; ib < 2; ++ib)
#pragma unroll
        for (int ks = 0; ks < 2; ++ks) qf[ib][ks] = *(const bf16x8*)(Z + (size_t)(row0 + 64 * ih + 32 * ib + li) * ZW + ZQ_RQ + 32 * h + 16 * ks + 8 * hh);
    f32x16 o[2][2];
#pragma unroll
    for (int eb = 0; eb < 2; ++eb)
#pragma unroll
        for (int ib = 0; ib < 2; ++ib)
#pragma unroll
            for (int r = 0; r < 16; ++r) o[eb][ib][r] = 0.f;
    const unsigned vbase = (unsigned)(size_t)L + (h * 64 + 16 * blk) * 2 + 8 * p;
    bf16x8 kfa[4][2];
#pragma unroll
    for (int jb = 0; jb < 4; ++jb)
#pragma unroll
        for (int ks = 0; ks < 2; ++ks) kfa[jb][ks] = *(const GAS bf16x8*)((const GAS bf16*)Z + (size_t)(row0 + 32 * jb + li) * ZW + ZQ_RK + 32 * h + 16 * ks + 8 * hh);
#pragma unroll
    for (int jb = 0; jb < 4; ++jb) {
        bf16x8 kf[2]; kf[0] = kfa[jb][0]; kf[1] = kfa[jb][1];
        bf16x8 vf[2][2];
#pragma unroll
        for (int s2 = 0; s2 < 2; ++s2) { const int r0 = 32 * jb + 16 * s2 + 4 * hh + q, r1 = r0 + 8;
            vf[0][s2] = tr_read2(vbase + r0 * RS_VSTR, vbase + r1 * RS_VSTR); vf[1][s2] = tr_read2(vbase + 64 + r0 * RS_VSTR, vbase + 64 + r1 * RS_VSTR); }
#pragma unroll
        for (int ib = 0; ib < 2; ++ib) {
            f32x16 s;
#pragma unroll
            for (int r = 0; r < 16; ++r) s[r] = 0.f;
            s = MFMA32(kf[0], qf[ib][0], s); s = MFMA32(kf[1], qf[ib][1], s);
            const int iq = 64 * ih + 32 * ib + li;
#pragma unroll
            for (int r = 0; r < 16; ++r) { const int j = 32 * jb + (r & 3) + 8 * (r >> 2) + 4 * hh; const int dl = iq - j;
                s[r] *= dl >= 0 ? __builtin_amdgcn_exp2f((float)dl * lgf) : __builtin_amdgcn_exp2f((float)(-dl) * lgb); }
            const bf16x8 p0 = pack8(s, 0), p1 = pack8(s, 1);
            o[0][ib] = MFMA32(vf[0][0], p0, o[0][ib]); o[0][ib] = MFMA32(vf[0][1], p1, o[0][ib]);
            o[1][ib] = MFMA32(vf[1][0], p0, o[1][ib]); o[1][ib] = MFMA32(vf[1][1], p1, o[1][ib]);
        }
    }
#pragma unroll
    for (int dir = 0; dir < 2; ++dir) {
        const bf16* st = (const bf16*)(F.ws + WS_RETST) + ((((size_t)b * NCH + c) * 2 + dir) * 4 + h) * 2048;
#pragma unroll
        for (int eb = 0; eb < 2; ++eb) {
            const bf16x8 s0 = *(const bf16x8*)(st + (32 * eb + li) * 32 + 8 * hh), s1 = *(const bf16x8*)(st + (32 * eb + li) * 32 + 16 + 8 * hh);
#pragma unroll
            for (int ib = 0; ib < 2; ++ib) {
                f32x16 x;
#pragma unroll
                for (int r = 0; r < 16; ++r) x[r] = 0.f;
                x = MFMA32(s0, qf[ib][0], x); x = MFMA32(s1, qf[ib][1], x);
                const int a = 64 * ih + 32 * ib + li;
                const float wq = dir == 0 ? __builtin_amdgcn_exp2f((float)(a + 1) * lgf) : __builtin_amdgcn_exp2f((float)(128 - a) * lgb);
#pragma unroll
                for (int r = 0; r < 16; ++r) o[eb][ib][r] += wq * x[r];
            }
        }
    }
    bf16* xb = (bf16*)(F.ws + WS_XB);
#pragma unroll
    for (int ib = 0; ib < 2; ++ib) {
        float sm = 0.f;
#pragma unroll
        for (int r = 0; r < 16; ++r) sm += o[0][ib][r] + o[1][ib][r];
        sm += __shfl_xor(sm, 32); const float mean = sm * (1.0f / 64.0f);
        float sq = 0.f;
#pragma unroll
        for (int r = 0; r < 16; ++r) { const float d0 = o[0][ib][r] - mean, d1 = o[1][ib][r] - mean; sq += d0 * d0 + d1 * d1; }
        sq += __shfl_xor(sq, 32); const float rstd = 1.0f / sqrtf(sq * (1.0f / 64.0f) + EPS);
        const size_t row = (size_t)(row0 + 64 * ih + 32 * ib + li);
#pragma unroll
        for (int eb = 0; eb < 2; ++eb)
#pragma unroll
            for (int g4 = 0; g4 < 4; ++g4) { const int e = 32 * eb + 8 * g4 + 4 * hh;
                const u32x2 gw = *(const u32x2*)(Z + row * ZW + ZQ_RG + h * 64 + e);
                const float y0 = (o[eb][ib][4 * g4 + 0] - mean) * rstd * siluf_(bflo(gw.x)), y1 = (o[eb][ib][4 * g4 + 1] - mean) * rstd * siluf_(bfhi(gw.x));
                const float y2 = (o[eb][ib][4 * g4 + 2] - mean) * rstd * siluf_(bflo(gw.y)), y3 = (o[eb][ib][4 * g4 + 3] - mean) * rstd * siluf_(bfhi(gw.y));
                u32x2 w; w.x = cvt_pk_bf16(y0, y1); w.y = cvt_pk_bf16(y2, y3); *(u32x2*)(xb + row * 256 + h * 64 + e) = w; }
    }
    __syncthreads();
}

__device__ __forceinline__ void tr_read_vtile(unsigned base, bf16x8 (&vf)[2][4]) {
    s16x4 r[16];
    asm volatile("ds_read_b64_tr_b16 %0, %16 offset:0\n\t" "ds_read_b64_tr_b16 %1, %16 offset:1152\n\t" "ds_read_b64_tr_b16 %2, %16 offset:2304\n\t" "ds_read_b64_tr_b16 %3, %16 offset:3456\n\t" "ds_read_b64_tr_b16 %4, %16 offset:4608\n\t" "ds_read_b64_tr_b16 %5, %16 offset:5760\n\t" "ds_read_b64_tr_b16 %6, %16 offset:6912\n\t" "ds_read_b64_tr_b16 %7, %16 offset:8064\n\t" "ds_read_b64_tr_b16 %8, %16 offset:64\n\t" "ds_read_b64_tr_b16 %9, %16 offset:1216\n\t" "ds_read_b64_tr_b16 %10, %16 offset:2368\n\t" "ds_read_b64_tr_b16 %11, %16 offset:3520\n\t" "ds_read_b64_tr_b16 %12, %16 offset:4672\n\t" "ds_read_b64_tr_b16 %13, %16 offset:5824\n\t" "ds_read_b64_tr_b16 %14, %16 offset:6976\n\t" "ds_read_b64_tr_b16 %15, %16 offset:8128\n\t" "s_waitcnt lgkmcnt(0)" : "=&v"(r[0]), "=&v"(r[1]), "=&v"(r[2]), "=&v"(r[3]), "=&v"(r[4]), "=&v"(r[5]), "=&v"(r[6]), "=&v"(r[7]), "=&v"(r[8]), "=&v"(r[9]), "=&v"(r[10]), "=&v"(r[11]), "=&v"(r[12]), "=&v"(r[13]), "=&v"(r[14]), "=&v"(r[15]) : "v"(base) : "memory");
#pragma unroll
    for (int eb = 0; eb < 2; ++eb)
#pragma unroll
        for (int k4 = 0; k4 < 4; ++k4) vf[eb][k4] = __builtin_shufflevector(r[(eb * 4 + k4) * 2], r[(eb * 4 + k4) * 2 + 1], 0, 1, 2, 3, 4, 5, 6, 7);
}
constexpr int AT_STR = 144, AT_TILE = 64 * AT_STR;
__device__ __forceinline__ void attn_unit(Frame& F, int b, int h, int qrow0, int nkt, bool ctx_only, float lam, float omli, const float* subln_g) {
    const bf16* Z = (const bf16*)(F.ws + WS_Z);
    LAS unsigned char* L = F.lds; const unsigned lb = (unsigned)(size_t)L;
    const int l = opaque_v(F.lane), li = l & 31, hh = l >> 5, blk = (l >> 4) & 1, q4 = (l & 15) >> 2, p = l & 3;
    const int qrow = qrow0 + 32 * F.wave + li;
    bf16x8 qf[2][2];
#pragma unroll
    for (int mp = 0; mp < 2; ++mp)
#pragma unroll
        for (int ks = 0; ks < 2; ++ks) qf[mp][ks] = *(const bf16x8*)(Z + (size_t)qrow * ZW + ZQ_DQ + h * 64 + mp * 32 + 16 * ks + 8 * hh);
    f32x16 o[2][2];
#pragma unroll
    for (int mp = 0; mp < 2; ++mp)
#pragma unroll
        for (int eb = 0; eb < 2; ++eb)
#pragma unroll
            for (int r = 0; r < 16; ++r) o[mp][eb][r] = 0.f;
    float mx[2] = {-3.0e38f, -3.0e38f}, ls[2] = {0.f, 0.f};
    const int stid = opaque_v(F.tid), skey = stid >> 3, sch = stid & 7;
    auto key_row = [&](int kt) -> int { const int k0 = kt * 64; return (ctx_only || k0 < NCTX) ? RL + b * NCTX + k0 : b * SEQ + (k0 - NCTX); };
    u32x4 kreg, vreg;
    { const size_t r = (size_t)(key_row(0) + skey); kreg = *(const u32x4*)(Z + r * ZW + ZQ_DK + h * 64 + sch * 8); vreg = *(const u32x4*)(Z + r * ZW + ZQ_DV + h * 64 + sch * 8); }
#pragma unroll 1
    for (int kt = 0; kt < nkt; ++kt) {
        const int buf = kt & 1;
        *(LAS u32x4*)(L + buf * 2 * AT_TILE + skey * AT_STR + sch * 16) = kreg;
        *(LAS u32x4*)(L + buf * 2 * AT_TILE + AT_TILE + skey * AT_STR + sch * 16) = vreg;
        __syncthreads();
        if (kt + 1 < nkt) { const size_t r = (size_t)(key_row(kt + 1) + skey); kreg = *(const u32x4*)(Z + r * ZW + ZQ_DK + h * 64 + sch * 8); vreg = *(const u32x4*)(Z + r * ZW + ZQ_DV + h * 64 + sch * 8); }
        const LAS unsigned char* Kt = L + buf * 2 * AT_TILE; const unsigned vb = lb + buf * 2 * AT_TILE + AT_TILE + 16 * blk * 2 + 8 * p;
        bf16x8 vf[2][4];
        tr_read_vtile(vb + (4 * hh + q4) * AT_STR, vf);
#pragma unroll
        for (int mp = 0; mp < 2; ++mp) {
            f32x16 s[2];
#pragma unroll
            for (int kb = 0; kb < 2; ++kb) {
#pragma unroll
                for (int r = 0; r < 16; ++r) s[kb][r] = 0.f;
#pragma unroll
                for (int ks = 0; ks < 2; ++ks) { const bf16x8 ka = *(const LAS bf16x8*)(Kt + (32 * kb + li) * AT_STR + (mp * 32 + 16 * ks + 8 * hh) * 2); s[kb] = MFMA32(ka, qf[mp][ks], s[kb]); }
            }
            if (kt < 4 || (kt & 3) == 0) {
                float tm = s[0][0];
#pragma unroll
                for (int r = 1; r < 16; ++r) tm = fmaxf(tm, s[0][r]);
#pragma unroll
                for (int r = 0; r < 16; ++r) tm = fmaxf(tm, s[1][r]);
                tm = fmaxf(tm, __shfl_xor(tm, 32));
                if (__any(tm > mx[mp])) {
                    const float mn = fmaxf(mx[mp], tm), al = __builtin_amdgcn_exp2f((mx[mp] - mn) * 1.44269504f);
                    mx[mp] = mn; ls[mp] *= al;
#pragma unroll
                    for (int eb = 0; eb < 2; ++eb)
#pragma unroll
                        for (int r = 0; r < 16; ++r) o[mp][eb][r] *= al;
                }
            }
            const float mb = mx[mp] * 1.44269504f; f32x2 rs2 = (f32x2){0.f, 0.f};
#pragma unroll
            for (int kb = 0; kb < 2; ++kb)
#pragma unroll
                for (int r = 0; r < 16; r += 2) { const float p0 = __builtin_amdgcn_exp2f(s[kb][r] * 1.44269504f - mb), p1 = __builtin_amdgcn_exp2f(s[kb][r + 1] * 1.44269504f - mb);
                    s[kb][r] = p0; s[kb][r + 1] = p1; rs2 += (f32x2){p0, p1}; }
            const float rs = rs2.x + rs2.y;
            ls[mp] += rs;
#pragma unroll
            for (int kb = 0; kb < 2; ++kb)
#pragma unroll
                for (int s2 = 0; s2 < 2; ++s2) { const bf16x8 pb = pack8(s[kb], s2);
                    o[mp][0] = MFMA32(vf[0][2 * kb + s2], pb, o[mp][0]); o[mp][1] = MFMA32(vf[1][2 * kb + s2], pb, o[mp][1]); }
        }
    }
    const float l0 = ls[0] + __shfl_xor(ls[0], 32), l1 = ls[1] + __shfl_xor(ls[1], 32);
    const float i0 = 1.0f / l0, i1 = lam / l1;
    float sq = 0.f;
#pragma unroll
    for (int eb = 0; eb < 2; ++eb)
#pragma unroll
        for (int r = 0; r < 16; ++r) { const float v = o[0][eb][r] * i0 - o[1][eb][r] * i1; o[0][eb][r] = v; sq += v * v; }
    sq += __shfl_xor(sq, 32);
    const float rstd = omli / sqrtf(sq * (1.0f / 64.0f) + EPS);
    bf16* xb = (bf16*)(F.ws + WS_XB) + (size_t)2 * RT * 256;
#pragma unroll
    for (int eb = 0; eb < 2; ++eb)
#pragma unroll
        for (int g4 = 0; g4 < 4; ++g4) { const int e = 32 * eb + 8 * g4 + 4 * hh; const f32x4 sg = *(const f32x4*)(subln_g + e);
            u32x2 w; w.x = cvt_pk_bf16(o[0][eb][4 * g4] * rstd * sg[0], o[0][eb][4 * g4 + 1] * rstd * sg[1]); w.y = cvt_pk_bf16(o[0][eb][4 * g4 + 2] * rstd * sg[2], o[0][eb][4 * g4 + 3] * rstd * sg[3]);
            *(u32x2*)(xb + (size_t)qrow * 256 + h * 64 + e) = w; }
    __syncthreads();
}

__device__ __forceinline__ void conv_unit(Frame& F, int seq_row0, int seq_len, int tok0, const float* dw, const float* db, const float* lng, const float* lnb) {
    const bf16* Z = (const bf16*)(F.ws + WS_Z);
    LAS unsigned short* U = (LAS unsigned short*)F.lds;
    LAS float* Yt = (LAS float*)(F.lds + 94 * 512);
    for (int i = F.tid; i < 94 * 32; i += 512) { const int tt = i >> 5, ch = i & 31; const int t = tok0 - 15 + tt;
        u32x4 v = (u32x4){0u, 0u, 0u, 0u}; if (t >= 0 && t < seq_len) v = *(const u32x4*)(Z + (size_t)(seq_row0 + t) * ZW + ZQ_CV + ch * 8);
        *(LAS u32x4*)(U + tt * 256 + ch * 8) = v; }
    __syncthreads();
    const int ctid = opaque_v(F.tid), ch = ctid & 255, half = ctid >> 8;
    float w[31];
#pragma unroll
    for (int k = 0; k < 31; ++k) w[k] = dw[k * 256 + ch];
    const float bias = db[ch];
#pragma unroll 1
    for (int g = 0; g < 2; ++g) {
        const int t0 = half * 32 + g * 16;
        float x[46];
#pragma unroll
        for (int i = 0; i < 46; ++i) x[i] = bf2f(U[(t0 + i) * 256 + ch]);
#pragma unroll
        for (int j = 0; j < 16; ++j) { float a = bias;
#pragma unroll
            for (int k = 0; k < 31; ++k) a += w[k] * x[j + k];
            Yt[(t0 + j) * 256 + ch] = a; }
    }
    __syncthreads();
    bf16* xb = (bf16*)(F.ws + WS_XB) + (size_t)3 * RT * 256;
    for (int t = F.wave; t < 64; t += 8) {
        const f32x4 y = *(const LAS f32x4*)(Yt + t * 256 + 4 * F.lane);
        const float mean = wave_sum((y[0] + y[1]) + (y[2] + y[3])) * (1.0f / 256.0f);
        const f32x4 dv = y - mean; const float var = wave_sum((dv[0] * dv[0] + dv[1] * dv[1]) + (dv[2] * dv[2] + dv[3] * dv[3])) * (1.0f / 256.0f);
        const float rstd = 1.0f / sqrtf(var + EPS);
        const f32x4 g4 = *(const f32x4*)(lng + 4 * F.lane), b4 = *(const f32x4*)(lnb + 4 * F.lane);
        const f32x4 z = dv * rstd * g4 + b4;
        u32x2 wv; wv.x = cvt_pk_bf16(siluf_(z[0]), siluf_(z[1])); wv.y = cvt_pk_bf16(siluf_(z[2]), siluf_(z[3]));
        *(u32x2*)(xb + (size_t)(seq_row0 + tok0 + t) * 256 + 4 * F.lane) = wv;
    }
    __syncthreads();
}
#ifndef F8_LAYER_MASK
#define F8_LAYER_MASK 0xF
#endif
constexpr int F8MASK = F8_LAYER_MASK;
constexpr int NSTEP_L = 12, NSTEPS = 2 + DEPTH * NSTEP_L;
struct Args { const float* in[39]; float* out; unsigned char* ws; int s_lo, s_hi; };
static_assert(sizeof(Args) == 39 * 8 + 8 + 8 + 8, "Args has no padding");

template <int OFF> __device__ __forceinline__ unsigned long long ka64() { unsigned long long v; asm volatile("s_load_dwordx2 %0, %1, %2\n\ts_waitcnt lgkmcnt(0)" : "=s"(v) : "s"(__builtin_amdgcn_kernarg_segment_ptr()), "n"(OFF)); return v; }
template <int OFF> __device__ __forceinline__ int ka32() { int v; asm volatile("s_load_dword %0, %1, %2\n\ts_waitcnt lgkmcnt(0)" : "=s"(v) : "s"(__builtin_amdgcn_kernarg_segment_ptr()), "n"(OFF)); return v; }
#define KIN(k) ((const float*)ka64<8 * (k)>())
#define KOUT ((float*)ka64<312>())
#define KWS ((unsigned char*)ka64<320>())
__global__ void __launch_bounds__(NWAVES * 64, 2) fwd_kernel(Args) {
    extern __shared__ __attribute__((aligned(16))) unsigned char lds[];
    Frame F;
    F.lds = (LAS unsigned char*)lds;
    F.MISC = (volatile LAS unsigned*)(F.lds + MISC_OFF);
    F.tid = threadIdx.x; F.lane = F.tid & 63; F.wave = __builtin_amdgcn_readfirstlane(F.tid >> 6);
    F.G = gridDim.x; { const int bx = blockIdx.x; F.vcu = (F.G % 8 == 0) ? (bx % 8) * (F.G / 8) + bx / 8 : bx; }
    F.ws = KWS;
    unsigned char* ws = F.ws;
    for (int u = F.tid; u < (LDS_BYTES - LDSCTL_OFF) / 4; u += NWAVES * 64) ((LAS unsigned*)(F.lds + LDSCTL_OFF))[u] = 0u;
    __syncthreads();
    unsigned* barw = (unsigned*)(ws + WS_CTL) + CW_BAR; asm volatile("" : "+s"(barw));
    const int lo = ka32<328>(), hi = ka32<332>();
    XcdBarrier bar; bar.bar = barw; bar.x = 0; bar.st = nullptr;
    if (hi - lo > 1) bar = xcd_barrier_post(barw, F.MISC + 8, F.tid);
#ifndef BR_REP
#define BR_REP 0
#endif
#ifndef PH_MASK
#define PH_MASK 0xFFFFF
#endif
#define EN(j) (((PH_MASK) >> (j)) & 1)
#define IN(k) (lo <= (k) && (k) < hi)
#define FRESH() do { int ln_; asm volatile("v_mbcnt_lo_u32_b32 %0, -1, 0\n\tv_mbcnt_hi_u32_b32 %0, -1, %0" : "=v"(ln_)); F.wave = opaque_s(F.wave); F.lane = ln_; F.tid = F.wave * 64 + ln_; \
    F.vcu = opaque_s(F.vcu); F.G = opaque_s(F.G); asm volatile("" : "+s"(F.ws)); ws = F.ws; } while (0)
#define GW (F.vcu * NWAVES + F.wave)
#define NGW_ (F.G * NWAVES)
#define SEAM(k) do { if (IN(k) && IN((k) + 1)) { FRESH(); xcd_barrier(bar, F.tid); } } while (0)

    if (EN(12) && IN(0)) { FRESH();
        P0Args P; P.c = KIN(1); P.c_ctx = KIN(3); P.ada_w = KIN(4); P.ada_b = KIN(5); P.w_in = KIN(10); P.w_gate = KIN(11); P.ret_w_o = KIN(14); P.s5_w_glu = KIN(23);
        P.diff_w_o = KIN(26); P.conv_w_o = KIN(31); P.w_out = KIN(32); P.ffn_w_gu = KIN(33); P.ffn_w_d = KIN(34); P.moe_w_gu = KIN(37); P.moe_w_d = KIN(38);
        P.ret_decay = KIN(13); P.s5_a_re = KIN(15); P.s5_a_im = KIN(16); P.s5_log_dt = KIN(17); P.s5_b_re = KIN(18); P.s5_b_im = KIN(19); P.s5_c_re = KIN(20); P.s5_c_im = KIN(21); P.diff_lambda = KIN(24);
        P.f8mask = F8MASK;
        p0_prologue(F, P);
    }
    SEAM(0);
    if (EN(13) && IN(1)) { FRESH(); RowArgs A{}; A.x = KIN(0); A.ctx = KIN(2); A.pre_g = KIN(6); A.l = 0; A.nrows = RT; row_pass<0>(F, A); }
    SEAM(1);

#pragma unroll 1
    for (int l = 0; l < DEPTH; ++l) {
        const int s0 = 2 + l * NSTEP_L;
        if (hi <= s0 || lo >= s0 + NSTEP_L) continue;
        const bool need_ctx = l < DEPTH - 1, moe = (l & 1) != 0;
        const int nrows = need_ctx ? RT : RL, nM = nrows / 256, j2 = l >> 1;
#define lp ((const float*)(ws + WS_LAYP) + l * 64)
#define AF ((bf16*)(ws + WS_AF))
#define Z ((bf16*)(ws + WS_Z))

        if (EN(0) && IN(s0 + 0)) { FRESH();
            pg8::Gemm g{AF, (const bf16*)(ws + WS_WIN) + (size_t)l * E_WIN, D, 0, 0}; pg8::SchedWin S; S.init(F.G, opaque_s((int)blockIdx.x), need_ctx ? 0 : 2);
            pg8::EpiWin E{Z, (const float*)(ws + WS_ROPE)};
            pg8::gemm_phase(F.lds, g, S, E, F.tid);
        }
        SEAM(s0 + 0);
        if (EN(1) && IN(s0 + 1)) { FRESH();
            unsigned* dep = (unsigned*)(ws + WS_CTL) + CW_DEP + 1024 * l;
            if (need_ctx) {
                pg8::Gemm g{AF, (const bf16*)(ws + WS_WIN) + (size_t)l * E_WIN, D, 0, 0}; pg8::SchedWin S; S.init(F.G, opaque_s((int)blockIdx.x), 1);
                pg8::EpiWin E{Z, (const float*)(ws + WS_ROPE)};
                pg8::gemm_phase(F.lds, g, S, E, F.tid);
                __syncthreads(); FRESH();
                const int bx = opaque_s((int)blockIdx.x), nmine = bx < 16 ? (16 - bx + F.G - 1) / F.G : 0;
                if (nmine > 0) dep_signal(F, dep + 128, (unsigned)nmine);
            }
            unsigned* ctr = (unsigned*)(ws + WS_CTL) + 8192 + 64 * (l * 2 + 0);
            const int n_rs = NB * NCH, nS = n_rs + NB * NCH * 2, nP = 80, e0 = nS + nP;
            const int c_lo = need_ctx ? 0 : 2, nch = NCH - c_lo;
            const int n_at = 512, n_ret = NB * nch, n_s5 = NB * nch * 2, n_cv = need_ctx ? 576 : 512, n_ac = need_ctx ? 64 : 0;
            const int e1 = e0 + n_at, e2 = e1 + n_ret, e3 = e2 + n_s5, e4 = e3 + n_cv, total = e4 + n_ac;
            int u = F.vcu, nsum = 0;
            while (u < total) {
                int nx = 0; if (F.tid == 0) nx = F.G + (int)__hip_atomic_fetch_add(ctr, 1u, RLX_AGENT);
                FRESH();
                if (u < n_rs) { for (int rp_ = 0; rp_ < 1 + ((BR_REP >> 4) & 1); ++rp_) ret_summary_unit(F, u / NCH, u % NCH, lp); }
                else if (u < nS) { const int wu = (u - n_rs) * 8 + F.wave; const int g = wu & 15, bc = wu >> 4; for (int rp_ = 0; rp_ < 1 + ((BR_REP >> 5) & 1); ++rp_) s5_wave_unit<false>(F, bc / NCH, bc % NCH, g, l, nullptr); }
                else if (u < e0) { dep_wait(F, dep, (unsigned)nS); FRESH();
                    const int wu = (u - nS) * 8 + F.wave;
                    if (wu < 128) ret_prefix_unit(F, wu >> 3, (wu >> 1) & 3, wu & 1, lp);
                    else { const int v = wu - 128; s5_prefix_unit(F, v >> 5, (v >> 1) & 15, v & 1, l); } }
                else if (u < e1) { const int v = u - e0; for (int rp_ = 0; rp_ < 1 + ((BR_REP >> 0) & 1); ++rp_) attn_unit(F, v >> 5, (v >> 3) & 3, (v >> 5) * SEQ + (v & 7) * 256, 36, false, lp[8], lp[9], KIN(25) + l * 64); }
                else if (u < e2) { dep_wait(F, dep + 64, (unsigned)nP); FRESH(); const int v = u - e1; for (int rp_ = 0; rp_ < 1 + ((BR_REP >> 1) & 1); ++rp_) ret_out_unit(F, v / nch, c_lo + v % nch, lp); }
                else if (u < e3) { dep_wait(F, dep + 64, (unsigned)nP); FRESH(); const int wu = (u - e2) * 8 + F.wave; const int g = wu & 15, bc = wu >> 4; for (int rp_ = 0; rp_ < 1 + ((BR_REP >> 2) & 1); ++rp_) s5_wave_unit<true>(F, bc / nch, c_lo + bc % nch, g, l, KIN(22)); }
                else if (u < e4) { const int v = u - e3; const float* dw = KIN(27) + (size_t)l * 31 * 256; const float* db = KIN(28) + l * 256; const float* lng = KIN(29) + l * 256; const float* lnb = KIN(30) + l * 256;
                    if (v >= 512) { dep_wait(F, dep + 128, 16u); FRESH(); }
                    for (int rp_ = 0; rp_ < 1 + ((BR_REP >> 3) & 1); ++rp_)
                    if (v < 512) conv_unit(F, (v >> 5) * SEQ, SEQ, (v & 31) * 64, dw, db, lng, lnb);
                    else { const int v2 = v - 512; conv_unit(F, RL + (v2 >> 2) * NCTX, NCTX, (v2 & 3) * 64, dw, db, lng, lnb); } }
                else { const int v = u - e4; attn_unit(F, v >> 2, v & 3, RL + (v >> 2) * NCTX, 4, true, lp[8], lp[9], KIN(25) + l * 64); }
                if (F.tid == 0) F.MISC[24] = (unsigned)nx;
                __syncthreads(); const int un = (int)F.MISC[24]; __syncthreads();
                if (u < nS) { ++nsum; if (un >= nS) dep_signal(F, dep, (unsigned)nsum); }
                else if (u < e0) dep_signal(F, dep + 64, 1u);
                u = un;
            }
        }
        SEAM(s0 + 3);
        if (EN(4) && IN(s0 + 4)) { FRESH();
            pg8::Gemm g{(const bf16*)(ws + WS_XB), (const bf16*)(ws + WS_WBR) + (size_t)l * E_WBR, 256}; pg8::SchedBr S; S.init(nM, F.G, opaque_s((int)blockIdx.x));
            pg8::EpiBr E{(bf16*)(ws + WS_BO)};
            pg8::gemm_phase(F.lds, g, S, E, F.tid);
        }
        SEAM(s0 + 4);
        if (EN(5) && IN(s0 + 5)) { FRESH();
            pg8::Gemm g{ws + WS_AF8, ws + WS_WG + (size_t)l * E_WG * 2, D, 121, 125}; pg8::SchedStd S; S.init(nM, 16, F.G, opaque_s((int)blockIdx.x));
            pg8::EpiGate E{(const bf16*)(ws + WS_BO), (bf16*)(ws + WS_MM), KIN(12) + (size_t)l * 4 * D, F.lds + 131072};
            pg8::gemm_phase<pg8::EpiGate, pg8::SchedStd, true>(F.lds, g, S, E, F.tid);
        }
        SEAM(s0 + 5);
        if (EN(6) && IN(s0 + 6)) { FRESH();
            pg8::Gemm g{(const bf16*)(ws + WS_MM), (const bf16*)(ws + WS_WOUT) + (size_t)l * E_WOUT, D}; pg8::SchedStd S; S.init(nM, 4, F.G, opaque_s((int)blockIdx.x));
            pg8::EpiBf16 E{(bf16*)(ws + WS_Y), D};
            pg8::gemm_phase(F.lds, g, S, E, F.tid);
        }
        SEAM(s0 + 6);
        if (EN(7) && IN(s0 + 7)) { FRESH(); RowArgs A{}; A.post_g = KIN(7) + l * D; A.pre_g = KIN(8) + l * D; A.l = l; A.nrows = nrows; A.moe = moe ? 1 : 0;
            A.f8 = (F8MASK >> l) & 1; A.router_w = KIN(35) + (size_t)j2 * D * NE; A.router_b = KIN(36) + j2 * NE;
#if defined(PROBE_DRY) && (PROBE_DRY & 1)
            if ((PROBE_DRY_L >> l) & 1) { for (int rp_ = 0; rp_ < PROBE_DRY_N; ++rp_) { A.dry = 1; row_pass<1>(F, A); A.dry = 0; __syncthreads(); FRESH(); } }
#endif
            row_pass<1>(F, A); }
        SEAM(s0 + 7);
        if (moe) {
            if (EN(8) && IN(s0 + 8)) { FRESH(); moe_dispatch(F, nrows, (F8MASK >> l) & 1); }
            SEAM(s0 + 8);
            if (EN(9) && IN(s0 + 9)) { FRESH();
                const int* te = (const int*)(ws + WS_TILEE); const int nt = __builtin_amdgcn_readfirstlane(__hip_atomic_load(te + 400, RLX_AGENT));
                pg8::SchedMoe S; S.init(nt, 2 * FFE / 256, F.G, opaque_s((int)blockIdx.x), te);
                if ((F8MASK & 0xA) && ((F8MASK >> l) & 1)) {
                    pg8::Gemm g{ws + WS_FS, ws + WS_MGU + (size_t)j2 * NE * E_MGU * 2, D, 121, 125}; pg8::EpiSwiGLU8 E{ws + WS_GS, FFE};
                    pg8::gemm_phase<pg8::EpiSwiGLU8, pg8::SchedMoe, true>(F.lds, g, S, E, F.tid);
                } else if ((~F8MASK) & 0xA) {
                    pg8::Gemm g{ws + WS_FS, ws + WS_MGU + (size_t)j2 * NE * E_MGU * 2, D, 0, 0}; pg8::EpiSwiGLU E{(bf16*)(ws + WS_GS), FFE};
                    pg8::gemm_phase(F.lds, g, S, E, F.tid);
                }
            }
            SEAM(s0 + 9);
            if (EN(10) && IN(s0 + 10)) { FRESH();
                const int* te = (const int*)(ws + WS_TILEE); const int nt = __builtin_amdgcn_readfirstlane(__hip_atomic_load(te + 400, RLX_AGENT));
                pg8::SchedMoe S; S.init(nt, 4, F.G, opaque_s((int)blockIdx.x), te); pg8::EpiBf16 E{(bf16*)(ws + WS_YS), D};
                if ((F8MASK & 0xA) && ((F8MASK >> l) & 1)) {
                    pg8::Gemm g{ws + WS_GS, ws + WS_MWD + (size_t)j2 * NE * E_MWD * 2, FFE, 121, 124};
                    pg8::gemm_phase<pg8::EpiBf16, pg8::SchedMoe, true>(F.lds, g, S, E, F.tid);
                } else if ((~F8MASK) & 0xA) {
                    pg8::Gemm g{ws + WS_GS, ws + WS_MWD + (size_t)j2 * NE * E_MWD * 2, FFE, 0, 0};
                    pg8::gemm_phase(F.lds, g, S, E, F.tid);
                }
            }
            SEAM(s0 + 10);
        } else {
            if (EN(9) && IN(s0 + 9)) { FRESH();
                pg8::SchedStd S; S.init(nM, 2 * FFD / 256, F.G, opaque_s((int)blockIdx.x));
                if ((F8MASK & 0x5) && ((F8MASK >> l) & 1)) {
                    pg8::Gemm g{AF, ws + WS_WGU + (size_t)j2 * E_WGU * 2, D, 121, 125}; pg8::EpiSwiGLU8 E{ws + WS_G, FFD};
                    pg8::gemm_phase<pg8::EpiSwiGLU8, pg8::SchedStd, true>(F.lds, g, S, E, F.tid);
                } else if ((~F8MASK) & 0x5) {
                    pg8::Gemm g{AF, ws + WS_WGU + (size_t)j2 * E_WGU * 2, D, 0, 0}; pg8::EpiSwiGLU E{(bf16*)(ws + WS_G), FFD};
                    pg8::gemm_phase(F.lds, g, S, E, F.tid);
                }
            }
            SEAM(s0 + 9);
            if (EN(10) && IN(s0 + 10)) { FRESH();
                pg8::SchedStd S; S.init(nM, 4, F.G, opaque_s((int)blockIdx.x)); pg8::EpiBf16 E{(bf16*)(ws + WS_Y), D};
                if ((F8MASK & 0x5) && ((F8MASK >> l) & 1)) {
                    pg8::Gemm g{ws + WS_G, ws + WS_WD + (size_t)j2 * E_WD * 2, FFD, 121, 124};
                    pg8::gemm_phase<pg8::EpiBf16, pg8::SchedStd, true>(F.lds, g, S, E, F.tid);
                } else if ((~F8MASK) & 0x5) {
                    pg8::Gemm g{ws + WS_G, ws + WS_WD + (size_t)j2 * E_WD * 2, FFD, 0, 0};
                    pg8::gemm_phase(F.lds, g, S, E, F.tid);
                }
            }
            SEAM(s0 + 10);
        }
        if (EN(11) && IN(s0 + 11)) { FRESH(); RowArgs A{}; A.post_g = KIN(9) + l * D; A.pre_g = KIN(6) + (l + 1 < DEPTH ? l + 1 : l) * D; A.l = l; A.nrows = nrows; A.moe = moe ? 1 : 0; A.last = need_ctx ? 0 : 1; A.out = KOUT;
#if defined(PROBE_DRY) && (PROBE_DRY & 2)
            if ((PROBE_DRY_L >> l) & 1) { for (int rp_ = 0; rp_ < PROBE_DRY_N; ++rp_) { A.dry = 1; row_pass<2>(F, A); A.dry = 0; __syncthreads(); FRESH(); } }
#endif
            row_pass<2>(F, A); }
        if (l + 1 < DEPTH) SEAM(s0 + 11);
    }
#undef lp
#undef AF
#undef Z
#undef IN
#undef SEAM
}

#ifndef MK_LAUNCH_PER_STEP
#define MK_LAUNCH_PER_STEP 0
#endif
extern "C" void kernel_launch(void* const* d_in, const int* in_sizes, int n_in, void* d_out, int out_size, void* d_ws, size_t ws_size, hipStream_t stream) {
    static int grid = 0;
    if (grid == 0) {
        if (n_in != 39 || out_size != RL * D || ws_size < WS_END) { fprintf(stderr, "kernel_launch: unexpected shapes: n_in %d out %d ws %zu (need %zu)\n", n_in, out_size, ws_size, (size_t)WS_END); grid = -1; return; }
        int dev = 0, cus = 0, per_cu = 0;
        if (hipGetDevice(&dev) != hipSuccess || hipDeviceGetAttribute(&cus, hipDeviceAttributeMultiprocessorCount, dev) != hipSuccess) { grid = -1; return; }
        if (hipFuncSetAttribute((const void*)fwd_kernel, hipFuncAttributeMaxDynamicSharedMemorySize, LDS_BYTES) != hipSuccess) { fprintf(stderr, "kernel_launch: hipFuncSetAttribute failed\n"); grid = -1; return; }
        if (hipOccupancyMaxActiveBlocksPerMultiprocessor(&per_cu, (const void*)fwd_kernel, NWAVES * 64, LDS_BYTES) != hipSuccess || per_cu < 1) { fprintf(stderr, "kernel_launch: occupancy query says %d\n", per_cu); }
        (void)hipGetLastError();
        grid = cus;
    }
    if (grid < 0) return;
    if (hipMemsetAsync((char*)d_ws + WS_CTL, 0, CTL_ZERO_BYTES, stream) != hipSuccess) return;
    Args a{};
    for (int i = 0; i < 39; ++i) a.in[i] = (const float*)d_in[i];
    a.out = (float*)d_out; a.ws = (unsigned char*)d_ws;
#if MK_LAUNCH_PER_STEP
    for (int s = 0; s < NSTEPS; ++s) { a.s_lo = s; a.s_hi = s + 1;
        int rep = 1;
#ifdef PROBE_REP_MASK
        if (s >= 2) { const int j = (s - 2) % NSTEP_L, l = (s - 2) / NSTEP_L; if (((PROBE_REP_MASK) >> j) & 1 && ((PROBE_LAYER_MASK) >> l) & 1) rep = 2; } else if (((PROBE_REP_MASK) >> (12 + s)) & 1) rep = 2;
#endif
        for (int r = 0; r < rep; ++r) hipLaunchKernelGGL(fwd_kernel, dim3(grid), dim3(NWAVES * 64), LDS_BYTES, stream, a); }
#else
    a.s_lo = 0; a.s_hi = NSTEPS;
    hipLaunchKernelGGL(fwd_kernel, dim3(grid), dim3(NWAVES * 64), LDS_BYTES, stream, a);
#endif
    const hipError_t le = hipPeekAtLastError();
    if (le != hipSuccess) fprintf(stderr, "kernel_launch: launch failed: %s\n", hipGetErrorName(le));
}
```

```cpp
#include <hip/hip_runtime.h>
#include <cstdio>
#include <cstdint>

#define LAS __attribute__((address_space(3)))
#define GAS __attribute__((address_space(1)))
typedef unsigned short bf16;
typedef short bf16x8 __attribute__((ext_vector_type(8)));
typedef short s16x4 __attribute__((ext_vector_type(4)));
typedef float f32x4 __attribute__((ext_vector_type(4)));
typedef float f32x2 __attribute__((ext_vector_type(2)));
typedef float f32x16 __attribute__((ext_vector_type(16)));
typedef unsigned u32x4 __attribute__((ext_vector_type(4)));
typedef unsigned u32x2 __attribute__((ext_vector_type(2)));

constexpr int D = 1024, NB = 16, SEQ = 2048, NCTX = 256, DEPTH = 4;
constexpr int RL = NB * SEQ;
constexpr int RC = NB * NCTX;
constexpr int RT = RL + RC;
constexpr int NIN = 2304;
constexpr int ZW = 2048;
constexpr int ZQ_RQ = 0, ZQ_RK = 128, ZQ_RV = 256, ZQ_RG = 512, ZQ_SU = 768, ZQ_DQ = 1024, ZQ_DK = 1280, ZQ_DV = 1536, ZQ_CV = 1792;
constexpr int FFD = 2816, FFE = 3584, NE = 8;
constexpr int MOE_ROWS = 2 * RT + NE * 256;
constexpr int NCH = 18;
constexpr float EPS = 1e-6f;

__device__ __forceinline__ unsigned f2bf(float f) { unsigned u = __builtin_bit_cast(unsigned, f); return (u + 0x7fffu + ((u >> 16) & 1u)) >> 16; }
__device__ __forceinline__ unsigned pk2(float lo, float hi) { return f2bf(lo) | (f2bf(hi) << 16); }
__device__ __forceinline__ float bf2f(unsigned short b) { return __builtin_bit_cast(float, ((unsigned)b) << 16); }
__device__ __forceinline__ float bflo(unsigned w) { return __builtin_bit_cast(float, w << 16); }
__device__ __forceinline__ float bfhi(unsigned w) { return __builtin_bit_cast(float, w & 0xffff0000u); }
__device__ __forceinline__ unsigned cvt_pk_bf16(float lo, float hi) { unsigned r; asm volatile("v_cvt_pk_bf16_f32 %0, %1, %2" : "=v"(r) : "v"(lo), "v"(hi)); return r; }
__device__ __forceinline__ float sigmoidf_(float x) { return __builtin_amdgcn_rcpf(1.0f + __builtin_amdgcn_exp2f(-1.44269504f * x)); }
__device__ __forceinline__ float siluf_(float x) { return x * sigmoidf_(x); }
__device__ __forceinline__ float wave_sum(float v) {
#pragma unroll
    for (int o = 1; o < 64; o <<= 1) v += __shfl_xor(v, o);
    return v;
}
__device__ __forceinline__ float opaque_f(float x) { asm volatile("" : "+v"(x)); return x; }
__device__ __forceinline__ float sigk(float x, float k) { return __builtin_amdgcn_rcpf(1.0f + __builtin_amdgcn_exp2f(k * x)); }
__device__ __forceinline__ float silk(float x, float k) { return x * sigk(x, k); }
__device__ __forceinline__ int opaque_v(int x) { asm volatile("" : "+v"(x)); return x; }
__device__ __forceinline__ int opaque_s(int x) { asm volatile("" : "+s"(x)); return x; }
#define LDS_WAIT() asm volatile("s_waitcnt lgkmcnt(0)" ::: "memory")
#define VM_WAIT() asm volatile("s_waitcnt vmcnt(0)" ::: "memory")
namespace pg8 {
constexpr int BM = 256, BK = 64, HALF = 128, HTB = HALF * BK * 2  , STAGE_BYTES = 8 * HTB, NXCD = 8, WGM = 8;

__host__ __device__ __forceinline__ int lds_byte(int r, int c) { const int st = (r >> 4) * 2 + (c >> 5), rr = r & 15, cc = c & 31, ob = rr * 64 + cc * 2; return st * 1024 + (ob ^ (((ob >> 9) & 1) << 5)); }
__host__ __device__ __forceinline__ void stage_rc(int b, int& R, int& C) { const int st = b / 1024, sb = b % 1024, swz = sb ^ (((sb >> 9) & 1) << 5); R = (st >> 1) * 16 + swz / 64; C = (st & 1) * 32 + (swz % 64) / 2; }
__host__ __device__ __forceinline__ int perm32(int rho) { const int n = rho >> 4, i = rho & 15; return 8 * (i >> 2) + 4 * n + (i & 3); }

struct Unit { int pm, pn, am, bn, z; };
struct Gemm { const void* A; const void* Bt; int K; int sa, sb; };
typedef int v8i_t __attribute__((ext_vector_type(8))); typedef int v4i_t __attribute__((ext_vector_type(4)));

__device__ __forceinline__ void decode_tile(int wgid, int nM, int nN, int& pm, int& pn) {
    const int nwg = nM * nN;
    { const int q = nwg / NXCD, r = nwg % NXCD, xcd = wgid % NXCD, off = wgid / NXCD; wgid = (xcd < r ? xcd * (q + 1) : r * (q + 1) + (xcd - r) * q) + off; }
    const int nig = WGM * nN, gid = wgid / nig, fm = gid * WGM, gsz = (nM - fm) < WGM ? (nM - fm) : WGM;
    pm = fm + ((wgid % nig) % gsz); pn = (wgid % nig) / gsz;
}
struct SchedStd {
    int nM, nN, G, c;
    __device__ __forceinline__ void init(int nM_, int nN_, int G_, int c_) { nM = nM_; nN = nN_; G = G_; c = c_; }
    __device__ __forceinline__ bool next(int i, Unit& u) const {
        const long L = (long)i * G + c; if (L >= (long)nM * nN) return false;
        decode_tile((int)L, nM, nN, u.pm, u.pn); u.am = u.pm; u.bn = u.pn; u.z = 0; return true;
    }
};
struct SchedWin {
    int G, c, mode;
    __device__ __forceinline__ void init(int G_, int c_, int mode_) { G = G_; c = c_; mode = mode_; }
    __device__ __forceinline__ bool next(int i, Unit& u) const {
        const int L = i * G + c; u.z = 0;
        if (mode == 1) { if (L >= 16) return false; u.pm = 128 + L; u.pn = 8; }
        else if (L < 1152) decode_tile(L, 128, 9, u.pm, u.pn);
        else if (mode == 0) { if (L >= 1280) return false; decode_tile(L - 1152, 16, 8, u.pm, u.pn); u.pm += 128; }
        else { if (L >= 1232) return false; int q; decode_tile(L - 1152, 16, 5, u.pm, q); u.pm += 128; u.pn = q < 2 ? q : (q == 2 ? 3 : q + 2); }
        u.am = u.pm; u.bn = u.pn; return true;
    }
};
struct SchedBr {
    int nM, G, c;
    __device__ __forceinline__ void init(int nM_, int G_, int c_) { nM = nM_; G = G_; c = c_; }
    __device__ __forceinline__ bool next(int i, Unit& u) const {
        const long L = (long)i * G + c; if (L >= (long)nM * 20) return false;
        int pm, pa; decode_tile((int)L, nM, 20, pm, pa);
        const int z = pa < 4 ? 0 : (pa < 12 ? 1 : (pa < 16 ? 2 : 3)), st = z == 0 ? 0 : (z == 1 ? 4 : (z == 2 ? 12 : 16));
        u.pm = pm; u.pn = pa - st; u.am = z * (RT / 256) + pm; u.bn = pa; u.z = z; return true;
    }
};
struct SchedGate {
    int nM, G, c;
    __device__ __forceinline__ void init(int nM_, int G_, int c_) { nM = nM_; G = G_; c = c_; }
    __device__ __forceinline__ bool next(int i, Unit& u) const {
        const long L = (long)(i >> 2) * G + c; if (L >= (long)nM * 4) return false;
        decode_tile((int)L, nM, 4, u.pm, u.pn); u.z = i & 3; u.am = u.pm; u.bn = u.z * 4 + u.pn; return true;
    }
};
struct SchedMoe {
    int nM, nN, G, c; const int* tile_e;
    __device__ __forceinline__ void init(int nM_, int nN_, int G_, int c_, const int* te) { nM = nM_; nN = nN_; G = G_; c = c_; tile_e = te; }
    __device__ __forceinline__ bool next(int i, Unit& u) const {
        const long L = (long)i * G + c; if (L >= (long)nM * nN) return false;
        decode_tile((int)L, nM, nN, u.pm, u.pn); u.am = u.pm; u.z = 0;
        const int e = __builtin_amdgcn_readfirstlane(__hip_atomic_load(tile_e + u.pm, __ATOMIC_RELAXED, __HIP_MEMORY_SCOPE_AGENT));
        u.bn = e * nN + u.pn; return true;
    }
};

#define EPI_ROWS(...) _Pragma("unroll") for (int ai = 0; ai < 2; ++ai) _Pragma("unroll") for (int m = 0; m < 4; ++m) { const int row = u.pm * BM + wr * 64 + fr + ai * HALF + m * 16; _Pragma("unroll") for (int bj = 0; bj < 2; ++bj) { const f32x4 v0 = acc[ai][bj][m][0], v1 = acc[ai][bj][m][1]; const int cb = 128 * bj + 32 * wc + 8 * fq; __VA_ARGS__ } }
typedef GAS u32x4* gq4; typedef GAS u32x2* gq2; typedef const GAS u32x4* cgq4; typedef const GAS f32x4* cgf4;

struct EpiF32 {
    static constexpr bool PERM = false;
    float* C; int ldc;
    __device__ __forceinline__ void operator()(const f32x4 (&acc)[2][2][4][2], const Unit& u, int wr, int wc, int fr, int fq) const {
        const int row0 = u.pm * BM + wr * 64 + fr, col0 = u.pn * BM + wc * 32 + 4 * fq;
#pragma unroll
        for (int ai = 0; ai < 2; ++ai)
#pragma unroll
            for (int m = 0; m < 4; ++m) { GAS float* rowp = (GAS float*)C + (size_t)(row0 + ai * HALF + m * 16) * ldc + col0;
#pragma unroll
                for (int bj = 0; bj < 2; ++bj)
#pragma unroll
                    for (int n = 0; n < 2; ++n) *(GAS f32x4*)(rowp + bj * HALF + n * 16) = acc[ai][bj][m][n]; }
    }
};
struct EpiBf16 {
    static constexpr bool PERM = true;
    bf16* O; int ldc;
    __device__ __forceinline__ void operator()(const f32x4 (&acc)[2][2][4][2], const Unit& u, int wr, int wc, int fr, int fq) const {
        EPI_ROWS({ u32x4 w; w.x = cvt_pk_bf16(v0[0], v0[1]); w.y = cvt_pk_bf16(v0[2], v0[3]); w.z = cvt_pk_bf16(v1[0], v1[1]); w.w = cvt_pk_bf16(v1[2], v1[3]);
                   *(gq4)((GAS bf16*)O + (size_t)row * ldc + u.pn * BM + cb) = w; })
    }
};
struct EpiSwiGLU {
    static constexpr bool PERM = true;
    bf16* O; int ldc;
    __device__ __forceinline__ void operator()(const f32x4 (&acc)[2][2][4][2], const Unit& u, int wr, int wc, int fr, int fq) const {
        const float kq = opaque_f(-1.44269504f);
        EPI_ROWS({ u32x2 w; w.x = cvt_pk_bf16(silk(v0[0], kq) * v0[1], silk(v0[2], kq) * v0[3]); w.y = cvt_pk_bf16(silk(v1[0], kq) * v1[1], silk(v1[2], kq) * v1[3]);
                   *(gq2)((GAS bf16*)O + (size_t)row * ldc + ((u.pn * BM + cb) >> 1)) = w; })
    }
};
struct EpiSwiGLU8 {
    static constexpr bool PERM = true;
    unsigned char* O; int ldc;
    __device__ __forceinline__ void operator()(const f32x4 (&acc)[2][2][4][2], const Unit& u, int wr, int wc, int fr, int fq) const {
        const float one = opaque_f(1.0f);
#define SG8(x, y) ((x) * __builtin_amdgcn_rcpf(one + __builtin_amdgcn_exp2f(x)) * (y))
        EPI_ROWS({ unsigned w = 0; w = __builtin_amdgcn_cvt_pk_fp8_f32(SG8(v0[0], v0[1]), SG8(v0[2], v0[3]), w, false); w = __builtin_amdgcn_cvt_pk_fp8_f32(SG8(v1[0], v1[1]), SG8(v1[2], v1[3]), w, true);
                   *(GAS unsigned*)((GAS unsigned char*)O + (size_t)row * ldc + ((u.pn * BM + cb) >> 1)) = w; })
#undef SG8
    }
};
struct EpiWin {
    static constexpr bool PERM = true;
    bf16* Z; const float* rope;
    __device__ __forceinline__ void operator()(const f32x4 (&acc)[2][2][4][2], const Unit& u, int wr, int wc, int fr, int fq) const {
        const float kq = opaque_f(-1.44269504f);
        GAS bf16* Zg = (GAS bf16*)Z;
        if (u.pn >= 7) {
            EPI_ROWS({ u32x2 w; w.x = cvt_pk_bf16(v0[0] * sigk(v0[1], kq), v0[2] * sigk(v0[3], kq)); w.y = cvt_pk_bf16(v1[0] * sigk(v1[1], kq), v1[2] * sigk(v1[3], kq));
                       *(gq2)(Zg + (size_t)row * ZW + ZQ_CV + (u.pn - 7) * 128 + (cb >> 1)) = w; })
        } else if ((u.pn == 4 || u.pn == 5) && u.pm < RL / 256) {
#pragma unroll
            for (int ai = 0; ai < 2; ++ai) {
                f32x4 c0[4], c1[4];
#pragma unroll
                for (int m = 0; m < 4; ++m) { const int row = u.pm * BM + wr * 64 + fr + ai * HALF + m * 16; cgf4 rp = (cgf4)((const GAS float*)rope + (size_t)(row & (SEQ - 1)) * 32 + fq * 8); c0[m] = rp[0]; c1[m] = rp[1]; }
#pragma unroll
                for (int m = 0; m < 4; ++m) { const int row = u.pm * BM + wr * 64 + fr + ai * HALF + m * 16;
#pragma unroll
                    for (int bj = 0; bj < 2; ++bj) { const f32x4 v0 = acc[ai][bj][m][0], v1 = acc[ai][bj][m][1]; const int cb = 128 * bj + 32 * wc + 8 * fq; const f32x4 a = c0[m], b = c1[m];
                        u32x4 w; w.x = cvt_pk_bf16(v0[0] * a[0] - v0[1] * a[1], v0[1] * a[0] + v0[0] * a[1]); w.y = cvt_pk_bf16(v0[2] * a[2] - v0[3] * a[3], v0[3] * a[2] + v0[2] * a[3]);
                        w.z = cvt_pk_bf16(v1[0] * b[0] - v1[1] * b[1], v1[1] * b[0] + v1[0] * b[1]); w.w = cvt_pk_bf16(v1[2] * b[2] - v1[3] * b[3], v1[3] * b[2] + v1[2] * b[3]);
                        *(gq4)(Zg + (size_t)row * ZW + u.pn * BM + cb) = w; } }
            }
        } else {
            EPI_ROWS({ u32x4 w; w.x = cvt_pk_bf16(v0[0], v0[1]); w.y = cvt_pk_bf16(v0[2], v0[3]); w.z = cvt_pk_bf16(v1[0], v1[1]); w.w = cvt_pk_bf16(v1[2], v1[3]);
                       *(gq4)(Zg + (size_t)row * ZW + u.pn * BM + cb) = w; })
        }
    }
};
struct EpiBr {
    static constexpr bool PERM = true;
    bf16* BO;
    __device__ __forceinline__ void operator()(const f32x4 (&acc)[2][2][4][2], const Unit& u, int wr, int wc, int fr, int fq) const {
        const float kq = opaque_f(-1.44269504f);
        GAS unsigned char* base = (GAS unsigned char*)((GAS bf16*)BO + (size_t)u.z * RT * D) + (size_t)u.pm * (128 * 256 * 16) + (size_t)((wr * 64 + fr) * 16);
        if (u.z == 1) {
            GAS unsigned char* lp = base + (size_t)(16 * u.pn + 2 * wc + (fq >> 1)) * 4096 + (fq & 1) * 8;
#pragma unroll
            for (int ai = 0; ai < 2; ++ai)
#pragma unroll
                for (int m = 0; m < 4; ++m)
#pragma unroll
                    for (int bj = 0; bj < 2; ++bj) { const f32x4 v0 = acc[ai][bj][m][0], v1 = acc[ai][bj][m][1];
                        u32x2 w; w.x = cvt_pk_bf16(v0[0] * sigk(v0[1], kq), v0[2] * sigk(v0[3], kq)); w.y = cvt_pk_bf16(v1[0] * sigk(v1[1], kq), v1[2] * sigk(v1[3], kq));
                        __builtin_nontemporal_store(w, (gq2)(lp + bj * (8 * 4096) + (ai * 128 + m * 16) * 16)); }
        } else {
            GAS unsigned char* lp = base + (size_t)(32 * u.pn + 4 * wc + fq) * 4096;
#pragma unroll
            for (int ai = 0; ai < 2; ++ai)
#pragma unroll
                for (int m = 0; m < 4; ++m)
#pragma unroll
                    for (int bj = 0; bj < 2; ++bj) { const f32x4 v0 = acc[ai][bj][m][0], v1 = acc[ai][bj][m][1];
                        u32x4 w; w.x = cvt_pk_bf16(v0[0], v0[1]); w.y = cvt_pk_bf16(v0[2], v0[3]); w.z = cvt_pk_bf16(v1[0], v1[1]); w.w = cvt_pk_bf16(v1[2], v1[3]);
                        __builtin_nontemporal_store(w, (gq4)(lp + bj * (16 * 4096) + (ai * 128 + m * 16) * 16)); }
        }
    }
};
struct EpiGate {
    static constexpr bool PERM = true;
    const bf16* BO; bf16* MM; const float* bgate; LAS unsigned char* xl;
    __device__ __forceinline__ void operator()(const f32x4 (&acc)[2][2][4][2], const Unit& u, int wr, int wc, int fr, int fq) const {
#define SG2(x) __builtin_amdgcn_rcpf(one_ + __builtin_amdgcn_exp2f(x))
        const float kq = opaque_f(-1.44269504f), one_ = opaque_f(1.0f); fr = opaque_v(fr); fq = opaque_v(fq);
        const int oc = u.pn * 64 + 32 * (wc & 1) + 8 * fq, zlo = wc >> 1, lane = fr + 16 * fq;
        const GAS unsigned char* bo0 = (const GAS unsigned char*)((const GAS bf16*)BO + (size_t)zlo * RT * D) + ((size_t)u.pm * 128 + (oc >> 3)) * (256 * 16); const GAS unsigned char* bo1 = bo0 + (size_t)2 * RT * D * 2; GAS bf16* mm = (GAS bf16*)MM + oc;
        f32x4 bs[2][2];
#pragma unroll
        for (int bj = 0; bj < 2; ++bj) { const GAS float* bg = (const GAS float*)bgate + (2 * bj + zlo) * D + oc; bs[bj][0] = *(cgf4)bg * kq; bs[bj][1] = *(cgf4)(bg + 4) * kq; }
        LAS u32x4* xs = (LAS u32x4*)xl + ((wr * 2 + (wc & 1)) * 4) * 64 + lane;
#pragma unroll
        for (int ai = 0; ai < 2; ++ai) {
            u32x4 bw[4][2];
#pragma unroll
            for (int m = 0; m < 4; ++m) { const size_t ro = (size_t)(wr * 64 + fr + ai * HALF + m * 16) * 16; bw[m][0] = *(cgq4)(bo0 + ro); bw[m][1] = *(cgq4)(bo1 + ro); }
            float r[4][8];
#pragma unroll
            for (int m = 0; m < 4; ++m) {
#pragma unroll
                for (int j = 0; j < 8; ++j) r[m][j] = 0.f;
#pragma unroll
                for (int bj = 0; bj < 2; ++bj) { const f32x4 v0 = acc[ai][bj][m][0] + bs[bj][0], v1 = acc[ai][bj][m][1] + bs[bj][1]; const u32x4 b = bw[m][bj];
                    r[m][0] += SG2(v0[0]) * bflo(b.x); r[m][1] += SG2(v0[1]) * bfhi(b.x); r[m][2] += SG2(v0[2]) * bflo(b.y); r[m][3] += SG2(v0[3]) * bfhi(b.y);
                    r[m][4] += SG2(v1[0]) * bflo(b.z); r[m][5] += SG2(v1[1]) * bfhi(b.z); r[m][6] += SG2(v1[2]) * bflo(b.w); r[m][7] += SG2(v1[3]) * bfhi(b.w); }
            }
            if (wc >= 2) {
#pragma unroll
                for (int m = 0; m < 4; ++m) { u32x4 w; w.x = cvt_pk_bf16(r[m][0], r[m][1]); w.y = cvt_pk_bf16(r[m][2], r[m][3]); w.z = cvt_pk_bf16(r[m][4], r[m][5]); w.w = cvt_pk_bf16(r[m][6], r[m][7]); xs[m * 64] = w; }
            }
            asm volatile("s_waitcnt lgkmcnt(0)" ::: "memory"); __builtin_amdgcn_s_barrier(); asm volatile("" ::: "memory");
            if (wc < 2) {
#pragma unroll
                for (int m = 0; m < 4; ++m) { const u32x4 q = xs[m * 64]; const size_t ro = (size_t)(u.pm * BM + wr * 64 + fr + ai * HALF + m * 16) * D;
                    u32x4 w; w.x = cvt_pk_bf16(r[m][0] + bflo(q.x), r[m][1] + bfhi(q.x)); w.y = cvt_pk_bf16(r[m][2] + bflo(q.y), r[m][3] + bfhi(q.y));
                    w.z = cvt_pk_bf16(r[m][4] + bflo(q.z), r[m][5] + bfhi(q.z)); w.w = cvt_pk_bf16(r[m][6] + bflo(q.w), r[m][7] + bfhi(q.w));
                    *(gq4)(mm + ro) = w; }
            }
            if (ai == 0) { asm volatile("s_waitcnt lgkmcnt(0)" ::: "memory"); __builtin_amdgcn_s_barrier(); asm volatile("" ::: "memory"); }
        }
    }
};

#undef SG2
template <class Epi, class Sched, bool F8 = false>
__device__ __forceinline__ void gemm_phase(LAS unsigned char* lds, const Gemm g, const Sched& S, const Epi& E, int tid_in) {
    const int tid = opaque_v(tid_in), wid = __builtin_amdgcn_readfirstlane(tid >> 6), lane = tid & 63, wr = wid >> 2, wc = wid & 3, fr = lane & 15, fq = lane >> 4;
    const int K = opaque_s(g.K), rowb = F8 ? K : 2 * K, nt = rowb / 128;
    unsigned voffA[2], voffB[2];
#pragma unroll
    for (int i = 0; i < 2; ++i) { int R, C; stage_rc(tid * 16 + i * 8192, R, C); const int Rb = Epi::PERM ? ((R & ~31) + perm32(R & 31)) : R;
        voffA[i] = (unsigned)(R * rowb + C * 2); voffB[i] = (unsigned)(Rb * rowb + C * 2); }
    const size_t kstep = (size_t)(BK * 2);
    const size_t hstep = (size_t)HALF * rowb;
    const size_t tstep = 2 * hstep;
    const unsigned ldsw = (unsigned)wid * 1024u;
    const int aoff = lds_byte(wr * 64 + fr, fq * 8), boff = lds_byte(wc * 32 + fr, fq * 8);
#define PG8_SA(b, h) (((b) * 2 + (h)) * HTB)
#define PG8_SB(b, h) ((4 + (b) * 2 + (h)) * HTB)
#define PG8_STAGE(bufoff, gbase, voff) do { _Pragma("unroll") for (int _i = 0; _i < 2; ++_i) \
        __builtin_amdgcn_global_load_lds((const unsigned*)((const char*)(gbase) + (voff)[_i]), (LAS unsigned*)(lds + (bufoff) + ldsw + _i * 8192), 16, 0, 0); } while (0)
#define PG8_LD1(off) (*(const LAS v4i_t*)(lds + (off)))
#define PG8_LDA(dst, b, h) do { if constexpr (F8) { _Pragma("unroll") for (int m = 0; m < 4; ++m) dst##8[m] = __builtin_shufflevector(PG8_LD1(PG8_SA(b, h) + aoff + m * 2048), PG8_LD1(PG8_SA(b, h) + aoff + m * 2048 + 1024), 0, 1, 2, 3, 4, 5, 6, 7); } \
        else { _Pragma("unroll") for (int m = 0; m < 4; ++m) _Pragma("unroll") for (int k = 0; k < 2; ++k) dst[m][k] = *(const LAS bf16x8*)(lds + PG8_SA(b, h) + aoff + m * 2048 + k * 1024); } } while (0)
#define PG8_LDB(dst, b, h) do { if constexpr (F8) { _Pragma("unroll") for (int n = 0; n < 2; ++n) dst##8[n] = __builtin_shufflevector(PG8_LD1(PG8_SB(b, h) + boff + n * 2048), PG8_LD1(PG8_SB(b, h) + boff + n * 2048 + 1024), 0, 1, 2, 3, 4, 5, 6, 7); } \
        else { _Pragma("unroll") for (int n = 0; n < 2; ++n) _Pragma("unroll") for (int k = 0; k < 2; ++k) dst[n][k] = *(const LAS bf16x8*)(lds + PG8_SB(b, h) + boff + n * 2048 + k * 1024); } } while (0)
#define PG8_MMA1(ai, bj, At, Bt) do { _Pragma("unroll") for (int m = 0; m < 4; ++m) _Pragma("unroll") for (int n = 0; n < 2; ++n) { \
        if constexpr (F8) { asm volatile("v_mfma_scale_f32_16x16x128_f8f6f4 %0, %1, %2, %0, %3, %4 op_sel_hi:[0,0,0]" : "+v"(acc[ai][bj][m][n]) : "v"(Bt##8[n]), "v"(At##8[m]), "v"(sclB), "v"(sclA)); } \
        else { _Pragma("unroll") for (int k = 0; k < 2; ++k) acc[ai][bj][m][n] = __builtin_amdgcn_mfma_f32_16x16x32_bf16(Bt[n][k], At[m][k], acc[ai][bj][m][n], 0, 0, 0); } } } while (0)
#define PG8_MMA0(ai, bj, At, Bt) do { _Pragma("unroll") for (int m = 0; m < 4; ++m) _Pragma("unroll") for (int n = 0; n < 2; ++n) { \
        if constexpr (F8) { asm volatile("v_mfma_scale_f32_16x16x128_f8f6f4 %0, %1, %2, 0, %3, %4 op_sel_hi:[0,0,0]" : "+v"(acc[ai][bj][m][n]) : "v"(Bt##8[n]), "v"(At##8[m]), "v"(sclB), "v"(sclA)); } \
        else { acc[ai][bj][m][n] = __builtin_amdgcn_mfma_f32_16x16x32_bf16(Bt[n][0], At[m][0], (f32x4){0.f, 0.f, 0.f, 0.f}, 0, 0, 0); \
               acc[ai][bj][m][n] = __builtin_amdgcn_mfma_f32_16x16x32_bf16(Bt[n][1], At[m][1], acc[ai][bj][m][n], 0, 0, 0); } } } while (0)
#define PG8_MMA(ai, bj, At, Bt) do { __builtin_amdgcn_s_setprio(1); PG8_MMA1(ai, bj, At, Bt); __builtin_amdgcn_s_setprio(0); } while (0)
#define PG8_MMAF(ai, At) do { __builtin_amdgcn_s_setprio(1); if (F8 && first) { PG8_MMA0(ai, 0, At, B0); PG8_MMA0(ai, 1, At, B1); } else { PG8_MMA1(ai, 0, At, B0); PG8_MMA1(ai, 1, At, B1); } __builtin_amdgcn_s_setprio(0); } while (0)
#define PG8_WAIT_V(n) asm volatile("s_waitcnt vmcnt(" #n ")" ::: "memory")
#define PG8_WAIT_L(n) asm volatile("s_waitcnt lgkmcnt(" #n ")" ::: "memory")
#define PG8_BAR __builtin_amdgcn_s_barrier()
#define PG8_SCHED __builtin_amdgcn_sched_barrier(0)
    const int sclB = g.sa * 0x01010101, sclA = g.sb * 0x01010101;
    Unit cur, nxt; int ui = 0;
    if (!S.next(0, cur)) return;
#ifndef GEMM_STAGGER
#define GEMM_STAGGER 0
#endif
    if (GEMM_STAGGER) {
        const unsigned long long t0 = __builtin_amdgcn_s_memrealtime(); const unsigned long long dl = (unsigned long long)(((blockIdx.x >> 3) & 3) * ((K >> 6) * 29 + 350));
        while (__builtin_amdgcn_s_memrealtime() - t0 < dl) __builtin_amdgcn_s_sleep(16);
    }
    f32x4 acc[2][2][4][2];
#pragma unroll
    for (int a = 0; a < 2; ++a)
#pragma unroll
        for (int b = 0; b < 2; ++b)
#pragma unroll
            for (int m = 0; m < 4; ++m)
#pragma unroll
                for (int n = 0; n < 2; ++n) acc[a][b][m][n] = (f32x4){0.f, 0.f, 0.f, 0.f};
    bf16x8 At[4][2], B0[2][2], B1[2][2]; v8i_t At8[4], B08[2], B18[2];
    const char* cA = (const char*)g.A + (size_t)cur.am * tstep; const char* cB = (const char*)g.Bt + (size_t)cur.bn * tstep;
    PG8_STAGE(PG8_SB(0, 0), cB, voffB); PG8_STAGE(PG8_SB(0, 1), cB + hstep, voffB); PG8_STAGE(PG8_SA(0, 0), cA, voffA); PG8_STAGE(PG8_SA(0, 1), cA + hstep, voffA);
    if (wr == 1) PG8_BAR;
    PG8_WAIT_V(2); PG8_BAR;
    PG8_STAGE(PG8_SB(1, 0), cB + kstep, voffB); PG8_STAGE(PG8_SA(1, 0), cA + kstep, voffA); PG8_STAGE(PG8_SB(1, 1), cB + hstep + kstep, voffB);
    PG8_WAIT_V(6); PG8_BAR;
    for (;;) {
        const bool has_next = S.next(ui + 1, nxt);
        const char* nA = has_next ? (const char*)g.A + (size_t)nxt.am * tstep : cA; const char* nB = has_next ? (const char*)g.Bt + (size_t)nxt.bn * tstep : cB;
        for (int t = 0; t < nt; t += 2) {
            const bool last = (t == nt - 2), first = (t == 0);
            const char* a1 = cA + (size_t)(t + 1) * kstep;
            const char* a2 = last ? nA : cA + (size_t)(t + 2) * kstep; const char* b2 = last ? nB : cB + (size_t)(t + 2) * kstep;
            const char* a3 = a2 + kstep; const char* b3 = b2 + kstep;
            PG8_LDB(B0, 0, 0); PG8_LDB(B1, 0, 1); PG8_SCHED; PG8_LDA(At, 0, 0); PG8_STAGE(PG8_SA(1, 1), a1 + hstep, voffA);
            PG8_WAIT_V(8); PG8_WAIT_L(0); PG8_BAR; PG8_MMAF(0, At); PG8_BAR; PG8_SCHED;
            PG8_LDA(At, 0, 1); PG8_STAGE(PG8_SB(0, 0), b2, voffB); PG8_STAGE(PG8_SB(0, 1), b2 + hstep, voffB); PG8_STAGE(PG8_SA(0, 0), a2, voffA);
            PG8_WAIT_V(8); PG8_WAIT_L(0); PG8_BAR; PG8_MMAF(1, At); PG8_BAR; PG8_SCHED;
            PG8_LDB(B0, 1, 0); PG8_LDB(B1, 1, 1); PG8_SCHED; PG8_LDA(At, 1, 0); PG8_STAGE(PG8_SA(0, 1), a2 + hstep, voffA);
            PG8_WAIT_V(8); PG8_WAIT_L(0); PG8_BAR; PG8_MMA(0, 0, At, B0); PG8_MMA(0, 1, At, B1); PG8_BAR; PG8_SCHED;
            PG8_LDA(At, 1, 1); PG8_STAGE(PG8_SB(1, 0), b3, voffB); PG8_STAGE(PG8_SB(1, 1), b3 + hstep, voffB); PG8_STAGE(PG8_SA(1, 0), a3, voffA);
            PG8_WAIT_V(8); PG8_WAIT_L(0); PG8_BAR; PG8_MMA(1, 0, At, B0); PG8_MMA(1, 1, At, B1); PG8_BAR; PG8_SCHED;
        }
        if (wr == 0) PG8_BAR;
        if constexpr (F8) asm volatile("s_nop 15\n\ts_nop 15" ::: "memory");
        E(acc, cur, wr, wc, fr, fq);
        if (!has_next) break;
        if constexpr (!F8) {
#pragma unroll
            for (int a = 0; a < 2; ++a)
#pragma unroll
                for (int b = 0; b < 2; ++b)
#pragma unroll
                    for (int m = 0; m < 4; ++m)
#pragma unroll
                        for (int n = 0; n < 2; ++n) acc[a][b][m][n] = (f32x4){0.f, 0.f, 0.f, 0.f};
        }
        cur = nxt; cA = nA; cB = nB; ++ui;
        if (wr == 1) PG8_BAR;
    }
    PG8_WAIT_V(0);
    PG8_BAR;
#undef PG8_SA
#undef PG8_SB
#undef PG8_STAGE
#undef PG8_LD1
#undef PG8_LDA
#undef PG8_LDB
#undef PG8_MMA
#undef PG8_MMA0
#undef PG8_MMA1
#undef PG8_MMAF
#undef PG8_WAIT_V
#undef PG8_WAIT_L
#undef PG8_BAR
#undef PG8_SCHED
}
}
constexpr size_t al256(size_t x) { return (x + 255) & ~(size_t)255; }
constexpr size_t WS_CTL = 0, CTL_ZERO_BYTES = 1u << 20;
constexpr size_t E_WIN = (size_t)NIN * D, E_WG = (size_t)4 * D * D, E_WBR = (size_t)5120 * 256, E_WOUT = (size_t)D * D;
constexpr size_t E_WGU = (size_t)2 * FFD * D, E_WD = (size_t)D * FFD, E_MGU = (size_t)2 * FFE * D, E_MWD = (size_t)D * FFE;
constexpr size_t WS_WIN = CTL_ZERO_BYTES;
constexpr size_t WS_WG = WS_WIN + 2 * DEPTH * E_WIN;
constexpr size_t WS_WBR = WS_WG + 2 * DEPTH * E_WG;
constexpr size_t WS_WOUT = WS_WBR + 2 * DEPTH * E_WBR;
constexpr size_t WS_WGU = WS_WOUT + 2 * DEPTH * E_WOUT;
constexpr size_t WS_WD = WS_WGU + 2 * 2 * E_WGU;
constexpr size_t WS_MGU = WS_WD + 2 * 2 * E_WD;
constexpr size_t WS_MWD = WS_MGU + 2 * 2 * NE * E_MGU;
constexpr size_t WS_WEND = WS_MWD + 2 * 2 * NE * E_MWD;
constexpr size_t WS_MODS = al256(WS_WEND);
constexpr size_t WS_ROPE = WS_MODS + al256((size_t)DEPTH * 17 * 6 * D * 4);
constexpr size_t S5P_ABAR = 0, S5P_A128 = 16384, S5P_BP = 32768, S5P_CH = S5P_BP + 2 * 16 * 128 * 16 * 2, S5P_BYTES = S5P_CH + 16 * 16 * 128 * 2;
constexpr size_t WS_S5P = WS_ROPE + (size_t)SEQ * 32 * 4;
constexpr size_t WS_LAYP = WS_S5P + DEPTH * S5P_BYTES;
constexpr size_t WS_RETSUM = al256(WS_LAYP + DEPTH * 64 * 4);
constexpr size_t WS_RETST = WS_RETSUM + (size_t)NB * NCH * 2 * 4 * 2048 * 4;
constexpr size_t WS_S5E = WS_RETST + (size_t)NB * NCH * 2 * 4 * 2048 * 2;
constexpr size_t WS_S5C = WS_S5E + (size_t)NB * NCH * 16 * 2 * 64 * 8;
constexpr size_t WS_REC = WS_S5C + (size_t)NB * NCH * 16 * 2 * 64 * 8;
constexpr size_t WS_HIST = WS_REC + (size_t)RT * 32;
constexpr size_t WS_TILEE = WS_HIST + 256 * 8 * 4;
constexpr size_t WS_H = al256(WS_TILEE + 512 * 4);
constexpr size_t WS_AF = WS_H + (size_t)RT * D * 4;
constexpr size_t WS_AF8 = WS_AF + (size_t)RT * D * 2;
constexpr size_t WS_RA = WS_AF8 + (size_t)RT * D;
constexpr size_t WS_Z = WS_RA;
constexpr size_t WS_XB = WS_Z + (size_t)RT * ZW * 2;
constexpr size_t WS_BO = WS_XB + (size_t)4 * RT * 256 * 2;
constexpr size_t WS_MM = WS_BO + (size_t)4 * RT * D * 2;
constexpr size_t WS_Y = WS_MM + (size_t)RT * D * 2;
constexpr size_t WS_RA_END = WS_Y + (size_t)RT * D * 4;
constexpr size_t WS_G = WS_RA;
constexpr size_t WS_FS = WS_RA;
constexpr size_t WS_GS = WS_FS + (size_t)MOE_ROWS * D * 2;
constexpr size_t WS_YS = WS_GS + (size_t)MOE_ROWS * FFE * 2;
constexpr size_t WS_RB_END = WS_YS + (size_t)MOE_ROWS * D * 2;
constexpr size_t WS_END = WS_RA_END > WS_RB_END ? WS_RA_END : WS_RB_END;
static_assert(WS_G + (size_t)RT * FFD * 2 <= WS_Y, "dense hidden must not reach Y");
constexpr int CW_DEP = 12288;
constexpr int CW_BAR = 4096;

constexpr int SCRATCH_BYTES = 153600;
constexpr int LDSCTL_OFF = SCRATCH_BYTES, MISC_OFF = LDSCTL_OFF + 320;
constexpr int LDS_BYTES = 155648;
constexpr int NWAVES = 8;

typedef GAS unsigned gu32;
#define RLX_AGENT __ATOMIC_RELAXED, __HIP_MEMORY_SCOPE_AGENT

#define XB_TMO      128
#define XB_XCNT(j)  (256  + 64 * (j))
#define XB_XSUB(j)  (1280 + 64 * (j))
#define XB_XGEN(j)  (2304 + 64 * (j))
#define XB_TOP      3328
#define XB_TOPGEN   3392
#define XCD_BAR_WORDS 3456
#define XB_SPIN_CAP (1u << 20)

__device__ __forceinline__ unsigned xb_ld(unsigned* p)              { return __hip_atomic_load(p, __ATOMIC_RELAXED, __HIP_MEMORY_SCOPE_AGENT); }
__device__ __forceinline__ unsigned xb_add(unsigned* p, unsigned v) { return __hip_atomic_fetch_add(p, v, __ATOMIC_RELAXED, __HIP_MEMORY_SCOPE_AGENT); }
__device__ __forceinline__ unsigned xb_xcc_id() { return (unsigned)__builtin_amdgcn_s_getreg((3 << 11) | 20) & 0xFu; }
#define XB_SPIN(cond, bar) do { unsigned _sp = 0; while (cond) { __builtin_amdgcn_s_sleep(1); \
    if ((++_sp & 255u) == 0u) { if (xb_ld(&(bar)[XB_TMO])) break; if (_sp > XB_SPIN_CAP) { atomicAdd(&(bar)[XB_TMO], 1u); break; } } } } while (0)

struct XcdBarrier {
    unsigned* bar; unsigned x;
    volatile LAS unsigned* st;
};
__device__ __forceinline__ XcdBarrier xcd_barrier_post(unsigned* bar, volatile LAS unsigned* st, int tid) {
    XcdBarrier b; b.bar = bar; b.x = xb_xcc_id(); b.st = st;
    if (tid == 0) (void)xb_add(&bar[XB_XCNT(b.x)], 1u);
    return b;
}
__device__ __forceinline__ void xcd_barrier_complete(unsigned* bar, unsigned x, unsigned& nloc, unsigned& nx) {
    const unsigned G = gridDim.x * gridDim.y * gridDim.z;
    unsigned sum, cnt, mine, sp = 0u;
    for (;;) {
        sum = 0u; cnt = 0u; mine = 0u;
#pragma unroll
        for (unsigned j = 0; j < 16; ++j) { const unsigned c = xb_ld(&bar[XB_XCNT(j)]); sum += c; cnt += (c > 0u) ? 1u : 0u; mine = (j == x) ? c : mine; }
        if (sum == G) break;
        __builtin_amdgcn_s_sleep(1);
        if ((++sp & 255u) == 0u) { if (xb_ld(&bar[XB_TMO])) break; if (sp > XB_SPIN_CAP) { atomicAdd(&bar[XB_TMO], 1u); break; } }
    }
    nloc = mine > 0u ? mine : 1u; nx = cnt > 0u ? cnt : 1u;
}
__device__ __forceinline__ void xcd_barrier(const XcdBarrier& b, int tid) {
    asm volatile("s_waitcnt vmcnt(0)" ::: "memory");
    __syncthreads();
    if (tid == 0) {
        unsigned* bar = b.bar;
        __builtin_amdgcn_s_waitcnt(0);
        unsigned nloc = b.st[0], nx = b.st[1];
        if (nloc == 0u) { xcd_barrier_complete(bar, b.x, nloc, nx); b.st[0] = nloc; b.st[1] = nx; }
        const unsigned old = xb_add(&bar[XB_XSUB(b.x)], 1u);
        const unsigned gen = old / nloc;
        if (old + 1u == (gen + 1u) * nloc) {
            __builtin_amdgcn_fence(__ATOMIC_RELEASE, "agent");
            asm volatile("s_waitcnt vmcnt(0)" ::: "memory");
            const unsigned og = xb_add(&bar[XB_TOP], 1u);
            const unsigned tg = og / nx;
            if (og + 1u == (tg + 1u) * nx) xb_add(&bar[XB_TOPGEN], 1u);
            else XB_SPIN(xb_ld(&bar[XB_TOPGEN]) == tg, bar);
            __builtin_amdgcn_fence(__ATOMIC_ACQUIRE, "agent");
            xb_add(&bar[XB_XGEN(b.x)], 1u);
            asm volatile("s_waitcnt vmcnt(0)" ::: "memory");
        } else {
            XB_SPIN(xb_ld(&bar[XB_XGEN(b.x)]) == gen, bar);
            __builtin_amdgcn_fence(__ATOMIC_ACQUIRE, "agent");
            asm volatile("s_waitcnt vmcnt(0)" ::: "memory");
        }
    }
    __syncthreads();
}

struct Frame {
    LAS unsigned char* lds;
    volatile LAS unsigned* MISC;
    int tid, lane, wave;
    int vcu, G;
    unsigned char* ws;
};

__device__ __forceinline__ void dep_signal(Frame& F, unsigned* ctr, unsigned n) {
    asm volatile("s_waitcnt vmcnt(0)" ::: "memory");
    __syncthreads();
    if (F.tid == 0) { __builtin_amdgcn_fence(__ATOMIC_RELEASE, "agent"); asm volatile("s_waitcnt vmcnt(0)" ::: "memory"); (void)xb_add(ctr, n); }
}
__device__ __forceinline__ void dep_wait(Frame& F, unsigned* ctr, unsigned target) {
    if (F.tid == 0) { unsigned sp = 0u; while (xb_ld(ctr) < target) { __builtin_amdgcn_s_sleep(2); if (++sp > (1u << 22)) break; }
        __builtin_amdgcn_fence(__ATOMIC_ACQUIRE, "agent"); asm volatile("s_waitcnt vmcnt(0)" ::: "memory"); }
    __syncthreads();
}
__device__ __forceinline__ int permqk(int c) { const int hm = c >> 5, d = c & 31, axis = d >> 4, half = (d >> 3) & 1, f = d & 7; return hm * 32 + axis * 16 + f * 2 + half; }
__device__ __forceinline__ int win_dest(int n, float& sc) {
    sc = 1.0f;
    if (n < 128) { sc = 0.17677669529663687f; return 128 + n; }
    if (n < 384) return 256 + (n - 128);
    if (n < 640) return 768 + (n - 384);
    if (n < 896) return 1280 + permqk(n - 640);
    if (n < 1152) return 1536 + (n - 896);
    if (n < 1280) return n - 1152;
    if (n < 1536) return 512 + (n - 1280);
    if (n < 1792) { sc = 0.17677669529663687f; return 1024 + permqk(n - 1536); }
    const int j = (n - 1792) & 255, half = (n - 1792) >> 8; return 1792 + 2 * j + half;
}
template <int MODE, bool OUT8 = false>
__device__ __forceinline__ void transpose_item(const float* __restrict__ W, int K, int N, bf16* WT, int row_off, LAS float* scr, int item, int lane) {
    const int nblk = N / 32, kb = item / nblk, nb = item % nblk, k0 = 64 * kb, n0 = 32 * nb;
    float wreg[32];
#pragma unroll
    for (int i = 0; i < 32; ++i) { const int kk = 2 * i + (lane >> 5); wreg[i] = __builtin_nontemporal_load(W + (size_t)(k0 + kk) * N + n0 + (lane & 31)); }
#pragma unroll
    for (int i = 0; i < 32; ++i) { const int kk = 2 * i + (lane >> 5); scr[kk * 33 + (lane & 31)] = wreg[i]; }
    LDS_WAIT(); asm volatile("" ::: "memory");
    const int c = lane & 7;
#pragma unroll
    for (int j = 0; j < 4; ++j) { const int n = (lane >> 3) + 8 * j; const LAS float* s = scr + (8 * c) * 33 + n;
        int dr; float sc = 1.0f; const int ng = n0 + n;
        if (MODE == 0) dr = row_off + ng; else if (MODE == 3) dr = ((ng >> 6) << 8) + row_off + (ng & 63); else if (MODE == 1) { const int Hh = N >> 1; dr = row_off + 2 * (ng % Hh) + ng / Hh; } else dr = win_dest(ng, sc);
        if (OUT8) { unsigned w0 = 0, w1 = 0;
            const float q8 = (MODE == 1) ? ((ng >= (N >> 1)) ? 64.f * (-8.0f / 1.44269504f) : 64.f * -1.44269504f) : (MODE == 3 ? 64.f * -1.44269504f : 64.f);
            w0 = __builtin_amdgcn_cvt_pk_fp8_f32(q8 * s[0 * 33], q8 * s[1 * 33], w0, false); w0 = __builtin_amdgcn_cvt_pk_fp8_f32(q8 * s[2 * 33], q8 * s[3 * 33], w0, true);
            w1 = __builtin_amdgcn_cvt_pk_fp8_f32(q8 * s[4 * 33], q8 * s[5 * 33], w1, false); w1 = __builtin_amdgcn_cvt_pk_fp8_f32(q8 * s[6 * 33], q8 * s[7 * 33], w1, true);
            __builtin_nontemporal_store((u32x2){w0, w1}, (u32x2*)((unsigned char*)WT + (size_t)dr * K + k0 + 8 * c)); }
        else { u32x4 o; o.x = pk2(s[0 * 33] * sc, s[1 * 33] * sc); o.y = pk2(s[2 * 33] * sc, s[3 * 33] * sc); o.z = pk2(s[4 * 33] * sc, s[5 * 33] * sc); o.w = pk2(s[6 * 33] * sc, s[7 * 33] * sc);
        __builtin_nontemporal_store(o, (u32x4*)(WT + (size_t)dr * K + k0 + 8 * c)); } }
    LDS_WAIT(); asm volatile("" ::: "memory");
}
__device__ __forceinline__ void sincos_d(double x, double& s, double& c) {
    const double tp = 6.283185307179586476925287; x -= tp * rint(x / tp);
    const double x2 = x * x; double cs = 1.0, sn = 1.0;
    double tc = 1.0, ts = 1.0; cs = 1.0; sn = 1.0;
#pragma unroll
    for (int k = 1; k <= 17; ++k) { tc *= -x2 / (double)((2 * k - 1) * (2 * k)); ts *= -x2 / (double)((2 * k) * (2 * k + 1)); cs += tc; sn += ts; }
    s = sn * x; c = cs;
}

struct P0Args {
    const float *c, *c_ctx, *ada_w, *ada_b, *w_in, *w_gate, *ret_w_o, *s5_w_glu, *diff_w_o, *conv_w_o, *w_out, *ffn_w_gu, *ffn_w_d, *moe_w_gu, *moe_w_d;
    int f8mask;
    const float *ret_decay, *s5_a_re, *s5_a_im, *s5_log_dt, *s5_b_re, *s5_b_im, *s5_c_re, *s5_c_im, *diff_lambda;
};
__device__ __forceinline__ void p0_prologue(Frame& F, const P0Args& P) {
    unsigned char* ws = F.ws;
    {
        LAS float* scr = (LAS float*)(F.lds + F.wave * 8448);
        const int gw = F.vcu * NWAVES + F.wave, NGW = F.G * NWAVES;
        constexpr int I_WIN = 16 * (NIN / 32), I_WG = 16 * 32, I_BR1 = 4 * 32, I_BR2 = 4 * 64, I_WOUT = 16 * 32;
        constexpr int I_LAYER = I_WIN + 4 * I_WG + I_BR1 + I_BR2 + I_BR1 + I_BR1 + I_WOUT;
        constexpr int I_GU = 16 * (2 * FFD / 32), I_DD = (FFD / 64) * 32, I_DENSE = I_GU + I_DD;
        constexpr int I_MGU = 16 * (2 * FFE / 32), I_MD = (FFE / 64) * 32, I_EXP = I_MGU + I_MD;
        constexpr int NITEMS = DEPTH * I_LAYER + 2 * I_DENSE + 2 * NE * I_EXP;
        for (int it = gw; it < NITEMS; it += NGW) {
            int r = it;
            if (r < DEPTH * I_LAYER) {
                const int l = r / I_LAYER; r -= l * I_LAYER;
                if (r < I_WIN) { transpose_item<2>(P.w_in + (size_t)l * D * NIN, D, NIN, (bf16*)(ws + WS_WIN) + (size_t)l * E_WIN, 0, scr, r, F.lane); continue; } r -= I_WIN;
                if (r < 4 * I_WG) { const int z = r / I_WG; transpose_item<3, true>(P.w_gate + ((size_t)l * 4 + z) * D * D, D, D, (bf16*)(ws + WS_WG) + (size_t)l * E_WG, z * 64, scr, r % I_WG, F.lane); continue; } r -= 4 * I_WG;
                bf16* wbr = (bf16*)(ws + WS_WBR) + (size_t)l * E_WBR;
                if (r < I_BR1) { transpose_item<0>(P.ret_w_o + (size_t)l * 256 * D, 256, D, wbr, 0, scr, r, F.lane); continue; } r -= I_BR1;
                if (r < I_BR2) { transpose_item<1>(P.s5_w_glu + (size_t)l * 256 * 2 * D, 256, 2 * D, wbr, 1024, scr, r, F.lane); continue; } r -= I_BR2;
                if (r < I_BR1) { transpose_item<0>(P.diff_w_o + (size_t)l * 256 * D, 256, D, wbr, 3072, scr, r, F.lane); continue; } r -= I_BR1;
                if (r < I_BR1) { transpose_item<0>(P.conv_w_o + (size_t)l * 256 * D, 256, D, wbr, 4096, scr, r, F.lane); continue; } r -= I_BR1;
                transpose_item<0>(P.w_out + (size_t)l * D * D, D, D, (bf16*)(ws + WS_WOUT) + (size_t)l * E_WOUT, 0, scr, r, F.lane); continue;
            }
            r -= DEPTH * I_LAYER;
            if (r < 2 * I_DENSE) {
                const int j = r / I_DENSE; r -= j * I_DENSE;
                const bool f8 = (P.f8mask >> (2 * j)) & 1; bf16* wgu = (bf16*)(ws + WS_WGU + (size_t)j * E_WGU * 2); bf16* wd = (bf16*)(ws + WS_WD + (size_t)j * E_WD * 2);
                if (r < I_GU) { if (f8) transpose_item<1, true>(P.ffn_w_gu + (size_t)j * D * 2 * FFD, D, 2 * FFD, wgu, 0, scr, r, F.lane); else transpose_item<1, false>(P.ffn_w_gu + (size_t)j * D * 2 * FFD, D, 2 * FFD, wgu, 0, scr, r, F.lane); continue; } r -= I_GU;
                if (f8) transpose_item<0, true>(P.ffn_w_d + (size_t)j * FFD * D, FFD, D, wd, 0, scr, r, F.lane); else transpose_item<0, false>(P.ffn_w_d + (size_t)j * FFD * D, FFD, D, wd, 0, scr, r, F.lane); continue;
            }
            r -= 2 * I_DENSE;
            { const int je = r / I_EXP; r -= je * I_EXP;
              const int jj = je >> 3, ee = je & 7; const bool f8 = (P.f8mask >> (2 * jj + 1)) & 1; const size_t esz = f8 ? 1 : 2;
              bf16* wgu = (bf16*)(ws + WS_MGU + (size_t)jj * NE * E_MGU * 2 + (size_t)ee * E_MGU * esz); bf16* wd = (bf16*)(ws + WS_MWD + (size_t)jj * NE * E_MWD * 2 + (size_t)ee * E_MWD * esz);
              if (r < I_MGU) { if (f8) transpose_item<1, true>(P.moe_w_gu + (size_t)je * D * 2 * FFE, D, 2 * FFE, wgu, 0, scr, r, F.lane); else transpose_item<1, false>(P.moe_w_gu + (size_t)je * D * 2 * FFE, D, 2 * FFE, wgu, 0, scr, r, F.lane); continue; } r -= I_MGU;
              if (f8) transpose_item<0, true>(P.moe_w_d + (size_t)je * FFE * D, FFE, D, wd, 0, scr, r, F.lane); else transpose_item<0, false>(P.moe_w_d + (size_t)je * FFE * D, FFE, D, wd, 0, scr, r, F.lane); }
        }
    }
    __syncthreads();
    {
        LAS float* sc = (LAS float*)F.lds;
        LAS float* part = (LAS float*)(F.lds + 17 * 1024 * 4);
        for (int i = F.tid; i < 17 * D; i += 512) { const int r = i >> 10, k = i & 1023; const float v = r < 16 ? P.c[r * D + k] : P.c_ctx[k]; sc[i] = v / (1.0f + __expf(-v)); }
        __syncthreads();
        float* mods = (float*)(ws + WS_MODS);
        for (int u = F.vcu; u < DEPTH * 96; u += F.G) {
            const int l = u / 96, n0 = (u % 96) * 64;
            const float* w = P.ada_w + (size_t)l * D * 6 * D + n0 + F.lane;
            float acc[17];
#pragma unroll
            for (int r = 0; r < 17; ++r) acc[r] = 0.f;
            const int kb = F.wave * 128;
#pragma unroll 2
            for (int k4 = 0; k4 < 128; k4 += 4) {
                float wv[4];
#pragma unroll
                for (int j = 0; j < 4; ++j) wv[j] = w[(size_t)(kb + k4 + j) * 6 * D];
#pragma unroll
                for (int r = 0; r < 17; ++r) { const f32x4 s = *(const LAS f32x4*)(sc + r * 1024 + kb + k4); acc[r] += wv[0] * s[0] + wv[1] * s[1] + wv[2] * s[2] + wv[3] * s[3]; }
            }
#pragma unroll
            for (int r = 0; r < 17; ++r) part[(F.wave * 17 + r) * 64 + F.lane] = acc[r];
            __syncthreads();
            for (int i = F.tid; i < 17 * 64; i += 512) { float s = 0.f;
#pragma unroll
                for (int w8 = 0; w8 < 8; ++w8) s += part[w8 * 17 * 64 + i];
                const int r = i >> 6, n = n0 + (i & 63); mods[((size_t)l * 17 + r) * 6 * D + n] = s + P.ada_b[(size_t)l * 6 * D + n]; }
            __syncthreads();
        }
    }
    {
        const int gt = F.vcu * 512 + F.tid, NGT = F.G * 512;
        float* rope = (float*)(ws + WS_ROPE);
        for (int i = gt; i < SEQ * 16; i += NGT) { const int t = i >> 4, pi = i & 15, axis = pi >> 3, f = pi & 7;
            const float inv = exp2f(-(float)f * (13.287712379549449f / 8.0f));
            const float ang = (float)(axis ? (t & 63) : (t >> 6)) * inv; float s, c; sincosf(ang, &s, &c); rope[2 * i] = c; rope[2 * i + 1] = s; }
        for (int i = gt; i < DEPTH * 2048; i += NGT) {
            const int l = i >> 11, d = (i >> 10) & 1, g = (i >> 6) & 15, p = i & 63;
            unsigned char* sp = ws + WS_S5P + (size_t)l * S5P_BYTES;
            const float are = fminf(P.s5_a_re[i], -1e-4f), aim = P.s5_a_im[i];
            const float dt = expf(P.s5_log_dt[(l * 2 + d) * 16 + g]);
            const float zre = dt * are; const double zim = (double)dt * (double)aim;
            double sn, cs; sincos_d(zim, sn, cs);
            const float mag = expf(zre), abre = mag * (float)cs, abim = mag * (float)sn;
            double sn2, cs2; sincos_d(128.0 * zim, sn2, cs2); const float mag2 = expf(128.0f * zre);
            ((f32x2*)(sp + S5P_ABAR))[i & 2047] = (f32x2){abre, abim};
            ((f32x2*)(sp + S5P_A128))[i & 2047] = (f32x2){mag2 * (float)cs2, mag2 * (float)sn2};
            const float den = are * are + aim * aim, nre = abre - 1.0f;
            const float cfre = (nre * are + abim * aim) / den, cfim = (abim * are - nre * aim) / den;
            const float* bre = P.s5_b_re + (((size_t)l * 16 + g) * 64 + p) * 16; const float* bim = P.s5_b_im + (((size_t)l * 16 + g) * 64 + p) * 16;
            bf16* bp = (bf16*)(sp + S5P_BP) + (((size_t)d * 16 + g) * 128 + 2 * p) * 16;
#pragma unroll
            for (int c = 0; c < 16; ++c) { const float br = bre[c], bi = bim[c]; bp[c] = (bf16)f2bf(cfre * br - cfim * bi); bp[16 + c] = (bf16)f2bf(cfre * bi + cfim * br); }
            if (d == 0) { bf16* ch = (bf16*)(sp + S5P_CH) + (size_t)g * 16 * 128;
#pragma unroll
                for (int c = 0; c < 16; ++c) { const size_t ci = (((size_t)l * 16 + g) * 16 + c) * 64 + p; ch[c * 128 + 2 * p] = (bf16)f2bf(P.s5_c_re[ci]); ch[c * 128 + 2 * p + 1] = (bf16)f2bf(-P.s5_c_im[ci]); } }
        }
        if (gt < DEPTH) { const int l = gt; float* lp = (float*)(ws + WS_LAYP) + l * 64;
            for (int j = 0; j < 8; ++j) { const float x = P.ret_decay[l * 8 + j]; lp[j] = -log2f(1.0f + expf(-x)); }
            const float* dl = P.diff_lambda + l * 128; float d01 = 0.f, d23 = 0.f;
            for (int j = 0; j < 32; ++j) { d01 += dl[j] * dl[32 + j]; d23 += dl[64 + j] * dl[96 + j]; }
            const float li = 0.8f - 0.6f * expf(-0.3f * (float)l);
            lp[8] = expf(d01) - expf(d23) + li; lp[9] = 1.0f - li; }
    }
}
struct RowArgs {
    const float *x, *ctx;
    const float *post_g;
    const float *pre_g;
    const float *router_w, *router_b;
    float* out;
    int l, nrows, moe, last, f8, dry;
};
template <int MODE>
__device__ __forceinline__ void row_pass(Frame& F, const RowArgs& A) {
    unsigned char* ws = F.ws;
    float* H = (float*)(ws + WS_H); bf16* AF = (bf16*)(ws + WS_AF); const float* Y = (const float*)(ws + WS_Y);
    float* Hst = A.dry ? (float*)(ws + WS_END) : H; if (A.dry) AF = (bf16*)(ws + WS_END + (size_t)RT * D * 2);
    const float* mods = (const float*)(ws + WS_MODS);
    const int gw = F.vcu * NWAVES + F.wave, NGW = F.G * NWAVES, lane = opaque_v(F.lane);
    volatile LAS unsigned* cnt = F.MISC + 16;
    if (MODE == 1 && A.moe) { if (F.tid < 8) cnt[F.tid] = 0u; __syncthreads(); }
    const int lg = A.l, lm = (MODE == 2) ? A.l + 1 : A.l;
    const int goff = (MODE == 1) ? 2 * D : 5 * D, shoff = (MODE == 1) ? 3 * D : 0, scoff = (MODE == 1) ? 4 * D : D;
    LAS float* rwL = (LAS float*)F.lds;
    if (MODE == 1 && A.moe) {
        for (int i = F.tid; i < D * NE; i += 512) rwL[(i & 7) * D + (i >> 3)] = A.router_w[i];
        __syncthreads();
    }
    const bool wr_af = !(MODE == 2 && A.last);
    f32x4 pg[4], pg2[4];
#pragma unroll
    for (int j = 0; j < 4; ++j) { const int c = 4 * lane + 256 * j; pg[j] = (MODE != 0) ? *(const GAS f32x4*)((const GAS float*)A.post_g + c) : (f32x4){0.f, 0.f, 0.f, 0.f}; pg2[j] = wr_af ? *(const GAS f32x4*)((const GAS float*)A.pre_g + c) : (f32x4){0.f, 0.f, 0.f, 0.f}; }
    struct Raw { u32x2 ya[4], yb[4], hw[4]; f32x4 gv[4], sh[4], sc[4], x[4]; };
    Raw cur, nx;
    u32x4 recn = (u32x4){0u, 0u, 0u, 0u}; u32x2 posn = (u32x2){0u, 0u};
    u32x4 recc = recn, recx = recn; u32x2 posc = posn, posx = posn;
#define ROW_REC(R4, P2, rw) do { if (false) { const GAS int* rec_ = (const GAS int*)(ws + WS_REC) + (size_t)(rw) * 8; R4 = (u32x4){0u, 0u, (unsigned)rec_[2], (unsigned)rec_[3]}; P2 = (u32x2){(unsigned)rec_[6], (unsigned)rec_[7]}; } } while (0)
#define ROW_LOAD(R, rw, R4, P2) do { const int br_ = (rw) < RL ? ((rw) >> 11) : 16; \
        if (wr_af) { const GAS float* mrow_ = (const GAS float*)mods + ((size_t)lm * 17 + br_) * 6 * D; _Pragma("unroll") for (int j = 0; j < 4; ++j) { const int c = 4 * lane + 256 * j; R.sh[j] = *(const GAS f32x4*)(mrow_ + shoff + c); R.sc[j] = *(const GAS f32x4*)(mrow_ + scoff + c); } } \
        if (MODE == 0) { const GAS float* src_ = (rw) < RL ? (const GAS float*)A.x + (size_t)(rw) * D : (const GAS float*)A.ctx + (size_t)((rw) - RL) * D; _Pragma("unroll") for (int j = 0; j < 4; ++j) R.x[j] = *(const GAS f32x4*)(src_ + 4 * lane + 256 * j); } \
        else { const GAS float* gate_ = (const GAS float*)mods + ((size_t)lg * 17 + br_) * 6 * D + goff; \
            _Pragma("unroll") for (int j = 0; j < 4; ++j) { const int c = 4 * lane + 256 * j; R.hw[j] = *(const GAS u32x2*)((const GAS bf16*)H + (size_t)(rw) * D + c); R.gv[j] = *(const GAS f32x4*)(gate_ + c); } \
            if (MODE == 2 && A.moe) { } else if (false) { const GAS bf16* ys_ = (const GAS bf16*)(ws + WS_YS); const size_t p0_ = (size_t)P2.x, p1_ = (size_t)P2.y; \
                _Pragma("unroll") for (int j = 0; j < 4; ++j) { R.ya[j] = *(const GAS u32x2*)(ys_ + p0_ * D + 4 * lane + 256 * j); R.yb[j] = *(const GAS u32x2*)(ys_ + p1_ * D + 4 * lane + 256 * j); } } \
            else { _Pragma("unroll") for (int j = 0; j < 4; ++j) R.ya[j] = *(const GAS u32x2*)((const GAS bf16*)Y + (size_t)(rw) * D + 4 * lane + 256 * j); } } } while (0)
    if (gw < A.nrows) { ROW_REC(recc, posc, gw); if (gw + NGW < A.nrows) ROW_REC(recx, posx, gw + NGW); ROW_LOAD(cur, gw, recc, posc); }
    for (int row = gw; row < A.nrows; row += NGW) {
        const int nrow = row + NGW;
        if (nrow + NGW < A.nrows) ROW_REC(recn, posn, nrow + NGW);
        if (nrow < A.nrows) ROW_LOAD(nx, nrow, recx, posx);
        f32x4 h[4]; f32x4 sh[4], sc[4];
#pragma unroll
        for (int j = 0; j < 4; ++j) { sh[j] = cur.sh[j]; sc[j] = cur.sc[j]; }
        if (MODE == 0) {
#pragma unroll
            for (int j = 0; j < 4; ++j) h[j] = cur.x[j];
        } else {
            f32x4 y[4]; float ss = 0.f;
            if (MODE == 2 && A.moe) { const GAS int* rec = (const GAS int*)(ws + WS_REC) + (size_t)row * 8;
                const int p0 = rec[6], p1 = rec[7]; const float w0 = __builtin_bit_cast(float, rec[2]), w1 = __builtin_bit_cast(float, rec[3]);
                const GAS bf16* ys = (const GAS bf16*)(ws + WS_YS);
#pragma unroll
                for (int j = 0; j < 4; ++j) { const u32x2 a = *(const GAS u32x2*)(ys + (size_t)p0 * D + 4 * lane + 256 * j), b = *(const GAS u32x2*)(ys + (size_t)p1 * D + 4 * lane + 256 * j);
                    y[j] = (f32x4){w0 * bflo(a.x) + w1 * bflo(b.x), w0 * bfhi(a.x) + w1 * bfhi(b.x), w0 * bflo(a.y) + w1 * bflo(b.y), w0 * bfhi(a.y) + w1 * bfhi(b.y)}; }
            } else {
#pragma unroll
                for (int j = 0; j < 4; ++j) { const u32x2 a = cur.ya[j]; y[j] = (f32x4){bflo(a.x), bfhi(a.x), bflo(a.y), bfhi(a.y)}; }
            }
#pragma unroll
            for (int j = 0; j < 4; ++j) ss += (y[j][0] * y[j][0] + y[j][1] * y[j][1]) + (y[j][2] * y[j][2] + y[j][3] * y[j][3]);
            const float rstd = 1.0f / sqrtf(wave_sum(ss) * (1.0f / D) + EPS);
#pragma unroll
            for (int j = 0; j < 4; ++j) { const u32x2 hw = cur.hw[j]; const f32x4 hv = (f32x4){bflo(hw.x), bfhi(hw.x), bflo(hw.y), bfhi(hw.y)}; h[j] = hv + cur.gv[j] * (y[j] * rstd * pg[j]); }
        }
        cur = nx; recc = recx; posc = posx; recx = recn; posx = posn;
        if (!wr_af) {
#pragma unroll
            for (int j = 0; j < 4; ++j) if (!A.dry) __builtin_nontemporal_store(h[j], (GAS f32x4*)((GAS float*)A.out + (size_t)row * D + 4 * lane + 256 * j));
            continue;
        }
#pragma unroll
        for (int j = 0; j < 4; ++j) { u32x2 hw; hw.x = pk2(h[j][0], h[j][1]); hw.y = pk2(h[j][2], h[j][3]); *(GAS u32x2*)((GAS bf16*)Hst + (size_t)row * D + 4 * lane + 256 * j) = hw; }
        float s2 = 0.f;
#pragma unroll
        for (int j = 0; j < 4; ++j) s2 += (h[j][0] * h[j][0] + h[j][1] * h[j][1]) + (h[j][2] * h[j][2] + h[j][3] * h[j][3]);
        const float rs2 = 1.0f / sqrtf(wave_sum(s2) * (1.0f / D) + EPS);
        f32x4 f[4];
#pragma unroll
        for (int j = 0; j < 4; ++j) { const int c = 4 * lane + 256 * j;
            f[j] = (h[j] * rs2 * pg2[j]) * (1.0f + sc[j]) + sh[j];
            if (MODE == 1 && A.f8) { unsigned w = 0; w = __builtin_amdgcn_cvt_pk_fp8_f32(4.f * f[j][0], 4.f * f[j][1], w, false); w = __builtin_amdgcn_cvt_pk_fp8_f32(4.f * f[j][2], 4.f * f[j][3], w, true);
                *(GAS unsigned*)((GAS unsigned char*)AF + (size_t)row * D + c) = w; }
            else { u32x2 w; w.x = pk2(f[j][0], f[j][1]); w.y = pk2(f[j][2], f[j][3]); *(GAS u32x2*)((GAS bf16*)AF + (size_t)row * D + c) = w;
                if (MODE != 1) { unsigned w8 = 0; w8 = __builtin_amdgcn_cvt_pk_fp8_f32(4.f * f[j][0], 4.f * f[j][1], w8, false); w8 = __builtin_amdgcn_cvt_pk_fp8_f32(4.f * f[j][2], 4.f * f[j][3], w8, true);
                    *(GAS unsigned*)((GAS unsigned char*)(ws + (A.dry ? WS_END + (size_t)RT * D * 4 : WS_AF8)) + (size_t)row * D + c) = w8; } } }
        if (MODE == 1 && A.moe) {
            float pl[8];
#pragma unroll
            for (int e = 0; e < 8; ++e) pl[e] = 0.f;
#pragma unroll
            for (int j = 0; j < 4; ++j)
#pragma unroll
                for (int e = 0; e < 8; ++e) { const f32x4 w4 = *(const LAS f32x4*)(rwL + e * D + 4 * lane + 256 * j); pl[e] += (f[j][0] * w4[0] + f[j][1] * w4[1]) + (f[j][2] * w4[2] + f[j][3] * w4[3]); }
            float a4[4], a2[2], a1;
            { const bool hi = (lane & 32) != 0;
#pragma unroll
              for (int k = 0; k < 4; ++k) { const float mine = hi ? pl[4 + k] : pl[k], theirs = hi ? pl[k] : pl[4 + k]; a4[k] = mine + __shfl_xor(theirs, 32); } }
            { const bool hi = (lane & 16) != 0;
#pragma unroll
              for (int k = 0; k < 2; ++k) { const float mine = hi ? a4[2 + k] : a4[k], theirs = hi ? a4[k] : a4[2 + k]; a2[k] = mine + __shfl_xor(theirs, 16); } }
            { const bool hi = (lane & 8) != 0; const float mine = hi ? a2[1] : a2[0], theirs = hi ? a2[0] : a2[1]; a1 = mine + __shfl_xor(theirs, 8); }
            a1 += __shfl_xor(a1, 4); a1 += __shfl_xor(a1, 2); a1 += __shfl_xor(a1, 1);
            float lg8[8];
#pragma unroll
            for (int e = 0; e < 8; ++e) lg8[e] = __builtin_bit_cast(float, __builtin_amdgcn_readlane(__builtin_bit_cast(int, a1), 8 * e)) + A.router_b[e];
            int e0 = 0; float v0 = lg8[0];
#pragma unroll
            for (int e = 1; e < 8; ++e) if (lg8[e] > v0) { v0 = lg8[e]; e0 = e; }
            int e1 = -1; float v1 = -3.0e38f;
#pragma unroll
            for (int e = 0; e < 8; ++e) if (e != e0 && lg8[e] > v1) { v1 = lg8[e]; e1 = e; }
            const float w0 = 1.0f / (1.0f + __expf(v1 - v0)), w1 = 1.0f - w0;
            if (lane == 0) {
                const unsigned r0 = __hip_atomic_fetch_add((LAS unsigned*)(cnt + e0), 1u, __ATOMIC_RELAXED, __HIP_MEMORY_SCOPE_WORKGROUP);
                const unsigned r1 = __hip_atomic_fetch_add((LAS unsigned*)(cnt + e1), 1u, __ATOMIC_RELAXED, __HIP_MEMORY_SCOPE_WORKGROUP);
                int* rec = (int*)(ws + (A.dry ? WS_END + (size_t)RT * D * 5 : WS_REC)) + (size_t)row * 8;
                rec[0] = e0; rec[1] = e1; rec[2] = __builtin_bit_cast(int, w0); rec[3] = __builtin_bit_cast(int, w1); rec[4] = (int)r0; rec[5] = (int)r1;
            }
        }
    }
#undef ROW_REC
#undef ROW_LOAD
    if (MODE == 1 && A.moe) { __syncthreads(); if (F.tid < 8 && !A.dry) ((int*)(ws + WS_HIST))[blockIdx.x * 8 + F.tid] = (int)cnt[F.tid]; }
}

__device__ __forceinline__ void moe_dispatch(Frame& F, int nrows, int f8) {
    unsigned char* ws = F.ws;
    volatile LAS int* sh = (volatile LAS int*)F.lds;
    const int* hist = (const int*)(ws + WS_HIST);
    if (F.tid < 16) sh[F.tid] = 0;
    __syncthreads();
    { const int e = F.tid & 7; int tot = 0, pre = 0;
      int v[4];
#pragma unroll
      for (int q = 0; q < 4; ++q) { const int b = (F.tid >> 3) + 64 * q; v[q] = b < (int)gridDim.x ? __hip_atomic_load(hist + b * 8 + e, __ATOMIC_RELAXED, __HIP_MEMORY_SCOPE_AGENT) : 0; }
#pragma unroll
      for (int q = 0; q < 4; ++q) { const int b = (F.tid >> 3) + 64 * q; tot += v[q]; if (b < (int)blockIdx.x) pre += v[q]; }
      __hip_atomic_fetch_add((LAS int*)(sh + e), tot, __ATOMIC_RELAXED, __HIP_MEMORY_SCOPE_WORKGROUP); __hip_atomic_fetch_add((LAS int*)(sh + 8 + e), pre, __ATOMIC_RELAXED, __HIP_MEMORY_SCOPE_WORKGROUP); }
    __syncthreads();
    if (F.tid == 0) { int base = 0; for (int e = 0; e < 8; ++e) { sh[24 + e] = base; sh[16 + e] = base + sh[8 + e]; base += (sh[e] + 255) & ~255; } sh[32] = base; }
    __syncthreads();
    if (blockIdx.x == 0) {
        int* te = (int*)(ws + WS_TILEE); const int ntile = sh[32] >> 8;
        int bs[7];
#pragma unroll
        for (int q = 1; q < 8; ++q) bs[q - 1] = sh[24 + q];
        for (int t = F.tid; t < ntile; t += 512) { int e = 0;
#pragma unroll
            for (int q = 0; q < 7; ++q) e += (t * 256 >= bs[q]) ? 1 : 0;
            te[t] = e; }
        if (F.tid == 0) te[400] = ntile;
    }
    const int gw = F.vcu * NWAVES + F.wave, NGW = F.G * NWAVES, lane = F.lane;
    const GAS unsigned char* AFb = (const GAS unsigned char*)(ws + WS_AF); GAS unsigned char* FSb = (GAS unsigned char*)(ws + WS_FS);
    const int nmine = (nrows - gw + NGW - 1) / NGW;
    for (int k0 = 0; k0 < nmine; k0 += 64) {
        int p0v = 0, p1v = 0;
        if (k0 + lane < nmine) { GAS int* rec = (GAS int*)(ws + WS_REC) + (size_t)(gw + (k0 + lane) * NGW) * 8;
            const u32x4 ra = *(const GAS u32x4*)rec; const u32x2 rb = *(const GAS u32x2*)(rec + 4);
            p0v = sh[16 + (int)ra.x] + (int)rb.x; p1v = sh[16 + (int)ra.y] + (int)rb.y; *(GAS u32x2*)(rec + 6) = (u32x2){(unsigned)p0v, (unsigned)p1v}; }
        const int nk = (nmine - k0) < 64 ? (nmine - k0) : 64;
        for (int kb = 0; kb < nk; kb += 6) {
            u32x4 a[6], b[6];
#pragma unroll
            for (int q = 0; q < 6; ++q) if (kb + q < nk) { const size_t row = (size_t)(gw + (k0 + kb + q) * NGW);
                if (f8) a[q] = *(const GAS u32x4*)(AFb + row * D + 16 * lane);
                else { a[q] = *(const GAS u32x4*)(AFb + row * 2 * D + 16 * lane); b[q] = *(const GAS u32x4*)(AFb + row * 2 * D + 1024 + 16 * lane); } }
#pragma unroll
            for (int q = 0; q < 6; ++q) if (kb + q < nk) { const size_t p0 = (size_t)__builtin_amdgcn_readlane(p0v, kb + q), p1 = (size_t)__builtin_amdgcn_readlane(p1v, kb + q);
                if (f8) { *(GAS u32x4*)(FSb + p0 * D + 16 * lane) = a[q]; *(GAS u32x4*)(FSb + p1 * D + 16 * lane) = a[q]; }
                else { *(GAS u32x4*)(FSb + p0 * 2 * D + 16 * lane) = a[q]; *(GAS u32x4*)(FSb + p0 * 2 * D + 1024 + 16 * lane) = b[q];
                       *(GAS u32x4*)(FSb + p1 * 2 * D + 16 * lane) = a[q]; *(GAS u32x4*)(FSb + p1 * 2 * D + 1024 + 16 * lane) = b[q]; } }
        }
    }
}
__device__ __forceinline__ int chunk_row0(int b, int c) { return c < 2 ? RL + b * NCTX + c * 128 : b * SEQ + (c - 2) * 128; }
__device__ __forceinline__ bf16x8 tr_read2(unsigned a0, unsigned a1) {
    s16x4 lo, hi; asm volatile("ds_read_b64_tr_b16 %0, %2\n\tds_read_b64_tr_b16 %1, %3\n\ts_waitcnt lgkmcnt(0)" : "=&v"(lo), "=&v"(hi) : "v"(a0), "v"(a1) : "memory");
    return __builtin_shufflevector(lo, hi, 0, 1, 2, 3, 4, 5, 6, 7);
}
__device__ __forceinline__ unsigned scale_pk(unsigned w, float s) { return pk2(bflo(w) * s, bfhi(w) * s); }

constexpr int RS_KSTR = 288, RS_VSTR = 544, RS_KF = 0, RS_KB = 128 * RS_KSTR, RS_V = 2 * 128 * RS_KSTR;

__device__ __forceinline__ void ret_summary_unit(Frame& F, int b, int c, const float* lp) {
    const bf16* Z = (const bf16*)(F.ws + WS_Z); const int row0 = chunk_row0(b, c);
    LAS unsigned char* L = F.lds;
    for (int i = F.tid; i < 2048; i += 512) { const int a = i >> 4, ch = i & 15, hd = ch >> 2;
        const u32x4 kv = *(const u32x4*)(Z + (size_t)(row0 + a) * ZW + ZQ_RK + ch * 8);
        const float wf = __builtin_amdgcn_exp2f((float)(127 - a) * lp[hd]), wb = __builtin_amdgcn_exp2f((float)a * lp[4 + hd]);
        u32x4 f, g; f.x = scale_pk(kv.x, wf); f.y = scale_pk(kv.y, wf); f.z = scale_pk(kv.z, wf); f.w = scale_pk(kv.w, wf);
        g.x = scale_pk(kv.x, wb); g.y = scale_pk(kv.y, wb); g.z = scale_pk(kv.z, wb); g.w = scale_pk(kv.w, wb);
        *(LAS u32x4*)(L + RS_KF + a * RS_KSTR + ch * 16) = f; *(LAS u32x4*)(L + RS_KB + a * RS_KSTR + ch * 16) = g; }
    for (int i = F.tid; i < 4096; i += 512) { const int a = i >> 5, ch = i & 31;
        *(LAS u32x4*)(L + RS_V + a * RS_VSTR + ch * 16) = *(const u32x4*)(Z + (size_t)(row0 + a) * ZW + ZQ_RV + ch * 8); }
    __syncthreads();
    const int h = F.wave & 3, dir = F.wave >> 2, l = opaque_v(F.lane), hh = l >> 5, blk = (l >> 4) & 1, q = (l & 15) >> 2, p = l & 3;
    const unsigned lb = (unsigned)(size_t)L;
    f32x16 acc0, acc1;
#pragma unroll
    for (int r = 0; r < 16; ++r) { acc0[r] = 0.f; acc1[r] = 0.f; }
    const unsigned kbase = lb + (dir ? RS_KB : RS_KF) + (h * 32 + 16 * blk) * 2 + 8 * p;
    const unsigned vbase = lb + RS_V + (h * 64 + 16 * blk) * 2 + 8 * p;
#pragma unroll 2
    for (int ks = 0; ks < 8; ++ks) {
        const int r0 = 16 * ks + 8 * hh + q, r1 = r0 + 4;
        const bf16x8 bk = tr_read2(kbase + r0 * RS_KSTR, kbase + r1 * RS_KSTR);
        const bf16x8 a0 = tr_read2(vbase + r0 * RS_VSTR, vbase + r1 * RS_VSTR);
        const bf16x8 a1 = tr_read2(vbase + 64 + r0 * RS_VSTR, vbase + 64 + r1 * RS_VSTR);
        acc0 = __builtin_amdgcn_mfma_f32_32x32x16_bf16(a0, bk, acc0, 0, 0, 0);
        acc1 = __builtin_amdgcn_mfma_f32_32x32x16_bf16(a1, bk, acc1, 0, 0, 0);
    }
    float* out = (float*)(F.ws + WS_RETSUM) + ((((size_t)b * NCH + c) * 2 + dir) * 4 + h) * 2048;
#pragma unroll
    for (int r = 0; r < 16; ++r) { const int e = (r & 3) + 8 * (r >> 2) + 4 * hh; out[e * 32 + (l & 31)] = acc0[r]; out[(32 + e) * 32 + (l & 31)] = acc1[r]; }
    __syncthreads();
}

__device__ __forceinline__ int prefix_chunk(int dir, int i) { return dir == 0 ? i : (i == 0 ? 1 : (i == 1 ? 0 : 19 - i)); }
__device__ __forceinline__ void ret_prefix_unit(Frame& F, int b, int h, int dir, const float* lp) {
    const int lane_ = opaque_v(F.lane);
    const float g128 = __builtin_amdgcn_exp2f(128.0f * lp[dir * 4 + h]);
    f32x4 S[8], nx[8]; const float z0 = opaque_f(0.f);
#pragma unroll
    for (int j = 0; j < 8; ++j) S[j] = (f32x4){z0, z0, z0, z0};
    { const size_t idx = ((((size_t)b * NCH + prefix_chunk(dir, 0)) * 2 + dir) * 4 + h) * 2048; const GAS float* kv = (const GAS float*)(F.ws + WS_RETSUM) + idx;
#pragma unroll
      for (int j = 0; j < 8; ++j) nx[j] = *(const GAS f32x4*)(kv + 4 * lane_ + 256 * j); }
#pragma unroll 1
    for (int i = 0; i < NCH; ++i) {
        const size_t idx = ((((size_t)b * NCH + prefix_chunk(dir, i)) * 2 + dir) * 4 + h) * 2048;
        GAS bf16* st = (GAS bf16*)(F.ws + WS_RETST) + idx;
        f32x4 cur[8];
#pragma unroll
        for (int j = 0; j < 8; ++j) cur[j] = nx[j];
        if (i + 1 < NCH) { const size_t idn = ((((size_t)b * NCH + prefix_chunk(dir, i + 1)) * 2 + dir) * 4 + h) * 2048; const GAS float* kv = (const GAS float*)(F.ws + WS_RETSUM) + idn;
#pragma unroll
            for (int j = 0; j < 8; ++j) nx[j] = *(const GAS f32x4*)(kv + 4 * lane_ + 256 * j); }
#pragma unroll
        for (int j = 0; j < 8; ++j) { const int o = 4 * lane_ + 256 * j;
            u32x2 w; w.x = pk2(S[j][0], S[j][1]); w.y = pk2(S[j][2], S[j][3]); *(GAS u32x2*)(st + o) = w;
            S[j] = S[j] * g128 + cur[j]; }
    }
}
__device__ __forceinline__ void s5_prefix_unit(Frame& F, int b, int g, int d, int l) {
    const int lane_ = opaque_v(F.lane);
    const f32x2 a = ((const GAS f32x2*)(F.ws + WS_S5P + (size_t)l * S5P_BYTES + S5P_A128))[(d * 16 + g) * 64 + lane_];
    f32x2 e[NCH];
#pragma unroll
    for (int i = 0; i < NCH; ++i) e[i] = ((const GAS f32x2*)(F.ws + WS_S5E))[((((size_t)b * NCH + prefix_chunk(d, i)) * 16 + g) * 2 + d) * 64 + lane_];
    float cr = opaque_f(0.f), ci = cr;
#pragma unroll
    for (int i = 0; i < NCH; ++i) {
        ((GAS f32x2*)(F.ws + WS_S5C))[((((size_t)b * NCH + prefix_chunk(d, i)) * 16 + g) * 2 + d) * 64 + lane_] = (f32x2){cr, ci};
        const float nr = a.x * cr - a.y * ci + e[i].x, ni = a.x * ci + a.y * cr + e[i].y; cr = nr; ci = ni;
    }
}

constexpr int S5_XSTR = 132  , S5_HSTR = 272  , S5_WAVE_LDS = 16 * S5_XSTR * 4 + 16 * S5_HSTR;
template <bool OUT, int DIR>
__device__ __forceinline__ void s5_scan_dir(const unsigned char* sp, unsigned char* wsb, LAS float* X, LAS unsigned char* Hb, int lane, int tk, int kg, int g, size_t sidx, const bf16x8 (&ufr)[8], const bf16x8 (&chf)[4], f32x4 (&yacc)[8]) {
    const bf16x8 zero8 = (bf16x8){0, 0, 0, 0, 0, 0, 0, 0};
    const f32x2 ab = ((const GAS f32x2*)(sp + S5P_ABAR))[(DIR * 16 + g) * 64 + lane];
    bf16x8 af[8];
#pragma unroll
    for (int rb = 0; rb < 8; ++rb) af[rb] = kg < 2 ? *(const GAS bf16x8*)((const GAS bf16*)(sp + S5P_BP) + (((size_t)DIR * 16 + g) * 128 + 16 * rb + tk) * 16 + 8 * kg) : zero8;
    float hr = 0.f, hi = 0.f;
    if (OUT) { const f32x2 cin = ((const GAS f32x2*)(wsb + WS_S5C))[sidx + DIR * 64]; hr = cin.x; hi = cin.y; }
#pragma unroll
    for (int si = 0; si < 8; ++si) {
        const int sub = DIR ? 7 - si : si;
#pragma unroll
        for (int rb = 0; rb < 8; ++rb) { const f32x4 xa = __builtin_amdgcn_mfma_f32_16x16x32_bf16(af[rb], ufr[sub], (f32x4){0.f, 0.f, 0.f, 0.f}, 0, 0, 0);
            *(LAS f32x4*)(X + tk * S5_XSTR + 16 * rb + 4 * kg) = xa; }
        asm volatile("" ::: "memory");
#pragma unroll
        for (int ti = 0; ti < 16; ++ti) {
            const int tok = DIR ? 15 - ti : ti;
            const f32x2 x = *(const LAS f32x2*)(X + tok * S5_XSTR + 2 * lane);
            const float nr = ab.x * hr - ab.y * hi + x.x, ni = ab.x * hi + ab.y * hr + x.y; hr = nr; hi = ni;
            if (OUT) *(LAS unsigned*)(Hb + tok * S5_HSTR + 4 * lane) = cvt_pk_bf16(hr, hi);
        }
        asm volatile("" ::: "memory");
        if (OUT) {
#pragma unroll
            for (int ks = 0; ks < 4; ++ks) { const bf16x8 hf = *(const LAS bf16x8*)(Hb + tk * S5_HSTR + (32 * ks + 8 * kg) * 2); yacc[sub] = __builtin_amdgcn_mfma_f32_16x16x32_bf16(hf, chf[ks], yacc[sub], 0, 0, 0); }
        }
        asm volatile("" ::: "memory");
    }
    if (!OUT) ((GAS f32x2*)(wsb + WS_S5E))[sidx + DIR * 64] = (f32x2){hr, hi};
}
template <bool OUT>
__device__ __forceinline__ void s5_wave_unit(Frame& F, int b, int c, int g, int l, const float* s5_d) {
    const unsigned char* sp = F.ws + WS_S5P + (size_t)l * S5P_BYTES;
    const bf16* Z = (const bf16*)(F.ws + WS_Z); const int row0 = chunk_row0(b, c);
    LAS float* X = (LAS float*)(F.lds + F.wave * S5_WAVE_LDS);
    LAS unsigned char* Hb = (LAS unsigned char*)X + 16 * S5_XSTR * 4;
    const int lane = opaque_v(F.lane), tk = lane & 15, kg = lane >> 4;
    const bf16x8 zero8 = (bf16x8){0, 0, 0, 0, 0, 0, 0, 0};
    f32x4 yacc[8]; bf16x8 chf[4];
#pragma unroll
    for (int s8 = 0; s8 < 8; ++s8) yacc[s8] = (f32x4){0.f, 0.f, 0.f, 0.f};
#pragma unroll
    for (int ks = 0; ks < 4; ++ks) chf[ks] = OUT ? *(const GAS bf16x8*)((const GAS bf16*)(sp + S5P_CH) + ((size_t)g * 16 + tk) * 128 + 32 * ks + 8 * kg) : zero8;
    bf16x8 ufr[8];
#pragma unroll
    for (int sb = 0; sb < 8; ++sb) ufr[sb] = kg < 2 ? *(const GAS bf16x8*)((const GAS bf16*)Z + (size_t)(row0 + 16 * sb + tk) * ZW + ZQ_SU + g * 16 + 8 * kg) : zero8;
    const size_t sidx = ((((size_t)b * NCH + c) * 16 + g) * 2) * 64 + lane;
    s5_scan_dir<OUT, 0>(sp, F.ws, X, Hb, lane, tk, kg, g, sidx, ufr, chf, yacc);
    s5_scan_dir<OUT, 1>(sp, F.ws, X, Hb, lane, tk, kg, g, sidx, ufr, chf, yacc);
    if (OUT) {
        GAS bf16* xb = (GAS bf16*)(F.ws + WS_XB) + (size_t)1 * RT * 256;
        const float dsk = s5_d[((size_t)l * 16 + g) * 16 + tk];
#pragma unroll
        for (int s8 = 0; s8 < 8; ++s8)
#pragma unroll
            for (int r = 0; r < 4; ++r) { const int row = row0 + 16 * s8 + 4 * kg + r;
                const float u = bf2f(((const GAS bf16*)Z)[(size_t)row * ZW + ZQ_SU + g * 16 + tk]);
                const float y = yacc[s8][r] + dsk * u;
                const float o = y * sigmoidf_(1.5957691216f * (y + 0.044715f * y * y * y));
                xb[(size_t)row * 256 + g * 16 + tk] = (bf16)f2bf(o); }
    }
}
__device__ __forceinline__ bf16x8 pack8(const f32x16& x, int s) {
    u32x4 p;
    if (s == 0) { p.x = cvt_pk_bf16(x[0], x[1]); p.y = cvt_pk_bf16(x[2], x[3]); p.z = cvt_pk_bf16(x[4], x[5]); p.w = cvt_pk_bf16(x[6], x[7]); }
    else { p.x = cvt_pk_bf16(x[8], x[9]); p.y = cvt_pk_bf16(x[10], x[11]); p.z = cvt_pk_bf16(x[12], x[13]); p.w = cvt_pk_bf16(x[14], x[15]); }
    return __builtin_bit_cast(bf16x8, p);
}
#define MFMA32(a, b, c) __builtin_amdgcn_mfma_f32_32x32x16_bf16((a), (b), (c), 0, 0, 0)

__device__ __forceinline__ void ret_out_unit(Frame& F, int b, int c, const float* lp) {
    const bf16* Z = (const bf16*)(F.ws + WS_Z); const int row0 = chunk_row0(b, c);
    LAS unsigned char* L = F.lds;
    for (int i = F.tid; i < 4096; i += 512) { const int a = i >> 5, ch = i & 31;
        *(LAS u32x4*)(L + a * RS_VSTR + ch * 16) = *(const u32x4*)(Z + (size_t)(row0 + a) * ZW + ZQ_RV + ch * 8); }
    __syncthreads();
    const int h = F.wave >> 1, ih = F.wave & 1, l = opaque_v(F.lane), li = l & 31, hh = l >> 5, blk = (l >> 4) & 1, q = (l & 15) >> 2, p = l & 3;
    const float lgf = lp[h], lgb = lp[4 + h];
    bf16x8 qf[2][2];
#pragma unroll
    for (int ib = 0; ib < 2; ++ib)
#pragma unroll
        for (int ks = 0; ks < 2; ++ks) qf[ib][ks] = *(const bf16x8*)(Z + (size_t)(row0 + 64 * ih + 32 * ib + li) * ZW + ZQ_RQ + 32 * h + 16 * ks + 8 * hh);
    f32x16 o[2][2];
#pragma unroll
    for (int eb = 0; eb < 2; ++eb)
#pragma unroll
        for (int ib = 0; ib < 2; ++ib)
#pragma unroll
            for (int r = 0; r < 16; ++r) o[eb][ib][r] = 0.f;
    const unsigned vbase = (unsigned)(size_t)L + (h * 64 + 16 * blk) * 2 + 8 * p;
    bf16x8 kfa[4][2];
#pragma unroll
    for (int jb = 0; jb < 4; ++jb)
#pragma unroll
        for (int ks = 0; ks < 2; ++ks) kfa[jb][ks] = *(const GAS bf16x8*)((const GAS bf16*)Z + (size_t)(row0 + 32 * jb + li) * ZW + ZQ_RK + 32 * h + 16 * ks + 8 * hh);
#pragma unroll
    for (int jb = 0; jb < 4; ++jb) {
        bf16x8 kf[2]; kf[0] = kfa[jb][0]; kf[1] = kfa[jb][1];
        bf16x8 vf[2][2];
#pragma unroll
        for (int s2 = 0; s2 < 2; ++s2) { const int r0 = 32 * jb + 16 * s2 + 4 * hh + q, r1 = r0 + 8;
            vf[0][s2] = tr_read2(vbase + r0 * RS_VSTR, vbase + r1 * RS_VSTR); vf[1][s2] = tr_read2(vbase + 64 + r0 * RS_VSTR, vbase + 64 + r1 * RS_VSTR); }
#pragma unroll
        for (int ib = 0; ib < 2; ++ib) {
            f32x16 s;
#pragma unroll
            for (int r = 0; r < 16; ++r) s[r] = 0.f;
            s = MFMA32(kf[0], qf[ib][0], s); s = MFMA32(kf[1], qf[ib][1], s);
            const int iq = 64 * ih + 32 * ib + li;
#pragma unroll
            for (int r = 0; r < 16; ++r) { const int j = 32 * jb + (r & 3) + 8 * (r >> 2) + 4 * hh; const int dl = iq - j;
                s[r] *= dl >= 0 ? __builtin_amdgcn_exp2f((float)dl * lgf) : __builtin_amdgcn_exp2f((float)(-dl) * lgb); }
            const bf16x8 p0 = pack8(s, 0), p1 = pack8(s, 1);
            o[0][ib] = MFMA32(vf[0][0], p0, o[0][ib]); o[0][ib] = MFMA32(vf[0][1], p1, o[0][ib]);
            o[1][ib] = MFMA32(vf[1][0], p0, o[1][ib]); o[1][ib] = MFMA32(vf[1][1], p1, o[1][ib]);
        }
    }
#pragma unroll
    for (int dir = 0; dir < 2; ++dir) {
        const bf16* st = (const bf16*)(F.ws + WS_RETST) + ((((size_t)b * NCH + c) * 2 + dir) * 4 + h) * 2048;
#pragma unroll
        for (int eb = 0; eb < 2; ++eb) {
            const bf16x8 s0 = *(const bf16x8*)(st + (32 * eb + li) * 32 + 8 * hh), s1 = *(const bf16x8*)(st + (32 * eb + li) * 32 + 16 + 8 * hh);
#pragma unroll
            for (int ib = 0; ib < 2; ++ib) {
                f32x16 x;
#pragma unroll
                for (int r = 0; r < 16; ++r) x[r] = 0.f;
                x = MFMA32(s0, qf[ib][0], x); x = MFMA32(s1, qf[ib][1], x);
                const int a = 64 * ih + 32 * ib + li;
                const float wq = dir == 0 ? __builtin_amdgcn_exp2f((float)(a + 1) * lgf) : __builtin_amdgcn_exp2f((float)(128 - a) * lgb);
#pragma unroll
                for (int r = 0; r < 16; ++r) o[eb][ib][r] += wq * x[r];
            }
        }
    }
    bf16* xb = (bf16*)(F.ws + WS_XB);
#pragma unroll
    for (int ib = 0; ib < 2; ++ib) {
        float sm = 0.f;
#pragma unroll
        for (int r = 0; r < 16; ++r) sm += o[0][ib][r] + o[1][ib][r];
        sm += __shfl_xor(sm, 32); const float mean = sm * (1.0f / 64.0f);
        float sq = 0.f;
#pragma unroll
        for (int r = 0; r < 16; ++r) { const float d0 = o[0][ib][r] - mean, d1 = o[1][ib][r] - mean; sq += d0 * d0 + d1 * d1; }
        sq += __shfl_xor(sq, 32); const float rstd = 1.0f / sqrtf(sq * (1.0f / 64.0f) + EPS);
        const size_t row = (size_t)(row0 + 64 * ih + 32 * ib + li);
#pragma unroll
        for (int eb = 0; eb < 2; ++eb)
#pragma unroll
            for (int g4 = 0; g4 < 4; ++g4) { const int e = 32 * eb + 8 * g4 + 4 * hh;
                const u32x2 gw = *(const u32x2*)(Z + row * ZW + ZQ_RG + h * 64 + e);
                const float y0 = (o[eb][ib][4 * g4 + 0] - mean) * rstd * siluf_(bflo(gw.x)), y1 = (o[eb][ib][4 * g4 + 1] - mean) * rstd * siluf_(bfhi(gw.x));
                const float y2 = (o[eb][ib][4 * g4 + 2] - mean) * rstd * siluf_(bflo(gw.y)), y3 = (o[eb][ib][4 * g4 + 3] - mean) * rstd * siluf_(bfhi(gw.y));
                u32x2 w; w.x = cvt_pk_bf16(y0, y1); w.y = cvt_pk_bf16(y2, y3); *(u32x2*)(xb + row * 256 + h * 64 + e) = w; }
    }
    __syncthreads();
}

__device__ __forceinline__ void tr_read_vtile(unsigned base, bf16x8 (&vf)[2][4]) {
    s16x4 r[16];
    asm volatile("ds_read_b64_tr_b16 %0, %16 offset:0\n\t" "ds_read_b64_tr_b16 %1, %16 offset:1152\n\t" "ds_read_b64_tr_b16 %2, %16 offset:2304\n\t" "ds_read_b64_tr_b16 %3, %16 offset:3456\n\t" "ds_read_b64_tr_b16 %4, %16 offset:4608\n\t" "ds_read_b64_tr_b16 %5, %16 offset:5760\n\t" "ds_read_b64_tr_b16 %6, %16 offset:6912\n\t" "ds_read_b64_tr_b16 %7, %16 offset:8064\n\t" "ds_read_b64_tr_b16 %8, %16 offset:64\n\t" "ds_read_b64_tr_b16 %9, %16 offset:1216\n\t" "ds_read_b64_tr_b16 %10, %16 offset:2368\n\t" "ds_read_b64_tr_b16 %11, %16 offset:3520\n\t" "ds_read_b64_tr_b16 %12, %16 offset:4672\n\t" "ds_read_b64_tr_b16 %13, %16 offset:5824\n\t" "ds_read_b64_tr_b16 %14, %16 offset:6976\n\t" "ds_read_b64_tr_b16 %15, %16 offset:8128\n\t" "s_waitcnt lgkmcnt(0)" : "=&v"(r[0]), "=&v"(r[1]), "=&v"(r[2]), "=&v"(r[3]), "=&v"(r[4]), "=&v"(r[5]), "=&v"(r[6]), "=&v"(r[7]), "=&v"(r[8]), "=&v"(r[9]), "=&v"(r[10]), "=&v"(r[11]), "=&v"(r[12]), "=&v"(r[13]), "=&v"(r[14]), "=&v"(r[15]) : "v"(base) : "memory");
#pragma unroll
    for (int eb = 0; eb < 2; ++eb)
#pragma unroll
        for (int k4 = 0; k4 < 4; ++k4) vf[eb][k4] = __builtin_shufflevector(r[(eb * 4 + k4) * 2], r[(eb * 4 + k4) * 2 + 1], 0, 1, 2, 3, 4, 5, 6, 7);
}
constexpr int AT_STR = 144, AT_TILE = 64 * AT_STR;
__device__ __forceinline__ void attn_unit(Frame& F, int b, int h, int qrow0, int nkt, bool ctx_only, float lam, float omli, const float* subln_g) {
    const bf16* Z = (const bf16*)(F.ws + WS_Z);
    LAS unsigned char* L = F.lds; const unsigned lb = (unsigned)(size_t)L;
    const int l = opaque_v(F.lane), li = l & 31, hh = l >> 5, blk = (l >> 4) & 1, q4 = (l & 15) >> 2, p = l & 3;
    const int qrow = qrow0 + 32 * F.wave + li;
    bf16x8 qf[2][2];
#pragma unroll
    for (int mp = 0; mp < 2; ++mp)
#pragma unroll
        for (int ks = 0; ks < 2; ++ks) qf[mp][ks] = *(const bf16x8*)(Z + (size_t)qrow * ZW + ZQ_DQ + h * 64 + mp * 32 + 16 * ks + 8 * hh);
    f32x16 o[2][2];
#pragma unroll
    for (int mp = 0; mp < 2; ++mp)
#pragma unroll
        for (int eb = 0; eb < 2; ++eb)
#pragma unroll
            for (int r = 0; r < 16; ++r) o[mp][eb][r] = 0.f;
    float mx[2] = {-3.0e38f, -3.0e38f}, ls[2] = {0.f, 0.f};
    const int stid = opaque_v(F.tid), skey = stid >> 3, sch = stid & 7;
    auto key_row = [&](int kt) -> int { const int k0 = kt * 64; return (ctx_only || k0 < NCTX) ? RL + b * NCTX + k0 : b * SEQ + (k0 - NCTX); };
    u32x4 kreg, vreg;
    { const size_t r = (size_t)(key_row(0) + skey); kreg = *(const u32x4*)(Z + r * ZW + ZQ_DK + h * 64 + sch * 8); vreg = *(const u32x4*)(Z + r * ZW + ZQ_DV + h * 64 + sch * 8); }
#pragma unroll 1
    for (int kt = 0; kt < nkt; ++kt) {
        const int buf = kt & 1;
        *(LAS u32x4*)(L + buf * 2 * AT_TILE + skey * AT_STR + sch * 16) = kreg;
        *(LAS u32x4*)(L + buf * 2 * AT_TILE + AT_TILE + skey * AT_STR + sch * 16) = vreg;
        __syncthreads();
        if (kt + 1 < nkt) { const size_t r = (size_t)(key_row(kt + 1) + skey); kreg = *(const u32x4*)(Z + r * ZW + ZQ_DK + h * 64 + sch * 8); vreg = *(const u32x4*)(Z + r * ZW + ZQ_DV + h * 64 + sch * 8); }
        const LAS unsigned char* Kt = L + buf * 2 * AT_TILE; const unsigned vb = lb + buf * 2 * AT_TILE + AT_TILE + 16 * blk * 2 + 8 * p;
        bf16x8 vf[2][4];
        tr_read_vtile(vb + (4 * hh + q4) * AT_STR, vf);
#pragma unroll
        for (int mp = 0; mp < 2; ++mp) {
            f32x16 s[2];
#pragma unroll
            for (int kb = 0; kb < 2; ++kb) {
#pragma unroll
                for (int r = 0; r < 16; ++r) s[kb][r] = 0.f;
#pragma unroll
                for (int ks = 0; ks < 2; ++ks) { const bf16x8 ka = *(const LAS bf16x8*)(Kt + (32 * kb + li) * AT_STR + (mp * 32 + 16 * ks + 8 * hh) * 2); s[kb] = MFMA32(ka, qf[mp][ks], s[kb]); }
            }
            if (kt < 4 || (kt & 3) == 0) {
                float tm = s[0][0];
#pragma unroll
                for (int r = 1; r < 16; ++r) tm = fmaxf(tm, s[0][r]);
#pragma unroll
                for (int r = 0; r < 16; ++r) tm = fmaxf(tm, s[1][r]);
                tm = fmaxf(tm, __shfl_xor(tm, 32));
                if (__any(tm > mx[mp])) {
                    const float mn = fmaxf(mx[mp], tm), al = __builtin_amdgcn_exp2f((mx[mp] - mn) * 1.44269504f);
                    mx[mp] = mn; ls[mp] *= al;
#pragma unroll
                    for (int eb = 0; eb < 2; ++eb)
#pragma unroll
                        for (int r = 0; r < 16; ++r) o[mp][eb][r] *= al;
                }
            }
            const float mb = mx[mp] * 1.44269504f; f32x2 rs2 = (f32x2){0.f, 0.f};
#pragma unroll
            for (int kb = 0; kb < 2; ++kb)
#pragma unroll
                for (int r = 0; r < 16; r += 2) { const float p0 = __builtin_amdgcn_exp2f(s[kb][r] * 1.44269504f - mb), p1 = __builtin_amdgcn_exp2f(s[kb][r + 1] * 1.44269504f - mb);
                    s[kb][r] = p0; s[kb][r + 1] = p1; rs2 += (f32x2){p0, p1}; }
            const float rs = rs2.x + rs2.y;
            ls[mp] += rs;
#pragma unroll
            for (int kb = 0; kb < 2; ++kb)
#pragma unroll
                for (int s2 = 0; s2 < 2; ++s2) { const bf16x8 pb = pack8(s[kb], s2);
                    o[mp][0] = MFMA32(vf[0][2 * kb + s2], pb, o[mp][0]); o[mp][1] = MFMA32(vf[1][2 * kb + s2], pb, o[mp][1]); }
        }
    }
    const float l0 = ls[0] + __shfl_xor(ls[0], 32), l1 = ls[1] + __shfl_xor(ls[1], 32);
    const float i0 = 1.0f / l0, i1 = lam / l1;
    float sq = 0.f;
#pragma unroll
    for (int eb = 0; eb < 2; ++eb)
#pragma unroll
        for (int r = 0; r < 16; ++r) { const float v = o[0][eb][r] * i0 - o[1][eb][r] * i1; o[0][eb][r] = v; sq += v * v; }
    sq += __shfl_xor(sq, 32);
    const float rstd = omli / sqrtf(sq * (1.0f / 64.0f) + EPS);
    bf16* xb = (bf16*)(F.ws + WS_XB) + (size_t)2 * RT * 256;
#pragma unroll
    for (int eb = 0; eb < 2; ++eb)
#pragma unroll
        for (int g4 = 0; g4 < 4; ++g4) { const int e = 32 * eb + 8 * g4 + 4 * hh; const f32x4 sg = *(const f32x4*)(subln_g + e);
            u32x2 w; w.x = cvt_pk_bf16(o[0][eb][4 * g4] * rstd * sg[0], o[0][eb][4 * g4 + 1] * rstd * sg[1]); w.y = cvt_pk_bf16(o[0][eb][4 * g4 + 2] * rstd * sg[2], o[0][eb][4 * g4 + 3] * rstd * sg[3]);
            *(u32x2*)(xb + (size_t)qrow * 256 + h * 64 + e) = w; }
    __syncthreads();
}

__device__ __forceinline__ void conv_unit(Frame& F, int seq_row0, int seq_len, int tok0, const float* dw, const float* db, const float* lng, const float* lnb) {
    const bf16* Z = (const bf16*)(F.ws + WS_Z);
    LAS unsigned short* U = (LAS unsigned short*)F.lds;
    LAS float* Yt = (LAS float*)(F.lds + 94 * 512);
    for (int i = F.tid; i < 94 * 32; i += 512) { const int tt = i >> 5, ch = i & 31; const int t = tok0 - 15 + tt;
        u32x4 v = (u32x4){0u, 0u, 0u, 0u}; if (t >= 0 && t < seq_len) v = *(const u32x4*)(Z + (size_t)(seq_row0 + t) * ZW + ZQ_CV + ch * 8);
        *(LAS u32x4*)(U + tt * 256 + ch * 8) = v; }
    __syncthreads();
    const int ctid = opaque_v(F.tid), ch = ctid & 255, half = ctid >> 8;
    float w[31];
#pragma unroll
    for (int k = 0; k < 31; ++k) w[k] = dw[k * 256 + ch];
    const float bias = db[ch];
#pragma unroll 1
    for (int g = 0; g < 2; ++g) {
        const int t0 = half * 32 + g * 16;
        float x[46];
#pragma unroll
        for (int i = 0; i < 46; ++i) x[i] = bf2f(U[(t0 + i) * 256 + ch]);
#pragma unroll
        for (int j = 0; j < 16; ++j) { float a = bias;
#pragma unroll
            for (int k = 0; k < 31; ++k) a += w[k] * x[j + k];
            Yt[(t0 + j) * 256 + ch] = a; }
    }
    __syncthreads();
    bf16* xb = (bf16*)(F.ws + WS_XB) + (size_t)3 * RT * 256;
    for (int t = F.wave; t < 64; t += 8) {
        const f32x4 y = *(const LAS f32x4*)(Yt + t * 256 + 4 * F.lane);
        const float mean = wave_sum((y[0] + y[1]) + (y[2] + y[3])) * (1.0f / 256.0f);
        const f32x4 dv = y - mean; const float var = wave_sum((dv[0] * dv[0] + dv[1] * dv[1]) + (dv[2] * dv[2] + dv[3] * dv[3])) * (1.0f / 256.0f);
        const float rstd = 1.0f / sqrtf(var + EPS);
        const f32x4 g4 = *(const f32x4*)(lng + 4 * F.lane), b4 = *(const f32x4*)(lnb + 4 * F.lane);
        const f32x4 z = dv * rstd * g4 + b4;
        u32x2 wv; wv.x = cvt_pk_bf16(siluf_(z[0]), siluf_(z[1])); wv.y = cvt_pk_bf16(siluf_(z[2]), siluf_(z[3]));
        *(u32x2*)(xb + (size_t)(seq_row0 + tok0 + t) * 256 + 4 * F.lane) = wv;
    }
    __syncthreads();
}
#ifndef F8_LAYER_MASK
#define F8_LAYER_MASK 0xF
#endif
constexpr int F8MASK = F8_LAYER_MASK;
constexpr int NSTEP_L = 12, NSTEPS = 2 + DEPTH * NSTEP_L;
struct Args { const float* in[39]; float* out; unsigned char* ws; int s_lo, s_hi; };
static_assert(sizeof(Args) == 39 * 8 + 8 + 8 + 8, "Args has no padding");

template <int OFF> __device__ __forceinline__ unsigned long long ka64() { unsigned long long v; asm volatile("s_load_dwordx2 %0, %1, %2\n\ts_waitcnt lgkmcnt(0)" : "=s"(v) : "s"(__builtin_amdgcn_kernarg_segment_ptr()), "n"(OFF)); return v; }
template <int OFF> __device__ __forceinline__ int ka32() { int v; asm volatile("s_load_dword %0, %1, %2\n\ts_waitcnt lgkmcnt(0)" : "=s"(v) : "s"(__builtin_amdgcn_kernarg_segment_ptr()), "n"(OFF)); return v; }
#define KIN(k) ((const float*)ka64<8 * (k)>())
#define KOUT ((float*)ka64<312>())
#define KWS ((unsigned char*)ka64<320>())
__global__ void __launch_bounds__(NWAVES * 64, 2) fwd_kernel(Args) {
    extern __shared__ __attribute__((aligned(16))) unsigned char lds[];
    Frame F;
    F.lds = (LAS unsigned char*)lds;
    F.MISC = (volatile LAS unsigned*)(F.lds + MISC_OFF);
    F.tid = threadIdx.x; F.lane = F.tid & 63; F.wave = __builtin_amdgcn_readfirstlane(F.tid >> 6);
    F.G = gridDim.x; { const int bx = blockIdx.x; F.vcu = (F.G % 8 == 0) ? (bx % 8) * (F.G / 8) + bx / 8 : bx; }
    F.ws = KWS;
    unsigned char* ws = F.ws;
    for (int u = F.tid; u < (LDS_BYTES - LDSCTL_OFF) / 4; u += NWAVES * 64) ((LAS unsigned*)(F.lds + LDSCTL_OFF))[u] = 0u;
    __syncthreads();
    unsigned* barw = (unsigned*)(ws + WS_CTL) + CW_BAR; asm volatile("" : "+s"(barw));
    const int lo = ka32<328>(), hi = ka32<332>();
    XcdBarrier bar; bar.bar = barw; bar.x = 0; bar.st = nullptr;
    if (hi - lo > 1) bar = xcd_barrier_post(barw, F.MISC + 8, F.tid);
#ifndef BR_REP
#define BR_REP 0
#endif
#ifndef PH_MASK
#define PH_MASK 0xFFFFF
#endif
#define EN(j) (((PH_MASK) >> (j)) & 1)
#define IN(k) (lo <= (k) && (k) < hi)
#define FRESH() do { int ln_; asm volatile("v_mbcnt_lo_u32_b32 %0, -1, 0\n\tv_mbcnt_hi_u32_b32 %0, -1, %0" : "=v"(ln_)); F.wave = opaque_s(F.wave); F.lane = ln_; F.tid = F.wave * 64 + ln_; \
    F.vcu = opaque_s(F.vcu); F.G = opaque_s(F.G); asm volatile("" : "+s"(F.ws)); ws = F.ws; } while (0)
#define GW (F.vcu * NWAVES + F.wave)
#define NGW_ (F.G * NWAVES)
#define SEAM(k) do { if (IN(k) && IN((k) + 1)) { FRESH(); xcd_barrier(bar, F.tid); } } while (0)

    if (EN(12) && IN(0)) { FRESH();
        P0Args P; P.c = KIN(1); P.c_ctx = KIN(3); P.ada_w = KIN(4); P.ada_b = KIN(5); P.w_in = KIN(10); P.w_gate = KIN(11); P.ret_w_o = KIN(14); P.s5_w_glu = KIN(23);
        P.diff_w_o = KIN(26); P.conv_w_o = KIN(31); P.w_out = KIN(32); P.ffn_w_gu = KIN(33); P.ffn_w_d = KIN(34); P.moe_w_gu = KIN(37); P.moe_w_d = KIN(38);
        P.ret_decay = KIN(13); P.s5_a_re = KIN(15); P.s5_a_im = KIN(16); P.s5_log_dt = KIN(17); P.s5_b_re = KIN(18); P.s5_b_im = KIN(19); P.s5_c_re = KIN(20); P.s5_c_im = KIN(21); P.diff_lambda = KIN(24);
        P.f8mask = F8MASK;
        p0_prologue(F, P);
    }
    SEAM(0);
    if (EN(13) && IN(1)) { FRESH(); RowArgs A{}; A.x = KIN(0); A.ctx = KIN(2); A.pre_g = KIN(6); A.l = 0; A.nrows = RT; row_pass<0>(F, A); }
    SEAM(1);

#pragma unroll 1
    for (int l = 0; l < DEPTH; ++l) {
        const int s0 = 2 + l * NSTEP_L;
        if (hi <= s0 || lo >= s0 + NSTEP_L) continue;
        const bool need_ctx = l < DEPTH - 1, moe = (l & 1) != 0;
        const int nrows = need_ctx ? RT : RL, nM = nrows / 256, j2 = l >> 1;
#define lp ((const float*)(ws + WS_LAYP) + l * 64)
#define AF ((bf16*)(ws + WS_AF))
#define Z ((bf16*)(ws + WS_Z))

        if (EN(0) && IN(s0 + 0)) { FRESH();
            pg8::Gemm g{AF, (const bf16*)(ws + WS_WIN) + (size_t)l * E_WIN, D, 0, 0}; pg8::SchedWin S; S.init(F.G, opaque_s((int)blockIdx.x), need_ctx ? 0 : 2);
            pg8::EpiWin E{Z, (const float*)(ws + WS_ROPE)};
            pg8::gemm_phase(F.lds, g, S, E, F.tid);
        }
        SEAM(s0 + 0);
        if (EN(1) && IN(s0 + 1)) { FRESH();
            unsigned* dep = (unsigned*)(ws + WS_CTL) + CW_DEP + 1024 * l;
            if (need_ctx) {
                pg8::Gemm g{AF, (const bf16*)(ws + WS_WIN) + (size_t)l * E_WIN, D, 0, 0}; pg8::SchedWin S; S.init(F.G, opaque_s((int)blockIdx.x), 1);
                pg8::EpiWin E{Z, (const float*)(ws + WS_ROPE)};
                pg8::gemm_phase(F.lds, g, S, E, F.tid);
                __syncthreads(); FRESH();
                const int bx = opaque_s((int)blockIdx.x), nmine = bx < 16 ? (16 - bx + F.G - 1) / F.G : 0;
                if (nmine > 0) dep_signal(F, dep + 128, (unsigned)nmine);
            }
            unsigned* ctr = (unsigned*)(ws + WS_CTL) + 8192 + 64 * (l * 2 + 0);
            const int n_rs = NB * NCH, nS = n_rs + NB * NCH * 2, nP = 80, e0 = nS + nP;
            const int c_lo = need_ctx ? 0 : 2, nch = NCH - c_lo;
            const int n_at = 512, n_ret = NB * nch, n_s5 = NB * nch * 2, n_cv = need_ctx ? 576 : 512, n_ac = need_ctx ? 64 : 0;
            const int e1 = e0 + n_at, e2 = e1 + n_ret, e3 = e2 + n_s5, e4 = e3 + n_cv, total = e4 + n_ac;
            int u = F.vcu, nsum = 0;
            while (u < total) {
                int nx = 0; if (F.tid == 0) nx = F.G + (int)__hip_atomic_fetch_add(ctr, 1u, RLX_AGENT);
                FRESH();
                int uu = u; if (u >= e1) { const int w = u - e1; uu = w < 512 ? e3 + w : (w < 512 + n_ret + n_s5 ? e1 + (w - 512) : e3 + w - n_ret - n_s5); }
                if (u < n_rs) { for (int rp_ = 0; rp_ < 1 + ((BR_REP >> 4) & 1); ++rp_) ret_summary_unit(F, u / NCH, u % NCH, lp); }
                else if (u < nS) { const int wu = (u - n_rs) * 8 + F.wave; const int g = wu & 15, bc = wu >> 4; for (int rp_ = 0; rp_ < 1 + ((BR_REP >> 5) & 1); ++rp_) s5_wave_unit<false>(F, bc / NCH, bc % NCH, g, l, nullptr); }
                else if (u < e0) { dep_wait(F, dep, (unsigned)nS); FRESH();
                    const int wu = (u - nS) * 8 + F.wave;
                    if (wu < 128) ret_prefix_unit(F, wu >> 3, (wu >> 1) & 3, wu & 1, lp);
                    else { const int v = wu - 128; s5_prefix_unit(F, v >> 5, (v >> 1) & 15, v & 1, l); } }
                else if (uu < e1) { const int v = uu - e0; for (int rp_ = 0; rp_ < 1 + ((BR_REP >> 0) & 1); ++rp_) attn_unit(F, v >> 5, (v >> 3) & 3, (v >> 5) * SEQ + (v & 7) * 256, 36, false, lp[8], lp[9], KIN(25) + l * 64); }
                else if (uu < e2) { dep_wait(F, dep + 64, (unsigned)nP); FRESH(); const int v = uu - e1; for (int rp_ = 0; rp_ < 1 + ((BR_REP >> 1) & 1); ++rp_) ret_out_unit(F, v / nch, c_lo + v % nch, lp); }
                else if (uu < e3) { dep_wait(F, dep + 64, (unsigned)nP); FRESH(); const int wu = (uu - e2) * 8 + F.wave; const int g = wu & 15, bc = wu >> 4; for (int rp_ = 0; rp_ < 1 + ((BR_REP >> 2) & 1); ++rp_) s5_wave_unit<true>(F, bc / nch, c_lo + bc % nch, g, l, KIN(22)); }
                else if (uu < e4) { const int v = uu - e3; const float* dw = KIN(27) + (size_t)l * 31 * 256; const float* db = KIN(28) + l * 256; const float* lng = KIN(29) + l * 256; const float* lnb = KIN(30) + l * 256;
                    if (v >= 512) { dep_wait(F, dep + 128, 16u); FRESH(); }
                    for (int rp_ = 0; rp_ < 1 + ((BR_REP >> 3) & 1); ++rp_)
                    if (v < 512) conv_unit(F, (v >> 5) * SEQ, SEQ, (v & 31) * 64, dw, db, lng, lnb);
                    else { const int v2 = v - 512; conv_unit(F, RL + (v2 >> 2) * NCTX, NCTX, (v2 & 3) * 64, dw, db, lng, lnb); } }
                else { const int v = uu - e4; attn_unit(F, v >> 2, v & 3, RL + (v >> 2) * NCTX, 4, true, lp[8], lp[9], KIN(25) + l * 64); }
                if (F.tid == 0) F.MISC[24] = (unsigned)nx;
                __syncthreads(); const int un = (int)F.MISC[24]; __syncthreads();
                if (u < nS) { ++nsum; if (un >= nS) dep_signal(F, dep, (unsigned)nsum); }
                else if (u < e0) dep_signal(F, dep + 64, 1u);
                u = un;
            }
        }
        SEAM(s0 + 3);
        if (EN(4) && IN(s0 + 4)) { FRESH();
            pg8::Gemm g{(const bf16*)(ws + WS_XB), (const bf16*)(ws + WS_WBR) + (size_t)l * E_WBR, 256}; pg8::SchedBr S; S.init(nM, F.G, opaque_s((int)blockIdx.x));
            pg8::EpiBr E{(bf16*)(ws + WS_BO)};
            pg8::gemm_phase(F.lds, g, S, E, F.tid);
        }
        SEAM(s0 + 4);
        if (EN(5) && IN(s0 + 5)) { FRESH();
            pg8::Gemm g{ws + WS_AF8, ws + WS_WG + (size_t)l * E_WG * 2, D, 121, 125}; pg8::SchedStd S; S.init(nM, 16, F.G, opaque_s((int)blockIdx.x));
            pg8::EpiGate E{(const bf16*)(ws + WS_BO), (bf16*)(ws + WS_MM), KIN(12) + (size_t)l * 4 * D, F.lds + 131072};
            pg8::gemm_phase<pg8::EpiGate, pg8::SchedStd, true>(F.lds, g, S, E, F.tid);
        }
        SEAM(s0 + 5);
        if (EN(6) && IN(s0 + 6)) { FRESH();
            pg8::Gemm g{(const bf16*)(ws + WS_MM), (const bf16*)(ws + WS_WOUT) + (size_t)l * E_WOUT, D}; pg8::SchedStd S; S.init(nM, 4, F.G, opaque_s((int)blockIdx.x));
            pg8::EpiBf16 E{(bf16*)(ws + WS_Y), D};
            pg8::gemm_phase(F.lds, g, S, E, F.tid);
        }
        SEAM(s0 + 6);
        if (EN(7) && IN(s0 + 7)) { FRESH(); RowArgs A{}; A.post_g = KIN(7) + l * D; A.pre_g = KIN(8) + l * D; A.l = l; A.nrows = nrows; A.moe = moe ? 1 : 0;
            A.f8 = (F8MASK >> l) & 1; A.router_w = KIN(35) + (size_t)j2 * D * NE; A.router_b = KIN(36) + j2 * NE;
#if defined(PROBE_DRY) && (PROBE_DRY & 1)
            if ((PROBE_DRY_L >> l) & 1) { for (int rp_ = 0; rp_ < PROBE_DRY_N; ++rp_) { A.dry = 1; row_pass<1>(F, A); A.dry = 0; __syncthreads(); FRESH(); } }
#endif
            row_pass<1>(F, A); }
        SEAM(s0 + 7);
        if (moe) {
            if (EN(8) && IN(s0 + 8)) { FRESH(); moe_dispatch(F, nrows, (F8MASK >> l) & 1); }
            SEAM(s0 + 8);
            if (EN(9) && IN(s0 + 9)) { FRESH();
                const int* te = (const int*)(ws + WS_TILEE); const int nt = __builtin_amdgcn_readfirstlane(__hip_atomic_load(te + 400, RLX_AGENT));
                pg8::SchedMoe S; S.init(nt, 2 * FFE / 256, F.G, opaque_s((int)blockIdx.x), te);
                if ((F8MASK & 0xA) && ((F8MASK >> l) & 1)) {
                    pg8::Gemm g{ws + WS_FS, ws + WS_MGU + (size_t)j2 * NE * E_MGU * 2, D, 121, 125}; pg8::EpiSwiGLU8 E{ws + WS_GS, FFE};
                    pg8::gemm_phase<pg8::EpiSwiGLU8, pg8::SchedMoe, true>(F.lds, g, S, E, F.tid);
                } else if ((~F8MASK) & 0xA) {
                    pg8::Gemm g{ws + WS_FS, ws + WS_MGU + (size_t)j2 * NE * E_MGU * 2, D, 0, 0}; pg8::EpiSwiGLU E{(bf16*)(ws + WS_GS), FFE};
                    pg8::gemm_phase(F.lds, g, S, E, F.tid);
                }
            }
            SEAM(s0 + 9);
            if (EN(10) && IN(s0 + 10)) { FRESH();
                const int* te = (const int*)(ws + WS_TILEE); const int nt = __builtin_amdgcn_readfirstlane(__hip_atomic_load(te + 400, RLX_AGENT));
                pg8::SchedMoe S; S.init(nt, 4, F.G, opaque_s((int)blockIdx.x), te); pg8::EpiBf16 E{(bf16*)(ws + WS_YS), D};
                if ((F8MASK & 0xA) && ((F8MASK >> l) & 1)) {
                    pg8::Gemm g{ws + WS_GS, ws + WS_MWD + (size_t)j2 * NE * E_MWD * 2, FFE, 121, 124};
                    pg8::gemm_phase<pg8::EpiBf16, pg8::SchedMoe, true>(F.lds, g, S, E, F.tid);
                } else if ((~F8MASK) & 0xA) {
                    pg8::Gemm g{ws + WS_GS, ws + WS_MWD + (size_t)j2 * NE * E_MWD * 2, FFE, 0, 0};
                    pg8::gemm_phase(F.lds, g, S, E, F.tid);
                }
            }
            SEAM(s0 + 10);
        } else {
            if (EN(9) && IN(s0 + 9)) { FRESH();
                pg8::SchedStd S; S.init(nM, 2 * FFD / 256, F.G, opaque_s((int)blockIdx.x));
                if ((F8MASK & 0x5) && ((F8MASK >> l) & 1)) {
                    pg8::Gemm g{AF, ws + WS_WGU + (size_t)j2 * E_WGU * 2, D, 121, 125}; pg8::EpiSwiGLU8 E{ws + WS_G, FFD};
                    pg8::gemm_phase<pg8::EpiSwiGLU8, pg8::SchedStd, true>(F.lds, g, S, E, F.tid);
                } else if ((~F8MASK) & 0x5) {
                    pg8::Gemm g{AF, ws + WS_WGU + (size_t)j2 * E_WGU * 2, D, 0, 0}; pg8::EpiSwiGLU E{(bf16*)(ws + WS_G), FFD};
                    pg8::gemm_phase(F.lds, g, S, E, F.tid);
                }
            }
            SEAM(s0 + 9);
            if (EN(10) && IN(s0 + 10)) { FRESH();
                pg8::SchedStd S; S.init(nM, 4, F.G, opaque_s((int)blockIdx.x)); pg8::EpiBf16 E{(bf16*)(ws + WS_Y), D};
                if ((F8MASK & 0x5) && ((F8MASK >> l) & 1)) {
                    pg8::Gemm g{ws + WS_G, ws + WS_WD + (size_t)j2 * E_WD * 2, FFD, 121, 124};
                    pg8::gemm_phase<pg8::EpiBf16, pg8::SchedStd, true>(F.lds, g, S, E, F.tid);
                } else if ((~F8MASK) & 0x5) {
                    pg8::Gemm g{ws + WS_G, ws + WS_WD + (size_t)j2 * E_WD * 2, FFD, 0, 0};
                    pg8::gemm_phase(F.lds, g, S, E, F.tid);
                }
            }
            SEAM(s0 + 10);
        }
        if (EN(11) && IN(s0 + 11)) { FRESH(); RowArgs A{}; A.post_g = KIN(9) + l * D; A.pre_g = KIN(6) + (l + 1 < DEPTH ? l + 1 : l) * D; A.l = l; A.nrows = nrows; A.moe = moe ? 1 : 0; A.last = need_ctx ? 0 : 1; A.out = KOUT;
#if defined(PROBE_DRY) && (PROBE_DRY & 2)
            if ((PROBE_DRY_L >> l) & 1) { for (int rp_ = 0; rp_ < PROBE_DRY_N; ++rp_) { A.dry = 1; row_pass<2>(F, A); A.dry = 0; __syncthreads(); FRESH(); } }
#endif
            row_pass<2>(F, A); }
        if (l + 1 < DEPTH) SEAM(s0 + 11);
    }
#undef lp
#undef AF
#undef Z
#undef IN
#undef SEAM
}

#ifndef MK_LAUNCH_PER_STEP
#define MK_LAUNCH_PER_STEP 0
#endif
extern "C" void kernel_launch(void* const* d_in, const int* in_sizes, int n_in, void* d_out, int out_size, void* d_ws, size_t ws_size, hipStream_t stream) {
    static int grid = 0;
    if (grid == 0) {
        if (n_in != 39 || out_size != RL * D || ws_size < WS_END) { fprintf(stderr, "kernel_launch: unexpected shapes: n_in %d out %d ws %zu (need %zu)\n", n_in, out_size, ws_size, (size_t)WS_END); grid = -1; return; }
        int dev = 0, cus = 0, per_cu = 0;
        if (hipGetDevice(&dev) != hipSuccess || hipDeviceGetAttribute(&cus, hipDeviceAttributeMultiprocessorCount, dev) != hipSuccess) { grid = -1; return; }
        if (hipFuncSetAttribute((const void*)fwd_kernel, hipFuncAttributeMaxDynamicSharedMemorySize, LDS_BYTES) != hipSuccess) { fprintf(stderr, "kernel_launch: hipFuncSetAttribute failed\n"); grid = -1; return; }
        if (hipOccupancyMaxActiveBlocksPerMultiprocessor(&per_cu, (const void*)fwd_kernel, NWAVES * 64, LDS_BYTES) != hipSuccess || per_cu < 1) { fprintf(stderr, "kernel_launch: occupancy query says %d\n", per_cu); }
        (void)hipGetLastError();
        grid = cus;
    }
    if (grid < 0) return;
    if (hipMemsetAsync((char*)d_ws + WS_CTL, 0, CTL_ZERO_BYTES, stream) != hipSuccess) return;
    Args a{};
    for (int i = 0; i < 39; ++i) a.in[i] = (const float*)d_in[i];
    a.out = (float*)d_out; a.ws = (unsigned char*)d_ws;
#if MK_LAUNCH_PER_STEP
    for (int s = 0; s < NSTEPS; ++s) { a.s_lo = s; a.s_hi = s + 1;
        int rep = 1;
#ifdef PROBE_REP_MASK
        if (s >= 2) { const int j = (s - 2) % NSTEP_L, l = (s - 2) / NSTEP_L; if (((PROBE_REP_MASK) >> j) & 1 && ((PROBE_LAYER_MASK) >> l) & 1) rep = 2; } else if (((PROBE_REP_MASK) >> (12 + s)) & 1) rep = 2;
#endif
        for (int r = 0; r < rep; ++r) hipLaunchKernelGGL(fwd_kernel, dim3(grid), dim3(NWAVES * 64), LDS_BYTES, stream, a); }
#else
    a.s_lo = 0; a.s_hi = NSTEPS;
    hipLaunchKernelGGL(fwd_kernel, dim3(grid), dim3(NWAVES * 64), LDS_BYTES, stream, a);
#endif
    const hipError_t le = hipPeekAtLastError();
    if (le != hipSuccess) fprintf(stderr, "kernel_launch: launch failed: %s\n", hipGetErrorName(le));
}
```
